# Optimizing an MI355X kernel written in HIP

```python
import functools
import jax, jax.numpy as jnp
from jax import lax
import numpy as np

D_MODEL = 1024
BATCH = 2
SEQ = 8192
DEPTH = 1
DEC_BATCH = 32
DEC_SEQ = 64
PAST_LEN = 4096

CHUNK = 64
Q_BLOCK = 128
HEAD_DIM = 64
N_HEADS_A = 8
N_KV_A = 2
GROUP_A = N_HEADS_A // N_KV_A
N_IDX_HEADS = 8
IDX_DIM = 64
TOPK_MAX = 256
N_HEADS_B = 8
WIDTH_A = N_HEADS_A * HEAD_DIM
KV_WIDTH_A = N_KV_A * HEAD_DIM
WIDTH_B = N_HEADS_B * HEAD_DIM
D_FF = 2816
ROPE_THETA = 10000.0
LN_EPS = 1e-5
FORGET_BIAS = 3.0
ALPHA = (2.0 * DEPTH) ** 0.25
BETA = (8.0 * DEPTH) ** -0.25
N_IN = WIDTH_A + 2 * KV_WIDTH_A + N_IDX_HEADS * IDX_DIM + IDX_DIM + N_IDX_HEADS + 3 * WIDTH_B + N_HEADS_B + 2 * D_MODEL

kernel_name = 'dsa_fox_macaron_deepnorm_stream_step'


def _split_points():
    sizes = (WIDTH_A, KV_WIDTH_A, KV_WIDTH_A, N_IDX_HEADS * IDX_DIM, IDX_DIM, N_IDX_HEADS,
             WIDTH_B, WIDTH_B, WIDTH_B, N_HEADS_B, 2 * D_MODEL)
    pts, acc = [], 0
    for s in sizes[:-1]:
        acc += s
        pts.append(acc)
    return pts


def _layer_norm(x, g, b):
    xf = x.astype(jnp.float32)
    mu = jnp.mean(xf, axis=-1, keepdims=True)
    var = jnp.mean(jnp.square(xf - mu), axis=-1, keepdims=True)
    return ((xf - mu) * lax.rsqrt(var + LN_EPS) * g + b).astype(x.dtype)


def _ffn_sublayer(x, w_up, w_down, g, b):
    a, u = jnp.split(x @ w_up, 2, axis=-1)
    return _layer_norm(ALPHA * x + 0.5 * ((jax.nn.silu(a) * u) @ w_down), g, b)


def _rope(x, pos):
    half = x.shape[-1] // 2
    inv_freq = ROPE_THETA ** (-jnp.arange(half, dtype=jnp.float32) / half)
    ang = pos.astype(jnp.float32)[:, None] * inv_freq[None, :]
    cos = jnp.cos(ang)[:, None, :]
    sin = jnp.sin(ang)[:, None, :]
    xf = x.astype(jnp.float32)
    x1, x2 = xf[..., :half], xf[..., half:]
    return jnp.concatenate([x1 * cos - x2 * sin, x2 * cos + x1 * sin], axis=-1).astype(x.dtype)


def _project(x, pos, w_in, b_f, b_gate):
    B, T, _ = x.shape
    qa, ka, va, iq, ik, iw, qb, kb, vb, fb, gates = jnp.split(x @ w_in, _split_points(), axis=-1)
    qa = _rope(qa.reshape(B, T, N_HEADS_A, HEAD_DIM), pos)
    ka = _rope(ka.reshape(B, T, N_KV_A, HEAD_DIM), pos)
    va = va.reshape(B, T, N_KV_A, HEAD_DIM)
    iq = _rope(iq.reshape(B, T, N_IDX_HEADS, IDX_DIM), pos)
    ik = _rope(ik[:, :, None, :], pos)[:, :, 0, :]
    iw = iw * (N_IDX_HEADS ** -0.5)
    qb = qb.reshape(B, T, N_HEADS_B, HEAD_DIM)
    kb = kb.reshape(B, T, N_HEADS_B, HEAD_DIM)
    vb = vb.reshape(B, T, N_HEADS_B, HEAD_DIM)
    log_f = jax.nn.log_sigmoid((fb + b_f).astype(jnp.float32))
    g_a, g_b = jnp.split(jax.nn.sigmoid(gates + b_gate), 2, axis=-1)
    return qa, ka, va, iq, ik, iw, qb, kb, vb, log_f, g_a, g_b


def _dsa_attend(k, v, ik, kpos, k_top, q, iq, iw, qpos):
    B, Tq = q.shape[:2]
    idx_logits = jnp.einsum('bqhd,bkd->bqhk', iq, ik).astype(jnp.float32) * (IDX_DIM ** -0.5)
    score = jnp.einsum('bqhk,bqh->bqk', jax.nn.relu(idx_logits), iw.astype(jnp.float32))
    admissible = (kpos[None, :] // CHUNK) <= (qpos[:, None] // CHUNK)
    score = jnp.where(admissible[None], score, -jnp.inf)
    top_val, sel = lax.top_k(score, k_top)
    valid = jnp.isfinite(top_val)
    gather = jax.vmap(lambda rows, ids: rows[ids])
    k_rows = gather(k, sel)
    v_rows = gather(v, sel)
    qg = q.reshape(B, Tq, N_KV_A, GROUP_A, HEAD_DIM)
    logits = jnp.einsum('bqngd,bqknd->bqngk', qg, k_rows).astype(jnp.float32) * (HEAD_DIM ** -0.5)
    logits = jnp.where(valid[:, :, None, None, :], logits, -jnp.inf)
    p = jax.nn.softmax(logits, axis=-1)
    out = jnp.einsum('bqngk,bqknd->bqngd', p.astype(v.dtype), v_rows)
    return out.reshape(B, Tq, WIDTH_A)


def _fox_attend(k, v, c_k, kpos, q, c_q, qpos):
    B, Tq = q.shape[:2]
    s = jnp.einsum('bqhd,bkhd->bhqk', q, k).astype(jnp.float32) * (HEAD_DIM ** -0.5)
    s = s + jnp.swapaxes(c_q, 1, 2)[..., :, None] - jnp.swapaxes(c_k, 1, 2)[..., None, :]
    causal = kpos[None, :] <= qpos[:, None]
    s = jnp.where(causal, s, -jnp.inf)
    p = jax.nn.softmax(s, axis=-1)
    out = jnp.einsum('bhqk,bkhd->bqhd', p.astype(v.dtype), v)
    return out.reshape(B, Tq, WIDTH_B)


def _blocked(fn, q_args, qpos):
    B, T = q_args[0].shape[:2]

    def body(i):
        start = i * Q_BLOCK
        sl = [lax.dynamic_slice_in_dim(a, start, Q_BLOCK, axis=1) for a in q_args]
        return fn(*sl, lax.dynamic_slice_in_dim(qpos, start, Q_BLOCK, axis=0))

    out = lax.map(body, jnp.arange(T // Q_BLOCK))
    return jnp.moveaxis(out, 0, 1).reshape(B, T, out.shape[-1])


def _merge(h, y_a, y_b, g_a, g_b, w_proj_a, w_proj_b, w_out, g, b):
    m = g_a * (y_a @ w_proj_a) + g_b * (y_b @ w_proj_b)
    return _layer_norm(ALPHA * h + m @ w_out, g, b)


def setup_inputs(seed: int = 0) -> dict:
    key = jax.random.key(seed)
    ks = jax.random.split(key, 32)
    nrm = lambda k, shape, scale: jax.random.normal(k, shape, jnp.float32) * scale
    L = DEPTH
    return {
        'x_prompt': nrm(ks[0], (BATCH, SEQ, D_MODEL), 1.0),
        'x_sample': nrm(ks[1], (DEC_BATCH, DEC_SEQ, D_MODEL), 1.0),
        'cache_a_k': nrm(ks[2], (L, DEC_BATCH, PAST_LEN, N_KV_A, HEAD_DIM), 1.0),
        'cache_a_v': nrm(ks[3], (L, DEC_BATCH, PAST_LEN, N_KV_A, HEAD_DIM), 1.0),
        'cache_a_idx_k': nrm(ks[4], (L, DEC_BATCH, PAST_LEN, IDX_DIM), 1.0),
        'cache_b_k': nrm(ks[5], (L, DEC_BATCH, PAST_LEN, N_HEADS_B, HEAD_DIM), 1.0),
        'cache_b_v': nrm(ks[6], (L, DEC_BATCH, PAST_LEN, N_HEADS_B, HEAD_DIM), 1.0),
        'cache_b_logf': jax.nn.log_sigmoid(FORGET_BIAS + nrm(ks[7], (L, DEC_BATCH, PAST_LEN, N_HEADS_B), 1.0)),
        'ffn1_w_up': nrm(ks[8], (L, D_MODEL, 2 * D_FF), D_MODEL ** -0.5),
        'ffn1_w_down': nrm(ks[9], (L, D_FF, D_MODEL), BETA * D_FF ** -0.5),
        'ln1_g': 1.0 + nrm(ks[10], (L, D_MODEL), 0.01),
        'ln1_b': nrm(ks[11], (L, D_MODEL), 0.01),
        'w_in': nrm(ks[12], (L, D_MODEL, N_IN), D_MODEL ** -0.5),
        'b_f': FORGET_BIAS + nrm(ks[13], (L, N_HEADS_B), 0.1),
        'b_gate': nrm(ks[14], (L, 2 * D_MODEL), 0.01),
        'w_proj_a': nrm(ks[15], (L, WIDTH_A, D_MODEL), BETA * WIDTH_A ** -0.5),
        'w_proj_b': nrm(ks[16], (L, WIDTH_B, D_MODEL), BETA * WIDTH_B ** -0.5),
        'w_out': nrm(ks[17], (L, D_MODEL, D_MODEL), BETA * D_MODEL ** -0.5),
        'ln2_g': 1.0 + nrm(ks[18], (L, D_MODEL), 0.01),
        'ln2_b': nrm(ks[19], (L, D_MODEL), 0.01),
        'ffn2_w_up': nrm(ks[20], (L, D_MODEL, 2 * D_FF), D_MODEL ** -0.5),
        'ffn2_w_down': nrm(ks[21], (L, D_FF, D_MODEL), BETA * D_FF ** -0.5),
        'ln3_g': 1.0 + nrm(ks[22], (L, D_MODEL), 0.01),
        'ln3_b': nrm(ks[23], (L, D_MODEL), 0.01),
    }


def reference(x_prompt, x_sample, cache_a_k, cache_a_v, cache_a_idx_k, cache_b_k, cache_b_v, cache_b_logf,
              ffn1_w_up, ffn1_w_down, ln1_g, ln1_b, w_in, b_f, b_gate, w_proj_a, w_proj_b, w_out,
              ln2_g, ln2_b, ffn2_w_up, ffn2_w_down, ln3_g, ln3_b):
    pos_p = jnp.arange(SEQ, dtype=jnp.int32)
    pos_s = PAST_LEN + jnp.arange(DEC_SEQ, dtype=jnp.int32)
    kpos_s = jnp.arange(PAST_LEN + DEC_SEQ, dtype=jnp.int32)
    ktop_p = min(TOPK_MAX, SEQ // 4)
    ktop_s = min(TOPK_MAX, (PAST_LEN + DEC_SEQ) // 4)
    hp, hs = x_prompt, x_sample
    p_new = [[] for _ in range(6)]
    s_new = [[] for _ in range(6)]
    for l in range(DEPTH):
        hp = _ffn_sublayer(hp, ffn1_w_up[l], ffn1_w_down[l], ln1_g[l], ln1_b[l])
        qa, ka, va, iq, ik, iw, qb, kb, vb, lf, ga, gb = _project(hp, pos_p, w_in[l], b_f[l], b_gate[l])
        c_p = jnp.cumsum(lf, axis=1)
        y_a = _blocked(functools.partial(_dsa_attend, ka, va, ik, pos_p, ktop_p), (qa, iq, iw), pos_p)
        y_b = _blocked(functools.partial(_fox_attend, kb, vb, c_p, pos_p), (qb, c_p), pos_p)
        hp = _merge(hp, y_a, y_b, ga, gb, w_proj_a[l], w_proj_b[l], w_out[l], ln2_g[l], ln2_b[l])
        hp = _ffn_sublayer(hp, ffn2_w_up[l], ffn2_w_down[l], ln3_g[l], ln3_b[l])
        for lst, arr in zip(p_new, (ka, va, ik, kb, vb, lf)):
            lst.append(arr)
        hs = _ffn_sublayer(hs, ffn1_w_up[l], ffn1_w_down[l], ln1_g[l], ln1_b[l])
        qa, ka, va, iq, ik, iw, qb, kb, vb, lf, ga, gb = _project(hs, pos_s, w_in[l], b_f[l], b_gate[l])
        ka_all = jnp.concatenate([cache_a_k[l], ka], axis=1)
        va_all = jnp.concatenate([cache_a_v[l], va], axis=1)
        ik_all = jnp.concatenate([cache_a_idx_k[l], ik], axis=1)
        kb_all = jnp.concatenate([cache_b_k[l], kb], axis=1)
        vb_all = jnp.concatenate([cache_b_v[l], vb], axis=1)
        c_all = jnp.cumsum(jnp.concatenate([cache_b_logf[l].astype(jnp.float32), lf], axis=1), axis=1)
        y_a = _dsa_attend(ka_all, va_all, ik_all, kpos_s, ktop_s, qa, iq, iw, pos_s)
        y_b = _fox_attend(kb_all, vb_all, c_all, kpos_s, qb, c_all[:, PAST_LEN:], pos_s)
        hs = _merge(hs, y_a, y_b, ga, gb, w_proj_a[l], w_proj_b[l], w_out[l], ln2_g[l], ln2_b[l])
        hs = _ffn_sublayer(hs, ffn2_w_up[l], ffn2_w_down[l], ln3_g[l], ln3_b[l])
        for lst, arr in zip(s_new, (ka, va, ik, kb, vb, lf)):
            lst.append(arr)
    p_a_k, p_a_v, p_a_idx_k, p_b_k, p_b_v, p_b_logf = [jnp.stack(a) for a in p_new]
    s_a_k, s_a_v, s_a_idx_k, s_b_k, s_b_v, s_b_logf = [jnp.stack(a) for a in s_new]
    return (hp, hs, p_a_k, p_a_v, p_a_idx_k, p_b_k, p_b_v, p_b_logf,
            s_a_k, s_a_v, s_a_idx_k, s_b_k, s_b_v, s_b_logf)
```

```cpp
#include <hip/hip_runtime.h>
#include <hip/hip_cooperative_groups.h>
#include <cstdio>
#include <cstdint>
#include <cmath>
namespace cg = cooperative_groups;

constexpr int DM = 1024, SEQ = 8192, NB = 2, DB = 32, DS = 64, PAST = 4096, SKV = PAST + DS  ;
constexpr int MP = NB * SEQ  , MS = DB * DS  , MT = MP + MS  ;
constexpr int DFF = 2816, NUP = 2 * DFF, NIN = 4944, NINP = 5120;
constexpr float ALPHA = 1.189207115002721f;
constexpr float LN_EPS = 1e-5f;
constexpr float LOG2E = 1.4426950408889634f;
constexpr float QSCALE = 0.125f * LOG2E;
constexpr float IWSCALE = 0.35355339059327373f * 0.125f;
constexpr size_t O_Y = 0, O_PAK = 18874368, O_PAV = 20971520, O_PIK = 23068672, O_PBK = 24117248, O_PBV = 32505856, O_PLF = 40894464,
                 O_SAK = 41025536, O_SAV = 41287680, O_SIK = 41549824, O_SBK = 41680896, O_SBV = 42729472, O_SLF = 43778048;
#define MK_PER_PHASE 1
namespace pg8 {
#define PG8_LAS __attribute__((address_space(3)))
typedef unsigned short bf16_t;
typedef short bf16x8 __attribute__((ext_vector_type(8)));
typedef float f32x4 __attribute__((ext_vector_type(4)));
typedef unsigned u32x4 __attribute__((ext_vector_type(4)));
constexpr int BM = 256, BK = 64, HALF = 128, HTB = HALF * BK * 2  , STAGE_BYTES = 8 * HTB, NXCD = 8, WGM = 8;

__host__ __device__ __forceinline__ int lds_byte(int r, int c) { const int st = (r >> 4) * 2 + (c >> 5), rr = r & 15, cc = c & 31, ob = rr * 64 + cc * 2; return st * 1024 + (ob ^ (((ob >> 9) & 1) << 5)); }
__host__ __device__ __forceinline__ void stage_rc(int b, int& R, int& C) { const int st = b / 1024, sb = b % 1024, swz = sb ^ (((sb >> 9) & 1) << 5); R = (st >> 1) * 16 + swz / 64; C = (st & 1) * 32 + (swz % 64) / 2; }
__host__ __device__ __forceinline__ int perm32(int rho) { const int n = rho >> 4, i = rho & 15; return 8 * (i >> 2) + 4 * n + (i & 3); }

struct Unit { int pm, pn; };
struct Gemm { const bf16_t* A; const bf16_t* Bt; int M, N, K; };

struct StaticOrder {
    int nM, nN, nwg, G, c;
    __host__ __device__ void init(int M, int N, int G_, int c_) { nM = M / BM; nN = N / BM; nwg = nM * nN; G = G_; c = c_; }
    __host__ __device__ bool next(int i, Unit& u) const {
        const long L = (long)i * G + c; if (L >= nwg) return false;
        int wgid = (int)L; { const int q = nwg / NXCD, r = nwg % NXCD, xcd = wgid % NXCD, off = wgid / NXCD; wgid = (xcd < r ? xcd * (q + 1) : r * (q + 1) + (xcd - r) * q) + off; }
        const int nig = WGM * nN, gid = wgid / nig, fm = gid * WGM, gsz = (nM - fm) < WGM ? (nM - fm) : WGM;
        u.pm = fm + ((wgid % nig) % gsz); u.pn = (wgid % nig) / gsz; return true;
    }
    __device__ __forceinline__ void a_ready(const Unit&) const {}
    __device__ __forceinline__ void done(const Unit&) const {}
};

__device__ __forceinline__ unsigned cvt_pk_bf16(float lo, float hi) { unsigned r; asm volatile("v_cvt_pk_bf16_f32 %0, %1, %2" : "=v"(r) : "v"(lo), "v"(hi)); return r; }
typedef float f32x2 __attribute__((ext_vector_type(2)));
typedef unsigned u32x2 __attribute__((ext_vector_type(2)));
typedef float f32x2 __attribute__((ext_vector_type(2)));
__device__ __forceinline__ float bf2f(unsigned short b) { return __uint_as_float((unsigned)b << 16); }
__device__ __forceinline__ float fsigmoid(float x) { return __builtin_amdgcn_rcpf(1.0f + __builtin_amdgcn_exp2f(-x * LOG2E)); }
__device__ __forceinline__ float flogsig(float x) {
    const float e = __builtin_amdgcn_exp2f(-fabsf(x) * LOG2E);
    const float l1p = (e < 0.03125f) ? e * (1.0f - e * (0.5f - e * (0.33333333f - 0.25f * e))) : __logf(1.0f + e);
    return fminf(x, 0.f) - l1p;
}
__device__ __forceinline__ u32x2 pack4(f32x4 v) { u32x2 w; w.x = cvt_pk_bf16(v[0], v[1]); w.y = cvt_pk_bf16(v[2], v[3]); return w; }

struct EpiSwiGLU {
    static constexpr bool PERM = true, AFTER_DRAIN = false;
    bf16_t* H;
    __device__ __forceinline__ void operator()(const f32x4 (&acc)[2][2][4][2], const Unit& u, int wr, int wc, int fr, int fq) const {
        const int row0 = u.pm * BM + wr * 64 + fr, col0 = u.pn * 128 + wc * 32 + 8 * fq;
#pragma unroll
        for (int ai = 0; ai < 2; ++ai)
#pragma unroll
            for (int m = 0; m < 4; ++m) {
                bf16_t* rowp = H + (size_t)(row0 + ai * HALF + m * 16) * DFF + col0;
                f32x4 h[2];
#pragma unroll
                for (int n = 0; n < 2; ++n) { const f32x4 a = acc[ai][0][m][n], g = acc[ai][1][m][n];
#pragma unroll
                    for (int i = 0; i < 4; ++i) h[n][i] = a[i] * fsigmoid(a[i]) * g[i]; }
                u32x4 w; w.x = cvt_pk_bf16(h[0][0], h[0][1]); w.y = cvt_pk_bf16(h[0][2], h[0][3]); w.z = cvt_pk_bf16(h[1][0], h[1][1]); w.w = cvt_pk_bf16(h[1][2], h[1][3]);
                *(u32x4*)rowp = w;
            }
    }
};
struct EpiRes {
    static constexpr bool PERM = false, AFTER_DRAIN = false;
    const float* resP; const float* resS; float* Z; float s;
    __device__ __forceinline__ void operator()(const f32x4 (&acc)[2][2][4][2], const Unit& u, int wr, int wc, int fr, int fq) const {
        const int row0 = u.pm * BM + wr * 64 + fr, col0 = u.pn * BM + wc * 32 + 4 * fq;
        const float* rb = (u.pm < MP / BM) ? resP : (resS - (size_t)MP * DM);
#pragma unroll
        for (int ai = 0; ai < 2; ++ai)
#pragma unroll
            for (int m = 0; m < 4; ++m) { const size_t off = (size_t)(row0 + ai * HALF + m * 16) * DM + col0;
#pragma unroll
                for (int bj = 0; bj < 2; ++bj)
#pragma unroll
                    for (int n = 0; n < 2; ++n) { const f32x4 r = *(const f32x4*)(rb + off + bj * HALF + n * 16);
                        *(f32x4*)(Z + off + bj * HALF + n * 16) = r * ALPHA + acc[ai][bj][m][n] * s; } }
    }
};
struct EpiProjA {
    static constexpr bool PERM = false, AFTER_DRAIN = false;
    const bf16_t* G; float* MM;
    __device__ __forceinline__ void operator()(const f32x4 (&acc)[2][2][4][2], const Unit& u, int wr, int wc, int fr, int fq) const {
        const int row0 = u.pm * BM + wr * 64 + fr, col0 = u.pn * BM + wc * 32 + 4 * fq;
#pragma unroll
        for (int ai = 0; ai < 2; ++ai)
#pragma unroll
            for (int m = 0; m < 4; ++m) { const size_t row = (size_t)(row0 + ai * HALF + m * 16);
#pragma unroll
                for (int bj = 0; bj < 2; ++bj)
#pragma unroll
                    for (int n = 0; n < 2; ++n) { const int c = col0 + bj * HALF + n * 16; const u32x2 g = *(const u32x2*)(G + row * 2048 + c);
                        f32x4 gv; gv[0] = __uint_as_float(g.x << 16); gv[1] = __uint_as_float(g.x & 0xffff0000u); gv[2] = __uint_as_float(g.y << 16); gv[3] = __uint_as_float(g.y & 0xffff0000u);
                        *(f32x4*)(MM + row * DM + c) = gv * acc[ai][bj][m][n]; } }
    }
};
struct EpiProjB {
    static constexpr bool PERM = false, AFTER_DRAIN = false;
    const bf16_t* G; const float* MM; bf16_t* MMb;
    __device__ __forceinline__ void operator()(const f32x4 (&acc)[2][2][4][2], const Unit& u, int wr, int wc, int fr, int fq) const {
        const int row0 = u.pm * BM + wr * 64 + fr, col0 = u.pn * BM + wc * 32 + 4 * fq;
#pragma unroll
        for (int ai = 0; ai < 2; ++ai)
#pragma unroll
            for (int m = 0; m < 4; ++m) { const size_t row = (size_t)(row0 + ai * HALF + m * 16);
#pragma unroll
                for (int bj = 0; bj < 2; ++bj)
#pragma unroll
                    for (int n = 0; n < 2; ++n) { const int c = col0 + bj * HALF + n * 16; const u32x2 g = *(const u32x2*)(G + row * 2048 + 1024 + c);
                        f32x4 gv; gv[0] = __uint_as_float(g.x << 16); gv[1] = __uint_as_float(g.x & 0xffff0000u); gv[2] = __uint_as_float(g.y << 16); gv[3] = __uint_as_float(g.y & 0xffff0000u);
                        const f32x4 mm = *(const f32x4*)(MM + row * DM + c);
                        *(u32x2*)(MMb + row * DM + c) = pack4(mm + gv * acc[ai][bj][m][n]); } }
    }
};
struct EpiWin {
    static constexpr bool PERM = false, AFTER_DRAIN = false;
    float* out; bf16_t *QA, *IQ, *QB, *KAp, *VAp, *IKp, *KBp, *VBp, *KAs, *VAs, *IKs, *KBs, *VBs, *G; float *IW, *LF; const f32x2* rope; const float* b_f; const float* b_gate;
    __device__ __forceinline__ void operator()(const f32x4 (&acc)[2][2][4][2], const Unit& u, int wr, int wc, int fr, int fq) const {
        const int T = u.pn; const bool samp = u.pm >= MP / BM;
#pragma unroll
        for (int ai = 0; ai < 2; ++ai)
#pragma unroll
            for (int m = 0; m < 4; ++m) {
                const int row = u.pm * BM + ai * HALF + wr * 64 + m * 16 + fr; const int rs = row - MP;
                const int pos = samp ? PAST + (rs & 63) : (row & (SEQ - 1));
                const size_t srow = samp ? ((size_t)(rs >> 6) * SKV + PAST + (rs & 63)) : (size_t)row;
                if (T == 0 || T == 1 || T == 3 || T == 4) {
                    bf16_t* dst = (T < 2) ? QA + (size_t)row * 512 + 256 * T : IQ + (size_t)row * 512 + 256 * (T - 3);
                    const float sc = (T < 2) ? QSCALE : 1.0f;
#pragma unroll
                    for (int n = 0; n < 2; ++n) { const int j0 = 16 * n + 4 * fq; const f32x4 x1 = acc[ai][0][m][n], x2 = acc[ai][1][m][n]; f32x4 o1, o2;
#pragma unroll
                        for (int i = 0; i < 4; ++i) { const f32x2 cs = rope[pos * 32 + j0 + i]; o1[i] = (x1[i] * cs.x - x2[i] * cs.y) * sc; o2[i] = (x2[i] * cs.x + x1[i] * cs.y) * sc; }
                        *(u32x2*)(dst + 64 * wc + j0) = pack4(o1); *(u32x2*)(dst + 64 * wc + 32 + j0) = pack4(o2); }
                } else if (T == 2) {
                    if (wc < 2) {
                        float* kf = out + (samp ? O_SAK + (size_t)rs * 128 : O_PAK + (size_t)row * 128) + 64 * wc; bf16_t* kb = (samp ? KAs : KAp) + srow * 128 + 64 * wc;
#pragma unroll
                        for (int n = 0; n < 2; ++n) { const int j0 = 16 * n + 4 * fq; const f32x4 x1 = acc[ai][0][m][n], x2 = acc[ai][1][m][n]; f32x4 o1, o2;
#pragma unroll
                            for (int i = 0; i < 4; ++i) { const f32x2 cs = rope[pos * 32 + j0 + i]; o1[i] = x1[i] * cs.x - x2[i] * cs.y; o2[i] = x2[i] * cs.x + x1[i] * cs.y; }
                            *(f32x4*)(kf + j0) = o1; *(f32x4*)(kf + 32 + j0) = o2; *(u32x2*)(kb + j0) = pack4(o1); *(u32x2*)(kb + 32 + j0) = pack4(o2); }
                    } else {
                        float* vf = out + (samp ? O_SAV + (size_t)rs * 128 : O_PAV + (size_t)row * 128); bf16_t* vb = (samp ? VAs : VAp) + srow * 128;
#pragma unroll
                        for (int bj = 0; bj < 2; ++bj)
#pragma unroll
                            for (int n = 0; n < 2; ++n) { const int c = 64 * bj + 32 * (wc - 2) + 16 * n + 4 * fq; *(f32x4*)(vf + c) = acc[ai][bj][m][n]; *(u32x2*)(vb + c) = pack4(acc[ai][bj][m][n]); }
                    }
                } else if (T == 5) {
                    if (wc == 0) {
                        float* kf = out + (samp ? O_SIK + (size_t)rs * 64 : O_PIK + (size_t)row * 64); bf16_t* kb = (samp ? IKs : IKp) + srow * 64;
#pragma unroll
                        for (int n = 0; n < 2; ++n) { const int j0 = 16 * n + 4 * fq; const f32x4 x1 = acc[ai][0][m][n], x2 = acc[ai][1][m][n]; f32x4 o1, o2;
#pragma unroll
                            for (int i = 0; i < 4; ++i) { const f32x2 cs = rope[pos * 32 + j0 + i]; o1[i] = x1[i] * cs.x - x2[i] * cs.y; o2[i] = x2[i] * cs.x + x1[i] * cs.y; }
                            *(f32x4*)(kf + j0) = o1; *(f32x4*)(kf + 32 + j0) = o2; *(u32x2*)(kb + j0) = pack4(o1); *(u32x2*)(kb + 32 + j0) = pack4(o2); }
                    } else if (wc == 1) {
                        const f32x4 v = acc[ai][0][m][0];
                        if (fq < 2) { *(f32x4*)(IW + (size_t)row * 8 + 4 * fq) = v * IWSCALE; }
                        else { const int i0 = 4 * (fq - 2); f32x4 lf;
#pragma unroll
                            for (int i = 0; i < 4; ++i) lf[i] = flogsig(v[i] + b_f[i0 + i]);
                            *(f32x4*)(out + (samp ? O_SLF + (size_t)rs * 8 : O_PLF + (size_t)row * 8) + i0) = lf; *(f32x4*)(LF + (size_t)row * 8 + i0) = lf; }
                    }
                } else if (T < 8) {
                    bf16_t* dst = QB + (size_t)row * 512 + 256 * (T - 6) + 32 * wc + 4 * fq;
#pragma unroll
                    for (int bj = 0; bj < 2; ++bj)
#pragma unroll
                        for (int n = 0; n < 2; ++n) *(u32x2*)(dst + 128 * bj + 16 * n) = pack4(acc[ai][bj][m][n] * QSCALE);
                } else if (T < 12) {
                    const bool isv = T >= 10; const int c0 = 256 * ((T - 8) & 1) + 32 * wc + 4 * fq;
                    float* df = out + (isv ? (samp ? O_SBV + (size_t)rs * 512 : O_PBV + (size_t)row * 512) : (samp ? O_SBK + (size_t)rs * 512 : O_PBK + (size_t)row * 512)) + c0;
                    bf16_t* db = (isv ? (samp ? VBs + (size_t)rs * 512 : VBp + (size_t)row * 512) : (samp ? KBs + (size_t)rs * 512 : KBp + (size_t)row * 512)) + c0;
#pragma unroll
                    for (int bj = 0; bj < 2; ++bj)
#pragma unroll
                        for (int n = 0; n < 2; ++n) { *(f32x4*)(df + 128 * bj + 16 * n) = acc[ai][bj][m][n]; *(u32x2*)(db + 128 * bj + 16 * n) = pack4(acc[ai][bj][m][n]); }
                } else {
                    const int c0 = 256 * (T - 12) + 32 * wc + 4 * fq; bf16_t* dst = G + (size_t)row * 2048 + c0;
#pragma unroll
                    for (int bj = 0; bj < 2; ++bj)
#pragma unroll
                        for (int n = 0; n < 2; ++n) { const f32x4 bg = *(const f32x4*)(b_gate + c0 + 128 * bj + 16 * n); f32x4 g;
#pragma unroll
                            for (int i = 0; i < 4; ++i) g[i] = fsigmoid(acc[ai][bj][m][n][i] + bg[i]);
                            *(u32x2*)(dst + 128 * bj + 16 * n) = pack4(g); }
                }
            }
    }
};
template <class Epi, class Sched, bool ALIGN_EPI = false, bool SP2 = false>
__device__ __forceinline__ void gemm_phase(PG8_LAS unsigned char* lds, const Gemm g, const Sched& S, const Epi& E) {
    const int tid = threadIdx.x, wid = __builtin_amdgcn_readfirstlane(tid >> 6), lane = tid & 63, wr = wid >> 2, wc = wid & 3, fr = lane & 15, fq = lane >> 4;
    const int K = g.K, nt = K / BK;
    unsigned voffA[2], voffB[2];
#pragma unroll
    for (int i = 0; i < 2; ++i) { int R, C; stage_rc(tid * 16 + i * 8192, R, C); const int Rb = Epi::PERM ? ((R & ~31) + perm32(R & 31)) : R;
        voffA[i] = (unsigned)(R * K + C) * 2u; voffB[i] = (unsigned)(Rb * K + C) * 2u; }
    const size_t kstep = (size_t)(BK * 2);
    const size_t hstep = (size_t)HALF * K * 2;
    const size_t tstep = 2 * hstep;
    const unsigned ldsw = (unsigned)wid * 1024u;
    const int aoff = lds_byte(wr * 64 + fr, fq * 8), boff = lds_byte(wc * 32 + fr, fq * 8);
#define PG8_SA(b, h) (((b) * 2 + (h)) * HTB)
#define PG8_SB(b, h) ((4 + (b) * 2 + (h)) * HTB)
#define PG8_STAGE(bufoff, gbase, voff) do { _Pragma("unroll") for (int _i = 0; _i < 2; ++_i) \
        __builtin_amdgcn_global_load_lds((const unsigned*)((const char*)(gbase) + (voff)[_i]), (PG8_LAS unsigned*)(lds + (bufoff) + ldsw + _i * 8192), 16, 0, 0); } while (0)
#define PG8_LDA(dst, b, h) do { _Pragma("unroll") for (int m = 0; m < 4; ++m) _Pragma("unroll") for (int k = 0; k < 2; ++k) dst[m][k] = *(const PG8_LAS bf16x8*)(lds + PG8_SA(b, h) + aoff + m * 2048 + k * 1024); } while (0)
#define PG8_LDB(dst, b, h) do { _Pragma("unroll") for (int n = 0; n < 2; ++n) _Pragma("unroll") for (int k = 0; k < 2; ++k) dst[n][k] = *(const PG8_LAS bf16x8*)(lds + PG8_SB(b, h) + boff + n * 2048 + k * 1024); } while (0)
#define PG8_MMA(ai, bj, At, Bt) do { __builtin_amdgcn_s_setprio(1); _Pragma("unroll") for (int m = 0; m < 4; ++m) _Pragma("unroll") for (int n = 0; n < 2; ++n) _Pragma("unroll") for (int k = 0; k < 2; ++k) \
        acc[ai][bj][m][n] = __builtin_amdgcn_mfma_f32_16x16x32_bf16(Bt[n][k], At[m][k], acc[ai][bj][m][n], 0, 0, 0); __builtin_amdgcn_s_setprio(0); } while (0)
#define PG8_WAIT_V(n) asm volatile("s_waitcnt vmcnt(" #n ")" ::: "memory")
#define PG8_WAIT_L(n) asm volatile("s_waitcnt lgkmcnt(" #n ")" ::: "memory")
#define PG8_BAR __builtin_amdgcn_s_barrier()
#define PG8_SCHED __builtin_amdgcn_sched_barrier(0)
    Unit cur, nxt; int ui = 0;
    if (!S.next(0, cur)) return;
    f32x4 acc[2][2][4][2];
#pragma unroll
    for (int a = 0; a < 2; ++a)
#pragma unroll
        for (int b = 0; b < 2; ++b)
#pragma unroll
            for (int m = 0; m < 4; ++m)
#pragma unroll
                for (int n = 0; n < 2; ++n) acc[a][b][m][n] = (f32x4){0.f, 0.f, 0.f, 0.f};
    bf16x8 At[4][2], B0[2][2], B1[2][2];
    const char* cA = (const char*)g.A + (size_t)cur.pm * tstep; const char* cB = (const char*)g.Bt + (size_t)cur.pn * tstep;
    S.a_ready(cur);
    if constexpr (SP2) {
        PG8_STAGE(PG8_SB(0, 0), cB, voffB); PG8_STAGE(PG8_SB(0, 1), cB + hstep, voffB); PG8_STAGE(PG8_SA(0, 0), cA, voffA); PG8_STAGE(PG8_SA(0, 1), cA + hstep, voffA);
        if (wr == 1) PG8_BAR;
        PG8_WAIT_V(2); PG8_BAR;
        PG8_STAGE(PG8_SB(1, 0), cB + kstep, voffB); PG8_STAGE(PG8_SA(1, 0), cA + kstep, voffA); PG8_STAGE(PG8_SB(1, 1), cB + hstep + kstep, voffB);
        PG8_WAIT_V(6); PG8_BAR;
    } else {
        PG8_STAGE(PG8_SB(0, 0), cB, voffB); PG8_STAGE(PG8_SA(0, 0), cA, voffA); PG8_STAGE(PG8_SB(0, 1), cB + hstep, voffB); PG8_STAGE(PG8_SA(0, 1), cA + hstep, voffA);
        if (wr == 1) PG8_BAR;
        PG8_WAIT_V(4); PG8_BAR;
        PG8_STAGE(PG8_SB(1, 0), cB + kstep, voffB); PG8_STAGE(PG8_SA(1, 0), cA + kstep, voffA); PG8_STAGE(PG8_SB(1, 1), cB + hstep + kstep, voffB);
        PG8_WAIT_V(6); PG8_BAR;
    }
    for (;;) {
        const bool has_next = S.next(ui + 1, nxt);
        const char* nA = has_next ? (const char*)g.A + (size_t)nxt.pm * tstep : cA; const char* nB = has_next ? (const char*)g.Bt + (size_t)nxt.pn * tstep : cB;
        for (int t = 0; t < nt; t += 2) {
            const bool last = (t == nt - 2);
            const char* a1 = cA + (size_t)(t + 1) * kstep;
            const char* a2 = last ? nA : cA + (size_t)(t + 2) * kstep; const char* b2 = last ? nB : cB + (size_t)(t + 2) * kstep;
            const char* a3 = a2 + kstep; const char* b3 = b2 + kstep;
            if (last && has_next) S.a_ready(nxt);
            if constexpr (SP2) {
            PG8_LDB(B0, 0, 0); PG8_LDB(B1, 0, 1); PG8_SCHED; PG8_LDA(At, 0, 0); PG8_STAGE(PG8_SA(1, 1), a1 + hstep, voffA);
            PG8_WAIT_V(8); PG8_WAIT_L(0); PG8_BAR; PG8_MMA(0, 0, At, B0); PG8_MMA(0, 1, At, B1); PG8_BAR; PG8_SCHED;
            PG8_LDA(At, 0, 1); PG8_STAGE(PG8_SB(0, 0), b2, voffB); PG8_STAGE(PG8_SB(0, 1), b2 + hstep, voffB); PG8_STAGE(PG8_SA(0, 0), a2, voffA);
            PG8_WAIT_V(8); PG8_WAIT_L(0); PG8_BAR; PG8_MMA(1, 0, At, B0); PG8_MMA(1, 1, At, B1); PG8_BAR; PG8_SCHED;
            PG8_LDB(B0, 1, 0); PG8_LDB(B1, 1, 1); PG8_SCHED; PG8_LDA(At, 1, 0); PG8_STAGE(PG8_SA(0, 1), a2 + hstep, voffA);
            PG8_WAIT_V(8); PG8_WAIT_L(0); PG8_BAR; PG8_MMA(0, 0, At, B0); PG8_MMA(0, 1, At, B1); PG8_BAR; PG8_SCHED;
            PG8_LDA(At, 1, 1); PG8_STAGE(PG8_SB(1, 0), b3, voffB); PG8_STAGE(PG8_SB(1, 1), b3 + hstep, voffB); PG8_STAGE(PG8_SA(1, 0), a3, voffA);
            PG8_WAIT_V(8); PG8_WAIT_L(0); PG8_BAR; PG8_MMA(1, 0, At, B0); PG8_MMA(1, 1, At, B1); PG8_BAR; PG8_SCHED;
            } else {
            PG8_LDB(B0, 0, 0); PG8_SCHED; PG8_LDA(At, 0, 0); PG8_STAGE(PG8_SA(1, 1), a1 + hstep, voffA);
            PG8_WAIT_L(8); PG8_BAR; PG8_WAIT_L(0); PG8_MMA(0, 0, At, B0); PG8_BAR; PG8_SCHED;
            PG8_LDB(B1, 0, 1); PG8_STAGE(PG8_SB(0, 0), b2, voffB);
            PG8_BAR; PG8_WAIT_L(0); PG8_MMA(0, 1, At, B1); PG8_BAR;
            PG8_LDA(At, 0, 1); PG8_STAGE(PG8_SA(0, 0), a2, voffA);
            PG8_BAR; PG8_WAIT_L(0); PG8_MMA(1, 0, At, B0); PG8_BAR; PG8_SCHED;
            PG8_STAGE(PG8_SB(0, 1), b2 + hstep, voffB);
            PG8_WAIT_V(6); PG8_BAR; PG8_MMA(1, 1, At, B1); PG8_BAR;
            PG8_LDB(B0, 1, 0); PG8_SCHED; PG8_LDA(At, 1, 0); PG8_STAGE(PG8_SA(0, 1), a2 + hstep, voffA);
            PG8_WAIT_L(8); PG8_BAR; PG8_WAIT_L(0); PG8_MMA(0, 0, At, B0); PG8_BAR; PG8_SCHED;
            PG8_LDB(B1, 1, 1); PG8_STAGE(PG8_SB(1, 0), b3, voffB);
            PG8_BAR; PG8_WAIT_L(0); PG8_MMA(0, 1, At, B1); PG8_BAR;
            PG8_LDA(At, 1, 1); PG8_STAGE(PG8_SA(1, 0), a3, voffA);
            PG8_BAR; PG8_WAIT_L(0); PG8_MMA(1, 0, At, B0); PG8_BAR; PG8_SCHED;
            PG8_STAGE(PG8_SB(1, 1), b3 + hstep, voffB);
            PG8_WAIT_V(6); PG8_BAR; PG8_MMA(1, 1, At, B1); PG8_BAR;
            }
        }
        if constexpr (ALIGN_EPI) { if (wr == 0) PG8_BAR; }
        if constexpr (!Epi::AFTER_DRAIN) { E(acc, cur, wr, wc, fr, fq); S.done(cur); }
        if (!has_next) break;
#pragma unroll
        for (int a = 0; a < 2; ++a)
#pragma unroll
            for (int b = 0; b < 2; ++b)
#pragma unroll
                for (int m = 0; m < 4; ++m)
#pragma unroll
                    for (int n = 0; n < 2; ++n) acc[a][b][m][n] = (f32x4){0.f, 0.f, 0.f, 0.f};
        cur = nxt; cA = nA; cB = nB; ++ui;
        if constexpr (ALIGN_EPI) { if (wr == 1) PG8_BAR; }
    }
    PG8_WAIT_V(0);
    if constexpr (!ALIGN_EPI) { if (wr == 0) PG8_BAR; }
    PG8_BAR;
    if constexpr (Epi::AFTER_DRAIN) { E.fused(acc, cur, wr, wc, fr, fq, lds, wid, lane); S.done(cur); }
#undef PG8_SA
#undef PG8_SB
#undef PG8_STAGE
#undef PG8_LDA
#undef PG8_LDB
#undef PG8_MMA
#undef PG8_WAIT_V
#undef PG8_WAIT_L
#undef PG8_BAR
#undef PG8_SCHED
}
}
#define LAS __attribute__((address_space(3)))
typedef unsigned short bf16_t;
typedef short bf16x8 __attribute__((ext_vector_type(8)));
typedef short s16x4 __attribute__((ext_vector_type(4)));
typedef float f32x4 __attribute__((ext_vector_type(4)));
typedef float f32x2 __attribute__((ext_vector_type(2)));
typedef float f32x16 __attribute__((ext_vector_type(16)));
typedef unsigned u32x4 __attribute__((ext_vector_type(4)));
typedef unsigned u32x2 __attribute__((ext_vector_type(2)));
using pg8::cvt_pk_bf16; using pg8::bf2f;
constexpr int NWAVES = 8, NTHR = 512, LDS_BYTES = 147456;
constexpr size_t MiB = 1u << 20;
constexpr size_t WS_CTL = 0;
constexpr size_t WS_ROPE = 1 * MiB;
constexpr size_t WS_W1U = 4 * MiB, WS_W1D = 16 * MiB, WS_WIN = 22 * MiB, WS_WPA = 33 * MiB, WS_WPB = 34 * MiB, WS_WO = 35 * MiB, WS_W2U = 37 * MiB, WS_W2D = 49 * MiB;
constexpr size_t WS_XB = 56 * MiB;
constexpr size_t WS_H = 92 * MiB;
constexpr size_t WS_Z = 192 * MiB;
constexpr size_t WS_HF1 = 264 * MiB, WS_HF2 = 336 * MiB;
constexpr size_t WS_HB = 408 * MiB;
constexpr size_t WS_QA = 444 * MiB, WS_IQ = 462 * MiB, WS_QB = 480 * MiB;
constexpr size_t WS_KAP = 498 * MiB, WS_VAP = 502 * MiB, WS_IKP = 506 * MiB;
constexpr size_t WS_KBP = 508 * MiB, WS_VBP = 524 * MiB;
constexpr size_t WS_KAS = 540 * MiB, WS_VAS = 573 * MiB, WS_IKS = 606 * MiB;
constexpr size_t WS_KBS = 623 * MiB, WS_VBS = 625 * MiB;
constexpr size_t WS_IW = 627 * MiB, WS_LF = 628 * MiB;
constexpr size_t WS_CBP = 629 * MiB, WS_CBS = 630 * MiB;
constexpr size_t WS_G = 635 * MiB;
constexpr size_t WS_SEL = 707 * MiB;
constexpr size_t WS_YA = 725 * MiB, WS_YB = 743 * MiB;
constexpr size_t WS_MM = 761 * MiB;
constexpr size_t WS_MMB = 833 * MiB;
constexpr size_t WS_SCR = 869 * MiB;
constexpr size_t WS_END = 997 * MiB;

struct Args {
    const float *x_p, *x_s, *c_ak, *c_av, *c_aik, *c_bk, *c_bv, *c_blf, *w1u, *w1d, *ln1g, *ln1b, *win, *b_f, *b_gate, *wpa, *wpb, *wo, *ln2g, *ln2b, *w2u, *w2d, *ln3g, *ln3b;
    float* out; unsigned char* ws; double invf[32]; int ph_lo, ph_hi;
};
struct Frame { LAS unsigned char* lds; int tid, lane, wave, G, bid; };

__device__ __forceinline__ unsigned f2bf(float f) { unsigned u = __float_as_uint(f); return (u + 0x7fffu + ((u >> 16) & 1u)) >> 16; }
__device__ __forceinline__ unsigned pk2(float lo, float hi) { return cvt_pk_bf16(lo, hi); }
__device__ __forceinline__ float wave_sum(float v) {
#pragma unroll
    for (int o = 1; o < 64; o <<= 1) v += __shfl_xor(v, o);
    return v;
}
__host__ __device__ __forceinline__ int rope_src(int P) { return 64 * ((P & 127) >> 5) + (P & 31) + ((P >> 7) << 5); }
struct SrcId { __device__ __forceinline__ int operator()(int n) const { return n; } };
struct SrcUp { __device__ __forceinline__ int operator()(int n) const { const int t = n >> 8, p = n & 255; return (p < 128) ? 128 * t + p : DFF + 128 * t + (p - 128); } };
struct SrcWin { __device__ __forceinline__ int operator()(int n) const {
    const int T = n >> 8, P = n & 255, bj = P >> 7, q = P & 127;
    if (T < 2) return 256 * T + rope_src(P);
    if (T == 2) return (q < 64) ? 512 + 64 * (q >> 5) + (q & 31) + 32 * bj : 640 + 64 * bj + (q - 64);
    if (T < 5) return 768 + 256 * (T - 3) + rope_src(P);
    if (T == 5) { if (q < 32) return 1280 + q + 32 * bj; if (bj == 0 && q < 40) return 1344 + (q - 32); if (bj == 0 && q < 48) return 2888 + (q - 40); return -1; }
    if (T < 8) return 1352 + 256 * (T - 6) + P;
    if (T < 10) return 1864 + 256 * (T - 8) + P;
    if (T < 12) return 2376 + 256 * (T - 10) + P;
    return 2896 + 256 * (T - 12) + P; } };
template <class F> __device__ __forceinline__ void transpose_item(const float* W, int K, int N, int ND, bf16_t* WT, LAS float* scr, int item, int lane, F srcf) {
    const int nblk = ND / 32, kb = item / nblk, nb = item % nblk, k0 = 64 * kb, n0 = 32 * nb;
    const int sc = srcf(n0 + (lane & 31));
#pragma unroll 8
    for (int i = 0; i < 32; ++i) { const int kk = 2 * i + (lane >> 5); scr[kk * 33 + (lane & 31)] = (sc >= 0) ? W[(size_t)(k0 + kk) * N + sc] : 0.f; }
    asm volatile("s_waitcnt lgkmcnt(0)" ::: "memory");
    const int c = lane & 7;
#pragma unroll
    for (int j = 0; j < 4; ++j) { const int n = (lane >> 3) + 8 * j; const LAS float* s = scr + (8 * c) * 33 + n;
        u32x4 o; o.x = pk2(s[0 * 33], s[1 * 33]); o.y = pk2(s[2 * 33], s[3 * 33]); o.z = pk2(s[4 * 33], s[5 * 33]); o.w = pk2(s[6 * 33], s[7 * 33]);
        *(u32x4*)(WT + (size_t)(n0 + n) * K + k0 + 8 * c) = o; }
    asm volatile("s_waitcnt lgkmcnt(0)" ::: "memory");
}
__device__ __forceinline__ void cvt_rows(const float* src, bf16_t* dst, size_t n4, size_t per_src, size_t per_dst, size_t gt, size_t ngt) {
    for (size_t e = gt; e < n4; e += ngt) { const size_t b = e / per_src, r = e - b * per_src; const f32x4 v = *(const f32x4*)(src + 4 * e);
        u32x2 w; w.x = pk2(v[0], v[1]); w.y = pk2(v[2], v[3]); *(u32x2*)(dst + 4 * (b * per_dst + r)) = w; }
}
__device__ __forceinline__ void p0_prologue(const Frame& F, const Args& a) {
    unsigned char* ws = a.ws;
    if (F.bid == 0 && F.tid < 256) ((unsigned*)(ws + WS_CTL))[F.tid] = 0u;
    LAS float* scr = (LAS float*)(F.lds + F.wave * 16384);
    const int gw = F.bid * NWAVES + F.wave, NGW = F.G * NWAVES;
    constexpr int I_UP = 16 * (NUP / 32), I_DN = (DFF / 64) * 32, I_IN = 16 * (NINP / 32), I_P = 8 * 32, I_O = 16 * 32;
    constexpr int NIT = 2 * I_UP + 2 * I_DN + I_IN + 2 * I_P + I_O;
    for (int it = gw; it < NIT; it += NGW) {
        int r = it;
        if (r < I_UP) { transpose_item(a.w1u, DM, NUP, NUP, (bf16_t*)(ws + WS_W1U), scr, r, F.lane, SrcUp()); continue; } r -= I_UP;
        if (r < I_UP) { transpose_item(a.w2u, DM, NUP, NUP, (bf16_t*)(ws + WS_W2U), scr, r, F.lane, SrcUp()); continue; } r -= I_UP;
        if (r < I_DN) { transpose_item(a.w1d, DFF, DM, DM, (bf16_t*)(ws + WS_W1D), scr, r, F.lane, SrcId()); continue; } r -= I_DN;
        if (r < I_DN) { transpose_item(a.w2d, DFF, DM, DM, (bf16_t*)(ws + WS_W2D), scr, r, F.lane, SrcId()); continue; } r -= I_DN;
        if (r < I_IN) { transpose_item(a.win, DM, NIN, NINP, (bf16_t*)(ws + WS_WIN), scr, r, F.lane, SrcWin()); continue; } r -= I_IN;
        if (r < I_P) { transpose_item(a.wpa, 512, DM, DM, (bf16_t*)(ws + WS_WPA), scr, r, F.lane, SrcId()); continue; } r -= I_P;
        if (r < I_P) { transpose_item(a.wpb, 512, DM, DM, (bf16_t*)(ws + WS_WPB), scr, r, F.lane, SrcId()); continue; } r -= I_P;
        transpose_item(a.wo, DM, DM, DM, (bf16_t*)(ws + WS_WO), scr, r, F.lane, SrcId());
    }
    const size_t gt = (size_t)F.bid * NTHR + F.tid, ngt = (size_t)F.G * NTHR;
    cvt_rows(a.x_p, (bf16_t*)(ws + WS_XB), (size_t)MP * DM / 4, (size_t)MP * DM / 4, 0, gt, ngt);
    cvt_rows(a.x_s, (bf16_t*)(ws + WS_XB) + (size_t)MP * DM, (size_t)MS * DM / 4, (size_t)MS * DM / 4, 0, gt, ngt);
    cvt_rows(a.c_ak, (bf16_t*)(ws + WS_KAS), (size_t)DB * PAST * 32, (size_t)PAST * 32, (size_t)SKV * 32, gt, ngt);
    cvt_rows(a.c_av, (bf16_t*)(ws + WS_VAS), (size_t)DB * PAST * 32, (size_t)PAST * 32, (size_t)SKV * 32, gt, ngt);
    cvt_rows(a.c_aik, (bf16_t*)(ws + WS_IKS), (size_t)DB * PAST * 16, (size_t)PAST * 16, (size_t)SKV * 16, gt, ngt);
    f32x2* rope = (f32x2*)(ws + WS_ROPE);
    for (size_t e = gt; e < (size_t)SEQ * 32; e += ngt) {
        const int pos = (int)(e >> 5), j = (int)(e & 31); const double ang = (double)pos * a.invf[j];
        const double kq = __builtin_rint(ang * 0.63661977236758134308); double r = __builtin_fma(-kq, 1.57079632679489655800e+00, ang); r = __builtin_fma(-kq, 6.12323399573676603587e-17, r);
        const double r2 = r * r;
        const double sn = r * (1.0 + r2 * (-1.0 / 6 + r2 * (1.0 / 120 + r2 * (-1.0 / 5040 + r2 * (1.0 / 362880 + r2 * (-1.0 / 39916800 + r2 * (1.0 / 6227020800.0)))))));
        const double cn = 1.0 + r2 * (-0.5 + r2 * (1.0 / 24 + r2 * (-1.0 / 720 + r2 * (1.0 / 40320 + r2 * (-1.0 / 3628800 + r2 * (1.0 / 479001600.0))))));
        const int qd = ((int)(long long)kq) & 3; double s, c;
        if (qd == 0) { s = sn; c = cn; } else if (qd == 1) { s = cn; c = -sn; } else if (qd == 2) { s = -sn; c = -cn; } else { s = -cn; c = sn; }
        rope[e] = (f32x2){(float)c, (float)s};
    }
}
__device__ __forceinline__ void ln_pass(const Frame& F, const float* Z, const float* g, const float* b, float* of, bf16_t* ob) {
    const int gw = F.bid * NWAVES + F.wave, NGW = F.G * NWAVES;
    f32x4 gv[4], bv[4];
#pragma unroll
    for (int j = 0; j < 4; ++j) { gv[j] = *(const f32x4*)(g + 4 * F.lane + 256 * j); bv[j] = *(const f32x4*)(b + 4 * F.lane + 256 * j); }
    for (int row = gw; row < MT; row += NGW) {
        const f32x4* zr = (const f32x4*)(Z + (size_t)row * DM) + F.lane; f32x4 v[4]; float s = 0.f;
#pragma unroll
        for (int j = 0; j < 4; ++j) { v[j] = zr[64 * j]; s += (v[j][0] + v[j][1]) + (v[j][2] + v[j][3]); }
        const float mean = wave_sum(s) * (1.f / DM); float s2 = 0.f;
#pragma unroll
        for (int j = 0; j < 4; ++j) { v[j] = v[j] - mean; s2 += (v[j][0] * v[j][0] + v[j][1] * v[j][1]) + (v[j][2] * v[j][2] + v[j][3] * v[j][3]); }
        const float rstd = 1.f / sqrtf(wave_sum(s2) * (1.f / DM) + LN_EPS);
#pragma unroll
        for (int j = 0; j < 4; ++j) { const f32x4 y = v[j] * rstd * gv[j] + bv[j];
            *((f32x4*)(of + (size_t)row * DM) + F.lane + 64 * j) = y;
            if (ob) { u32x2 w; w.x = pk2(y[0], y[1]); w.y = pk2(y[2], y[3]); *((u32x2*)(ob + (size_t)row * DM) + F.lane + 64 * j) = w; } }
    }
}
__device__ __forceinline__ void cumsum_block(const Frame& F, const Args& a, int sb) {
    LAS float* tot = (LAS float*)F.lds;
    const int i = F.tid >> 3, h = F.tid & 7;
    const float* LF = (const float*)(a.ws + WS_LF);
    if (sb < NB) {
        const float* src = LF + ((size_t)sb * SEQ + 128 * i) * 8 + h; float s = 0.f;
        for (int t = 0; t < 128; ++t) s += src[t * 8];
        tot[i * 8 + h] = s; __syncthreads();
        float c = 0.f; for (int k = 0; k < i; ++k) c += tot[k * 8 + h];
        float* dst = (float*)(a.ws + WS_CBP) + ((size_t)sb * 8 + h) * SEQ + 128 * i;
        for (int t = 0; t < 128; ++t) { c += src[t * 8]; dst[t] = -c * LOG2E; }
    } else {
        const int b = sb - NB; const float* src = a.c_blf + ((size_t)b * PAST + 64 * i) * 8 + h; float s = 0.f;
        for (int t = 0; t < 64; ++t) s += src[t * 8];
        tot[i * 8 + h] = s; __syncthreads();
        float c = 0.f; for (int k = 0; k < i; ++k) c += tot[k * 8 + h];
        float* dst = (float*)(a.ws + WS_CBS) + ((size_t)b * 8 + h) * SKV + 64 * i;
        for (int t = 0; t < 64; ++t) { c += src[t * 8]; dst[t] = -c * LOG2E; }
        if (i == 63) { const float* sn = LF + ((size_t)MP + b * DS) * 8 + h; float* dn = (float*)(a.ws + WS_CBS) + ((size_t)b * 8 + h) * SKV + PAST;
            for (int t = 0; t < DS; ++t) { c += sn[t * 8]; dn[t] = -c * LOG2E; } }
    }
    __syncthreads();
}
__device__ __forceinline__ unsigned f2key(float f) { const unsigned u = __float_as_uint(f); return (u & 0x80000000u) ? ~u : (u | 0x80000000u); }
__device__ __forceinline__ void indexer_item(const Frame& F, const Args& a, int item) {
    int b, c, qq; bool samp;
    if (item < 504) { c = 127 - (item >> 3); b = (item >> 2) & 1; qq = item & 3; samp = false; }
    else if (item < 632) { const int s = item - 504; b = s >> 2; qq = s & 3; c = 64; samp = true; }
    else { const int r = item - 632; c = 64 - (r >> 3); b = (r >> 2) & 1; qq = r & 3; samp = false; }
    const int qrow0 = samp ? MP + b * DS + 16 * qq : b * SEQ + 64 * c + 16 * qq;
    const int n = samp ? SKV : 64 * (c + 1);
    const bf16_t* IK = samp ? (const bf16_t*)(a.ws + WS_IKS) + (size_t)b * SKV * 64 : (const bf16_t*)(a.ws + WS_IKP) + (size_t)b * SEQ * 64;
    const bf16_t* IQ = (const bf16_t*)(a.ws + WS_IQ); const float* IW = (const float*)(a.ws + WS_IW);
    int* SEL = (int*)(a.ws + WS_SEL);
    int lane = F.lane; asm volatile("" : "+v"(lane));
    const int l31 = lane & 31, hi = lane >> 5;
    if (n <= 256) {
        for (int e = F.tid; e < 16 * 256; e += NTHR) { const int q = e >> 8, s = e & 255; SEL[(size_t)(qrow0 + q) * 256 + s] = (s < n) ? s : 0; }
        return;
    }
    float* scr = (float*)(a.ws + WS_SCR) + (size_t)F.bid * 16 * 8192;
    {
        bf16x8 afr[4][4]; f32x4 wq[4][2][2];
        const int qa = 2 * ((l31 >> 2) & 1) + (l31 >> 4), ha = 4 * ((l31 >> 3) & 1) + (l31 & 3);
#pragma unroll
        for (int mt = 0; mt < 4; ++mt) {
#pragma unroll
            for (int ks = 0; ks < 4; ++ks) afr[mt][ks] = *(const bf16x8*)(IQ + (size_t)(qrow0 + 4 * mt + qa) * 512 + 64 * ha + 16 * ks + 8 * hi);
#pragma unroll
            for (int aa = 0; aa < 2; ++aa) { const float* wp = IW + (size_t)(qrow0 + 4 * mt + 2 * hi + aa) * 8; wq[mt][aa][0] = *(const f32x4*)wp; wq[mt][aa][1] = *(const f32x4*)(wp + 4); }
        }
        for (int kt = F.wave; kt < n / 32; kt += NWAVES) {
            bf16x8 bfr[4];
#pragma unroll
            for (int ks = 0; ks < 4; ++ks) bfr[ks] = *(const bf16x8*)(IK + (size_t)(32 * kt + l31) * 64 + 16 * ks + 8 * hi);
#pragma unroll
            for (int mt = 0; mt < 4; ++mt) {
                f32x16 acc = {};
#pragma unroll
                for (int ks = 0; ks < 4; ++ks) acc = __builtin_amdgcn_mfma_f32_32x32x16_bf16(afr[mt][ks], bfr[ks], acc, 0, 0, 0);
#pragma unroll
                for (int aa = 0; aa < 2; ++aa) { float s = 0.f;
#pragma unroll
                    for (int h = 0; h < 8; ++h) s += fmaxf(acc[8 * aa + h], 0.f) * wq[mt][aa][h >> 2][h & 3];
                    scr[(size_t)(4 * mt + 2 * hi + aa) * 8192 + 32 * kt + l31] = s; }
            }
        }
    }
    __syncthreads(); __builtin_amdgcn_fence(__ATOMIC_ACQUIRE, "agent");
    LAS unsigned* hist = (LAS unsigned*)(F.lds + F.wave * 8192);
    for (int q = F.wave; q < 16; q += NWAVES) {
        const float* sp = scr + (size_t)q * 8192; unsigned prefix = 0; int kk = 256;
#pragma unroll 1
        for (int lev = 0; lev < 3; ++lev) {
            const int shift = (lev == 0) ? 21 : (lev == 1) ? 10 : 0, bits = (lev == 2) ? 10 : 11, nbin = 1 << bits, per = nbin >> 6;
            for (int j = 0; j < per; ++j) hist[lane + 64 * j] = 0u;
            asm volatile("s_waitcnt lgkmcnt(0)" ::: "memory");
            for (int i = lane; i < n; i += 64) { const unsigned key = f2key(sp[i]);
                if (lev == 0 || (key >> (shift + bits)) == prefix) __hip_atomic_fetch_add(&hist[(key >> shift) & (nbin - 1)], 1u, __ATOMIC_RELAXED, __HIP_MEMORY_SCOPE_WORKGROUP); }
            asm volatile("s_waitcnt lgkmcnt(0)" ::: "memory");
            unsigned s = 0; for (int j = 0; j < per; ++j) s += hist[lane * per + j];
            unsigned T = s;
#pragma unroll
            for (int off = 1; off < 64; off <<= 1) { const unsigned v = __shfl_down(T, off); if (lane + off < 64) T += v; }
            const unsigned long long bal = __ballot(T >= (unsigned)kk);
            const int js = __popcll(bal) - 1;
            unsigned run = (js < 63) ? __shfl(T, js + 1) : 0u; if (js >= 63) run = 0u;
            int digit = js * per;
            for (int bb = per - 1; bb >= 0; --bb) { const unsigned cnt = hist[js * per + bb]; if (run + cnt >= (unsigned)kk) { digit = js * per + bb; break; } run += cnt; }
            kk -= (int)run; prefix = (prefix << bits) | (unsigned)digit;
            asm volatile("s_waitcnt lgkmcnt(0)" ::: "memory");
        }
        int* so = SEL + (size_t)(qrow0 + q) * 256; int obase = 0, ebase = 0;
        for (int i0 = 0; i0 < n; i0 += 64) { const int i = i0 + lane; const unsigned key = (i < n) ? f2key(sp[i]) : 0u;
            const bool gt = (i < n) && key > prefix, eq = (i < n) && key == prefix;
            const unsigned long long be = __ballot(eq); const int er = ebase + __popcll(be & ((1ull << lane) - 1ull));
            const bool take = gt || (eq && er < kk);
            const unsigned long long bt = __ballot(take); const int pos = obase + __popcll(bt & ((1ull << lane) - 1ull));
            if (take && pos < 256) so[pos] = i;
            obase += __popcll(bt); ebase += __popcll(be); }
    }
    __syncthreads();
}
__device__ __forceinline__ void dsa_query(const Frame& F, const Args& a, int row) {
    int lane = F.lane; asm volatile("" : "+v"(lane));
    const int j = lane & 15, kq = lane >> 4;
    const bool samp = row >= MP; const int rs = row - MP;
    const int nsel = samp ? 256 : min(256, 64 * (((row & (SEQ - 1)) >> 6) + 1));
    const bf16_t* KA = samp ? (const bf16_t*)(a.ws + WS_KAS) + (size_t)(rs >> 6) * SKV * 128 : (const bf16_t*)(a.ws + WS_KAP) + (size_t)(row >> 13) * SEQ * 128;
    const bf16_t* VA = samp ? (const bf16_t*)(a.ws + WS_VAS) + (size_t)(rs >> 6) * SKV * 128 : (const bf16_t*)(a.ws + WS_VAP) + (size_t)(row >> 13) * SEQ * 128;
    const int* sel = (const int*)(a.ws + WS_SEL) + (size_t)row * 256;
    const bf16_t* QA = (const bf16_t*)(a.ws + WS_QA) + (size_t)row * 512;
    LAS float* pl = (LAS float*)(F.lds + F.wave * 9216);
    LAS int* sl = (LAS int*)(F.lds + F.wave * 9216 + 8192);
#pragma unroll
    for (int i = 0; i < 4; ++i) sl[lane + 64 * i] = sel[lane + 64 * i];
    bf16x8 bq[4];
#pragma unroll
    for (int ks = 0; ks < 4; ++ks) { bf16x8 z = {}; bq[ks] = (j < 8 && (ks >> 1) == (j >> 2)) ? *(const bf16x8*)(QA + 64 * j + 32 * (ks & 1) + 8 * kq) : z; }
    asm volatile("s_waitcnt lgkmcnt(0)" ::: "memory");
    f32x4 acc[16]; const int nt = nsel >> 4;
#pragma unroll
    for (int t = 0; t < 16; ++t) {
        acc[t] = (f32x4){-INFINITY, -INFINITY, -INFINITY, -INFINITY};
        if (t < nt) { const int idx = sl[16 * t + j]; const bf16_t* kr = KA + (size_t)idx * 128 + 8 * kq; f32x4 c = {0.f, 0.f, 0.f, 0.f};
#pragma unroll
            for (int ks = 0; ks < 4; ++ks) c = __builtin_amdgcn_mfma_f32_16x16x32_bf16(*(const bf16x8*)(kr + 32 * ks), bq[ks], c, 0, 0, 0);
            acc[t] = c; }
    }
    float mx = -INFINITY;
#pragma unroll
    for (int t = 0; t < 16; ++t) mx = fmaxf(mx, fmaxf(fmaxf(acc[t][0], acc[t][1]), fmaxf(acc[t][2], acc[t][3])));
    mx = fmaxf(mx, __shfl_xor(mx, 16)); mx = fmaxf(mx, __shfl_xor(mx, 32));
    float sum = 0.f;
#pragma unroll
    for (int t = 0; t < 16; ++t)
#pragma unroll
        for (int i = 0; i < 4; ++i) { const float p = __builtin_amdgcn_exp2f(acc[t][i] - mx); acc[t][i] = p; sum += p; }
    sum += __shfl_xor(sum, 16); sum += __shfl_xor(sum, 32);
    const float inv = 1.0f / sum;
    if (j < 8) {
#pragma unroll
        for (int t = 0; t < 16; ++t)
#pragma unroll
            for (int i = 0; i < 4; ++i) pl[(16 * t + 4 * kq + i) * 8 + j] = acc[t][i] * inv;
    }
    asm volatile("s_waitcnt lgkmcnt(0)" ::: "memory");
    const int g = lane >> 5; float o[4][2] = {};
#pragma unroll 8
    for (int s = 0; s < nsel; ++s) { const int idx = sl[s]; const unsigned v = *(const unsigned*)(VA + (size_t)idx * 128 + 2 * lane); const f32x4 p4 = *(const LAS f32x4*)(pl + s * 8 + 4 * g);
        const float v0 = __uint_as_float(v << 16), v1 = __uint_as_float(v & 0xffff0000u);
#pragma unroll
        for (int hh = 0; hh < 4; ++hh) { o[hh][0] += p4[hh] * v0; o[hh][1] += p4[hh] * v1; } }
    bf16_t* ya = (bf16_t*)(a.ws + WS_YA) + (size_t)row * 512 + 2 * (lane & 31);
#pragma unroll
    for (int hh = 0; hh < 4; ++hh) *(unsigned*)(ya + 64 * (4 * g + hh)) = pk2(o[hh][0], o[hh][1]);
    asm volatile("s_waitcnt lgkmcnt(0)" ::: "memory");
}
constexpr int VST = 72;
constexpr int FOX_V = 0, FOX_M = 8 * 64 * VST * 2  , FOX_L = FOX_M + 2048, FOX_O = FOX_L + 256, FOX_END = FOX_O + 64 * 65 * 4;
static_assert(FOX_END <= 131072, "fox lds");
__device__ __forceinline__ int crow(int r, int hi) { return (r & 3) + 8 * (r >> 2) + 4 * hi; }
__device__ __forceinline__ bf16x8 cvt8(f32x4 a, f32x4 b) { u32x4 w; w.x = pk2(a[0], a[1]); w.y = pk2(a[2], a[3]); w.z = pk2(b[0], b[1]); w.w = pk2(b[2], b[3]); return __builtin_bit_cast(bf16x8, w); }
__device__ __forceinline__ void fox_unit(const Frame& F, const Args& a, int unit) {
    const bool samp = unit < 256; int b, h, qi, ntiles, rowq0; const float* Cb;
    if (samp) { b = unit >> 3; h = unit & 7; qi = 64; ntiles = 65; rowq0 = MP + b * DS; Cb = (const float*)(a.ws + WS_CBS) + ((size_t)b * 8 + h) * SKV; }
    else { const int r = unit - 256; qi = 127 - (r >> 4); b = (r >> 3) & 1; h = r & 7; ntiles = qi + 1; rowq0 = b * SEQ + 64 * qi; Cb = (const float*)(a.ws + WS_CBP) + ((size_t)b * 8 + h) * SEQ; }
    int lane = F.lane; asm volatile("" : "+v"(lane)); int tidl = F.tid; asm volatile("" : "+v"(tidl));
    const int q32 = lane & 31, hi = lane >> 5, w = F.wave;
    const bf16_t* Kb = samp ? (const bf16_t*)(a.ws + WS_KBS) + (size_t)(b * DS) * 512 + 64 * h : (const bf16_t*)(a.ws + WS_KBP) + (size_t)(b * SEQ) * 512 + 64 * h;
    const bf16_t* Vb = samp ? (const bf16_t*)(a.ws + WS_VBS) + (size_t)(b * DS) * 512 + 64 * h : (const bf16_t*)(a.ws + WS_VBP) + (size_t)(b * SEQ) * 512 + 64 * h;
    const float* Kc = a.c_bk + ((size_t)b * PAST * 8 + h) * 64; const float* Vc = a.c_bv + ((size_t)b * PAST * 8 + h) * 64;
    LAS bf16_t* vl = (LAS bf16_t*)(F.lds + FOX_V) + w * 64 * VST;
    LAS float* mb = (LAS float*)(F.lds + FOX_M); LAS float* lt = (LAS float*)(F.lds + FOX_L); LAS float* ot = (LAS float*)(F.lds + FOX_O);
    for (int e = tidl; e < 64 * 65 + 64; e += NTHR) lt[e] = 0.f;
    const bf16_t* QB = (const bf16_t*)(a.ws + WS_QB);
    bf16x8 qf[2][4];
#pragma unroll
    for (int qb = 0; qb < 2; ++qb)
#pragma unroll
        for (int ks = 0; ks < 4; ++ks) qf[qb][ks] = *(const bf16x8*)(QB + (size_t)(rowq0 + 32 * qb + q32) * 512 + 64 * h + 16 * ks + 8 * hi);
    float mrun[2] = {-INFINITY, -INFINITY}, lrun[2] = {0.f, 0.f};
    f32x16 o[2][2];
#pragma unroll
    for (int qb = 0; qb < 2; ++qb)
#pragma unroll
        for (int db = 0; db < 2; ++db)
#pragma unroll
            for (int r = 0; r < 16; ++r) o[qb][db][r] = 0.f;
    const int gi = lane >> 4, li = lane & 15;
    const unsigned kofb = (unsigned)(q32 * 1024 + 16 * hi);
    const unsigned kofc = (unsigned)(q32 * 2048 + 32 * hi);
    const unsigned cof = (unsigned)(16 * hi);
    const int troff = ((4 * hi + (li >> 2)) * VST + 16 * (gi & 1) + 4 * (li & 3));
    for (int tile = w; tile < ntiles; tile += NWAVES) {
        const bool cache = samp && tile < 64, diag = (tile == ntiles - 1);
        const int kv0 = 64 * tile; const int kvl = samp ? (cache ? kv0 : 0) : kv0;
        bf16x8 kf[2][4];
        if (cache) {
            const char* kp = (const char*)Kc + (size_t)kvl * 2048 + kofc;
#pragma unroll
            for (int hf = 0; hf < 2; ++hf) { const char* kph = kp + hf * 65536;
#pragma unroll
                for (int ks = 0; ks < 4; ++ks) kf[hf][ks] = cvt8(*(const f32x4*)(kph + 64 * ks), *(const f32x4*)(kph + 64 * ks + 16));
                asm volatile("" ::: "memory"); }
            const char* vp = (const char*)Vc + (size_t)kvl * 2048 + (unsigned)(lane * 2048);
#pragma unroll
            for (int c = 0; c < 16; ++c) { const f32x4 v = *(const f32x4*)(vp + 16 * c);
                u32x2 wv; wv.x = pk2(v[0], v[1]); wv.y = pk2(v[2], v[3]); *(LAS u32x2*)(vl + lane * VST + 4 * c) = wv;
                if ((c & 7) == 7) asm volatile("" ::: "memory"); }
        } else {
            const char* kp = (const char*)Kb + (size_t)kvl * 1024 + kofb;
#pragma unroll
            for (int hf = 0; hf < 2; ++hf) { const char* kph = kp + hf * 32768;
#pragma unroll
                for (int ks = 0; ks < 4; ++ks) kf[hf][ks] = *(const bf16x8*)(kph + 32 * ks); }
            asm volatile("" ::: "memory");
            const char* vp = (const char*)Vb + (size_t)kvl * 1024 + (unsigned)(lane * 1024);
#pragma unroll
            for (int c = 0; c < 8; ++c) *(LAS u32x4*)(vl + lane * VST + 8 * c) = *(const u32x4*)(vp + 16 * c);
            asm volatile("" ::: "memory");
        }
#pragma unroll
        for (int qb = 0; qb < 2; ++qb) {
            f32x16 s[2];
#pragma unroll
            for (int hf = 0; hf < 2; ++hf) {
#pragma unroll
                for (int g4 = 0; g4 < 4; ++g4) { const f32x4 c4 = *(const f32x4*)((const char*)(Cb + kv0) + cof + (128 * hf + 32 * g4));
                    s[hf][4 * g4 + 0] = c4[0]; s[hf][4 * g4 + 1] = c4[1]; s[hf][4 * g4 + 2] = c4[2]; s[hf][4 * g4 + 3] = c4[3]; }
#pragma unroll
                for (int ks = 0; ks < 4; ++ks) s[hf] = __builtin_amdgcn_mfma_f32_32x32x16_bf16(kf[hf][ks], qf[qb][ks], s[hf], 0, 0, 0);
            }
            if (diag) { const int ql = 32 * qb + q32;
#pragma unroll
                for (int hf = 0; hf < 2; ++hf)
#pragma unroll
                    for (int r = 0; r < 16; ++r) if (32 * hf + crow(r, hi) > ql) s[hf][r] = -INFINITY; }
            float mx = -INFINITY;
#pragma unroll
            for (int r = 0; r < 16; ++r) mx = fmaxf(mx, fmaxf(s[0][r], s[1][r]));
            mx = fmaxf(mx, __shfl_xor(mx, 32));
            const float mn = fmaxf(mrun[qb], mx); const float al = __builtin_amdgcn_exp2f(mrun[qb] - mn); mrun[qb] = mn;
            float sum = 0.f;
#pragma unroll
            for (int hf = 0; hf < 2; ++hf)
#pragma unroll
                for (int r = 0; r < 16; ++r) { const float p = __builtin_amdgcn_exp2f(s[hf][r] - mn); s[hf][r] = p; sum += p; }
            lrun[qb] = lrun[qb] * al + sum;
#pragma unroll
            for (int db = 0; db < 2; ++db)
#pragma unroll
                for (int r = 0; r < 16; ++r) o[qb][db][r] *= al;
            bf16x8 pk[4];
#pragma unroll
            for (int k4 = 0; k4 < 4; ++k4) { const int hf = k4 >> 1, r0 = 8 * (k4 & 1); u32x4 wv;
                wv.x = pk2(s[hf][r0 + 0], s[hf][r0 + 1]); wv.y = pk2(s[hf][r0 + 2], s[hf][r0 + 3]); wv.z = pk2(s[hf][r0 + 4], s[hf][r0 + 5]); wv.w = pk2(s[hf][r0 + 6], s[hf][r0 + 7]);
                pk[k4] = __builtin_bit_cast(bf16x8, wv); }
            asm volatile("s_waitcnt lgkmcnt(0)" ::: "memory");
#pragma unroll
            for (int db = 0; db < 2; ++db)
#pragma unroll
                for (int k4 = 0; k4 < 4; ++k4) {
                    const LAS bf16_t* p0 = vl + troff + (16 * k4) * VST + 32 * db;
                    const s16x4 lo = __builtin_bit_cast(s16x4, __builtin_amdgcn_ds_read_tr16_b64_v4i16((LAS s16x4*)p0));
                    const s16x4 hh = __builtin_bit_cast(s16x4, __builtin_amdgcn_ds_read_tr16_b64_v4i16((LAS s16x4*)(p0 + 8 * VST)));
                    const bf16x8 vt = (bf16x8){lo[0], lo[1], lo[2], lo[3], hh[0], hh[1], hh[2], hh[3]};
                    o[qb][db] = __builtin_amdgcn_mfma_f32_32x32x16_bf16(vt, pk[k4], o[qb][db], 0, 0, 0);
                }
        }
        asm volatile("s_waitcnt lgkmcnt(0)" ::: "memory");
    }
#pragma unroll
    for (int qb = 0; qb < 2; ++qb) { lrun[qb] += __shfl_xor(lrun[qb], 32); if (hi == 0) mb[w * 64 + 32 * qb + q32] = mrun[qb]; }
    __syncthreads();
#pragma unroll
    for (int qb = 0; qb < 2; ++qb) {
        const int q = 32 * qb + q32; float mg = -INFINITY;
#pragma unroll
        for (int ww = 0; ww < NWAVES; ++ww) mg = fmaxf(mg, mb[ww * 64 + q]);
        const float sc = __builtin_amdgcn_exp2f(mrun[qb] - mg);
        if (w < ntiles) {
            if (hi == 0) __hip_atomic_fetch_add(lt + q, lrun[qb] * sc, __ATOMIC_RELAXED, __HIP_MEMORY_SCOPE_WORKGROUP);
#pragma unroll
            for (int db = 0; db < 2; ++db)
#pragma unroll
                for (int r = 0; r < 16; ++r) __hip_atomic_fetch_add(ot + q * 65 + 32 * db + crow(r, hi), o[qb][db][r] * sc, __ATOMIC_RELAXED, __HIP_MEMORY_SCOPE_WORKGROUP);
        }
    }
    __syncthreads();
    { const int q = tidl >> 3, d0 = 8 * (tidl & 7); const float il = 1.0f / lt[q]; const LAS float* op = ot + q * 65 + d0;
      u32x4 wv; wv.x = pk2(op[0] * il, op[1] * il); wv.y = pk2(op[2] * il, op[3] * il); wv.z = pk2(op[4] * il, op[5] * il); wv.w = pk2(op[6] * il, op[7] * il);
      *(u32x4*)((bf16_t*)(a.ws + WS_YB) + (size_t)(rowq0 + q) * 512 + 64 * h + d0) = wv; }
    __syncthreads();
}
constexpr int N_PHASES = 13;
#ifndef MK_PER_PHASE
#define MK_PER_PHASE 0
#endif
template <class Epi> __device__ __forceinline__ void run_gemm(const Frame& F, const bf16_t* A, const bf16_t* Bt, int N, int K, const Epi& E) {
    pg8::Gemm g{A, Bt, MT, N, K}; pg8::StaticOrder S; S.init(MT, N, F.G, F.bid);
    pg8::gemm_phase<Epi, pg8::StaticOrder, true, true>(F.lds, g, S, E);
}
__global__ void __launch_bounds__(NTHR, 2) mega_fwd(Args a) {
    __builtin_assume(__builtin_amdgcn_workitem_id_y() == 0); __builtin_assume(__builtin_amdgcn_workitem_id_z() == 0);
    extern __shared__ __attribute__((aligned(16))) unsigned char lds_raw[];
    cg::grid_group grid = cg::this_grid();
    Frame F; F.lds = (LAS unsigned char*)lds_raw; F.tid = threadIdx.x; F.lane = F.tid & 63; F.wave = __builtin_amdgcn_readfirstlane(F.tid >> 6); F.G = gridDim.x; F.bid = blockIdx.x;
    unsigned char* ws = a.ws;
    LAS int* sh_item = (LAS int*)(F.lds + 131072);
    const int lo = a.ph_lo, hi = a.ph_hi;
#define IN(k) (lo <= (k) && (k) < hi)
#define SEAM(k) do { if (IN(k) && IN((k) + 1)) grid.sync(); } while (0)
    if (IN(0)) { p0_prologue(F, a); } SEAM(0);
    if (IN(1)) { pg8::EpiSwiGLU E{(bf16_t*)(ws + WS_H)}; run_gemm(F, (const bf16_t*)(ws + WS_XB), (const bf16_t*)(ws + WS_W1U), NUP, DM, E); } SEAM(1);
    if (IN(2)) { pg8::EpiRes E{a.x_p, a.x_s, (float*)(ws + WS_Z), 0.5f}; run_gemm(F, (const bf16_t*)(ws + WS_H), (const bf16_t*)(ws + WS_W1D), DM, DFF, E); } SEAM(2);
    if (IN(3)) { ln_pass(F, (const float*)(ws + WS_Z), a.ln1g, a.ln1b, (float*)(ws + WS_HF1), (bf16_t*)(ws + WS_HB)); } SEAM(3);
    if (IN(4)) {
        pg8::EpiWin E{a.out, (bf16_t*)(ws + WS_QA), (bf16_t*)(ws + WS_IQ), (bf16_t*)(ws + WS_QB), (bf16_t*)(ws + WS_KAP), (bf16_t*)(ws + WS_VAP), (bf16_t*)(ws + WS_IKP), (bf16_t*)(ws + WS_KBP), (bf16_t*)(ws + WS_VBP),
                      (bf16_t*)(ws + WS_KAS), (bf16_t*)(ws + WS_VAS), (bf16_t*)(ws + WS_IKS), (bf16_t*)(ws + WS_KBS), (bf16_t*)(ws + WS_VBS), (bf16_t*)(ws + WS_G), (float*)(ws + WS_IW), (float*)(ws + WS_LF),
                      (const pg8::f32x2*)(ws + WS_ROPE), a.b_f, a.b_gate};
        run_gemm(F, (const bf16_t*)(ws + WS_HB), (const bf16_t*)(ws + WS_WIN), NINP, DM, E);
    } SEAM(4);
    if (IN(5)) {
        if (F.bid < NB + DB) cumsum_block(F, a, F.bid);
        unsigned* ctr = (unsigned*)(ws + WS_CTL);
        for (;;) { if (F.tid == 0) *sh_item = (int)atomicAdd(ctr, 1u); __syncthreads(); const int item = *sh_item; __syncthreads(); if (item >= 1152) break; indexer_item(F, a, item); }
    } SEAM(5);
    if (IN(6)) {
        unsigned* ctr = (unsigned*)(ws + WS_CTL) + 64;
        for (;;) { if (F.tid == 0) *sh_item = (int)atomicAdd(ctr, 1u); __syncthreads(); const int item = *sh_item; __syncthreads();
            if (item >= 2304 + MT / 64) break;
            if (item < 2304) fox_unit(F, a, item);
            else { const int r0 = (item - 2304) * 64; for (int i = 0; i < 8; ++i) dsa_query(F, a, r0 + 8 * i + F.wave); } }
    } SEAM(6);
    if (IN(7)) {
        pg8::EpiProjA EA{(const bf16_t*)(ws + WS_G), (float*)(ws + WS_MM)}; run_gemm(F, (const bf16_t*)(ws + WS_YA), (const bf16_t*)(ws + WS_WPA), DM, 512, EA);
        pg8::EpiProjB EB{(const bf16_t*)(ws + WS_G), (const float*)(ws + WS_MM), (bf16_t*)(ws + WS_MMB)}; run_gemm(F, (const bf16_t*)(ws + WS_YB), (const bf16_t*)(ws + WS_WPB), DM, 512, EB);
    } SEAM(7);
    if (IN(8)) { pg8::EpiRes E{(const float*)(ws + WS_HF1), (const float*)(ws + WS_HF1) + (size_t)MP * DM, (float*)(ws + WS_Z), 1.0f}; run_gemm(F, (const bf16_t*)(ws + WS_MMB), (const bf16_t*)(ws + WS_WO), DM, DM, E); } SEAM(8);
    if (IN(9)) { ln_pass(F, (const float*)(ws + WS_Z), a.ln2g, a.ln2b, (float*)(ws + WS_HF2), (bf16_t*)(ws + WS_HB)); } SEAM(9);
    if (IN(10)) { pg8::EpiSwiGLU E{(bf16_t*)(ws + WS_H)}; run_gemm(F, (const bf16_t*)(ws + WS_HB), (const bf16_t*)(ws + WS_W2U), NUP, DM, E); } SEAM(10);
    if (IN(11)) { pg8::EpiRes E{(const float*)(ws + WS_HF2), (const float*)(ws + WS_HF2) + (size_t)MP * DM, (float*)(ws + WS_Z), 0.5f}; run_gemm(F, (const bf16_t*)(ws + WS_H), (const bf16_t*)(ws + WS_W2D), DM, DFF, E); } SEAM(11);
    if (IN(12)) { ln_pass(F, (const float*)(ws + WS_Z), a.ln3g, a.ln3b, a.out + O_Y, nullptr); }
#undef IN
#undef SEAM
}

extern "C" void kernel_launch(void* const* d_in, const int* in_sizes, int n_in, void* d_out, int out_size, void* d_ws, size_t ws_size, hipStream_t stream) {
    static int grid = 0;
    if (grid == 0) {
        if (n_in != 24 || ws_size < WS_END) { fprintf(stderr, "kernel_launch: expected 24 inputs and >= %zu bytes of workspace (got %d, %zu)\n", (size_t)WS_END, n_in, ws_size); grid = -1; return; }
        int dev = 0, cus = 0, per_cu = 0;
        hipGetDevice(&dev); hipDeviceGetAttribute(&cus, hipDeviceAttributeMultiprocessorCount, dev);
        if (hipFuncSetAttribute((const void*)mega_fwd, hipFuncAttributeMaxDynamicSharedMemorySize, LDS_BYTES) != hipSuccess) { fprintf(stderr, "kernel_launch: hipFuncSetAttribute failed\n"); grid = -1; return; }
        hipOccupancyMaxActiveBlocksPerMultiprocessor(&per_cu, (const void*)mega_fwd, NTHR, LDS_BYTES);
        (void)hipGetLastError();
        if (per_cu < 1) { fprintf(stderr, "kernel_launch: occupancy query says %d blocks per CU\n", per_cu); per_cu = 1; }
        grid = cus;
    }
    if (grid < 0) return;
    Args a{};
    const float** p = (const float**)&a;
    for (int i = 0; i < 24; ++i) p[i] = (const float*)d_in[i];
    a.out = (float*)d_out; a.ws = (unsigned char*)d_ws;
    for (int j = 0; j < 32; ++j) a.invf[j] = pow(10000.0, -(double)j / 32.0);
#if MK_PER_PHASE
    for (int ph = 0; ph < N_PHASES; ++ph) { a.ph_lo = ph; a.ph_hi = ph + 1; void* args[] = {&a};
        hipError_t e = hipLaunchCooperativeKernel((const void*)mega_fwd, dim3(grid), dim3(NTHR), args, LDS_BYTES, stream);
        if (e != hipSuccess) { fprintf(stderr, "launch of phase %d failed: %s\n", ph, hipGetErrorString(e)); break; } }
#else
    a.ph_lo = 0; a.ph_hi = N_PHASES; void* args[] = {&a};
    hipError_t e = hipLaunchCooperativeKernel((const void*)mega_fwd, dim3(grid), dim3(NTHR), args, LDS_BYTES, stream);
    if (e != hipSuccess) fprintf(stderr, "cooperative launch failed: %s (grid %d)\n", hipGetErrorString(e), grid);
#endif
}
```

```cpp
#include <hip/hip_runtime.h>
#include <hip/hip_cooperative_groups.h>
#include <cstdio>
#include <cstdint>
#include <cmath>
namespace cg = cooperative_groups;

constexpr int DM = 1024, SEQ = 8192, NB = 2, DB = 32, DS = 64, PAST = 4096, SKV = PAST + DS  ;
constexpr int MP = NB * SEQ  , MS = DB * DS  , MT = MP + MS  ;
constexpr int DFF = 2816, NUP = 2 * DFF, NIN = 4944, NINP = 5120;
constexpr float ALPHA = 1.189207115002721f;
constexpr float LN_EPS = 1e-5f;
constexpr float LOG2E = 1.4426950408889634f;
constexpr float QSCALE = 0.125f * LOG2E;
constexpr float IWSCALE = 0.35355339059327373f * 0.125f;
constexpr size_t O_Y = 0, O_PAK = 18874368, O_PAV = 20971520, O_PIK = 23068672, O_PBK = 24117248, O_PBV = 32505856, O_PLF = 40894464,
                 O_SAK = 41025536, O_SAV = 41287680, O_SIK = 41549824, O_SBK = 41680896, O_SBV = 42729472, O_SLF = 43778048;
#define MK_PER_PHASE 0
namespace pg8 {
#define PG8_LAS __attribute__((address_space(3)))
typedef unsigned short bf16_t;
typedef short bf16x8 __attribute__((ext_vector_type(8)));
typedef float f32x4 __attribute__((ext_vector_type(4)));
typedef unsigned u32x4 __attribute__((ext_vector_type(4)));
constexpr int BM = 256, BK = 64, HALF = 128, HTB = HALF * BK * 2  , STAGE_BYTES = 8 * HTB, NXCD = 8, WGM = 8;

__host__ __device__ __forceinline__ int lds_byte(int r, int c) { const int st = (r >> 4) * 2 + (c >> 5), rr = r & 15, cc = c & 31, ob = rr * 64 + cc * 2; return st * 1024 + (ob ^ (((ob >> 9) & 1) << 5)); }
__host__ __device__ __forceinline__ void stage_rc(int b, int& R, int& C) { const int st = b / 1024, sb = b % 1024, swz = sb ^ (((sb >> 9) & 1) << 5); R = (st >> 1) * 16 + swz / 64; C = (st & 1) * 32 + (swz % 64) / 2; }
__host__ __device__ __forceinline__ int perm32(int rho) { const int n = rho >> 4, i = rho & 15; return 8 * (i >> 2) + 4 * n + (i & 3); }

struct Unit { int pm, pn; };
struct Gemm { const bf16_t* A; const bf16_t* Bt; int M, N, K; };

struct StaticOrder {
    int nM, nN, nwg, G, c;
    __host__ __device__ void init(int M, int N, int G_, int c_) { nM = M / BM; nN = N / BM; nwg = nM * nN; G = G_; c = c_; }
    __host__ __device__ bool next(int i, Unit& u) const {
        const long L = (long)i * G + c; if (L >= nwg) return false;
        int wgid = (int)L; { const int q = nwg / NXCD, r = nwg % NXCD, xcd = wgid % NXCD, off = wgid / NXCD; wgid = (xcd < r ? xcd * (q + 1) : r * (q + 1) + (xcd - r) * q) + off; }
        const int nig = WGM * nN, gid = wgid / nig, fm = gid * WGM, gsz = (nM - fm) < WGM ? (nM - fm) : WGM;
        u.pm = fm + ((wgid % nig) % gsz); u.pn = (wgid % nig) / gsz; return true;
    }
    __device__ __forceinline__ void a_ready(const Unit&) const {}
    __device__ __forceinline__ void done(const Unit&) const {}
};

__device__ __forceinline__ unsigned cvt_pk_bf16(float lo, float hi) { unsigned r; asm volatile("v_cvt_pk_bf16_f32 %0, %1, %2" : "=v"(r) : "v"(lo), "v"(hi)); return r; }
typedef float f32x2 __attribute__((ext_vector_type(2)));
typedef unsigned u32x2 __attribute__((ext_vector_type(2)));
typedef float f32x2 __attribute__((ext_vector_type(2)));
__device__ __forceinline__ float bf2f(unsigned short b) { return __uint_as_float((unsigned)b << 16); }
__device__ __forceinline__ float fsigmoid(float x) { return __builtin_amdgcn_rcpf(1.0f + __builtin_amdgcn_exp2f(-x * LOG2E)); }
__device__ __forceinline__ float flogsig(float x) {
    const float e = __builtin_amdgcn_exp2f(-fabsf(x) * LOG2E);
    const float l1p = (e < 0.03125f) ? e * (1.0f - e * (0.5f - e * (0.33333333f - 0.25f * e))) : __logf(1.0f + e);
    return fminf(x, 0.f) - l1p;
}
__device__ __forceinline__ u32x2 pack4(f32x4 v) { u32x2 w; w.x = cvt_pk_bf16(v[0], v[1]); w.y = cvt_pk_bf16(v[2], v[3]); return w; }

struct EpiSwiGLU {
    static constexpr bool PERM = true, AFTER_DRAIN = false;
    bf16_t* H;
    __device__ __forceinline__ void operator()(const f32x4 (&acc)[2][2][4][2], const Unit& u, int wr, int wc, int fr, int fq) const {
        const int row0 = u.pm * BM + wr * 64 + fr, col0 = u.pn * 128 + wc * 32 + 8 * fq;
#pragma unroll
        for (int ai = 0; ai < 2; ++ai)
#pragma unroll
            for (int m = 0; m < 4; ++m) {
                bf16_t* rowp = H + (size_t)(row0 + ai * HALF + m * 16) * DFF + col0;
                f32x4 h[2];
#pragma unroll
                for (int n = 0; n < 2; ++n) { const f32x4 a = acc[ai][0][m][n], g = acc[ai][1][m][n];
#pragma unroll
                    for (int i = 0; i < 4; ++i) h[n][i] = a[i] * fsigmoid(a[i]) * g[i]; }
                u32x4 w; w.x = cvt_pk_bf16(h[0][0], h[0][1]); w.y = cvt_pk_bf16(h[0][2], h[0][3]); w.z = cvt_pk_bf16(h[1][0], h[1][1]); w.w = cvt_pk_bf16(h[1][2], h[1][3]);
                *(u32x4*)rowp = w;
            }
    }
};
struct EpiRes {
    static constexpr bool PERM = false, AFTER_DRAIN = false;
    const float* resP; const float* resS; float* Z; float s;
    __device__ __forceinline__ void operator()(const f32x4 (&acc)[2][2][4][2], const Unit& u, int wr, int wc, int fr, int fq) const {
        const int row0 = u.pm * BM + wr * 64 + fr, col0 = u.pn * BM + wc * 32 + 4 * fq;
        const float* rb = (u.pm < MP / BM) ? resP : (resS - (size_t)MP * DM);
#pragma unroll
        for (int ai = 0; ai < 2; ++ai)
#pragma unroll
            for (int m = 0; m < 4; ++m) { const size_t off = (size_t)(row0 + ai * HALF + m * 16) * DM + col0;
#pragma unroll
                for (int bj = 0; bj < 2; ++bj)
#pragma unroll
                    for (int n = 0; n < 2; ++n) { const f32x4 r = *(const f32x4*)(rb + off + bj * HALF + n * 16);
                        *(f32x4*)(Z + off + bj * HALF + n * 16) = r * ALPHA + acc[ai][bj][m][n] * s; } }
    }
};
struct EpiProjA {
    static constexpr bool PERM = false, AFTER_DRAIN = false;
    const bf16_t* G; float* MM;
    __device__ __forceinline__ void operator()(const f32x4 (&acc)[2][2][4][2], const Unit& u, int wr, int wc, int fr, int fq) const {
        const int row0 = u.pm * BM + wr * 64 + fr, col0 = u.pn * BM + wc * 32 + 4 * fq;
#pragma unroll
        for (int ai = 0; ai < 2; ++ai)
#pragma unroll
            for (int m = 0; m < 4; ++m) { const size_t row = (size_t)(row0 + ai * HALF + m * 16);
#pragma unroll
                for (int bj = 0; bj < 2; ++bj)
#pragma unroll
                    for (int n = 0; n < 2; ++n) { const int c = col0 + bj * HALF + n * 16; const u32x2 g = *(const u32x2*)(G + row * 2048 + c);
                        f32x4 gv; gv[0] = __uint_as_float(g.x << 16); gv[1] = __uint_as_float(g.x & 0xffff0000u); gv[2] = __uint_as_float(g.y << 16); gv[3] = __uint_as_float(g.y & 0xffff0000u);
                        *(f32x4*)(MM + row * DM + c) = gv * acc[ai][bj][m][n]; } }
    }
};
struct EpiProjB {
    static constexpr bool PERM = false, AFTER_DRAIN = false;
    const bf16_t* G; const float* MM; bf16_t* MMb;
    __device__ __forceinline__ void operator()(const f32x4 (&acc)[2][2][4][2], const Unit& u, int wr, int wc, int fr, int fq) const {
        const int row0 = u.pm * BM + wr * 64 + fr, col0 = u.pn * BM + wc * 32 + 4 * fq;
#pragma unroll
        for (int ai = 0; ai < 2; ++ai)
#pragma unroll
            for (int m = 0; m < 4; ++m) { const size_t row = (size_t)(row0 + ai * HALF + m * 16);
#pragma unroll
                for (int bj = 0; bj < 2; ++bj)
#pragma unroll
                    for (int n = 0; n < 2; ++n) { const int c = col0 + bj * HALF + n * 16; const u32x2 g = *(const u32x2*)(G + row * 2048 + 1024 + c);
                        f32x4 gv; gv[0] = __uint_as_float(g.x << 16); gv[1] = __uint_as_float(g.x & 0xffff0000u); gv[2] = __uint_as_float(g.y << 16); gv[3] = __uint_as_float(g.y & 0xffff0000u);
                        const f32x4 mm = *(const f32x4*)(MM + row * DM + c);
                        *(u32x2*)(MMb + row * DM + c) = pack4(mm + gv * acc[ai][bj][m][n]); } }
    }
};
struct EpiWin {
    static constexpr bool PERM = false, AFTER_DRAIN = false;
    float* out; bf16_t *QA, *IQ, *QB, *KAp, *VAp, *IKp, *KBp, *VBp, *KAs, *VAs, *IKs, *KBs, *VBs, *G; float *IW, *LF; const f32x2* rope; const float* b_f; const float* b_gate;
    __device__ __forceinline__ void operator()(const f32x4 (&acc)[2][2][4][2], const Unit& u, int wr, int wc, int fr, int fq) const {
        const int T = u.pn; const bool samp = u.pm >= MP / BM;
#pragma unroll
        for (int ai = 0; ai < 2; ++ai)
#pragma unroll
            for (int m = 0; m < 4; ++m) {
                const int row = u.pm * BM + ai * HALF + wr * 64 + m * 16 + fr; const int rs = row - MP;
                const int pos = samp ? PAST + (rs & 63) : (row & (SEQ - 1));
                const size_t srow = samp ? ((size_t)(rs >> 6) * SKV + PAST + (rs & 63)) : (size_t)row;
                if (T == 0 || T == 1 || T == 3 || T == 4) {
                    bf16_t* dst = (T < 2) ? QA + (size_t)row * 512 + 256 * T : IQ + (size_t)row * 512 + 256 * (T - 3);
                    const float sc = (T < 2) ? QSCALE : 1.0f;
#pragma unroll
                    for (int n = 0; n < 2; ++n) { const int j0 = 16 * n + 4 * fq; const f32x4 x1 = acc[ai][0][m][n], x2 = acc[ai][1][m][n]; f32x4 o1, o2;
#pragma unroll
                        for (int i = 0; i < 4; ++i) { const f32x2 cs = rope[pos * 32 + j0 + i]; o1[i] = (x1[i] * cs.x - x2[i] * cs.y) * sc; o2[i] = (x2[i] * cs.x + x1[i] * cs.y) * sc; }
                        *(u32x2*)(dst + 64 * wc + j0) = pack4(o1); *(u32x2*)(dst + 64 * wc + 32 + j0) = pack4(o2); }
                } else if (T == 2) {
                    if (wc < 2) {
                        float* kf = out + (samp ? O_SAK + (size_t)rs * 128 : O_PAK + (size_t)row * 128) + 64 * wc; bf16_t* kb = (samp ? KAs : KAp) + srow * 128 + 64 * wc;
#pragma unroll
                        for (int n = 0; n < 2; ++n) { const int j0 = 16 * n + 4 * fq; const f32x4 x1 = acc[ai][0][m][n], x2 = acc[ai][1][m][n]; f32x4 o1, o2;
#pragma unroll
                            for (int i = 0; i < 4; ++i) { const f32x2 cs = rope[pos * 32 + j0 + i]; o1[i] = x1[i] * cs.x - x2[i] * cs.y; o2[i] = x2[i] * cs.x + x1[i] * cs.y; }
                            *(f32x4*)(kf + j0) = o1; *(f32x4*)(kf + 32 + j0) = o2; *(u32x2*)(kb + j0) = pack4(o1); *(u32x2*)(kb + 32 + j0) = pack4(o2); }
                    } else {
                        float* vf = out + (samp ? O_SAV + (size_t)rs * 128 : O_PAV + (size_t)row * 128); bf16_t* vb = (samp ? VAs : VAp) + srow * 128;
#pragma unroll
                        for (int bj = 0; bj < 2; ++bj)
#pragma unroll
                            for (int n = 0; n < 2; ++n) { const int c = 64 * bj + 32 * (wc - 2) + 16 * n + 4 * fq; *(f32x4*)(vf + c) = acc[ai][bj][m][n]; *(u32x2*)(vb + c) = pack4(acc[ai][bj][m][n]); }
                    }
                } else if (T == 5) {
                    if (wc == 0) {
                        float* kf = out + (samp ? O_SIK + (size_t)rs * 64 : O_PIK + (size_t)row * 64); bf16_t* kb = (samp ? IKs : IKp) + srow * 64;
#pragma unroll
                        for (int n = 0; n < 2; ++n) { const int j0 = 16 * n + 4 * fq; const f32x4 x1 = acc[ai][0][m][n], x2 = acc[ai][1][m][n]; f32x4 o1, o2;
#pragma unroll
                            for (int i = 0; i < 4; ++i) { const f32x2 cs = rope[pos * 32 + j0 + i]; o1[i] = x1[i] * cs.x - x2[i] * cs.y; o2[i] = x2[i] * cs.x + x1[i] * cs.y; }
                            *(f32x4*)(kf + j0) = o1; *(f32x4*)(kf + 32 + j0) = o2; *(u32x2*)(kb + j0) = pack4(o1); *(u32x2*)(kb + 32 + j0) = pack4(o2); }
                    } else if (wc == 1) {
                        const f32x4 v = acc[ai][0][m][0];
                        if (fq < 2) { *(f32x4*)(IW + (size_t)row * 8 + 4 * fq) = v * IWSCALE; }
                        else { const int i0 = 4 * (fq - 2); f32x4 lf;
#pragma unroll
                            for (int i = 0; i < 4; ++i) lf[i] = flogsig(v[i] + b_f[i0 + i]);
                            *(f32x4*)(out + (samp ? O_SLF + (size_t)rs * 8 : O_PLF + (size_t)row * 8) + i0) = lf; *(f32x4*)(LF + (size_t)row * 8 + i0) = lf; }
                    }
                } else if (T < 8) {
                    bf16_t* dst = QB + (size_t)row * 512 + 256 * (T - 6) + 32 * wc + 4 * fq;
#pragma unroll
                    for (int bj = 0; bj < 2; ++bj)
#pragma unroll
                        for (int n = 0; n < 2; ++n) *(u32x2*)(dst + 128 * bj + 16 * n) = pack4(acc[ai][bj][m][n] * QSCALE);
                } else if (T < 12) {
                    const bool isv = T >= 10; const int c0 = 256 * ((T - 8) & 1) + 32 * wc + 4 * fq;
                    float* df = out + (isv ? (samp ? O_SBV + (size_t)rs * 512 : O_PBV + (size_t)row * 512) : (samp ? O_SBK + (size_t)rs * 512 : O_PBK + (size_t)row * 512)) + c0;
                    bf16_t* db = (isv ? (samp ? VBs + (size_t)rs * 512 : VBp + (size_t)row * 512) : (samp ? KBs + (size_t)rs * 512 : KBp + (size_t)row * 512)) + c0;
#pragma unroll
                    for (int bj = 0; bj < 2; ++bj)
#pragma unroll
                        for (int n = 0; n < 2; ++n) { *(f32x4*)(df + 128 * bj + 16 * n) = acc[ai][bj][m][n]; *(u32x2*)(db + 128 * bj + 16 * n) = pack4(acc[ai][bj][m][n]); }
                } else {
                    const int c0 = 256 * (T - 12) + 32 * wc + 4 * fq; bf16_t* dst = G + (size_t)row * 2048 + c0;
#pragma unroll
                    for (int bj = 0; bj < 2; ++bj)
#pragma unroll
                        for (int n = 0; n < 2; ++n) { const f32x4 bg = *(const f32x4*)(b_gate + c0 + 128 * bj + 16 * n); f32x4 g;
#pragma unroll
                            for (int i = 0; i < 4; ++i) g[i] = fsigmoid(acc[ai][bj][m][n][i] + bg[i]);
                            *(u32x2*)(dst + 128 * bj + 16 * n) = pack4(g); }
                }
            }
    }
};
template <class Epi, class Sched, bool ALIGN_EPI = false, bool SP2 = false>
__device__ __forceinline__ void gemm_phase(PG8_LAS unsigned char* lds, const Gemm g, const Sched& S, const Epi& E) {
    const int tid = threadIdx.x, wid = __builtin_amdgcn_readfirstlane(tid >> 6), lane = tid & 63, wr = wid >> 2, wc = wid & 3, fr = lane & 15, fq = lane >> 4;
    const int K = g.K, nt = K / BK;
    unsigned voffA[2], voffB[2];
#pragma unroll
    for (int i = 0; i < 2; ++i) { int R, C; stage_rc(tid * 16 + i * 8192, R, C); const int Rb = Epi::PERM ? ((R & ~31) + perm32(R & 31)) : R;
        voffA[i] = (unsigned)(R * K + C) * 2u; voffB[i] = (unsigned)(Rb * K + C) * 2u; }
    const size_t kstep = (size_t)(BK * 2);
    const size_t hstep = (size_t)HALF * K * 2;
    const size_t tstep = 2 * hstep;
    const unsigned ldsw = (unsigned)wid * 1024u;
    const int aoff = lds_byte(wr * 64 + fr, fq * 8), boff = lds_byte(wc * 32 + fr, fq * 8);
#define PG8_SA(b, h) (((b) * 2 + (h)) * HTB)
#define PG8_SB(b, h) ((4 + (b) * 2 + (h)) * HTB)
#define PG8_STAGE(bufoff, gbase, voff) do { _Pragma("unroll") for (int _i = 0; _i < 2; ++_i) \
        __builtin_amdgcn_global_load_lds((const unsigned*)((const char*)(gbase) + (voff)[_i]), (PG8_LAS unsigned*)(lds + (bufoff) + ldsw + _i * 8192), 16, 0, 0); } while (0)
#define PG8_LDA(dst, b, h) do { _Pragma("unroll") for (int m = 0; m < 4; ++m) _Pragma("unroll") for (int k = 0; k < 2; ++k) dst[m][k] = *(const PG8_LAS bf16x8*)(lds + PG8_SA(b, h) + aoff + m * 2048 + k * 1024); } while (0)
#define PG8_LDB(dst, b, h) do { _Pragma("unroll") for (int n = 0; n < 2; ++n) _Pragma("unroll") for (int k = 0; k < 2; ++k) dst[n][k] = *(const PG8_LAS bf16x8*)(lds + PG8_SB(b, h) + boff + n * 2048 + k * 1024); } while (0)
#define PG8_MMA(ai, bj, At, Bt) do { __builtin_amdgcn_s_setprio(1); _Pragma("unroll") for (int m = 0; m < 4; ++m) _Pragma("unroll") for (int n = 0; n < 2; ++n) _Pragma("unroll") for (int k = 0; k < 2; ++k) \
        acc[ai][bj][m][n] = __builtin_amdgcn_mfma_f32_16x16x32_bf16(Bt[n][k], At[m][k], acc[ai][bj][m][n], 0, 0, 0); __builtin_amdgcn_s_setprio(0); } while (0)
#define PG8_WAIT_V(n) asm volatile("s_waitcnt vmcnt(" #n ")" ::: "memory")
#define PG8_WAIT_L(n) asm volatile("s_waitcnt lgkmcnt(" #n ")" ::: "memory")
#define PG8_BAR __builtin_amdgcn_s_barrier()
#define PG8_SCHED __builtin_amdgcn_sched_barrier(0)
    Unit cur, nxt; int ui = 0;
    if (!S.next(0, cur)) return;
    f32x4 acc[2][2][4][2];
#pragma unroll
    for (int a = 0; a < 2; ++a)
#pragma unroll
        for (int b = 0; b < 2; ++b)
#pragma unroll
            for (int m = 0; m < 4; ++m)
#pragma unroll
                for (int n = 0; n < 2; ++n) acc[a][b][m][n] = (f32x4){0.f, 0.f, 0.f, 0.f};
    bf16x8 At[4][2], B0[2][2], B1[2][2];
    const char* cA = (const char*)g.A + (size_t)cur.pm * tstep; const char* cB = (const char*)g.Bt + (size_t)cur.pn * tstep;
    S.a_ready(cur);
    if constexpr (SP2) {
        PG8_STAGE(PG8_SB(0, 0), cB, voffB); PG8_STAGE(PG8_SB(0, 1), cB + hstep, voffB); PG8_STAGE(PG8_SA(0, 0), cA, voffA); PG8_STAGE(PG8_SA(0, 1), cA + hstep, voffA);
        if (wr == 1) PG8_BAR;
        PG8_WAIT_V(2); PG8_BAR;
        PG8_STAGE(PG8_SB(1, 0), cB + kstep, voffB); PG8_STAGE(PG8_SA(1, 0), cA + kstep, voffA); PG8_STAGE(PG8_SB(1, 1), cB + hstep + kstep, voffB);
        PG8_WAIT_V(6); PG8_BAR;
    } else {
        PG8_STAGE(PG8_SB(0, 0), cB, voffB); PG8_STAGE(PG8_SA(0, 0), cA, voffA); PG8_STAGE(PG8_SB(0, 1), cB + hstep, voffB); PG8_STAGE(PG8_SA(0, 1), cA + hstep, voffA);
        if (wr == 1) PG8_BAR;
        PG8_WAIT_V(4); PG8_BAR;
        PG8_STAGE(PG8_SB(1, 0), cB + kstep, voffB); PG8_STAGE(PG8_SA(1, 0), cA + kstep, voffA); PG8_STAGE(PG8_SB(1, 1), cB + hstep + kstep, voffB);
        PG8_WAIT_V(6); PG8_BAR;
    }
    for (;;) {
        const bool has_next = S.next(ui + 1, nxt);
        const char* nA = has_next ? (const char*)g.A + (size_t)nxt.pm * tstep : cA; const char* nB = has_next ? (const char*)g.Bt + (size_t)nxt.pn * tstep : cB;
        for (int t = 0; t < nt; t += 2) {
            const bool last = (t == nt - 2);
            const char* a1 = cA + (size_t)(t + 1) * kstep;
            const char* a2 = last ? nA : cA + (size_t)(t + 2) * kstep; const char* b2 = last ? nB : cB + (size_t)(t + 2) * kstep;
            const char* a3 = a2 + kstep; const char* b3 = b2 + kstep;
            if (last && has_next) S.a_ready(nxt);
            if constexpr (SP2) {
            PG8_LDB(B0, 0, 0); PG8_LDB(B1, 0, 1); PG8_SCHED; PG8_LDA(At, 0, 0); PG8_STAGE(PG8_SA(1, 1), a1 + hstep, voffA);
            PG8_WAIT_V(8); PG8_WAIT_L(0); PG8_BAR; PG8_MMA(0, 0, At, B0); PG8_MMA(0, 1, At, B1); PG8_BAR; PG8_SCHED;
            PG8_LDA(At, 0, 1); PG8_STAGE(PG8_SB(0, 0), b2, voffB); PG8_STAGE(PG8_SB(0, 1), b2 + hstep, voffB); PG8_STAGE(PG8_SA(0, 0), a2, voffA);
            PG8_WAIT_V(8); PG8_WAIT_L(0); PG8_BAR; PG8_MMA(1, 0, At, B0); PG8_MMA(1, 1, At, B1); PG8_BAR; PG8_SCHED;
            PG8_LDB(B0, 1, 0); PG8_LDB(B1, 1, 1); PG8_SCHED; PG8_LDA(At, 1, 0); PG8_STAGE(PG8_SA(0, 1), a2 + hstep, voffA);
            PG8_WAIT_V(8); PG8_WAIT_L(0); PG8_BAR; PG8_MMA(0, 0, At, B0); PG8_MMA(0, 1, At, B1); PG8_BAR; PG8_SCHED;
            PG8_LDA(At, 1, 1); PG8_STAGE(PG8_SB(1, 0), b3, voffB); PG8_STAGE(PG8_SB(1, 1), b3 + hstep, voffB); PG8_STAGE(PG8_SA(1, 0), a3, voffA);
            PG8_WAIT_V(8); PG8_WAIT_L(0); PG8_BAR; PG8_MMA(1, 0, At, B0); PG8_MMA(1, 1, At, B1); PG8_BAR; PG8_SCHED;
            } else {
            PG8_LDB(B0, 0, 0); PG8_SCHED; PG8_LDA(At, 0, 0); PG8_STAGE(PG8_SA(1, 1), a1 + hstep, voffA);
            PG8_WAIT_L(8); PG8_BAR; PG8_WAIT_L(0); PG8_MMA(0, 0, At, B0); PG8_BAR; PG8_SCHED;
            PG8_LDB(B1, 0, 1); PG8_STAGE(PG8_SB(0, 0), b2, voffB);
            PG8_BAR; PG8_WAIT_L(0); PG8_MMA(0, 1, At, B1); PG8_BAR;
            PG8_LDA(At, 0, 1); PG8_STAGE(PG8_SA(0, 0), a2, voffA);
            PG8_BAR; PG8_WAIT_L(0); PG8_MMA(1, 0, At, B0); PG8_BAR; PG8_SCHED;
            PG8_STAGE(PG8_SB(0, 1), b2 + hstep, voffB);
            PG8_WAIT_V(6); PG8_BAR; PG8_MMA(1, 1, At, B1); PG8_BAR;
            PG8_LDB(B0, 1, 0); PG8_SCHED; PG8_LDA(At, 1, 0); PG8_STAGE(PG8_SA(0, 1), a2 + hstep, voffA);
            PG8_WAIT_L(8); PG8_BAR; PG8_WAIT_L(0); PG8_MMA(0, 0, At, B0); PG8_BAR; PG8_SCHED;
            PG8_LDB(B1, 1, 1); PG8_STAGE(PG8_SB(1, 0), b3, voffB);
            PG8_BAR; PG8_WAIT_L(0); PG8_MMA(0, 1, At, B1); PG8_BAR;
            PG8_LDA(At, 1, 1); PG8_STAGE(PG8_SA(1, 0), a3, voffA);
            PG8_BAR; PG8_WAIT_L(0); PG8_MMA(1, 0, At, B0); PG8_BAR; PG8_SCHED;
            PG8_STAGE(PG8_SB(1, 1), b3 + hstep, voffB);
            PG8_WAIT_V(6); PG8_BAR; PG8_MMA(1, 1, At, B1); PG8_BAR;
            }
        }
        if constexpr (ALIGN_EPI) { if (wr == 0) PG8_BAR; }
        if constexpr (!Epi::AFTER_DRAIN) { E(acc, cur, wr, wc, fr, fq); S.done(cur); }
        if (!has_next) break;
#pragma unroll
        for (int a = 0; a < 2; ++a)
#pragma unroll
            for (int b = 0; b < 2; ++b)
#pragma unroll
                for (int m = 0; m < 4; ++m)
#pragma unroll
                    for (int n = 0; n < 2; ++n) acc[a][b][m][n] = (f32x4){0.f, 0.f, 0.f, 0.f};
        cur = nxt; cA = nA; cB = nB; ++ui;
        if constexpr (ALIGN_EPI) { if (wr == 1) PG8_BAR; }
    }
    PG8_WAIT_V(0);
    if constexpr (!ALIGN_EPI) { if (wr == 0) PG8_BAR; }
    PG8_BAR;
    if constexpr (Epi::AFTER_DRAIN) { E.fused(acc, cur, wr, wc, fr, fq, lds, wid, lane); S.done(cur); }
#undef PG8_SA
#undef PG8_SB
#undef PG8_STAGE
#undef PG8_LDA
#undef PG8_LDB
#undef PG8_MMA
#undef PG8_WAIT_V
#undef PG8_WAIT_L
#undef PG8_BAR
#undef PG8_SCHED
}
}
#define LAS __attribute__((address_space(3)))
typedef unsigned short bf16_t;
typedef short bf16x8 __attribute__((ext_vector_type(8)));
typedef short s16x4 __attribute__((ext_vector_type(4)));
typedef float f32x4 __attribute__((ext_vector_type(4)));
typedef float f32x2 __attribute__((ext_vector_type(2)));
typedef float f32x16 __attribute__((ext_vector_type(16)));
typedef unsigned u32x4 __attribute__((ext_vector_type(4)));
typedef unsigned u32x2 __attribute__((ext_vector_type(2)));
using pg8::cvt_pk_bf16; using pg8::bf2f;
constexpr int NWAVES = 8, NTHR = 512, LDS_BYTES = 147456;
constexpr size_t MiB = 1u << 20;
constexpr size_t WS_CTL = 0;
constexpr size_t WS_ROPE = 1 * MiB;
constexpr size_t WS_W1U = 4 * MiB, WS_W1D = 16 * MiB, WS_WIN = 22 * MiB, WS_WPA = 33 * MiB, WS_WPB = 34 * MiB, WS_WO = 35 * MiB, WS_W2U = 37 * MiB, WS_W2D = 49 * MiB;
constexpr size_t WS_XB = 56 * MiB;
constexpr size_t WS_H = 92 * MiB;
constexpr size_t WS_Z = 192 * MiB;
constexpr size_t WS_HF1 = 264 * MiB, WS_HF2 = 336 * MiB;
constexpr size_t WS_HB = 408 * MiB;
constexpr size_t WS_QA = 444 * MiB, WS_IQ = 462 * MiB, WS_QB = 480 * MiB;
constexpr size_t WS_KAP = 498 * MiB, WS_VAP = 502 * MiB, WS_IKP = 506 * MiB;
constexpr size_t WS_KBP = 508 * MiB, WS_VBP = 524 * MiB;
constexpr size_t WS_KAS = 540 * MiB, WS_VAS = 573 * MiB, WS_IKS = 606 * MiB;
constexpr size_t WS_KBS = 623 * MiB, WS_VBS = 625 * MiB;
constexpr size_t WS_IW = 627 * MiB, WS_LF = 628 * MiB;
constexpr size_t WS_CBP = 629 * MiB, WS_CBS = 630 * MiB;
constexpr size_t WS_G = 635 * MiB;
constexpr size_t WS_SEL = 707 * MiB;
constexpr size_t WS_YA = 725 * MiB, WS_YB = 743 * MiB;
constexpr size_t WS_MM = 761 * MiB;
constexpr size_t WS_MMB = 833 * MiB;
constexpr size_t WS_SCR = 869 * MiB;
constexpr size_t WS_END = 997 * MiB;

struct Args {
    const float *x_p, *x_s, *c_ak, *c_av, *c_aik, *c_bk, *c_bv, *c_blf, *w1u, *w1d, *ln1g, *ln1b, *win, *b_f, *b_gate, *wpa, *wpb, *wo, *ln2g, *ln2b, *w2u, *w2d, *ln3g, *ln3b;
    float* out; unsigned char* ws; double invf[32]; int ph_lo, ph_hi;
};
struct Frame { LAS unsigned char* lds; int tid, lane, wave, G, bid; };

__device__ __forceinline__ unsigned f2bf(float f) { unsigned u = __float_as_uint(f); return (u + 0x7fffu + ((u >> 16) & 1u)) >> 16; }
__device__ __forceinline__ unsigned pk2(float lo, float hi) { return cvt_pk_bf16(lo, hi); }
__device__ __forceinline__ float wave_sum(float v) {
#pragma unroll
    for (int o = 1; o < 64; o <<= 1) v += __shfl_xor(v, o);
    return v;
}
__host__ __device__ __forceinline__ int rope_src(int P) { return 64 * ((P & 127) >> 5) + (P & 31) + ((P >> 7) << 5); }
struct SrcId { __device__ __forceinline__ int operator()(int n) const { return n; } };
struct SrcUp { __device__ __forceinline__ int operator()(int n) const { const int t = n >> 8, p = n & 255; return (p < 128) ? 128 * t + p : DFF + 128 * t + (p - 128); } };
struct SrcWin { __device__ __forceinline__ int operator()(int n) const {
    const int T = n >> 8, P = n & 255, bj = P >> 7, q = P & 127;
    if (T < 2) return 256 * T + rope_src(P);
    if (T == 2) return (q < 64) ? 512 + 64 * (q >> 5) + (q & 31) + 32 * bj : 640 + 64 * bj + (q - 64);
    if (T < 5) return 768 + 256 * (T - 3) + rope_src(P);
    if (T == 5) { if (q < 32) return 1280 + q + 32 * bj; if (bj == 0 && q < 40) return 1344 + (q - 32); if (bj == 0 && q < 48) return 2888 + (q - 40); return -1; }
    if (T < 8) return 1352 + 256 * (T - 6) + P;
    if (T < 10) return 1864 + 256 * (T - 8) + P;
    if (T < 12) return 2376 + 256 * (T - 10) + P;
    return 2896 + 256 * (T - 12) + P; } };
template <class F> __device__ __forceinline__ void transpose_item(const float* W, int K, int N, int ND, bf16_t* WT, LAS float* scr, int item, int lane, F srcf) {
    const int nblk = ND / 32, kb = item / nblk, nb = item % nblk, k0 = 64 * kb, n0 = 32 * nb;
    const int sc = srcf(n0 + (lane & 31));
#pragma unroll 8
    for (int i = 0; i < 32; ++i) { const int kk = 2 * i + (lane >> 5); scr[kk * 33 + (lane & 31)] = (sc >= 0) ? W[(size_t)(k0 + kk) * N + sc] : 0.f; }
    asm volatile("s_waitcnt lgkmcnt(0)" ::: "memory");
    const int c = lane & 7;
#pragma unroll
    for (int j = 0; j < 4; ++j) { const int n = (lane >> 3) + 8 * j; const LAS float* s = scr + (8 * c) * 33 + n;
        u32x4 o; o.x = pk2(s[0 * 33], s[1 * 33]); o.y = pk2(s[2 * 33], s[3 * 33]); o.z = pk2(s[4 * 33], s[5 * 33]); o.w = pk2(s[6 * 33], s[7 * 33]);
        *(u32x4*)(WT + (size_t)(n0 + n) * K + k0 + 8 * c) = o; }
    asm volatile("s_waitcnt lgkmcnt(0)" ::: "memory");
}
__device__ __forceinline__ void cvt_rows(const float* src, bf16_t* dst, size_t n4, size_t per_src, size_t per_dst, size_t gt, size_t ngt) {
    for (size_t e = gt; e < n4; e += ngt) { const size_t b = e / per_src, r = e - b * per_src; const f32x4 v = *(const f32x4*)(src + 4 * e);
        u32x2 w; w.x = pk2(v[0], v[1]); w.y = pk2(v[2], v[3]); *(u32x2*)(dst + 4 * (b * per_dst + r)) = w; }
}
__device__ __forceinline__ void p0_prologue(const Frame& F, const Args& a) {
    unsigned char* ws = a.ws;
    if (F.bid == 0 && F.tid < 256) ((unsigned*)(ws + WS_CTL))[F.tid] = 0u;
    LAS float* scr = (LAS float*)(F.lds + F.wave * 16384);
    const int gw = F.bid * NWAVES + F.wave, NGW = F.G * NWAVES;
    constexpr int I_UP = 16 * (NUP / 32), I_DN = (DFF / 64) * 32, I_IN = 16 * (NINP / 32), I_P = 8 * 32, I_O = 16 * 32;
    constexpr int NIT = 2 * I_UP + 2 * I_DN + I_IN + 2 * I_P + I_O;
    for (int it = gw; it < NIT; it += NGW) {
        int r = it;
        if (r < I_UP) { transpose_item(a.w1u, DM, NUP, NUP, (bf16_t*)(ws + WS_W1U), scr, r, F.lane, SrcUp()); continue; } r -= I_UP;
        if (r < I_UP) { transpose_item(a.w2u, DM, NUP, NUP, (bf16_t*)(ws + WS_W2U), scr, r, F.lane, SrcUp()); continue; } r -= I_UP;
        if (r < I_DN) { transpose_item(a.w1d, DFF, DM, DM, (bf16_t*)(ws + WS_W1D), scr, r, F.lane, SrcId()); continue; } r -= I_DN;
        if (r < I_DN) { transpose_item(a.w2d, DFF, DM, DM, (bf16_t*)(ws + WS_W2D), scr, r, F.lane, SrcId()); continue; } r -= I_DN;
        if (r < I_IN) { transpose_item(a.win, DM, NIN, NINP, (bf16_t*)(ws + WS_WIN), scr, r, F.lane, SrcWin()); continue; } r -= I_IN;
        if (r < I_P) { transpose_item(a.wpa, 512, DM, DM, (bf16_t*)(ws + WS_WPA), scr, r, F.lane, SrcId()); continue; } r -= I_P;
        if (r < I_P) { transpose_item(a.wpb, 512, DM, DM, (bf16_t*)(ws + WS_WPB), scr, r, F.lane, SrcId()); continue; } r -= I_P;
        transpose_item(a.wo, DM, DM, DM, (bf16_t*)(ws + WS_WO), scr, r, F.lane, SrcId());
    }
    const size_t gt = (size_t)F.bid * NTHR + F.tid, ngt = (size_t)F.G * NTHR;
    cvt_rows(a.x_p, (bf16_t*)(ws + WS_XB), (size_t)MP * DM / 4, (size_t)MP * DM / 4, 0, gt, ngt);
    cvt_rows(a.x_s, (bf16_t*)(ws + WS_XB) + (size_t)MP * DM, (size_t)MS * DM / 4, (size_t)MS * DM / 4, 0, gt, ngt);
    cvt_rows(a.c_ak, (bf16_t*)(ws + WS_KAS), (size_t)DB * PAST * 32, (size_t)PAST * 32, (size_t)SKV * 32, gt, ngt);
    cvt_rows(a.c_av, (bf16_t*)(ws + WS_VAS), (size_t)DB * PAST * 32, (size_t)PAST * 32, (size_t)SKV * 32, gt, ngt);
    cvt_rows(a.c_aik, (bf16_t*)(ws + WS_IKS), (size_t)DB * PAST * 16, (size_t)PAST * 16, (size_t)SKV * 16, gt, ngt);
    f32x2* rope = (f32x2*)(ws + WS_ROPE);
    for (size_t e = gt; e < (size_t)SEQ * 32; e += ngt) {
        const int pos = (int)(e >> 5), j = (int)(e & 31); const double ang = (double)pos * a.invf[j];
        const double kq = __builtin_rint(ang * 0.63661977236758134308); double r = __builtin_fma(-kq, 1.57079632679489655800e+00, ang); r = __builtin_fma(-kq, 6.12323399573676603587e-17, r);
        const double r2 = r * r;
        const double sn = r * (1.0 + r2 * (-1.0 / 6 + r2 * (1.0 / 120 + r2 * (-1.0 / 5040 + r2 * (1.0 / 362880 + r2 * (-1.0 / 39916800 + r2 * (1.0 / 6227020800.0)))))));
        const double cn = 1.0 + r2 * (-0.5 + r2 * (1.0 / 24 + r2 * (-1.0 / 720 + r2 * (1.0 / 40320 + r2 * (-1.0 / 3628800 + r2 * (1.0 / 479001600.0))))));
        const int qd = ((int)(long long)kq) & 3; double s, c;
        if (qd == 0) { s = sn; c = cn; } else if (qd == 1) { s = cn; c = -sn; } else if (qd == 2) { s = -sn; c = -cn; } else { s = -cn; c = sn; }
        rope[e] = (f32x2){(float)c, (float)s};
    }
}
__device__ __forceinline__ void ln_pass(const Frame& F, const float* Z, const float* g, const float* b, float* of, bf16_t* ob) {
    const int gw = F.bid * NWAVES + F.wave, NGW = F.G * NWAVES;
    f32x4 gv[4], bv[4];
#pragma unroll
    for (int j = 0; j < 4; ++j) { gv[j] = *(const f32x4*)(g + 4 * F.lane + 256 * j); bv[j] = *(const f32x4*)(b + 4 * F.lane + 256 * j); }
    for (int row = gw; row < MT; row += NGW) {
        const f32x4* zr = (const f32x4*)(Z + (size_t)row * DM) + F.lane; f32x4 v[4]; float s = 0.f;
#pragma unroll
        for (int j = 0; j < 4; ++j) { v[j] = zr[64 * j]; s += (v[j][0] + v[j][1]) + (v[j][2] + v[j][3]); }
        const float mean = wave_sum(s) * (1.f / DM); float s2 = 0.f;
#pragma unroll
        for (int j = 0; j < 4; ++j) { v[j] = v[j] - mean; s2 += (v[j][0] * v[j][0] + v[j][1] * v[j][1]) + (v[j][2] * v[j][2] + v[j][3] * v[j][3]); }
        const float rstd = 1.f / sqrtf(wave_sum(s2) * (1.f / DM) + LN_EPS);
#pragma unroll
        for (int j = 0; j < 4; ++j) { const f32x4 y = v[j] * rstd * gv[j] + bv[j];
            *((f32x4*)(of + (size_t)row * DM) + F.lane + 64 * j) = y;
            if (ob) { u32x2 w; w.x = pk2(y[0], y[1]); w.y = pk2(y[2], y[3]); *((u32x2*)(ob + (size_t)row * DM) + F.lane + 64 * j) = w; } }
    }
}
__device__ __forceinline__ void cumsum_block(const Frame& F, const Args& a, int sb) {
    LAS float* tot = (LAS float*)F.lds;
    const int i = F.tid >> 3, h = F.tid & 7;
    const float* LF = (const float*)(a.ws + WS_LF);
    if (sb < NB) {
        const float* src = LF + ((size_t)sb * SEQ + 128 * i) * 8 + h; float s = 0.f;
        for (int t = 0; t < 128; ++t) s += src[t * 8];
        tot[i * 8 + h] = s; __syncthreads();
        float c = 0.f; for (int k = 0; k < i; ++k) c += tot[k * 8 + h];
        float* dst = (float*)(a.ws + WS_CBP) + ((size_t)sb * 8 + h) * SEQ + 128 * i;
        for (int t = 0; t < 128; ++t) { c += src[t * 8]; dst[t] = -c * LOG2E; }
    } else {
        const int b = sb - NB; const float* src = a.c_blf + ((size_t)b * PAST + 64 * i) * 8 + h; float s = 0.f;
        for (int t = 0; t < 64; ++t) s += src[t * 8];
        tot[i * 8 + h] = s; __syncthreads();
        float c = 0.f; for (int k = 0; k < i; ++k) c += tot[k * 8 + h];
        float* dst = (float*)(a.ws + WS_CBS) + ((size_t)b * 8 + h) * SKV + 64 * i;
        for (int t = 0; t < 64; ++t) { c += src[t * 8]; dst[t] = -c * LOG2E; }
        if (i == 63) { const float* sn = LF + ((size_t)MP + b * DS) * 8 + h; float* dn = (float*)(a.ws + WS_CBS) + ((size_t)b * 8 + h) * SKV + PAST;
            for (int t = 0; t < DS; ++t) { c += sn[t * 8]; dn[t] = -c * LOG2E; } }
    }
    __syncthreads();
}
__device__ __forceinline__ unsigned f2key(float f) { const unsigned u = __float_as_uint(f); return (u & 0x80000000u) ? ~u : (u | 0x80000000u); }
__device__ __forceinline__ void indexer_item(const Frame& F, const Args& a, int item) {
    int b, c, qq; bool samp;
    if (item < 504) { c = 127 - (item >> 3); b = (item >> 2) & 1; qq = item & 3; samp = false; }
    else if (item < 632) { const int s = item - 504; b = s >> 2; qq = s & 3; c = 64; samp = true; }
    else { const int r = item - 632; c = 64 - (r >> 3); b = (r >> 2) & 1; qq = r & 3; samp = false; }
    const int qrow0 = samp ? MP + b * DS + 16 * qq : b * SEQ + 64 * c + 16 * qq;
    const int n = samp ? SKV : 64 * (c + 1);
    const bf16_t* IK = samp ? (const bf16_t*)(a.ws + WS_IKS) + (size_t)b * SKV * 64 : (const bf16_t*)(a.ws + WS_IKP) + (size_t)b * SEQ * 64;
    const bf16_t* IQ = (const bf16_t*)(a.ws + WS_IQ); const float* IW = (const float*)(a.ws + WS_IW);
    int* SEL = (int*)(a.ws + WS_SEL);
    int lane = F.lane; asm volatile("" : "+v"(lane));
    const int l31 = lane & 31, hi = lane >> 5;
    if (n <= 256) {
        for (int e = F.tid; e < 16 * 256; e += NTHR) { const int q = e >> 8, s = e & 255; SEL[(size_t)(qrow0 + q) * 256 + s] = (s < n) ? s : 0; }
        return;
    }
    float* scr = (float*)(a.ws + WS_SCR) + (size_t)F.bid * 16 * 8192;
    {
        bf16x8 afr[4][4]; f32x4 wq[4][2][2];
        const int qa = 2 * ((l31 >> 2) & 1) + (l31 >> 4), ha = 4 * ((l31 >> 3) & 1) + (l31 & 3);
#pragma unroll
        for (int mt = 0; mt < 4; ++mt) {
#pragma unroll
            for (int ks = 0; ks < 4; ++ks) afr[mt][ks] = *(const bf16x8*)(IQ + (size_t)(qrow0 + 4 * mt + qa) * 512 + 64 * ha + 16 * ks + 8 * hi);
#pragma unroll
            for (int aa = 0; aa < 2; ++aa) { const float* wp = IW + (size_t)(qrow0 + 4 * mt + 2 * hi + aa) * 8; wq[mt][aa][0] = *(const f32x4*)wp; wq[mt][aa][1] = *(const f32x4*)(wp + 4); }
        }
        for (int kt = F.wave; kt < n / 32; kt += NWAVES) {
            bf16x8 bfr[4];
#pragma unroll
            for (int ks = 0; ks < 4; ++ks) bfr[ks] = *(const bf16x8*)(IK + (size_t)(32 * kt + l31) * 64 + 16 * ks + 8 * hi);
#pragma unroll
            for (int mt = 0; mt < 4; ++mt) {
                f32x16 acc = {};
#pragma unroll
                for (int ks = 0; ks < 4; ++ks) acc = __builtin_amdgcn_mfma_f32_32x32x16_bf16(afr[mt][ks], bfr[ks], acc, 0, 0, 0);
#pragma unroll
                for (int aa = 0; aa < 2; ++aa) { float s = 0.f;
#pragma unroll
                    for (int h = 0; h < 8; ++h) s += fmaxf(acc[8 * aa + h], 0.f) * wq[mt][aa][h >> 2][h & 3];
                    scr[(size_t)(4 * mt + 2 * hi + aa) * 8192 + 32 * kt + l31] = s; }
            }
        }
    }
    __syncthreads(); __builtin_amdgcn_fence(__ATOMIC_ACQUIRE, "agent");
    LAS unsigned* hist = (LAS unsigned*)(F.lds + F.wave * 8192);
    for (int q = F.wave; q < 16; q += NWAVES) {
        const float* sp = scr + (size_t)q * 8192; unsigned prefix = 0; int kk = 256;
#pragma unroll 1
        for (int lev = 0; lev < 3; ++lev) {
            const int shift = (lev == 0) ? 21 : (lev == 1) ? 10 : 0, bits = (lev == 2) ? 10 : 11, nbin = 1 << bits, per = nbin >> 6;
            for (int j = 0; j < per; ++j) hist[lane + 64 * j] = 0u;
            asm volatile("s_waitcnt lgkmcnt(0)" ::: "memory");
            for (int i = lane; i < n; i += 64) { const unsigned key = f2key(sp[i]);
                if (lev == 0 || (key >> (shift + bits)) == prefix) __hip_atomic_fetch_add(&hist[(key >> shift) & (nbin - 1)], 1u, __ATOMIC_RELAXED, __HIP_MEMORY_SCOPE_WORKGROUP); }
            asm volatile("s_waitcnt lgkmcnt(0)" ::: "memory");
            unsigned s = 0; for (int j = 0; j < per; ++j) s += hist[lane * per + j];
            unsigned T = s;
#pragma unroll
            for (int off = 1; off < 64; off <<= 1) { const unsigned v = __shfl_down(T, off); if (lane + off < 64) T += v; }
            const unsigned long long bal = __ballot(T >= (unsigned)kk);
            const int js = __popcll(bal) - 1;
            unsigned run = (js < 63) ? __shfl(T, js + 1) : 0u; if (js >= 63) run = 0u;
            int digit = js * per;
            for (int bb = per - 1; bb >= 0; --bb) { const unsigned cnt = hist[js * per + bb]; if (run + cnt >= (unsigned)kk) { digit = js * per + bb; break; } run += cnt; }
            kk -= (int)run; prefix = (prefix << bits) | (unsigned)digit;
            asm volatile("s_waitcnt lgkmcnt(0)" ::: "memory");
        }
        int* so = SEL + (size_t)(qrow0 + q) * 256; int obase = 0, ebase = 0;
        for (int i0 = 0; i0 < n; i0 += 64) { const int i = i0 + lane; const unsigned key = (i < n) ? f2key(sp[i]) : 0u;
            const bool gt = (i < n) && key > prefix, eq = (i < n) && key == prefix;
            const unsigned long long be = __ballot(eq); const int er = ebase + __popcll(be & ((1ull << lane) - 1ull));
            const bool take = gt || (eq && er < kk);
            const unsigned long long bt = __ballot(take); const int pos = obase + __popcll(bt & ((1ull << lane) - 1ull));
            if (take && pos < 256) so[pos] = i;
            obase += __popcll(bt); ebase += __popcll(be); }
    }
    __syncthreads();
}
__device__ __forceinline__ void dsa_query(const Frame& F, const Args& a, int row) {
    int lane = F.lane; asm volatile("" : "+v"(lane));
    const int j = lane & 15, kq = lane >> 4;
    const bool samp = row >= MP; const int rs = row - MP;
    const int nsel = samp ? 256 : min(256, 64 * (((row & (SEQ - 1)) >> 6) + 1));
    const bf16_t* KA = samp ? (const bf16_t*)(a.ws + WS_KAS) + (size_t)(rs >> 6) * SKV * 128 : (const bf16_t*)(a.ws + WS_KAP) + (size_t)(row >> 13) * SEQ * 128;
    const bf16_t* VA = samp ? (const bf16_t*)(a.ws + WS_VAS) + (size_t)(rs >> 6) * SKV * 128 : (const bf16_t*)(a.ws + WS_VAP) + (size_t)(row >> 13) * SEQ * 128;
    const int* sel = (const int*)(a.ws + WS_SEL) + (size_t)row * 256;
    const bf16_t* QA = (const bf16_t*)(a.ws + WS_QA) + (size_t)row * 512;
    LAS float* pl = (LAS float*)(F.lds + F.wave * 9216);
    LAS int* sl = (LAS int*)(F.lds + F.wave * 9216 + 8192);
#pragma unroll
    for (int i = 0; i < 4; ++i) sl[lane + 64 * i] = sel[lane + 64 * i];
    bf16x8 bq[4];
#pragma unroll
    for (int ks = 0; ks < 4; ++ks) { bf16x8 z = {}; bq[ks] = (j < 8 && (ks >> 1) == (j >> 2)) ? *(const bf16x8*)(QA + 64 * j + 32 * (ks & 1) + 8 * kq) : z; }
    asm volatile("s_waitcnt lgkmcnt(0)" ::: "memory");
    f32x4 acc[16]; const int nt = nsel >> 4;
#pragma unroll
    for (int t = 0; t < 16; ++t) {
        acc[t] = (f32x4){-INFINITY, -INFINITY, -INFINITY, -INFINITY};
        if (t < nt) { const int idx = sl[16 * t + j]; const bf16_t* kr = KA + (size_t)idx * 128 + 8 * kq; f32x4 c = {0.f, 0.f, 0.f, 0.f};
#pragma unroll
            for (int ks = 0; ks < 4; ++ks) c = __builtin_amdgcn_mfma_f32_16x16x32_bf16(*(const bf16x8*)(kr + 32 * ks), bq[ks], c, 0, 0, 0);
            acc[t] = c; }
    }
    float mx = -INFINITY;
#pragma unroll
    for (int t = 0; t < 16; ++t) mx = fmaxf(mx, fmaxf(fmaxf(acc[t][0], acc[t][1]), fmaxf(acc[t][2], acc[t][3])));
    mx = fmaxf(mx, __shfl_xor(mx, 16)); mx = fmaxf(mx, __shfl_xor(mx, 32));
    float sum = 0.f;
#pragma unroll
    for (int t = 0; t < 16; ++t)
#pragma unroll
        for (int i = 0; i < 4; ++i) { const float p = __builtin_amdgcn_exp2f(acc[t][i] - mx); acc[t][i] = p; sum += p; }
    sum += __shfl_xor(sum, 16); sum += __shfl_xor(sum, 32);
    const float inv = 1.0f / sum;
    if (j < 8) {
#pragma unroll
        for (int t = 0; t < 16; ++t)
#pragma unroll
            for (int i = 0; i < 4; ++i) pl[(16 * t + 4 * kq + i) * 8 + j] = acc[t][i] * inv;
    }
    asm volatile("s_waitcnt lgkmcnt(0)" ::: "memory");
    const int g = lane >> 5; float o[4][2] = {};
#pragma unroll 8
    for (int s = 0; s < nsel; ++s) { const int idx = sl[s]; const unsigned v = *(const unsigned*)(VA + (size_t)idx * 128 + 2 * lane); const f32x4 p4 = *(const LAS f32x4*)(pl + s * 8 + 4 * g);
        const float v0 = __uint_as_float(v << 16), v1 = __uint_as_float(v & 0xffff0000u);
#pragma unroll
        for (int hh = 0; hh < 4; ++hh) { o[hh][0] += p4[hh] * v0; o[hh][1] += p4[hh] * v1; } }
    bf16_t* ya = (bf16_t*)(a.ws + WS_YA) + (size_t)row * 512 + 2 * (lane & 31);
#pragma unroll
    for (int hh = 0; hh < 4; ++hh) *(unsigned*)(ya + 64 * (4 * g + hh)) = pk2(o[hh][0], o[hh][1]);
    asm volatile("s_waitcnt lgkmcnt(0)" ::: "memory");
}
constexpr int VST = 72;
constexpr int FOX_V = 0, FOX_M = 8 * 64 * VST * 2  , FOX_L = FOX_M + 2048, FOX_O = FOX_L + 256, FOX_END = FOX_O + 64 * 65 * 4;
static_assert(FOX_END <= 131072, "fox lds");
__device__ __forceinline__ int crow(int r, int hi) { return (r & 3) + 8 * (r >> 2) + 4 * hi; }
__device__ __forceinline__ bf16x8 cvt8(f32x4 a, f32x4 b) { u32x4 w; w.x = pk2(a[0], a[1]); w.y = pk2(a[2], a[3]); w.z = pk2(b[0], b[1]); w.w = pk2(b[2], b[3]); return __builtin_bit_cast(bf16x8, w); }
__device__ __forceinline__ void fox_unit(const Frame& F, const Args& a, int unit) {
    const bool samp = unit < 256; int b, h, qi, ntiles, rowq0; const float* Cb;
    if (samp) { b = unit >> 3; h = unit & 7; qi = 64; ntiles = 65; rowq0 = MP + b * DS; Cb = (const float*)(a.ws + WS_CBS) + ((size_t)b * 8 + h) * SKV; }
    else { const int r = unit - 256; qi = 127 - (r >> 4); b = (r >> 3) & 1; h = r & 7; ntiles = qi + 1; rowq0 = b * SEQ + 64 * qi; Cb = (const float*)(a.ws + WS_CBP) + ((size_t)b * 8 + h) * SEQ; }
    int lane = F.lane; asm volatile("" : "+v"(lane)); int tidl = F.tid; asm volatile("" : "+v"(tidl));
    const int q32 = lane & 31, hi = lane >> 5, w = F.wave;
    const bf16_t* Kb = samp ? (const bf16_t*)(a.ws + WS_KBS) + (size_t)(b * DS) * 512 + 64 * h : (const bf16_t*)(a.ws + WS_KBP) + (size_t)(b * SEQ) * 512 + 64 * h;
    const bf16_t* Vb = samp ? (const bf16_t*)(a.ws + WS_VBS) + (size_t)(b * DS) * 512 + 64 * h : (const bf16_t*)(a.ws + WS_VBP) + (size_t)(b * SEQ) * 512 + 64 * h;
    const float* Kc = a.c_bk + ((size_t)b * PAST * 8 + h) * 64; const float* Vc = a.c_bv + ((size_t)b * PAST * 8 + h) * 64;
    LAS bf16_t* vl = (LAS bf16_t*)(F.lds + FOX_V) + w * 64 * VST;
    LAS float* mb = (LAS float*)(F.lds + FOX_M); LAS float* lt = (LAS float*)(F.lds + FOX_L); LAS float* ot = (LAS float*)(F.lds + FOX_O);
    for (int e = tidl; e < 64 * 65 + 64; e += NTHR) lt[e] = 0.f;
    const bf16_t* QB = (const bf16_t*)(a.ws + WS_QB);
    bf16x8 qf[2][4];
#pragma unroll
    for (int qb = 0; qb < 2; ++qb)
#pragma unroll
        for (int ks = 0; ks < 4; ++ks) qf[qb][ks] = *(const bf16x8*)(QB + (size_t)(rowq0 + 32 * qb + q32) * 512 + 64 * h + 16 * ks + 8 * hi);
    float mrun[2] = {-INFINITY, -INFINITY}, lrun[2] = {0.f, 0.f};
    f32x16 o[2][2];
#pragma unroll
    for (int qb = 0; qb < 2; ++qb)
#pragma unroll
        for (int db = 0; db < 2; ++db)
#pragma unroll
            for (int r = 0; r < 16; ++r) o[qb][db][r] = 0.f;
    const int gi = lane >> 4, li = lane & 15;
    const unsigned kofb = (unsigned)(q32 * 1024 + 16 * hi);
    const unsigned kofc = (unsigned)(q32 * 2048 + 32 * hi);
    const unsigned cof = (unsigned)(16 * hi);
    const int troff = ((4 * hi + (li >> 2)) * VST + 16 * (gi & 1) + 4 * (li & 3));
    for (int tile = w; tile < ntiles; tile += NWAVES) {
        const bool cache = samp && tile < 64, diag = (tile == ntiles - 1);
        const int kv0 = 64 * tile; const int kvl = samp ? (cache ? kv0 : 0) : kv0;
        bf16x8 kf[2][4];
        if (cache) {
            const char* kp = (const char*)Kc + (size_t)kvl * 2048 + kofc;
#pragma unroll
            for (int hf = 0; hf < 2; ++hf) { const char* kph = kp + hf * 65536;
#pragma unroll
                for (int ks = 0; ks < 4; ++ks) kf[hf][ks] = cvt8(*(const f32x4*)(kph + 64 * ks), *(const f32x4*)(kph + 64 * ks + 16));
                asm volatile("" ::: "memory"); }
            const char* vp = (const char*)Vc + (size_t)kvl * 2048 + (unsigned)(lane * 2048);
#pragma unroll
            for (int c = 0; c < 16; ++c) { const f32x4 v = *(const f32x4*)(vp + 16 * c);
                u32x2 wv; wv.x = pk2(v[0], v[1]); wv.y = pk2(v[2], v[3]); *(LAS u32x2*)(vl + lane * VST + 4 * c) = wv;
                if ((c & 7) == 7) asm volatile("" ::: "memory"); }
        } else {
            const char* kp = (const char*)Kb + (size_t)kvl * 1024 + kofb;
#pragma unroll
            for (int hf = 0; hf < 2; ++hf) { const char* kph = kp + hf * 32768;
#pragma unroll
                for (int ks = 0; ks < 4; ++ks) kf[hf][ks] = *(const bf16x8*)(kph + 32 * ks); }
            asm volatile("" ::: "memory");
            const char* vp = (const char*)Vb + (size_t)kvl * 1024 + (unsigned)(lane * 1024);
#pragma unroll
            for (int c = 0; c < 8; ++c) *(LAS u32x4*)(vl + lane * VST + 8 * c) = *(const u32x4*)(vp + 16 * c);
            asm volatile("" ::: "memory");
        }
#pragma unroll
        for (int qb = 0; qb < 2; ++qb) {
            f32x16 s[2];
#pragma unroll
            for (int hf = 0; hf < 2; ++hf) {
#pragma unroll
                for (int g4 = 0; g4 < 4; ++g4) { const f32x4 c4 = *(const f32x4*)((const char*)(Cb + kv0) + cof + (128 * hf + 32 * g4));
                    s[hf][4 * g4 + 0] = c4[0]; s[hf][4 * g4 + 1] = c4[1]; s[hf][4 * g4 + 2] = c4[2]; s[hf][4 * g4 + 3] = c4[3]; }
#pragma unroll
                for (int ks = 0; ks < 4; ++ks) s[hf] = __builtin_amdgcn_mfma_f32_32x32x16_bf16(kf[hf][ks], qf[qb][ks], s[hf], 0, 0, 0);
            }
            if (diag) { const int ql = 32 * qb + q32;
#pragma unroll
                for (int hf = 0; hf < 2; ++hf)
#pragma unroll
                    for (int r = 0; r < 16; ++r) if (32 * hf + crow(r, hi) > ql) s[hf][r] = -INFINITY; }
            float mx = -INFINITY;
#pragma unroll
            for (int r = 0; r < 16; ++r) mx = fmaxf(mx, fmaxf(s[0][r], s[1][r]));
            mx = fmaxf(mx, __shfl_xor(mx, 32));
            const float mn = fmaxf(mrun[qb], mx); const float al = __builtin_amdgcn_exp2f(mrun[qb] - mn); mrun[qb] = mn;
            float sum = 0.f;
#pragma unroll
            for (int hf = 0; hf < 2; ++hf)
#pragma unroll
                for (int r = 0; r < 16; ++r) { const float p = __builtin_amdgcn_exp2f(s[hf][r] - mn); s[hf][r] = p; sum += p; }
            lrun[qb] = lrun[qb] * al + sum;
#pragma unroll
            for (int db = 0; db < 2; ++db)
#pragma unroll
                for (int r = 0; r < 16; ++r) o[qb][db][r] *= al;
            bf16x8 pk[4];
#pragma unroll
            for (int k4 = 0; k4 < 4; ++k4) { const int hf = k4 >> 1, r0 = 8 * (k4 & 1); u32x4 wv;
                wv.x = pk2(s[hf][r0 + 0], s[hf][r0 + 1]); wv.y = pk2(s[hf][r0 + 2], s[hf][r0 + 3]); wv.z = pk2(s[hf][r0 + 4], s[hf][r0 + 5]); wv.w = pk2(s[hf][r0 + 6], s[hf][r0 + 7]);
                pk[k4] = __builtin_bit_cast(bf16x8, wv); }
            asm volatile("s_waitcnt lgkmcnt(0)" ::: "memory");
#pragma unroll
            for (int db = 0; db < 2; ++db)
#pragma unroll
                for (int k4 = 0; k4 < 4; ++k4) {
                    const LAS bf16_t* p0 = vl + troff + (16 * k4) * VST + 32 * db;
                    const s16x4 lo = __builtin_bit_cast(s16x4, __builtin_amdgcn_ds_read_tr16_b64_v4i16((LAS s16x4*)p0));
                    const s16x4 hh = __builtin_bit_cast(s16x4, __builtin_amdgcn_ds_read_tr16_b64_v4i16((LAS s16x4*)(p0 + 8 * VST)));
                    const bf16x8 vt = (bf16x8){lo[0], lo[1], lo[2], lo[3], hh[0], hh[1], hh[2], hh[3]};
                    o[qb][db] = __builtin_amdgcn_mfma_f32_32x32x16_bf16(vt, pk[k4], o[qb][db], 0, 0, 0);
                }
        }
        asm volatile("s_waitcnt lgkmcnt(0)" ::: "memory");
    }
#pragma unroll
    for (int qb = 0; qb < 2; ++qb) { lrun[qb] += __shfl_xor(lrun[qb], 32); if (hi == 0) mb[w * 64 + 32 * qb + q32] = mrun[qb]; }
    __syncthreads();
#pragma unroll
    for (int qb = 0; qb < 2; ++qb) {
        const int q = 32 * qb + q32; float mg = -INFINITY;
#pragma unroll
        for (int ww = 0; ww < NWAVES; ++ww) mg = fmaxf(mg, mb[ww * 64 + q]);
        const float sc = __builtin_amdgcn_exp2f(mrun[qb] - mg);
        if (w < ntiles) {
            if (hi == 0) __hip_atomic_fetch_add(lt + q, lrun[qb] * sc, __ATOMIC_RELAXED, __HIP_MEMORY_SCOPE_WORKGROUP);
#pragma unroll
            for (int db = 0; db < 2; ++db)
#pragma unroll
                for (int r = 0; r < 16; ++r) __hip_atomic_fetch_add(ot + q * 65 + 32 * db + crow(r, hi), o[qb][db][r] * sc, __ATOMIC_RELAXED, __HIP_MEMORY_SCOPE_WORKGROUP);
        }
    }
    __syncthreads();
    { const int q = tidl >> 3, d0 = 8 * (tidl & 7); const float il = 1.0f / lt[q]; const LAS float* op = ot + q * 65 + d0;
      u32x4 wv; wv.x = pk2(op[0] * il, op[1] * il); wv.y = pk2(op[2] * il, op[3] * il); wv.z = pk2(op[4] * il, op[5] * il); wv.w = pk2(op[6] * il, op[7] * il);
      *(u32x4*)((bf16_t*)(a.ws + WS_YB) + (size_t)(rowq0 + q) * 512 + 64 * h + d0) = wv; }
    __syncthreads();
}
constexpr int N_PHASES = 13;
#ifndef MK_PER_PHASE
#define MK_PER_PHASE 0
#endif
template <class Epi> __device__ __forceinline__ void run_gemm(const Frame& F, const bf16_t* A, const bf16_t* Bt, int N, int K, const Epi& E) {
    pg8::Gemm g{A, Bt, MT, N, K}; pg8::StaticOrder S; S.init(MT, N, F.G, F.bid);
    pg8::gemm_phase<Epi, pg8::StaticOrder, true, true>(F.lds, g, S, E);
}
__global__ void __launch_bounds__(NTHR, 2) mega_fwd(Args a) {
    __builtin_assume(__builtin_amdgcn_workitem_id_y() == 0); __builtin_assume(__builtin_amdgcn_workitem_id_z() == 0);
    extern __shared__ __attribute__((aligned(16))) unsigned char lds_raw[];
    cg::grid_group grid = cg::this_grid();
    Frame F; F.lds = (LAS unsigned char*)lds_raw; F.tid = threadIdx.x; F.lane = F.tid & 63; F.wave = __builtin_amdgcn_readfirstlane(F.tid >> 6); F.G = gridDim.x; F.bid = blockIdx.x;
    unsigned char* ws = a.ws;
    LAS int* sh_item = (LAS int*)(F.lds + 131072);
    const int lo = a.ph_lo, hi = a.ph_hi;
#define IN(k) (lo <= (k) && (k) < hi)
#define SEAM(k) do { if (IN(k) && IN((k) + 1)) grid.sync(); } while (0)
    if (IN(0)) { p0_prologue(F, a); } SEAM(0);
    if (IN(1)) { pg8::EpiSwiGLU E{(bf16_t*)(ws + WS_H)}; run_gemm(F, (const bf16_t*)(ws + WS_XB), (const bf16_t*)(ws + WS_W1U), NUP, DM, E); } SEAM(1);
    if (IN(2)) { pg8::EpiRes E{a.x_p, a.x_s, (float*)(ws + WS_Z), 0.5f}; run_gemm(F, (const bf16_t*)(ws + WS_H), (const bf16_t*)(ws + WS_W1D), DM, DFF, E); } SEAM(2);
    if (IN(3)) { ln_pass(F, (const float*)(ws + WS_Z), a.ln1g, a.ln1b, (float*)(ws + WS_HF1), (bf16_t*)(ws + WS_HB)); } SEAM(3);
    if (IN(4)) {
        pg8::EpiWin E{a.out, (bf16_t*)(ws + WS_QA), (bf16_t*)(ws + WS_IQ), (bf16_t*)(ws + WS_QB), (bf16_t*)(ws + WS_KAP), (bf16_t*)(ws + WS_VAP), (bf16_t*)(ws + WS_IKP), (bf16_t*)(ws + WS_KBP), (bf16_t*)(ws + WS_VBP),
                      (bf16_t*)(ws + WS_KAS), (bf16_t*)(ws + WS_VAS), (bf16_t*)(ws + WS_IKS), (bf16_t*)(ws + WS_KBS), (bf16_t*)(ws + WS_VBS), (bf16_t*)(ws + WS_G), (float*)(ws + WS_IW), (float*)(ws + WS_LF),
                      (const pg8::f32x2*)(ws + WS_ROPE), a.b_f, a.b_gate};
        run_gemm(F, (const bf16_t*)(ws + WS_HB), (const bf16_t*)(ws + WS_WIN), NINP, DM, E);
    } SEAM(4);
    if (IN(5)) {
        if (F.bid < NB + DB) cumsum_block(F, a, F.bid);
        unsigned* ctr = (unsigned*)(ws + WS_CTL);
        for (;;) { if (F.tid == 0) *sh_item = (int)atomicAdd(ctr, 1u); __syncthreads(); const int item = *sh_item; __syncthreads(); if (item >= 1152) break; indexer_item(F, a, item); }
    } SEAM(5);
    if (IN(6)) {
        unsigned* ctr = (unsigned*)(ws + WS_CTL) + 64;
        for (;;) { if (F.tid == 0) *sh_item = (int)atomicAdd(ctr, 1u); __syncthreads(); const int item = *sh_item; __syncthreads();
            if (item >= 2304 + MT / 64) break;
            if (item < 2304) fox_unit(F, a, item);
            else { const int r0 = (item - 2304) * 64; for (int i = 0; i < 8; ++i) dsa_query(F, a, r0 + 8 * i + F.wave); } }
    } SEAM(6);
    if (IN(7)) {
        pg8::EpiProjA EA{(const bf16_t*)(ws + WS_G), (float*)(ws + WS_MM)}; run_gemm(F, (const bf16_t*)(ws + WS_YA), (const bf16_t*)(ws + WS_WPA), DM, 512, EA);
        pg8::EpiProjB EB{(const bf16_t*)(ws + WS_G), (const float*)(ws + WS_MM), (bf16_t*)(ws + WS_MMB)}; run_gemm(F, (const bf16_t*)(ws + WS_YB), (const bf16_t*)(ws + WS_WPB), DM, 512, EB);
    } SEAM(7);
    if (IN(8)) { pg8::EpiRes E{(const float*)(ws + WS_HF1), (const float*)(ws + WS_HF1) + (size_t)MP * DM, (float*)(ws + WS_Z), 1.0f}; run_gemm(F, (const bf16_t*)(ws + WS_MMB), (const bf16_t*)(ws + WS_WO), DM, DM, E); } SEAM(8);
    if (IN(9)) { ln_pass(F, (const float*)(ws + WS_Z), a.ln2g, a.ln2b, (float*)(ws + WS_HF2), (bf16_t*)(ws + WS_HB)); } SEAM(9);
    if (IN(10)) { pg8::EpiSwiGLU E{(bf16_t*)(ws + WS_H)}; run_gemm(F, (const bf16_t*)(ws + WS_HB), (const bf16_t*)(ws + WS_W2U), NUP, DM, E); } SEAM(10);
    if (IN(11)) { pg8::EpiRes E{(const float*)(ws + WS_HF2), (const float*)(ws + WS_HF2) + (size_t)MP * DM, (float*)(ws + WS_Z), 0.5f}; run_gemm(F, (const bf16_t*)(ws + WS_H), (const bf16_t*)(ws + WS_W2D), DM, DFF, E); } SEAM(11);
    if (IN(12)) { ln_pass(F, (const float*)(ws + WS_Z), a.ln3g, a.ln3b, a.out + O_Y, nullptr); }
#undef IN
#undef SEAM
}

extern "C" void kernel_launch(void* const* d_in, const int* in_sizes, int n_in, void* d_out, int out_size, void* d_ws, size_t ws_size, hipStream_t stream) {
    static int grid = 0;
    if (grid == 0) {
        if (n_in != 24 || ws_size < WS_END) { fprintf(stderr, "kernel_launch: expected 24 inputs and >= %zu bytes of workspace (got %d, %zu)\n", (size_t)WS_END, n_in, ws_size); grid = -1; return; }
        int dev = 0, cus = 0, per_cu = 0;
        hipGetDevice(&dev); hipDeviceGetAttribute(&cus, hipDeviceAttributeMultiprocessorCount, dev);
        if (hipFuncSetAttribute((const void*)mega_fwd, hipFuncAttributeMaxDynamicSharedMemorySize, LDS_BYTES) != hipSuccess) { fprintf(stderr, "kernel_launch: hipFuncSetAttribute failed\n"); grid = -1; return; }
        hipOccupancyMaxActiveBlocksPerMultiprocessor(&per_cu, (const void*)mega_fwd, NTHR, LDS_BYTES);
        (void)hipGetLastError();
        if (per_cu < 1) { fprintf(stderr, "kernel_launch: occupancy query says %d blocks per CU\n", per_cu); per_cu = 1; }
        grid = cus;
    }
    if (grid < 0) return;
    Args a{};
    const float** p = (const float**)&a;
    for (int i = 0; i < 24; ++i) p[i] = (const float*)d_in[i];
    a.out = (float*)d_out; a.ws = (unsigned char*)d_ws;
    for (int j = 0; j < 32; ++j) a.invf[j] = pow(10000.0, -(double)j / 32.0);
#if MK_PER_PHASE
    for (int ph = 0; ph < N_PHASES; ++ph) { a.ph_lo = ph; a.ph_hi = ph + 1; void* args[] = {&a};
        hipError_t e = hipLaunchCooperativeKernel((const void*)mega_fwd, dim3(grid), dim3(NTHR), args, LDS_BYTES, stream);
        if (e != hipSuccess) { fprintf(stderr, "launch of phase %d failed: %s\n", ph, hipGetErrorString(e)); break; } }
#else
    a.ph_lo = 0; a.ph_hi = N_PHASES; void* args[] = {&a};
    hipError_t e = hipLaunchCooperativeKernel((const void*)mega_fwd, dim3(grid), dim3(NTHR), args, LDS_BYTES, stream);
    if (e != hipSuccess) fprintf(stderr, "cooperative launch failed: %s (grid %d)\n", hipGetErrorString(e), grid);
#endif
}
```

```cpp
#include <hip/hip_runtime.h>
#include <hip/hip_cooperative_groups.h>
#include <cstdio>
#include <cstdint>
#include <cmath>
namespace cg = cooperative_groups;

constexpr int DM = 1024, SEQ = 8192, NB = 2, DB = 32, DS = 64, PAST = 4096, SKV = PAST + DS  ;
constexpr int MP = NB * SEQ  , MS = DB * DS  , MT = MP + MS  ;
constexpr int DFF = 2816, NUP = 2 * DFF, NIN = 4944, NINP = 5120;
constexpr float ALPHA = 1.189207115002721f;
constexpr float LN_EPS = 1e-5f;
constexpr float LOG2E = 1.4426950408889634f;
constexpr float QSCALE = 0.125f * LOG2E;
constexpr float IWSCALE = 0.35355339059327373f * 0.125f;
constexpr size_t O_Y = 0, O_PAK = 18874368, O_PAV = 20971520, O_PIK = 23068672, O_PBK = 24117248, O_PBV = 32505856, O_PLF = 40894464,
                 O_SAK = 41025536, O_SAV = 41287680, O_SIK = 41549824, O_SBK = 41680896, O_SBV = 42729472, O_SLF = 43778048;
#define MK_PER_PHASE 0
#define PROBE_DUP 0
namespace pg8 {
#define PG8_LAS __attribute__((address_space(3)))
typedef unsigned short bf16_t;
typedef short bf16x8 __attribute__((ext_vector_type(8)));
typedef float f32x4 __attribute__((ext_vector_type(4)));
typedef unsigned u32x4 __attribute__((ext_vector_type(4)));
constexpr int BM = 256, BK = 64, HALF = 128, HTB = HALF * BK * 2  , STAGE_BYTES = 8 * HTB, NXCD = 8, WGM = 8;

__host__ __device__ __forceinline__ int lds_byte(int r, int c) { const int st = (r >> 4) * 2 + (c >> 5), rr = r & 15, cc = c & 31, ob = rr * 64 + cc * 2; return st * 1024 + (ob ^ (((ob >> 9) & 1) << 5)); }
__host__ __device__ __forceinline__ void stage_rc(int b, int& R, int& C) { const int st = b / 1024, sb = b % 1024, swz = sb ^ (((sb >> 9) & 1) << 5); R = (st >> 1) * 16 + swz / 64; C = (st & 1) * 32 + (swz % 64) / 2; }
__host__ __device__ __forceinline__ int perm32(int rho) { const int n = rho >> 4, i = rho & 15; return 8 * (i >> 2) + 4 * n + (i & 3); }

struct Unit { int pm, pn; };
struct Gemm { const bf16_t* A; const bf16_t* Bt; int M, N, K; };

struct StaticOrder {
    int nM, nN, nwg, G, c;
    __host__ __device__ void init(int M, int N, int G_, int c_) { nM = M / BM; nN = N / BM; nwg = nM * nN; G = G_; c = c_; }
    __host__ __device__ bool next(int i, Unit& u) const {
        const long L = (long)i * G + c; if (L >= nwg) return false;
        int wgid = (int)L; { const int q = nwg / NXCD, r = nwg % NXCD, xcd = wgid % NXCD, off = wgid / NXCD; wgid = (xcd < r ? xcd * (q + 1) : r * (q + 1) + (xcd - r) * q) + off; }
        const int nig = WGM * nN, gid = wgid / nig, fm = gid * WGM, gsz = (nM - fm) < WGM ? (nM - fm) : WGM;
        u.pm = fm + ((wgid % nig) % gsz); u.pn = (wgid % nig) / gsz; return true;
    }
    __device__ __forceinline__ void a_ready(const Unit&) const {}
    __device__ __forceinline__ void done(const Unit&) const {}
};

__device__ __forceinline__ unsigned cvt_pk_bf16(float lo, float hi) { unsigned r; asm volatile("v_cvt_pk_bf16_f32 %0, %1, %2" : "=v"(r) : "v"(lo), "v"(hi)); return r; }
typedef float f32x2 __attribute__((ext_vector_type(2)));
typedef unsigned u32x2 __attribute__((ext_vector_type(2)));
typedef float f32x2 __attribute__((ext_vector_type(2)));
__device__ __forceinline__ float bf2f(unsigned short b) { return __uint_as_float((unsigned)b << 16); }
__device__ __forceinline__ float fsigmoid(float x) { return __builtin_amdgcn_rcpf(1.0f + __builtin_amdgcn_exp2f(-x * LOG2E)); }
__device__ __forceinline__ float flogsig(float x) {
    const float e = __builtin_amdgcn_exp2f(-fabsf(x) * LOG2E);
    const float l1p = (e < 0.03125f) ? e * (1.0f - e * (0.5f - e * (0.33333333f - 0.25f * e))) : __logf(1.0f + e);
    return fminf(x, 0.f) - l1p;
}
__device__ __forceinline__ u32x2 pack4(f32x4 v) { u32x2 w; w.x = cvt_pk_bf16(v[0], v[1]); w.y = cvt_pk_bf16(v[2], v[3]); return w; }

struct EpiSwiGLU {
    static constexpr bool PERM = true, AFTER_DRAIN = false;
    bf16_t* H;
    __device__ __forceinline__ void operator()(const f32x4 (&acc)[2][2][4][2], const Unit& u, int wr, int wc, int fr, int fq) const {
        const int row0 = u.pm * BM + wr * 64 + fr, col0 = u.pn * 128 + wc * 32 + 8 * fq;
#pragma unroll
        for (int ai = 0; ai < 2; ++ai)
#pragma unroll
            for (int m = 0; m < 4; ++m) {
                bf16_t* rowp = H + (size_t)(row0 + ai * HALF + m * 16) * DFF + col0;
                f32x4 h[2];
#pragma unroll
                for (int n = 0; n < 2; ++n) { const f32x4 a = acc[ai][0][m][n], g = acc[ai][1][m][n];
#pragma unroll
                    for (int i = 0; i < 4; ++i) h[n][i] = a[i] * fsigmoid(a[i]) * g[i]; }
                u32x4 w; w.x = cvt_pk_bf16(h[0][0], h[0][1]); w.y = cvt_pk_bf16(h[0][2], h[0][3]); w.z = cvt_pk_bf16(h[1][0], h[1][1]); w.w = cvt_pk_bf16(h[1][2], h[1][3]);
                *(u32x4*)rowp = w;
            }
    }
};
struct EpiRes {
    static constexpr bool PERM = false, AFTER_DRAIN = false;
    const float* resP; const float* resS; float* Z; float s;
    __device__ __forceinline__ void operator()(const f32x4 (&acc)[2][2][4][2], const Unit& u, int wr, int wc, int fr, int fq) const {
        const int row0 = u.pm * BM + wr * 64 + fr, col0 = u.pn * BM + wc * 32 + 4 * fq;
        const float* rb = (u.pm < MP / BM) ? resP : (resS - (size_t)MP * DM);
#pragma unroll
        for (int ai = 0; ai < 2; ++ai)
#pragma unroll
            for (int m = 0; m < 4; ++m) { const size_t off = (size_t)(row0 + ai * HALF + m * 16) * DM + col0;
#pragma unroll
                for (int bj = 0; bj < 2; ++bj)
#pragma unroll
                    for (int n = 0; n < 2; ++n) { const f32x4 r = *(const f32x4*)(rb + off + bj * HALF + n * 16);
                        *(f32x4*)(Z + off + bj * HALF + n * 16) = r * ALPHA + acc[ai][bj][m][n] * s; } }
    }
};
struct EpiProjA {
    static constexpr bool PERM = false, AFTER_DRAIN = false;
    const bf16_t* G; float* MM;
    __device__ __forceinline__ void operator()(const f32x4 (&acc)[2][2][4][2], const Unit& u, int wr, int wc, int fr, int fq) const {
        const int row0 = u.pm * BM + wr * 64 + fr, col0 = u.pn * BM + wc * 32 + 4 * fq;
#pragma unroll
        for (int ai = 0; ai < 2; ++ai)
#pragma unroll
            for (int m = 0; m < 4; ++m) { const size_t row = (size_t)(row0 + ai * HALF + m * 16);
#pragma unroll
                for (int bj = 0; bj < 2; ++bj)
#pragma unroll
                    for (int n = 0; n < 2; ++n) { const int c = col0 + bj * HALF + n * 16; const u32x2 g = *(const u32x2*)(G + row * 2048 + c);
                        f32x4 gv; gv[0] = __uint_as_float(g.x << 16); gv[1] = __uint_as_float(g.x & 0xffff0000u); gv[2] = __uint_as_float(g.y << 16); gv[3] = __uint_as_float(g.y & 0xffff0000u);
                        *(f32x4*)(MM + row * DM + c) = gv * acc[ai][bj][m][n]; } }
    }
};
struct EpiProjB {
    static constexpr bool PERM = false, AFTER_DRAIN = false;
    const bf16_t* G; const float* MM; bf16_t* MMb;
    __device__ __forceinline__ void operator()(const f32x4 (&acc)[2][2][4][2], const Unit& u, int wr, int wc, int fr, int fq) const {
        const int row0 = u.pm * BM + wr * 64 + fr, col0 = u.pn * BM + wc * 32 + 4 * fq;
#pragma unroll
        for (int ai = 0; ai < 2; ++ai)
#pragma unroll
            for (int m = 0; m < 4; ++m) { const size_t row = (size_t)(row0 + ai * HALF + m * 16);
#pragma unroll
                for (int bj = 0; bj < 2; ++bj)
#pragma unroll
                    for (int n = 0; n < 2; ++n) { const int c = col0 + bj * HALF + n * 16; const u32x2 g = *(const u32x2*)(G + row * 2048 + 1024 + c);
                        f32x4 gv; gv[0] = __uint_as_float(g.x << 16); gv[1] = __uint_as_float(g.x & 0xffff0000u); gv[2] = __uint_as_float(g.y << 16); gv[3] = __uint_as_float(g.y & 0xffff0000u);
                        const f32x4 mm = *(const f32x4*)(MM + row * DM + c);
                        *(u32x2*)(MMb + row * DM + c) = pack4(mm + gv * acc[ai][bj][m][n]); } }
    }
};
struct EpiWin {
    static constexpr bool PERM = false, AFTER_DRAIN = false;
    float* out; bf16_t *QA, *IQ, *QB, *KAp, *VAp, *IKp, *KBp, *VBp, *KAs, *VAs, *IKs, *KBs, *VBs, *G; float *IW, *LF; const f32x2* rope; const float* b_f; const float* b_gate;
    __device__ __forceinline__ void operator()(const f32x4 (&acc)[2][2][4][2], const Unit& u, int wr, int wc, int fr, int fq) const {
        const int T = u.pn; const bool samp = u.pm >= MP / BM;
#pragma unroll
        for (int ai = 0; ai < 2; ++ai)
#pragma unroll
            for (int m = 0; m < 4; ++m) {
                const int row = u.pm * BM + ai * HALF + wr * 64 + m * 16 + fr; const int rs = row - MP;
                const int pos = samp ? PAST + (rs & 63) : (row & (SEQ - 1));
                const size_t srow = samp ? ((size_t)(rs >> 6) * SKV + PAST + (rs & 63)) : (size_t)row;
                if (T == 0 || T == 1 || T == 3 || T == 4) {
                    bf16_t* dst = (T < 2) ? QA + (size_t)row * 512 + 256 * T : IQ + (size_t)row * 512 + 256 * (T - 3);
                    const float sc = (T < 2) ? QSCALE : 1.0f;
#pragma unroll
                    for (int n = 0; n < 2; ++n) { const int j0 = 16 * n + 4 * fq; const f32x4 x1 = acc[ai][0][m][n], x2 = acc[ai][1][m][n]; f32x4 o1, o2;
#pragma unroll
                        for (int i = 0; i < 4; ++i) { const f32x2 cs = rope[pos * 32 + j0 + i]; o1[i] = (x1[i] * cs.x - x2[i] * cs.y) * sc; o2[i] = (x2[i] * cs.x + x1[i] * cs.y) * sc; }
                        *(u32x2*)(dst + 64 * wc + j0) = pack4(o1); *(u32x2*)(dst + 64 * wc + 32 + j0) = pack4(o2); }
                } else if (T == 2) {
                    if (wc < 2) {
                        float* kf = out + (samp ? O_SAK + (size_t)rs * 128 : O_PAK + (size_t)row * 128) + 64 * wc; bf16_t* kb = (samp ? KAs : KAp) + srow * 128 + 64 * wc;
#pragma unroll
                        for (int n = 0; n < 2; ++n) { const int j0 = 16 * n + 4 * fq; const f32x4 x1 = acc[ai][0][m][n], x2 = acc[ai][1][m][n]; f32x4 o1, o2;
#pragma unroll
                            for (int i = 0; i < 4; ++i) { const f32x2 cs = rope[pos * 32 + j0 + i]; o1[i] = x1[i] * cs.x - x2[i] * cs.y; o2[i] = x2[i] * cs.x + x1[i] * cs.y; }
                            *(f32x4*)(kf + j0) = o1; *(f32x4*)(kf + 32 + j0) = o2; *(u32x2*)(kb + j0) = pack4(o1); *(u32x2*)(kb + 32 + j0) = pack4(o2); }
                    } else {
                        float* vf = out + (samp ? O_SAV + (size_t)rs * 128 : O_PAV + (size_t)row * 128); bf16_t* vb = (samp ? VAs : VAp) + srow * 128;
#pragma unroll
                        for (int bj = 0; bj < 2; ++bj)
#pragma unroll
                            for (int n = 0; n < 2; ++n) { const int c = 64 * bj + 32 * (wc - 2) + 16 * n + 4 * fq; *(f32x4*)(vf + c) = acc[ai][bj][m][n]; *(u32x2*)(vb + c) = pack4(acc[ai][bj][m][n]); }
                    }
                } else if (T == 5) {
                    if (wc == 0) {
                        float* kf = out + (samp ? O_SIK + (size_t)rs * 64 : O_PIK + (size_t)row * 64); bf16_t* kb = (samp ? IKs : IKp) + srow * 64;
#pragma unroll
                        for (int n = 0; n < 2; ++n) { const int j0 = 16 * n + 4 * fq; const f32x4 x1 = acc[ai][0][m][n], x2 = acc[ai][1][m][n]; f32x4 o1, o2;
#pragma unroll
                            for (int i = 0; i < 4; ++i) { const f32x2 cs = rope[pos * 32 + j0 + i]; o1[i] = x1[i] * cs.x - x2[i] * cs.y; o2[i] = x2[i] * cs.x + x1[i] * cs.y; }
                            *(f32x4*)(kf + j0) = o1; *(f32x4*)(kf + 32 + j0) = o2; *(u32x2*)(kb + j0) = pack4(o1); *(u32x2*)(kb + 32 + j0) = pack4(o2); }
                    } else if (wc == 1) {
                        const f32x4 v = acc[ai][0][m][0];
                        if (fq < 2) { *(f32x4*)(IW + (size_t)row * 8 + 4 * fq) = v * IWSCALE; }
                        else { const int i0 = 4 * (fq - 2); f32x4 lf; const f32x4 bf0 = *(const f32x4*)b_f, bf1 = *(const f32x4*)(b_f + 4); const f32x4 bfv = (fq == 2) ? bf0 : bf1;
#pragma unroll
                            for (int i = 0; i < 4; ++i) lf[i] = flogsig(v[i] + bfv[i]);
                            *(f32x4*)(out + (samp ? O_SLF + (size_t)rs * 8 : O_PLF + (size_t)row * 8) + i0) = lf; *(f32x4*)(LF + (size_t)row * 8 + i0) = lf; }
                    }
                } else if (T < 8) {
                    bf16_t* dst = QB + (size_t)row * 512 + 256 * (T - 6) + 32 * wc + 4 * fq;
#pragma unroll
                    for (int bj = 0; bj < 2; ++bj)
#pragma unroll
                        for (int n = 0; n < 2; ++n) *(u32x2*)(dst + 128 * bj + 16 * n) = pack4(acc[ai][bj][m][n] * QSCALE);
                } else if (T < 12) {
                    const bool isv = T >= 10; const int c0 = 256 * ((T - 8) & 1) + 32 * wc + 4 * fq;
                    float* df = out + (isv ? (samp ? O_SBV + (size_t)rs * 512 : O_PBV + (size_t)row * 512) : (samp ? O_SBK + (size_t)rs * 512 : O_PBK + (size_t)row * 512)) + c0;
                    bf16_t* db = (isv ? (samp ? VBs + (size_t)rs * 512 : VBp + (size_t)row * 512) : (samp ? KBs + (size_t)rs * 512 : KBp + (size_t)row * 512)) + c0;
#pragma unroll
                    for (int bj = 0; bj < 2; ++bj)
#pragma unroll
                        for (int n = 0; n < 2; ++n) { *(f32x4*)(df + 128 * bj + 16 * n) = acc[ai][bj][m][n]; *(u32x2*)(db + 128 * bj + 16 * n) = pack4(acc[ai][bj][m][n]); }
                } else {
                    const int c0 = 256 * (T - 12) + 32 * wc + 4 * fq; bf16_t* dst = G + (size_t)row * 2048 + c0;
#pragma unroll
                    for (int bj = 0; bj < 2; ++bj)
#pragma unroll
                        for (int n = 0; n < 2; ++n) { const f32x4 bg = *(const f32x4*)(b_gate + c0 + 128 * bj + 16 * n); f32x4 g;
#pragma unroll
                            for (int i = 0; i < 4; ++i) g[i] = fsigmoid(acc[ai][bj][m][n][i] + bg[i]);
                            *(u32x2*)(dst + 128 * bj + 16 * n) = pack4(g); }
                }
            }
    }
};
template <class Epi, class Sched, bool ALIGN_EPI = false, bool SP2 = false>
__device__ __forceinline__ void gemm_phase(PG8_LAS unsigned char* lds, const Gemm g, const Sched& S, const Epi& E) {
    const int tid = threadIdx.x, wid = __builtin_amdgcn_readfirstlane(tid >> 6), lane = tid & 63, wr = wid >> 2, wc = wid & 3, fr = lane & 15, fq = lane >> 4;
    const int K = g.K, nt = K / BK;
    unsigned voffA[2], voffB[2];
#pragma unroll
    for (int i = 0; i < 2; ++i) { int R, C; stage_rc(tid * 16 + i * 8192, R, C); const int Rb = Epi::PERM ? ((R & ~31) + perm32(R & 31)) : R;
        voffA[i] = (unsigned)(R * K + C) * 2u; voffB[i] = (unsigned)(Rb * K + C) * 2u; }
    const size_t kstep = (size_t)(BK * 2);
    const size_t hstep = (size_t)HALF * K * 2;
    const size_t tstep = 2 * hstep;
    const unsigned ldsw = (unsigned)wid * 1024u;
    const int aoff = lds_byte(wr * 64 + fr, fq * 8), boff = lds_byte(wc * 32 + fr, fq * 8);
#define PG8_SA(b, h) (((b) * 2 + (h)) * HTB)
#define PG8_SB(b, h) ((4 + (b) * 2 + (h)) * HTB)
#define PG8_STAGE(bufoff, gbase, voff) do { _Pragma("unroll") for (int _i = 0; _i < 2; ++_i) \
        __builtin_amdgcn_global_load_lds((const unsigned*)((const char*)(gbase) + (voff)[_i]), (PG8_LAS unsigned*)(lds + (bufoff) + ldsw + _i * 8192), 16, 0, 0); } while (0)
#define PG8_LDA(dst, b, h) do { _Pragma("unroll") for (int m = 0; m < 4; ++m) _Pragma("unroll") for (int k = 0; k < 2; ++k) dst[m][k] = *(const PG8_LAS bf16x8*)(lds + PG8_SA(b, h) + aoff + m * 2048 + k * 1024); } while (0)
#define PG8_LDB(dst, b, h) do { _Pragma("unroll") for (int n = 0; n < 2; ++n) _Pragma("unroll") for (int k = 0; k < 2; ++k) dst[n][k] = *(const PG8_LAS bf16x8*)(lds + PG8_SB(b, h) + boff + n * 2048 + k * 1024); } while (0)
#define PG8_MMA(ai, bj, At, Bt) do { __builtin_amdgcn_s_setprio(1); _Pragma("unroll") for (int m = 0; m < 4; ++m) _Pragma("unroll") for (int n = 0; n < 2; ++n) _Pragma("unroll") for (int k = 0; k < 2; ++k) \
        acc[ai][bj][m][n] = __builtin_amdgcn_mfma_f32_16x16x32_bf16(Bt[n][k], At[m][k], acc[ai][bj][m][n], 0, 0, 0); __builtin_amdgcn_s_setprio(0); } while (0)
#define PG8_WAIT_V(n) asm volatile("s_waitcnt vmcnt(" #n ")" ::: "memory")
#define PG8_WAIT_L(n) asm volatile("s_waitcnt lgkmcnt(" #n ")" ::: "memory")
#define PG8_BAR __builtin_amdgcn_s_barrier()
#define PG8_SCHED __builtin_amdgcn_sched_barrier(0)
    Unit cur, nxt; int ui = 0;
    if (!S.next(0, cur)) return;
    f32x4 acc[2][2][4][2];
#pragma unroll
    for (int a = 0; a < 2; ++a)
#pragma unroll
        for (int b = 0; b < 2; ++b)
#pragma unroll
            for (int m = 0; m < 4; ++m)
#pragma unroll
                for (int n = 0; n < 2; ++n) acc[a][b][m][n] = (f32x4){0.f, 0.f, 0.f, 0.f};
    bf16x8 At[4][2], B0[2][2], B1[2][2];
    const char* cA = (const char*)g.A + (size_t)cur.pm * tstep; const char* cB = (const char*)g.Bt + (size_t)cur.pn * tstep;
    S.a_ready(cur);
    if constexpr (SP2) {
        PG8_STAGE(PG8_SB(0, 0), cB, voffB); PG8_STAGE(PG8_SB(0, 1), cB + hstep, voffB); PG8_STAGE(PG8_SA(0, 0), cA, voffA); PG8_STAGE(PG8_SA(0, 1), cA + hstep, voffA);
        if (wr == 1) PG8_BAR;
        PG8_WAIT_V(2); PG8_BAR;
        PG8_STAGE(PG8_SB(1, 0), cB + kstep, voffB); PG8_STAGE(PG8_SA(1, 0), cA + kstep, voffA); PG8_STAGE(PG8_SB(1, 1), cB + hstep + kstep, voffB);
        PG8_WAIT_V(6); PG8_BAR;
    } else {
        PG8_STAGE(PG8_SB(0, 0), cB, voffB); PG8_STAGE(PG8_SA(0, 0), cA, voffA); PG8_STAGE(PG8_SB(0, 1), cB + hstep, voffB); PG8_STAGE(PG8_SA(0, 1), cA + hstep, voffA);
        if (wr == 1) PG8_BAR;
        PG8_WAIT_V(4); PG8_BAR;
        PG8_STAGE(PG8_SB(1, 0), cB + kstep, voffB); PG8_STAGE(PG8_SA(1, 0), cA + kstep, voffA); PG8_STAGE(PG8_SB(1, 1), cB + hstep + kstep, voffB);
        PG8_WAIT_V(6); PG8_BAR;
    }
    for (;;) {
        const bool has_next = S.next(ui + 1, nxt);
        const char* nA = has_next ? (const char*)g.A + (size_t)nxt.pm * tstep : cA; const char* nB = has_next ? (const char*)g.Bt + (size_t)nxt.pn * tstep : cB;
        for (int t = 0; t < nt; t += 2) {
            const bool last = (t == nt - 2);
            const char* a1 = cA + (size_t)(t + 1) * kstep;
            const char* a2 = last ? nA : cA + (size_t)(t + 2) * kstep; const char* b2 = last ? nB : cB + (size_t)(t + 2) * kstep;
            const char* a3 = a2 + kstep; const char* b3 = b2 + kstep;
            if (last && has_next) S.a_ready(nxt);
            if constexpr (SP2) {
            PG8_LDB(B0, 0, 0); PG8_LDB(B1, 0, 1); PG8_SCHED; PG8_LDA(At, 0, 0); PG8_STAGE(PG8_SA(1, 1), a1 + hstep, voffA);
            PG8_WAIT_V(8); PG8_WAIT_L(0); PG8_BAR; PG8_MMA(0, 0, At, B0); PG8_MMA(0, 1, At, B1); PG8_BAR; PG8_SCHED;
            PG8_LDA(At, 0, 1); PG8_STAGE(PG8_SB(0, 0), b2, voffB); PG8_STAGE(PG8_SB(0, 1), b2 + hstep, voffB); PG8_STAGE(PG8_SA(0, 0), a2, voffA);
            PG8_WAIT_V(8); PG8_WAIT_L(0); PG8_BAR; PG8_MMA(1, 0, At, B0); PG8_MMA(1, 1, At, B1); PG8_BAR; PG8_SCHED;
            PG8_LDB(B0, 1, 0); PG8_LDB(B1, 1, 1); PG8_SCHED; PG8_LDA(At, 1, 0); PG8_STAGE(PG8_SA(0, 1), a2 + hstep, voffA);
            PG8_WAIT_V(8); PG8_WAIT_L(0); PG8_BAR; PG8_MMA(0, 0, At, B0); PG8_MMA(0, 1, At, B1); PG8_BAR; PG8_SCHED;
            PG8_LDA(At, 1, 1); PG8_STAGE(PG8_SB(1, 0), b3, voffB); PG8_STAGE(PG8_SB(1, 1), b3 + hstep, voffB); PG8_STAGE(PG8_SA(1, 0), a3, voffA);
            PG8_WAIT_V(8); PG8_WAIT_L(0); PG8_BAR; PG8_MMA(1, 0, At, B0); PG8_MMA(1, 1, At, B1); PG8_BAR; PG8_SCHED;
            } else {
            PG8_LDB(B0, 0, 0); PG8_SCHED; PG8_LDA(At, 0, 0); PG8_STAGE(PG8_SA(1, 1), a1 + hstep, voffA);
            PG8_WAIT_L(8); PG8_BAR; PG8_WAIT_L(0); PG8_MMA(0, 0, At, B0); PG8_BAR; PG8_SCHED;
            PG8_LDB(B1, 0, 1); PG8_STAGE(PG8_SB(0, 0), b2, voffB);
            PG8_BAR; PG8_WAIT_L(0); PG8_MMA(0, 1, At, B1); PG8_BAR;
            PG8_LDA(At, 0, 1); PG8_STAGE(PG8_SA(0, 0), a2, voffA);
            PG8_BAR; PG8_WAIT_L(0); PG8_MMA(1, 0, At, B0); PG8_BAR; PG8_SCHED;
            PG8_STAGE(PG8_SB(0, 1), b2 + hstep, voffB);
            PG8_WAIT_V(6); PG8_BAR; PG8_MMA(1, 1, At, B1); PG8_BAR;
            PG8_LDB(B0, 1, 0); PG8_SCHED; PG8_LDA(At, 1, 0); PG8_STAGE(PG8_SA(0, 1), a2 + hstep, voffA);
            PG8_WAIT_L(8); PG8_BAR; PG8_WAIT_L(0); PG8_MMA(0, 0, At, B0); PG8_BAR; PG8_SCHED;
            PG8_LDB(B1, 1, 1); PG8_STAGE(PG8_SB(1, 0), b3, voffB);
            PG8_BAR; PG8_WAIT_L(0); PG8_MMA(0, 1, At, B1); PG8_BAR;
            PG8_LDA(At, 1, 1); PG8_STAGE(PG8_SA(1, 0), a3, voffA);
            PG8_BAR; PG8_WAIT_L(0); PG8_MMA(1, 0, At, B0); PG8_BAR; PG8_SCHED;
            PG8_STAGE(PG8_SB(1, 1), b3 + hstep, voffB);
            PG8_WAIT_V(6); PG8_BAR; PG8_MMA(1, 1, At, B1); PG8_BAR;
            }
        }
        if constexpr (ALIGN_EPI) { if (wr == 0) PG8_BAR; }
        if constexpr (!Epi::AFTER_DRAIN) { E(acc, cur, wr, wc, fr, fq); S.done(cur); }
        if (!has_next) break;
#pragma unroll
        for (int a = 0; a < 2; ++a)
#pragma unroll
            for (int b = 0; b < 2; ++b)
#pragma unroll
                for (int m = 0; m < 4; ++m)
#pragma unroll
                    for (int n = 0; n < 2; ++n) acc[a][b][m][n] = (f32x4){0.f, 0.f, 0.f, 0.f};
        cur = nxt; cA = nA; cB = nB; ++ui;
        if constexpr (ALIGN_EPI) { if (wr == 1) PG8_BAR; }
    }
    PG8_WAIT_V(0);
    if constexpr (!ALIGN_EPI) { if (wr == 0) PG8_BAR; }
    PG8_BAR;
    if constexpr (Epi::AFTER_DRAIN) { E.fused(acc, cur, wr, wc, fr, fq, lds, wid, lane); S.done(cur); }
#undef PG8_SA
#undef PG8_SB
#undef PG8_STAGE
#undef PG8_LDA
#undef PG8_LDB
#undef PG8_MMA
#undef PG8_WAIT_V
#undef PG8_WAIT_L
#undef PG8_BAR
#undef PG8_SCHED
}
}
#define LAS __attribute__((address_space(3)))
typedef unsigned short bf16_t;
typedef short bf16x8 __attribute__((ext_vector_type(8)));
typedef short s16x4 __attribute__((ext_vector_type(4)));
typedef float f32x4 __attribute__((ext_vector_type(4)));
typedef float f32x2 __attribute__((ext_vector_type(2)));
typedef float f32x16 __attribute__((ext_vector_type(16)));
typedef unsigned u32x4 __attribute__((ext_vector_type(4)));
typedef unsigned u32x2 __attribute__((ext_vector_type(2)));
using pg8::cvt_pk_bf16; using pg8::bf2f;
constexpr int NWAVES = 8, NTHR = 512, LDS_BYTES = 147456;
constexpr size_t MiB = 1u << 20;
constexpr size_t WS_CTL = 0;
constexpr size_t WS_ROPE = 1 * MiB;
constexpr size_t WS_W1U = 4 * MiB, WS_W1D = 16 * MiB, WS_WIN = 22 * MiB, WS_WPA = 33 * MiB, WS_WPB = 34 * MiB, WS_WO = 35 * MiB, WS_W2U = 37 * MiB, WS_W2D = 49 * MiB;
constexpr size_t WS_XB = 56 * MiB;
constexpr size_t WS_H = 92 * MiB;
constexpr size_t WS_Z = 192 * MiB;
constexpr size_t WS_HF1 = 264 * MiB, WS_HF2 = 336 * MiB;
constexpr size_t WS_HB = 408 * MiB;
constexpr size_t WS_QA = 444 * MiB, WS_IQ = 462 * MiB, WS_QB = 480 * MiB;
constexpr size_t WS_KAP = 498 * MiB, WS_VAP = 502 * MiB, WS_IKP = 506 * MiB;
constexpr size_t WS_KBP = 508 * MiB, WS_VBP = 524 * MiB;
constexpr size_t WS_KAS = 540 * MiB, WS_VAS = 573 * MiB, WS_IKS = 606 * MiB;
constexpr size_t WS_KBS = 623 * MiB, WS_VBS = 625 * MiB;
constexpr size_t WS_IW = 627 * MiB, WS_LF = 628 * MiB;
constexpr size_t WS_CBP = 629 * MiB, WS_CBS = 630 * MiB;
constexpr size_t WS_G = 635 * MiB;
constexpr size_t WS_SEL = 707 * MiB;
constexpr size_t WS_YA = 725 * MiB, WS_YB = 743 * MiB;
constexpr size_t WS_MM = 761 * MiB;
constexpr size_t WS_MMB = 833 * MiB;
constexpr size_t WS_SCR = 869 * MiB;
constexpr size_t WS_END = 997 * MiB;

struct Args {
    const float *x_p, *x_s, *c_ak, *c_av, *c_aik, *c_bk, *c_bv, *c_blf, *w1u, *w1d, *ln1g, *ln1b, *win, *b_f, *b_gate, *wpa, *wpb, *wo, *ln2g, *ln2b, *w2u, *w2d, *ln3g, *ln3b;
    float* out; unsigned char* ws; double invf[32]; int ph_lo, ph_hi;
};
struct Frame { LAS unsigned char* lds; int tid, lane, wave, G, bid; };

__device__ __forceinline__ unsigned f2bf(float f) { unsigned u = __float_as_uint(f); return (u + 0x7fffu + ((u >> 16) & 1u)) >> 16; }
__device__ __forceinline__ unsigned pk2(float lo, float hi) { return cvt_pk_bf16(lo, hi); }
__device__ __forceinline__ float wave_sum(float v) {
#pragma unroll
    for (int o = 1; o < 64; o <<= 1) v += __shfl_xor(v, o);
    return v;
}
__host__ __device__ __forceinline__ int rope_src(int P) { return 64 * ((P & 127) >> 5) + (P & 31) + ((P >> 7) << 5); }
struct SrcId { __device__ __forceinline__ int operator()(int n) const { return n; } };
struct SrcUp { __device__ __forceinline__ int operator()(int n) const { const int t = n >> 8, p = n & 255; return (p < 128) ? 128 * t + p : DFF + 128 * t + (p - 128); } };
struct SrcWin { __device__ __forceinline__ int operator()(int n) const {
    const int T = n >> 8, P = n & 255, bj = P >> 7, q = P & 127;
    if (T < 2) return 256 * T + rope_src(P);
    if (T == 2) return (q < 64) ? 512 + 64 * (q >> 5) + (q & 31) + 32 * bj : 640 + 64 * bj + (q - 64);
    if (T < 5) return 768 + 256 * (T - 3) + rope_src(P);
    if (T == 5) { if (q < 32) return 1280 + q + 32 * bj; if (bj == 0 && q < 40) return 1344 + (q - 32); if (bj == 0 && q < 48) return 2888 + (q - 40); return -1; }
    if (T < 8) return 1352 + 256 * (T - 6) + P;
    if (T < 10) return 1864 + 256 * (T - 8) + P;
    if (T < 12) return 2376 + 256 * (T - 10) + P;
    return 2896 + 256 * (T - 12) + P; } };
template <class F> __device__ __forceinline__ void transpose_item(const float* W, int K, int N, int ND, bf16_t* WT, LAS float* scr, int item, int lane, F srcf) {
    const int nblk = ND / 32, kb = item / nblk, nb = item % nblk, k0 = 64 * kb, n0 = 32 * nb;
    const int sc = srcf(n0 + (lane & 31));
#pragma unroll 8
    for (int i = 0; i < 32; ++i) { const int kk = 2 * i + (lane >> 5); scr[kk * 33 + (lane & 31)] = (sc >= 0) ? W[(size_t)(k0 + kk) * N + sc] : 0.f; }
    asm volatile("s_waitcnt lgkmcnt(0)" ::: "memory");
    const int c = lane & 7;
#pragma unroll
    for (int j = 0; j < 4; ++j) { const int n = (lane >> 3) + 8 * j; const LAS float* s = scr + (8 * c) * 33 + n;
        u32x4 o; o.x = pk2(s[0 * 33], s[1 * 33]); o.y = pk2(s[2 * 33], s[3 * 33]); o.z = pk2(s[4 * 33], s[5 * 33]); o.w = pk2(s[6 * 33], s[7 * 33]);
        *(u32x4*)(WT + (size_t)(n0 + n) * K + k0 + 8 * c) = o; }
    asm volatile("s_waitcnt lgkmcnt(0)" ::: "memory");
}
__device__ __forceinline__ void cvt_rows(const float* src, bf16_t* dst, size_t n4, size_t per_src, size_t per_dst, size_t gt, size_t ngt) {
    for (size_t e = gt; e < n4; e += ngt) { const size_t b = e / per_src, r = e - b * per_src; const f32x4 v = *(const f32x4*)(src + 4 * e);
        u32x2 w; w.x = pk2(v[0], v[1]); w.y = pk2(v[2], v[3]); *(u32x2*)(dst + 4 * (b * per_dst + r)) = w; }
}
__device__ __forceinline__ void p0_prologue(const Frame& F, const Args& a) {
    unsigned char* ws = a.ws;
    if (F.bid == 0 && F.tid < 256) ((unsigned*)(ws + WS_CTL))[F.tid] = 0u;
    LAS float* scr = (LAS float*)(F.lds + F.wave * 16384);
    const int gw = F.bid * NWAVES + F.wave, NGW = F.G * NWAVES;
    constexpr int I_UP = 16 * (NUP / 32), I_DN = (DFF / 64) * 32, I_IN = 16 * (NINP / 32), I_P = 8 * 32, I_O = 16 * 32;
    constexpr int NIT = 2 * I_UP + 2 * I_DN + I_IN + 2 * I_P + I_O;
    for (int it = gw; it < NIT; it += NGW) {
        int r = it;
        if (r < I_UP) { transpose_item(a.w1u, DM, NUP, NUP, (bf16_t*)(ws + WS_W1U), scr, r, F.lane, SrcUp()); continue; } r -= I_UP;
        if (r < I_UP) { transpose_item(a.w2u, DM, NUP, NUP, (bf16_t*)(ws + WS_W2U), scr, r, F.lane, SrcUp()); continue; } r -= I_UP;
        if (r < I_DN) { transpose_item(a.w1d, DFF, DM, DM, (bf16_t*)(ws + WS_W1D), scr, r, F.lane, SrcId()); continue; } r -= I_DN;
        if (r < I_DN) { transpose_item(a.w2d, DFF, DM, DM, (bf16_t*)(ws + WS_W2D), scr, r, F.lane, SrcId()); continue; } r -= I_DN;
        if (r < I_IN) { transpose_item(a.win, DM, NIN, NINP, (bf16_t*)(ws + WS_WIN), scr, r, F.lane, SrcWin()); continue; } r -= I_IN;
        if (r < I_P) { transpose_item(a.wpa, 512, DM, DM, (bf16_t*)(ws + WS_WPA), scr, r, F.lane, SrcId()); continue; } r -= I_P;
        if (r < I_P) { transpose_item(a.wpb, 512, DM, DM, (bf16_t*)(ws + WS_WPB), scr, r, F.lane, SrcId()); continue; } r -= I_P;
        transpose_item(a.wo, DM, DM, DM, (bf16_t*)(ws + WS_WO), scr, r, F.lane, SrcId());
    }
    const size_t gt = (size_t)F.bid * NTHR + F.tid, ngt = (size_t)F.G * NTHR;
    cvt_rows(a.x_p, (bf16_t*)(ws + WS_XB), (size_t)MP * DM / 4, (size_t)MP * DM / 4, 0, gt, ngt);
    cvt_rows(a.x_s, (bf16_t*)(ws + WS_XB) + (size_t)MP * DM, (size_t)MS * DM / 4, (size_t)MS * DM / 4, 0, gt, ngt);
    cvt_rows(a.c_ak, (bf16_t*)(ws + WS_KAS), (size_t)DB * PAST * 32, (size_t)PAST * 32, (size_t)SKV * 32, gt, ngt);
    cvt_rows(a.c_av, (bf16_t*)(ws + WS_VAS), (size_t)DB * PAST * 32, (size_t)PAST * 32, (size_t)SKV * 32, gt, ngt);
    cvt_rows(a.c_aik, (bf16_t*)(ws + WS_IKS), (size_t)DB * PAST * 16, (size_t)PAST * 16, (size_t)SKV * 16, gt, ngt);
    f32x2* rope = (f32x2*)(ws + WS_ROPE);
    for (size_t e = gt; e < (size_t)SEQ * 32; e += ngt) {
        const int pos = (int)(e >> 5), j = (int)(e & 31); const double ang = (double)pos * a.invf[j];
        const double kq = __builtin_rint(ang * 0.63661977236758134308); double r = __builtin_fma(-kq, 1.57079632679489655800e+00, ang); r = __builtin_fma(-kq, 6.12323399573676603587e-17, r);
        const double r2 = r * r;
        const double sn = r * (1.0 + r2 * (-1.0 / 6 + r2 * (1.0 / 120 + r2 * (-1.0 / 5040 + r2 * (1.0 / 362880 + r2 * (-1.0 / 39916800 + r2 * (1.0 / 6227020800.0)))))));
        const double cn = 1.0 + r2 * (-0.5 + r2 * (1.0 / 24 + r2 * (-1.0 / 720 + r2 * (1.0 / 40320 + r2 * (-1.0 / 3628800 + r2 * (1.0 / 479001600.0))))));
        const int qd = ((int)(long long)kq) & 3; double s, c;
        if (qd == 0) { s = sn; c = cn; } else if (qd == 1) { s = cn; c = -sn; } else if (qd == 2) { s = -sn; c = -cn; } else { s = -cn; c = sn; }
        rope[e] = (f32x2){(float)c, (float)s};
    }
}
__device__ __forceinline__ void ln_pass(const Frame& F, const float* Z, const float* g, const float* b, float* of, bf16_t* ob) {
    const int gw = F.bid * NWAVES + F.wave, NGW = F.G * NWAVES;
    f32x4 gv[4], bv[4];
#pragma unroll
    for (int j = 0; j < 4; ++j) { gv[j] = *(const f32x4*)(g + 4 * F.lane + 256 * j); bv[j] = *(const f32x4*)(b + 4 * F.lane + 256 * j); }
    for (int row = gw; row < MT; row += NGW) {
        const f32x4* zr = (const f32x4*)(Z + (size_t)row * DM) + F.lane; f32x4 v[4]; float s = 0.f;
#pragma unroll
        for (int j = 0; j < 4; ++j) { v[j] = zr[64 * j]; s += (v[j][0] + v[j][1]) + (v[j][2] + v[j][3]); }
        const float mean = wave_sum(s) * (1.f / DM); float s2 = 0.f;
#pragma unroll
        for (int j = 0; j < 4; ++j) { v[j] = v[j] - mean; s2 += (v[j][0] * v[j][0] + v[j][1] * v[j][1]) + (v[j][2] * v[j][2] + v[j][3] * v[j][3]); }
        const float rstd = 1.f / sqrtf(wave_sum(s2) * (1.f / DM) + LN_EPS);
#pragma unroll
        for (int j = 0; j < 4; ++j) { const f32x4 y = v[j] * rstd * gv[j] + bv[j];
            *((f32x4*)(of + (size_t)row * DM) + F.lane + 64 * j) = y;
            if (ob) { u32x2 w; w.x = pk2(y[0], y[1]); w.y = pk2(y[2], y[3]); *((u32x2*)(ob + (size_t)row * DM) + F.lane + 64 * j) = w; } }
    }
}
__device__ __forceinline__ void cumsum_block(const Frame& F, const Args& a, int sb) {
    LAS float* tot = (LAS float*)F.lds;
    const int i = F.tid >> 3, h = F.tid & 7;
    const float* LF = (const float*)(a.ws + WS_LF);
    if (sb < NB) {
        const float* src = LF + ((size_t)sb * SEQ + 128 * i) * 8 + h; float s = 0.f;
        for (int t = 0; t < 128; ++t) s += src[t * 8];
        tot[i * 8 + h] = s; __syncthreads();
        float c = 0.f; for (int k = 0; k < i; ++k) c += tot[k * 8 + h];
        float* dst = (float*)(a.ws + WS_CBP) + ((size_t)sb * 8 + h) * SEQ + 128 * i;
        for (int t = 0; t < 128; ++t) { c += src[t * 8]; dst[t] = -c * LOG2E; }
    } else {
        const int b = sb - NB; const float* src = a.c_blf + ((size_t)b * PAST + 64 * i) * 8 + h; float s = 0.f;
        for (int t = 0; t < 64; ++t) s += src[t * 8];
        tot[i * 8 + h] = s; __syncthreads();
        float c = 0.f; for (int k = 0; k < i; ++k) c += tot[k * 8 + h];
        float* dst = (float*)(a.ws + WS_CBS) + ((size_t)b * 8 + h) * SKV + 64 * i;
        for (int t = 0; t < 64; ++t) { c += src[t * 8]; dst[t] = -c * LOG2E; }
        if (i == 63) { const float* sn = LF + ((size_t)MP + b * DS) * 8 + h; float* dn = (float*)(a.ws + WS_CBS) + ((size_t)b * 8 + h) * SKV + PAST;
            for (int t = 0; t < DS; ++t) { c += sn[t * 8]; dn[t] = -c * LOG2E; } }
    }
    __syncthreads();
}
__device__ __forceinline__ unsigned f2key(float f) { const unsigned u = __float_as_uint(f); return (u & 0x80000000u) ? ~u : (u | 0x80000000u); }
__device__ __forceinline__ void indexer_item(const Frame& F, const Args& a, int item) {
    int b, c, qq; bool samp;
    if (item < 504) { c = 127 - (item >> 3); b = (item >> 2) & 1; qq = item & 3; samp = false; }
    else if (item < 632) { const int s = item - 504; b = s >> 2; qq = s & 3; c = 64; samp = true; }
    else { const int r = item - 632; c = 64 - (r >> 3); b = (r >> 2) & 1; qq = r & 3; samp = false; }
    const int qrow0 = samp ? MP + b * DS + 16 * qq : b * SEQ + 64 * c + 16 * qq;
    const int n = samp ? SKV : 64 * (c + 1);
    const bf16_t* IK = samp ? (const bf16_t*)(a.ws + WS_IKS) + (size_t)b * SKV * 64 : (const bf16_t*)(a.ws + WS_IKP) + (size_t)b * SEQ * 64;
    const bf16_t* IQ = (const bf16_t*)(a.ws + WS_IQ); const float* IW = (const float*)(a.ws + WS_IW);
    int* SEL = (int*)(a.ws + WS_SEL);
    int lane = F.lane; asm volatile("" : "+v"(lane));
    const int l31 = lane & 31, hi = lane >> 5;
    if (n <= 256) {
        for (int e = F.tid; e < 16 * 256; e += NTHR) { const int q = e >> 8, s = e & 255; SEL[(size_t)(qrow0 + q) * 256 + s] = (s < n) ? s : 0; }
        return;
    }
    float* scr = (float*)(a.ws + WS_SCR) + (size_t)F.bid * 16 * 8192;
    {
        bf16x8 afr[4][4]; f32x4 wq[4][2][2];
        const int qa = 2 * ((l31 >> 2) & 1) + (l31 >> 4), ha = 4 * ((l31 >> 3) & 1) + (l31 & 3);
#pragma unroll
        for (int mt = 0; mt < 4; ++mt) {
#pragma unroll
            for (int ks = 0; ks < 4; ++ks) afr[mt][ks] = *(const bf16x8*)(IQ + (size_t)(qrow0 + 4 * mt + qa) * 512 + 64 * ha + 16 * ks + 8 * hi);
#pragma unroll
            for (int aa = 0; aa < 2; ++aa) { const float* wp = IW + (size_t)(qrow0 + 4 * mt + 2 * hi + aa) * 8; wq[mt][aa][0] = *(const f32x4*)wp; wq[mt][aa][1] = *(const f32x4*)(wp + 4); }
        }
        bf16x8 bnx[4];
        { const int kt0 = (F.wave < n / 32) ? F.wave : 0;
#pragma unroll
          for (int ks = 0; ks < 4; ++ks) bnx[ks] = *(const bf16x8*)(IK + (size_t)(32 * kt0 + l31) * 64 + 16 * ks + 8 * hi); }
        for (int kt = F.wave; kt < n / 32; kt += NWAVES) {
            bf16x8 bfr[4];
#pragma unroll
            for (int ks = 0; ks < 4; ++ks) bfr[ks] = bnx[ks];
            { const int ktn = (kt + NWAVES < n / 32) ? kt + NWAVES : kt;
#pragma unroll
              for (int ks = 0; ks < 4; ++ks) bnx[ks] = *(const bf16x8*)(IK + (size_t)(32 * ktn + l31) * 64 + 16 * ks + 8 * hi); }
#pragma unroll
            for (int mt = 0; mt < 4; ++mt) {
                f32x16 acc = {};
#pragma unroll
                for (int ks = 0; ks < 4; ++ks) acc = __builtin_amdgcn_mfma_f32_32x32x16_bf16(afr[mt][ks], bfr[ks], acc, 0, 0, 0);
#pragma unroll
                for (int aa = 0; aa < 2; ++aa) { float s = 0.f;
#pragma unroll
                    for (int h = 0; h < 8; ++h) s += fmaxf(acc[8 * aa + h], 0.f) * wq[mt][aa][h >> 2][h & 3];
                    scr[(size_t)(4 * mt + 2 * hi + aa) * 8192 + 32 * kt + l31] = s; }
            }
        }
    }
    __syncthreads(); __builtin_amdgcn_fence(__ATOMIC_ACQUIRE, "agent");
    LAS unsigned* hist = (LAS unsigned*)(F.lds + F.wave * 8192);
    const int n4 = n >> 2;
    for (int q = F.wave; q < 16; q += NWAVES) {
        const float* sp = scr + (size_t)q * 8192;
        u32x4 k[32];
#pragma unroll
        for (int it = 0; it < 32; ++it) {
            k[it] = (u32x4){0u, 0u, 0u, 0u};
            if (64 * it < n4) { const int i4 = 64 * it + lane;
                if (i4 < n4) { const f32x4 v = *(const f32x4*)(sp + 4 * i4); k[it] = (u32x4){f2key(v[0]), f2key(v[1]), f2key(v[2]), f2key(v[3])}; } }
        }
        unsigned prefix = 0; int kk = 256;
#pragma unroll 1
        for (int lev = 0; lev < 3; ++lev) {
            const int shift = (lev == 0) ? 21 : (lev == 1) ? 10 : 0, bits = (lev == 2) ? 10 : 11, nbin = 1 << bits, per = nbin >> 6;
            const unsigned hshift = (unsigned)(shift + bits), bmask = (unsigned)(nbin - 1);
            for (int j = 0; j < per; ++j) hist[lane + 64 * j] = 0u;
            asm volatile("s_waitcnt lgkmcnt(0)" ::: "memory");
#pragma unroll
            for (int it = 0; it < 32; ++it) {
                if (64 * it < n4) {
#pragma unroll
                    for (int e = 0; e < 4; ++e) { const unsigned key = k[it][e];
                        const bool m = (lev == 0) ? (key != 0u) : ((key >> hshift) == prefix && key != 0u);
                        if (m) __hip_atomic_fetch_add(&hist[(key >> shift) & bmask], 1u, __ATOMIC_RELAXED, __HIP_MEMORY_SCOPE_WORKGROUP); }
                }
            }
            asm volatile("s_waitcnt lgkmcnt(0)" ::: "memory");
            unsigned s = 0; for (int j = 0; j < per; ++j) s += hist[lane * per + j];
            unsigned T = s;
#pragma unroll
            for (int off = 1; off < 64; off <<= 1) { const unsigned v = __shfl_down(T, off); if (lane + off < 64) T += v; }
            const unsigned long long bal = __ballot(T >= (unsigned)kk);
            const int js = __popcll(bal) - 1;
            unsigned run = __shfl(T, (js + 1) & 63); if (js >= 63) run = 0u;
            int digit = js * per;
            for (int bb = per - 1; bb >= 0; --bb) { const unsigned cnt = hist[js * per + bb]; if (run + cnt >= (unsigned)kk) { digit = js * per + bb; break; } run += cnt; }
            kk -= (int)run; prefix = (prefix << bits) | (unsigned)digit;
            asm volatile("s_waitcnt lgkmcnt(0)" ::: "memory");
        }
        int* so = SEL + (size_t)(qrow0 + q) * 256; int obase = 0, ebase = 0;
        const unsigned long long below = (1ull << lane) - 1ull;
#pragma unroll
        for (int it = 0; it < 32; ++it) {
            if (64 * it < n4) {
                bool tk[4]; unsigned long long be[4]; bool eqf[4]; unsigned long long anyeq = 0ull;
#pragma unroll
                for (int e = 0; e < 4; ++e) { eqf[e] = (k[it][e] == prefix); be[e] = __ballot(eqf[e]); anyeq |= be[e]; tk[e] = k[it][e] > prefix; }
                if (anyeq) {
                    int er = ebase + __popcll(be[0] & below) + __popcll(be[1] & below) + __popcll(be[2] & below) + __popcll(be[3] & below);
#pragma unroll
                    for (int e = 0; e < 4; ++e) { if (eqf[e]) { tk[e] = er < kk; ++er; } }
                    ebase += __popcll(be[0]) + __popcll(be[1]) + __popcll(be[2]) + __popcll(be[3]);
                }
                unsigned long long bt[4];
#pragma unroll
                for (int e = 0; e < 4; ++e) bt[e] = __ballot(tk[e]);
                int pos = obase + __popcll(bt[0] & below) + __popcll(bt[1] & below) + __popcll(bt[2] & below) + __popcll(bt[3] & below);
#pragma unroll
                for (int e = 0; e < 4; ++e) { if (tk[e]) { if (pos < 256) so[pos] = 256 * it + 4 * lane + e; ++pos; } }
                obase += __popcll(bt[0]) + __popcll(bt[1]) + __popcll(bt[2]) + __popcll(bt[3]);
            }
        }
    }
    __syncthreads();
}
__device__ __forceinline__ void dsa_query(const Frame& F, const Args& a, int row) {
    int lane = F.lane; asm volatile("" : "+v"(lane));
    const int j = lane & 15, kq = lane >> 4;
    const bool samp = row >= MP; const int rs = row - MP;
    const int nsel = samp ? 256 : min(256, 64 * (((row & (SEQ - 1)) >> 6) + 1));
    const bf16_t* KA = samp ? (const bf16_t*)(a.ws + WS_KAS) + (size_t)(rs >> 6) * SKV * 128 : (const bf16_t*)(a.ws + WS_KAP) + (size_t)(row >> 13) * SEQ * 128;
    const bf16_t* VA = samp ? (const bf16_t*)(a.ws + WS_VAS) + (size_t)(rs >> 6) * SKV * 128 : (const bf16_t*)(a.ws + WS_VAP) + (size_t)(row >> 13) * SEQ * 128;
    const int* sel = (const int*)(a.ws + WS_SEL) + (size_t)row * 256;
    const bf16_t* QA = (const bf16_t*)(a.ws + WS_QA) + (size_t)row * 512;
    LAS float* pl = (LAS float*)(F.lds + F.wave * 9216);
    LAS int* sl = (LAS int*)(F.lds + F.wave * 9216 + 8192);
#pragma unroll
    for (int i = 0; i < 4; ++i) sl[lane + 64 * i] = sel[lane + 64 * i];
    bf16x8 bq[4];
#pragma unroll
    for (int ks = 0; ks < 4; ++ks) { bf16x8 z = {}; bq[ks] = (j < 8 && (ks >> 1) == (j >> 2)) ? *(const bf16x8*)(QA + 64 * j + 32 * (ks & 1) + 8 * kq) : z; }
    asm volatile("s_waitcnt lgkmcnt(0)" ::: "memory");
    f32x4 acc[16]; const int nt = nsel >> 4;
#pragma unroll
    for (int t = 0; t < 16; ++t) {
        acc[t] = (f32x4){-INFINITY, -INFINITY, -INFINITY, -INFINITY};
        if (t < nt) { const int idx = sl[16 * t + j]; const bf16_t* kr = KA + (size_t)idx * 128 + 8 * kq; f32x4 c = {0.f, 0.f, 0.f, 0.f};
#pragma unroll
            for (int ks = 0; ks < 4; ++ks) c = __builtin_amdgcn_mfma_f32_16x16x32_bf16(*(const bf16x8*)(kr + 32 * ks), bq[ks], c, 0, 0, 0);
            acc[t] = c; }
    }
    float mx = -INFINITY;
#pragma unroll
    for (int t = 0; t < 16; ++t) mx = fmaxf(mx, fmaxf(fmaxf(acc[t][0], acc[t][1]), fmaxf(acc[t][2], acc[t][3])));
    mx = fmaxf(mx, __shfl_xor(mx, 16)); mx = fmaxf(mx, __shfl_xor(mx, 32));
    float sum = 0.f;
#pragma unroll
    for (int t = 0; t < 16; ++t)
#pragma unroll
        for (int i = 0; i < 4; ++i) { const float p = __builtin_amdgcn_exp2f(acc[t][i] - mx); acc[t][i] = p; sum += p; }
    sum += __shfl_xor(sum, 16); sum += __shfl_xor(sum, 32);
    const float inv = 1.0f / sum;
    if (j < 8) {
#pragma unroll
        for (int t = 0; t < 16; ++t)
#pragma unroll
            for (int i = 0; i < 4; ++i) pl[(16 * t + 4 * kq + i) * 8 + j] = acc[t][i] * inv;
    }
    asm volatile("s_waitcnt lgkmcnt(0)" ::: "memory");
    const int g = lane >> 5; float o[4][2] = {};
#pragma unroll 8
    for (int s = 0; s < nsel; ++s) { const int idx = sl[s]; const unsigned v = *(const unsigned*)(VA + (size_t)idx * 128 + 2 * lane); const f32x4 p4 = *(const LAS f32x4*)(pl + s * 8 + 4 * g);
        const float v0 = __uint_as_float(v << 16), v1 = __uint_as_float(v & 0xffff0000u);
#pragma unroll
        for (int hh = 0; hh < 4; ++hh) { o[hh][0] += p4[hh] * v0; o[hh][1] += p4[hh] * v1; } }
    bf16_t* ya = (bf16_t*)(a.ws + WS_YA) + (size_t)row * 512 + 2 * (lane & 31);
#pragma unroll
    for (int hh = 0; hh < 4; ++hh) *(unsigned*)(ya + 64 * (4 * g + hh)) = pk2(o[hh][0], o[hh][1]);
    asm volatile("s_waitcnt lgkmcnt(0)" ::: "memory");
}
constexpr int VST = 72;
constexpr int FOX_V = 0, FOX_M = 8 * 64 * VST * 2  , FOX_L = FOX_M + 2048, FOX_O = FOX_L + 256, FOX_END = FOX_O + 64 * 65 * 4;
static_assert(FOX_END <= 131072, "fox lds");
__device__ __forceinline__ int crow(int r, int hi) { return (r & 3) + 8 * (r >> 2) + 4 * hi; }
__device__ __forceinline__ bf16x8 cvt8(f32x4 a, f32x4 b) { u32x4 w; w.x = pk2(a[0], a[1]); w.y = pk2(a[2], a[3]); w.z = pk2(b[0], b[1]); w.w = pk2(b[2], b[3]); return __builtin_bit_cast(bf16x8, w); }
__device__ __forceinline__ void fox_unit(const Frame& F, const Args& a, int unit) {
    const bool samp = unit < 256; int b, h, qi, ntiles, rowq0; const float* Cb;
    if (samp) { b = unit >> 3; h = unit & 7; qi = 64; ntiles = 65; rowq0 = MP + b * DS; Cb = (const float*)(a.ws + WS_CBS) + ((size_t)b * 8 + h) * SKV; }
    else { const int r = unit - 256; qi = 127 - (r >> 4); b = (r >> 3) & 1; h = r & 7; ntiles = qi + 1; rowq0 = b * SEQ + 64 * qi; Cb = (const float*)(a.ws + WS_CBP) + ((size_t)b * 8 + h) * SEQ; }
    int lane = F.lane; asm volatile("" : "+v"(lane)); int tidl = F.tid; asm volatile("" : "+v"(tidl));
    const int q32 = lane & 31, hi = lane >> 5, w = F.wave;
    const bf16_t* Kb = samp ? (const bf16_t*)(a.ws + WS_KBS) + (size_t)(b * DS) * 512 + 64 * h : (const bf16_t*)(a.ws + WS_KBP) + (size_t)(b * SEQ) * 512 + 64 * h;
    const bf16_t* Vb = samp ? (const bf16_t*)(a.ws + WS_VBS) + (size_t)(b * DS) * 512 + 64 * h : (const bf16_t*)(a.ws + WS_VBP) + (size_t)(b * SEQ) * 512 + 64 * h;
    const float* Kc = a.c_bk + ((size_t)b * PAST * 8 + h) * 64; const float* Vc = a.c_bv + ((size_t)b * PAST * 8 + h) * 64;
    LAS bf16_t* vl = (LAS bf16_t*)(F.lds + FOX_V) + w * 64 * VST;
    LAS float* mb = (LAS float*)(F.lds + FOX_M); LAS float* lt = (LAS float*)(F.lds + FOX_L); LAS float* ot = (LAS float*)(F.lds + FOX_O);
    for (int e = tidl; e < 64 * 65 + 64; e += NTHR) lt[e] = 0.f;
    const bf16_t* QB = (const bf16_t*)(a.ws + WS_QB);
    bf16x8 qf[2][4];
#pragma unroll
    for (int qb = 0; qb < 2; ++qb)
#pragma unroll
        for (int ks = 0; ks < 4; ++ks) qf[qb][ks] = *(const bf16x8*)(QB + (size_t)(rowq0 + 32 * qb + q32) * 512 + 64 * h + 16 * ks + 8 * hi);
    float mrun[2] = {-INFINITY, -INFINITY}, lrun[2] = {0.f, 0.f};
    f32x16 o[2][2];
#pragma unroll
    for (int qb = 0; qb < 2; ++qb)
#pragma unroll
        for (int db = 0; db < 2; ++db)
#pragma unroll
            for (int r = 0; r < 16; ++r) o[qb][db][r] = 0.f;
    const int gi = lane >> 4, li = lane & 15;
    const unsigned kofb = (unsigned)(q32 * 1024 + 16 * hi);
    const unsigned kofc = (unsigned)(q32 * 2048 + 32 * hi);
    const unsigned cof = (unsigned)(16 * hi);
    const int troff = ((4 * hi + (li >> 2)) * VST + 16 * (gi & 1) + 4 * (li & 3));
    for (int tile = w; tile < ntiles; tile += NWAVES) {
        const bool cache = samp && tile < 64, diag = (tile == ntiles - 1);
        const int kv0 = 64 * tile; const int kvl = samp ? (cache ? kv0 : 0) : kv0;
        bf16x8 kf[2][4];
        if (cache) {
            const char* kp = (const char*)Kc + (size_t)kvl * 2048 + kofc;
#pragma unroll
            for (int hf = 0; hf < 2; ++hf) { const char* kph = kp + hf * 65536;
#pragma unroll
                for (int ks = 0; ks < 4; ++ks) kf[hf][ks] = cvt8(*(const f32x4*)(kph + 64 * ks), *(const f32x4*)(kph + 64 * ks + 16));
                asm volatile("" ::: "memory"); }
            const char* vp = (const char*)Vc + (size_t)kvl * 2048 + (unsigned)(lane * 2048);
#pragma unroll
            for (int c = 0; c < 16; ++c) { const f32x4 v = *(const f32x4*)(vp + 16 * c);
                u32x2 wv; wv.x = pk2(v[0], v[1]); wv.y = pk2(v[2], v[3]); *(LAS u32x2*)(vl + lane * VST + 4 * c) = wv;
                if ((c & 7) == 7) asm volatile("" ::: "memory"); }
        } else {
            const char* kp = (const char*)Kb + (size_t)kvl * 1024 + kofb;
#pragma unroll
            for (int hf = 0; hf < 2; ++hf) { const char* kph = kp + hf * 32768;
#pragma unroll
                for (int ks = 0; ks < 4; ++ks) kf[hf][ks] = *(const bf16x8*)(kph + 32 * ks); }
            asm volatile("" ::: "memory");
            const char* vp = (const char*)Vb + (size_t)kvl * 1024 + (unsigned)(lane * 1024);
#pragma unroll
            for (int c = 0; c < 8; ++c) *(LAS u32x4*)(vl + lane * VST + 8 * c) = *(const u32x4*)(vp + 16 * c);
            asm volatile("" ::: "memory");
        }
#pragma unroll
        for (int qb = 0; qb < 2; ++qb) {
            f32x16 s[2];
#pragma unroll
            for (int hf = 0; hf < 2; ++hf) {
#pragma unroll
                for (int g4 = 0; g4 < 4; ++g4) { const f32x4 c4 = *(const f32x4*)((const char*)(Cb + kv0) + cof + (128 * hf + 32 * g4));
                    s[hf][4 * g4 + 0] = c4[0]; s[hf][4 * g4 + 1] = c4[1]; s[hf][4 * g4 + 2] = c4[2]; s[hf][4 * g4 + 3] = c4[3]; }
#pragma unroll
                for (int ks = 0; ks < 4; ++ks) s[hf] = __builtin_amdgcn_mfma_f32_32x32x16_bf16(kf[hf][ks], qf[qb][ks], s[hf], 0, 0, 0);
            }
            if (diag) { const int ql = 32 * qb + q32;
#pragma unroll
                for (int hf = 0; hf < 2; ++hf)
#pragma unroll
                    for (int r = 0; r < 16; ++r) if (32 * hf + crow(r, hi) > ql) s[hf][r] = -INFINITY; }
            float mx = -INFINITY;
#pragma unroll
            for (int r = 0; r < 16; ++r) mx = fmaxf(mx, fmaxf(s[0][r], s[1][r]));
            mx = fmaxf(mx, __shfl_xor(mx, 32));
            const float mn = fmaxf(mrun[qb], mx); const float al = __builtin_amdgcn_exp2f(mrun[qb] - mn); mrun[qb] = mn;
            float sum = 0.f;
#pragma unroll
            for (int hf = 0; hf < 2; ++hf)
#pragma unroll
                for (int r = 0; r < 16; ++r) { const float p = __builtin_amdgcn_exp2f(s[hf][r] - mn); s[hf][r] = p; sum += p; }
            lrun[qb] = lrun[qb] * al + sum;
#pragma unroll
            for (int db = 0; db < 2; ++db)
#pragma unroll
                for (int r = 0; r < 16; ++r) o[qb][db][r] *= al;
            bf16x8 pk[4];
#pragma unroll
            for (int k4 = 0; k4 < 4; ++k4) { const int hf = k4 >> 1, r0 = 8 * (k4 & 1); u32x4 wv;
                wv.x = pk2(s[hf][r0 + 0], s[hf][r0 + 1]); wv.y = pk2(s[hf][r0 + 2], s[hf][r0 + 3]); wv.z = pk2(s[hf][r0 + 4], s[hf][r0 + 5]); wv.w = pk2(s[hf][r0 + 6], s[hf][r0 + 7]);
                pk[k4] = __builtin_bit_cast(bf16x8, wv); }
            asm volatile("s_waitcnt lgkmcnt(0)" ::: "memory");
#pragma unroll
            for (int db = 0; db < 2; ++db)
#pragma unroll
                for (int k4 = 0; k4 < 4; ++k4) {
                    const LAS bf16_t* p0 = vl + troff + (16 * k4) * VST + 32 * db;
                    const s16x4 lo = __builtin_bit_cast(s16x4, __builtin_amdgcn_ds_read_tr16_b64_v4i16((LAS s16x4*)p0));
                    const s16x4 hh = __builtin_bit_cast(s16x4, __builtin_amdgcn_ds_read_tr16_b64_v4i16((LAS s16x4*)(p0 + 8 * VST)));
                    const bf16x8 vt = (bf16x8){lo[0], lo[1], lo[2], lo[3], hh[0], hh[1], hh[2], hh[3]};
                    o[qb][db] = __builtin_amdgcn_mfma_f32_32x32x16_bf16(vt, pk[k4], o[qb][db], 0, 0, 0);
                }
        }
        asm volatile("s_waitcnt lgkmcnt(0)" ::: "memory");
    }
#pragma unroll
    for (int qb = 0; qb < 2; ++qb) { lrun[qb] += __shfl_xor(lrun[qb], 32); if (hi == 0) mb[w * 64 + 32 * qb + q32] = mrun[qb]; }
    __syncthreads();
#pragma unroll
    for (int qb = 0; qb < 2; ++qb) {
        const int q = 32 * qb + q32; float mg = -INFINITY;
#pragma unroll
        for (int ww = 0; ww < NWAVES; ++ww) mg = fmaxf(mg, mb[ww * 64 + q]);
        const float sc = __builtin_amdgcn_exp2f(mrun[qb] - mg);
        if (w < ntiles) {
            if (hi == 0) __hip_atomic_fetch_add(lt + q, lrun[qb] * sc, __ATOMIC_RELAXED, __HIP_MEMORY_SCOPE_WORKGROUP);
#pragma unroll
            for (int db = 0; db < 2; ++db)
#pragma unroll
                for (int r = 0; r < 16; ++r) __hip_atomic_fetch_add(ot + q * 65 + 32 * db + crow(r, hi), o[qb][db][r] * sc, __ATOMIC_RELAXED, __HIP_MEMORY_SCOPE_WORKGROUP);
        }
    }
    __syncthreads();
    { const int q = tidl >> 3, d0 = 8 * (tidl & 7); const float il = 1.0f / lt[q]; const LAS float* op = ot + q * 65 + d0;
      u32x4 wv; wv.x = pk2(op[0] * il, op[1] * il); wv.y = pk2(op[2] * il, op[3] * il); wv.z = pk2(op[4] * il, op[5] * il); wv.w = pk2(op[6] * il, op[7] * il);
      *(u32x4*)((bf16_t*)(a.ws + WS_YB) + (size_t)(rowq0 + q) * 512 + 64 * h + d0) = wv; }
    __syncthreads();
}
constexpr int N_PHASES = 13;
#ifndef MK_PER_PHASE
#define MK_PER_PHASE 0
#endif
template <class Epi> __device__ __forceinline__ void run_gemm(const Frame& F, const bf16_t* A, const bf16_t* Bt, int N, int K, const Epi& E) {
    pg8::Gemm g{A, Bt, MT, N, K}; pg8::StaticOrder S; S.init(MT, N, F.G, F.bid);
    pg8::gemm_phase<Epi, pg8::StaticOrder, true, true>(F.lds, g, S, E);
}
__global__ void __launch_bounds__(NTHR, 2) mega_fwd(Args a) {
    __builtin_assume(__builtin_amdgcn_workitem_id_y() == 0); __builtin_assume(__builtin_amdgcn_workitem_id_z() == 0);
    extern __shared__ __attribute__((aligned(16))) unsigned char lds_raw[];
    cg::grid_group grid = cg::this_grid();
    Frame F; F.lds = (LAS unsigned char*)lds_raw; F.tid = threadIdx.x; F.lane = F.tid & 63; F.wave = __builtin_amdgcn_readfirstlane(F.tid >> 6); F.G = gridDim.x; F.bid = blockIdx.x;
    unsigned char* ws = a.ws;
    LAS int* sh_item = (LAS int*)(F.lds + 131072);
    const int lo = a.ph_lo, hi = a.ph_hi;
#define IN(k) (lo <= (k) && (k) < hi)
#define SEAM(k) do { if (IN(k) && IN((k) + 1)) grid.sync(); } while (0)
#ifndef PROBE_DUP
#define PROBE_DUP 0
#endif
#define REP(code) (PROBE_DUP == (code) ? 2 : 1)
    if (IN(0)) { for (int rep = 0; rep < REP(1); ++rep) p0_prologue(F, a); } SEAM(0);
    if (PROBE_DUP == 8) { for (int i = 0; i < 10; ++i) grid.sync(); }
    if (IN(1)) for (int rep = 0; rep < 1; ++rep) { pg8::EpiSwiGLU E{(bf16_t*)(ws + WS_H)}; run_gemm(F, (const bf16_t*)(ws + WS_XB), (const bf16_t*)(ws + WS_W1U), NUP, DM, E); if (PROBE_DUP == 9) run_gemm(F, (const bf16_t*)(ws + WS_XB), (const bf16_t*)(ws + WS_W1U), NUP, DM, E); } SEAM(1);
    if (IN(2)) for (int rep = 0; rep < 1; ++rep) { pg8::EpiRes E{a.x_p, a.x_s, (float*)(ws + WS_Z), 0.5f}; run_gemm(F, (const bf16_t*)(ws + WS_H), (const bf16_t*)(ws + WS_W1D), DM, DFF, E); if (PROBE_DUP == 10) run_gemm(F, (const bf16_t*)(ws + WS_H), (const bf16_t*)(ws + WS_W1D), DM, DFF, E); } SEAM(2);
    if (IN(3)) for (int rep = 0; rep < REP(3); ++rep) { ln_pass(F, (const float*)(ws + WS_Z), a.ln1g, a.ln1b, (float*)(ws + WS_HF1), (bf16_t*)(ws + WS_HB)); } SEAM(3);
    if (IN(4)) for (int rep = 0; rep < 1; ++rep) {
        pg8::EpiWin E{a.out, (bf16_t*)(ws + WS_QA), (bf16_t*)(ws + WS_IQ), (bf16_t*)(ws + WS_QB), (bf16_t*)(ws + WS_KAP), (bf16_t*)(ws + WS_VAP), (bf16_t*)(ws + WS_IKP), (bf16_t*)(ws + WS_KBP), (bf16_t*)(ws + WS_VBP),
                      (bf16_t*)(ws + WS_KAS), (bf16_t*)(ws + WS_VAS), (bf16_t*)(ws + WS_IKS), (bf16_t*)(ws + WS_KBS), (bf16_t*)(ws + WS_VBS), (bf16_t*)(ws + WS_G), (float*)(ws + WS_IW), (float*)(ws + WS_LF),
                      (const pg8::f32x2*)(ws + WS_ROPE), a.b_f, a.b_gate};
        run_gemm(F, (const bf16_t*)(ws + WS_HB), (const bf16_t*)(ws + WS_WIN), NINP, DM, E);
        if (PROBE_DUP == 11) run_gemm(F, (const bf16_t*)(ws + WS_HB), (const bf16_t*)(ws + WS_WIN), NINP, DM, E);
    } SEAM(4);
    if (IN(5)) {
        if (F.bid < NB + DB) cumsum_block(F, a, F.bid);
        for (int rep = 0; rep < REP(5); ++rep) { unsigned* ctr = (unsigned*)(ws + WS_CTL) + 128 * rep;
        for (;;) { if (F.tid == 0) *sh_item = (int)atomicAdd(ctr, 1u); __syncthreads(); const int item = *sh_item; __syncthreads(); if (item >= 1152) break; indexer_item(F, a, item); } }
    } SEAM(5);
    if (IN(6)) {
        unsigned* ctr = (unsigned*)(ws + WS_CTL) + 64;
        for (;;) { if (F.tid == 0) *sh_item = (int)atomicAdd(ctr, 1u); __syncthreads(); const int item = *sh_item; __syncthreads();
            if (item >= 2304 + MT / 64) break;
            if (item < 2304) fox_unit(F, a, item);
            else { const int r0 = (item - 2304) * 64; for (int i = 0; i < 8; ++i) dsa_query(F, a, r0 + 8 * i + F.wave); } }
        if (PROBE_DUP == 6) { ctr += 64; for (;;) { if (F.tid == 0) *sh_item = (int)atomicAdd(ctr, 1u); __syncthreads(); const int item = *sh_item; __syncthreads(); if (item >= 2304) break; fox_unit(F, a, item); } }
        if (PROBE_DUP == 7) { ctr += 64; for (;;) { if (F.tid == 0) *sh_item = (int)atomicAdd(ctr, 1u); __syncthreads(); const int item = *sh_item; __syncthreads(); if (item >= MT / 64) break;
            const int r0 = item * 64; for (int i = 0; i < 8; ++i) dsa_query(F, a, r0 + 8 * i + F.wave); } }
    } SEAM(6);
    if (IN(7)) for (int rep = 0; rep < 1; ++rep) {
        pg8::EpiProjA EA{(const bf16_t*)(ws + WS_G), (float*)(ws + WS_MM)}; run_gemm(F, (const bf16_t*)(ws + WS_YA), (const bf16_t*)(ws + WS_WPA), DM, 512, EA);
        pg8::EpiProjB EB{(const bf16_t*)(ws + WS_G), (const float*)(ws + WS_MM), (bf16_t*)(ws + WS_MMB)}; run_gemm(F, (const bf16_t*)(ws + WS_YB), (const bf16_t*)(ws + WS_WPB), DM, 512, EB);
    } SEAM(7);
    if (IN(8)) for (int rep = 0; rep < 1; ++rep) { pg8::EpiRes E{(const float*)(ws + WS_HF1), (const float*)(ws + WS_HF1) + (size_t)MP * DM, (float*)(ws + WS_Z), 1.0f}; run_gemm(F, (const bf16_t*)(ws + WS_MMB), (const bf16_t*)(ws + WS_WO), DM, DM, E); if (PROBE_DUP == 12) run_gemm(F, (const bf16_t*)(ws + WS_MMB), (const bf16_t*)(ws + WS_WO), DM, DM, E); } SEAM(8);
    if (IN(9)) for (int rep = 0; rep < REP(3); ++rep) { ln_pass(F, (const float*)(ws + WS_Z), a.ln2g, a.ln2b, (float*)(ws + WS_HF2), (bf16_t*)(ws + WS_HB)); } SEAM(9);
    if (IN(10)) for (int rep = 0; rep < 1; ++rep) { pg8::EpiSwiGLU E{(bf16_t*)(ws + WS_H)}; run_gemm(F, (const bf16_t*)(ws + WS_HB), (const bf16_t*)(ws + WS_W2U), NUP, DM, E); if (PROBE_DUP == 14) run_gemm(F, (const bf16_t*)(ws + WS_HB), (const bf16_t*)(ws + WS_W2U), NUP, DM, E); } SEAM(10);
    if (IN(11)) for (int rep = 0; rep < 1; ++rep) { pg8::EpiRes E{(const float*)(ws + WS_HF2), (const float*)(ws + WS_HF2) + (size_t)MP * DM, (float*)(ws + WS_Z), 0.5f}; run_gemm(F, (const bf16_t*)(ws + WS_H), (const bf16_t*)(ws + WS_W2D), DM, DFF, E); if (PROBE_DUP == 13) run_gemm(F, (const bf16_t*)(ws + WS_H), (const bf16_t*)(ws + WS_W2D), DM, DFF, E); } SEAM(11);
    if (IN(12)) for (int rep = 0; rep < REP(3); ++rep) { ln_pass(F, (const float*)(ws + WS_Z), a.ln3g, a.ln3b, a.out + O_Y, nullptr); }
#undef IN
#undef SEAM
}

extern "C" void kernel_launch(void* const* d_in, const int* in_sizes, int n_in, void* d_out, int out_size, void* d_ws, size_t ws_size, hipStream_t stream) {
    static int grid = 0;
    if (grid == 0) {
        if (n_in != 24 || ws_size < WS_END) { fprintf(stderr, "kernel_launch: expected 24 inputs and >= %zu bytes of workspace (got %d, %zu)\n", (size_t)WS_END, n_in, ws_size); grid = -1; return; }
        int dev = 0, cus = 0, per_cu = 0;
        hipGetDevice(&dev); hipDeviceGetAttribute(&cus, hipDeviceAttributeMultiprocessorCount, dev);
        if (hipFuncSetAttribute((const void*)mega_fwd, hipFuncAttributeMaxDynamicSharedMemorySize, LDS_BYTES) != hipSuccess) { fprintf(stderr, "kernel_launch: hipFuncSetAttribute failed\n"); grid = -1; return; }
        hipOccupancyMaxActiveBlocksPerMultiprocessor(&per_cu, (const void*)mega_fwd, NTHR, LDS_BYTES);
        (void)hipGetLastError();
        if (per_cu < 1) { fprintf(stderr, "kernel_launch: occupancy query says %d blocks per CU\n", per_cu); per_cu = 1; }
        grid = cus;
    }
    if (grid < 0) return;
    Args a{};
    const float** p = (const float**)&a;
    for (int i = 0; i < 24; ++i) p[i] = (const float*)d_in[i];
    a.out = (float*)d_out; a.ws = (unsigned char*)d_ws;
    for (int j = 0; j < 32; ++j) a.invf[j] = pow(10000.0, -(double)j / 32.0);
#if MK_PER_PHASE
    for (int ph = 0; ph < N_PHASES; ++ph) { a.ph_lo = ph; a.ph_hi = ph + 1; void* args[] = {&a};
        hipError_t e = hipLaunchCooperativeKernel((const void*)mega_fwd, dim3(grid), dim3(NTHR), args, LDS_BYTES, stream);
        if (e != hipSuccess) { fprintf(stderr, "launch of phase %d failed: %s\n", ph, hipGetErrorString(e)); break; } }
#else
    a.ph_lo = 0; a.ph_hi = N_PHASES; void* args[] = {&a};
    hipError_t e = hipLaunchCooperativeKernel((const void*)mega_fwd, dim3(grid), dim3(NTHR), args, LDS_BYTES, stream);
    if (e != hipSuccess) fprintf(stderr, "cooperative launch failed: %s (grid %d)\n", hipGetErrorString(e), grid);
#endif
}
```

```cpp
#include <hip/hip_runtime.h>
#include <hip/hip_cooperative_groups.h>
#include <cstdio>
#include <cstdint>
#include <cmath>
namespace cg = cooperative_groups;

constexpr int DM = 1024, SEQ = 8192, NB = 2, DB = 32, DS = 64, PAST = 4096, SKV = PAST + DS  ;
constexpr int MP = NB * SEQ  , MS = DB * DS  , MT = MP + MS  ;
constexpr int DFF = 2816, NUP = 2 * DFF, NIN = 4944, NINP = 5120;
constexpr float ALPHA = 1.189207115002721f;
constexpr float LN_EPS = 1e-5f;
constexpr float LOG2E = 1.4426950408889634f;
constexpr float QSCALE = 0.125f * LOG2E;
constexpr float IWSCALE = 0.35355339059327373f * 0.125f;
constexpr size_t O_Y = 0, O_PAK = 18874368, O_PAV = 20971520, O_PIK = 23068672, O_PBK = 24117248, O_PBV = 32505856, O_PLF = 40894464,
                 O_SAK = 41025536, O_SAV = 41287680, O_SIK = 41549824, O_SBK = 41680896, O_SBV = 42729472, O_SLF = 43778048;
#define MK_PER_PHASE 0
#define PROBE_DUP 0
namespace pg8 {
#define PG8_LAS __attribute__((address_space(3)))
typedef unsigned short bf16_t;
typedef short bf16x8 __attribute__((ext_vector_type(8)));
typedef float f32x4 __attribute__((ext_vector_type(4)));
typedef unsigned u32x4 __attribute__((ext_vector_type(4)));
constexpr int BM = 256, BK = 64, HALF = 128, HTB = HALF * BK * 2  , STAGE_BYTES = 8 * HTB, NXCD = 8, WGM = 8;

__host__ __device__ __forceinline__ int lds_byte(int r, int c) { const int st = (r >> 4) * 2 + (c >> 5), rr = r & 15, cc = c & 31, ob = rr * 64 + cc * 2; return st * 1024 + (ob ^ (((ob >> 9) & 1) << 5)); }
__host__ __device__ __forceinline__ void stage_rc(int b, int& R, int& C) { const int st = b / 1024, sb = b % 1024, swz = sb ^ (((sb >> 9) & 1) << 5); R = (st >> 1) * 16 + swz / 64; C = (st & 1) * 32 + (swz % 64) / 2; }
__host__ __device__ __forceinline__ int perm32(int rho) { const int n = rho >> 4, i = rho & 15; return 8 * (i >> 2) + 4 * n + (i & 3); }

struct Unit { int pm, pn; };
struct Gemm { const bf16_t* A; const bf16_t* Bt; int M, N, K; };

struct StaticOrder {
    int nM, nN, nwg, G, c;
    __host__ __device__ void init(int M, int N, int G_, int c_) { nM = M / BM; nN = N / BM; nwg = nM * nN; G = G_; c = c_; }
    __host__ __device__ bool next(int i, Unit& u) const {
        const long L = (long)i * G + c; if (L >= nwg) return false;
        int wgid = (int)L; { const int q = nwg / NXCD, r = nwg % NXCD, xcd = wgid % NXCD, off = wgid / NXCD; wgid = (xcd < r ? xcd * (q + 1) : r * (q + 1) + (xcd - r) * q) + off; }
        const int nig = WGM * nN, gid = wgid / nig, fm = gid * WGM, gsz = (nM - fm) < WGM ? (nM - fm) : WGM;
        u.pm = fm + ((wgid % nig) % gsz); u.pn = (wgid % nig) / gsz; return true;
    }
    __device__ __forceinline__ void a_ready(const Unit&) const {}
    __device__ __forceinline__ void done(const Unit&) const {}
};

__device__ __forceinline__ unsigned cvt_pk_bf16(float lo, float hi) { unsigned r; asm volatile("v_cvt_pk_bf16_f32 %0, %1, %2" : "=v"(r) : "v"(lo), "v"(hi)); return r; }
typedef float f32x2 __attribute__((ext_vector_type(2)));
typedef unsigned u32x2 __attribute__((ext_vector_type(2)));
typedef float f32x2 __attribute__((ext_vector_type(2)));
__device__ __forceinline__ float bf2f(unsigned short b) { return __uint_as_float((unsigned)b << 16); }
__device__ __forceinline__ float fsigmoid(float x) { return __builtin_amdgcn_rcpf(1.0f + __builtin_amdgcn_exp2f(-x * LOG2E)); }
__device__ __forceinline__ float flogsig(float x) {
    const float e = __builtin_amdgcn_exp2f(-fabsf(x) * LOG2E);
    const float l1p = (e < 0.03125f) ? e * (1.0f - e * (0.5f - e * (0.33333333f - 0.25f * e))) : __logf(1.0f + e);
    return fminf(x, 0.f) - l1p;
}
__device__ __forceinline__ u32x2 pack4(f32x4 v) { u32x2 w; w.x = cvt_pk_bf16(v[0], v[1]); w.y = cvt_pk_bf16(v[2], v[3]); return w; }

struct EpiSwiGLU {
    static constexpr bool PERM = true, AFTER_DRAIN = false;
    bf16_t* H;
    __device__ __forceinline__ void operator()(const f32x4 (&acc)[2][2][4][2], const Unit& u, int wr, int wc, int fr, int fq) const {
        const int row0 = u.pm * BM + wr * 64 + fr, col0 = u.pn * 128 + wc * 32 + 8 * fq;
#pragma unroll
        for (int ai = 0; ai < 2; ++ai)
#pragma unroll
            for (int m = 0; m < 4; ++m) {
                bf16_t* rowp = H + (size_t)(row0 + ai * HALF + m * 16) * DFF + col0;
                f32x4 h[2];
#pragma unroll
                for (int n = 0; n < 2; ++n) { const f32x4 a = acc[ai][0][m][n], g = acc[ai][1][m][n];
#pragma unroll
                    for (int i = 0; i < 4; ++i) h[n][i] = a[i] * fsigmoid(a[i]) * g[i]; }
                u32x4 w; w.x = cvt_pk_bf16(h[0][0], h[0][1]); w.y = cvt_pk_bf16(h[0][2], h[0][3]); w.z = cvt_pk_bf16(h[1][0], h[1][1]); w.w = cvt_pk_bf16(h[1][2], h[1][3]);
                *(u32x4*)rowp = w;
            }
    }
};
struct EpiRes {
    static constexpr bool PERM = false, AFTER_DRAIN = false;
    const float* resP; const float* resS; float* Z; float s;
    __device__ __forceinline__ void operator()(const f32x4 (&acc)[2][2][4][2], const Unit& u, int wr, int wc, int fr, int fq) const {
        const int row0 = u.pm * BM + wr * 64 + fr, col0 = u.pn * BM + wc * 32 + 4 * fq;
        const float* rb = (u.pm < MP / BM) ? resP : (resS - (size_t)MP * DM);
#pragma unroll
        for (int ai = 0; ai < 2; ++ai)
#pragma unroll
            for (int m = 0; m < 4; ++m) { const size_t off = (size_t)(row0 + ai * HALF + m * 16) * DM + col0;
#pragma unroll
                for (int bj = 0; bj < 2; ++bj)
#pragma unroll
                    for (int n = 0; n < 2; ++n) { const f32x4 r = *(const f32x4*)(rb + off + bj * HALF + n * 16);
                        *(f32x4*)(Z + off + bj * HALF + n * 16) = r * ALPHA + acc[ai][bj][m][n] * s; } }
    }
};
struct EpiProjA {
    static constexpr bool PERM = false, AFTER_DRAIN = false;
    const bf16_t* G; float* MM;
    __device__ __forceinline__ void operator()(const f32x4 (&acc)[2][2][4][2], const Unit& u, int wr, int wc, int fr, int fq) const {
        const int row0 = u.pm * BM + wr * 64 + fr, col0 = u.pn * BM + wc * 32 + 4 * fq;
#pragma unroll
        for (int ai = 0; ai < 2; ++ai)
#pragma unroll
            for (int m = 0; m < 4; ++m) { const size_t row = (size_t)(row0 + ai * HALF + m * 16);
#pragma unroll
                for (int bj = 0; bj < 2; ++bj)
#pragma unroll
                    for (int n = 0; n < 2; ++n) { const int c = col0 + bj * HALF + n * 16; const u32x2 g = *(const u32x2*)(G + row * 2048 + c);
                        f32x4 gv; gv[0] = __uint_as_float(g.x << 16); gv[1] = __uint_as_float(g.x & 0xffff0000u); gv[2] = __uint_as_float(g.y << 16); gv[3] = __uint_as_float(g.y & 0xffff0000u);
                        *(f32x4*)(MM + row * DM + c) = gv * acc[ai][bj][m][n]; } }
    }
};
struct EpiProjB {
    static constexpr bool PERM = false, AFTER_DRAIN = false;
    const bf16_t* G; const float* MM; bf16_t* MMb;
    __device__ __forceinline__ void operator()(const f32x4 (&acc)[2][2][4][2], const Unit& u, int wr, int wc, int fr, int fq) const {
        const int row0 = u.pm * BM + wr * 64 + fr, col0 = u.pn * BM + wc * 32 + 4 * fq;
#pragma unroll
        for (int ai = 0; ai < 2; ++ai)
#pragma unroll
            for (int m = 0; m < 4; ++m) { const size_t row = (size_t)(row0 + ai * HALF + m * 16);
#pragma unroll
                for (int bj = 0; bj < 2; ++bj)
#pragma unroll
                    for (int n = 0; n < 2; ++n) { const int c = col0 + bj * HALF + n * 16; const u32x2 g = *(const u32x2*)(G + row * 2048 + 1024 + c);
                        f32x4 gv; gv[0] = __uint_as_float(g.x << 16); gv[1] = __uint_as_float(g.x & 0xffff0000u); gv[2] = __uint_as_float(g.y << 16); gv[3] = __uint_as_float(g.y & 0xffff0000u);
                        const f32x4 mm = *(const f32x4*)(MM + row * DM + c);
                        *(u32x2*)(MMb + row * DM + c) = pack4(mm + gv * acc[ai][bj][m][n]); } }
    }
};
struct EpiWin {
    static constexpr bool PERM = false, AFTER_DRAIN = false;
    float* out; bf16_t *QA, *IQ, *QB, *KAp, *VAp, *IKp, *KBp, *VBp, *KAs, *VAs, *IKs, *KBs, *VBs, *G; float *IW, *LF; const f32x2* rope; const float* b_f; const float* b_gate;
    __device__ __forceinline__ void operator()(const f32x4 (&acc)[2][2][4][2], const Unit& u, int wr, int wc, int fr, int fq) const {
        const int T = u.pn; const bool samp = u.pm >= MP / BM;
#pragma unroll
        for (int ai = 0; ai < 2; ++ai)
#pragma unroll
            for (int m = 0; m < 4; ++m) {
                const int row = u.pm * BM + ai * HALF + wr * 64 + m * 16 + fr; const int rs = row - MP;
                const int pos = samp ? PAST + (rs & 63) : (row & (SEQ - 1));
                const size_t srow = samp ? ((size_t)(rs >> 6) * SKV + PAST + (rs & 63)) : (size_t)row;
                if (T == 0 || T == 1 || T == 3 || T == 4) {
                    bf16_t* dst = (T < 2) ? QA + (size_t)row * 512 + 256 * T : IQ + (size_t)row * 512 + 256 * (T - 3);
                    const float sc = (T < 2) ? QSCALE : 1.0f;
#pragma unroll
                    for (int n = 0; n < 2; ++n) { const int j0 = 16 * n + 4 * fq; const f32x4 x1 = acc[ai][0][m][n], x2 = acc[ai][1][m][n]; f32x4 o1, o2;
#pragma unroll
                        for (int i = 0; i < 4; ++i) { const f32x2 cs = rope[pos * 32 + j0 + i]; o1[i] = (x1[i] * cs.x - x2[i] * cs.y) * sc; o2[i] = (x2[i] * cs.x + x1[i] * cs.y) * sc; }
                        *(u32x2*)(dst + 64 * wc + j0) = pack4(o1); *(u32x2*)(dst + 64 * wc + 32 + j0) = pack4(o2); }
                } else if (T == 2) {
                    if (wc < 2) {
                        float* kf = out + (samp ? O_SAK + (size_t)rs * 128 : O_PAK + (size_t)row * 128) + 64 * wc; bf16_t* kb = (samp ? KAs : KAp) + srow * 128 + 64 * wc;
#pragma unroll
                        for (int n = 0; n < 2; ++n) { const int j0 = 16 * n + 4 * fq; const f32x4 x1 = acc[ai][0][m][n], x2 = acc[ai][1][m][n]; f32x4 o1, o2;
#pragma unroll
                            for (int i = 0; i < 4; ++i) { const f32x2 cs = rope[pos * 32 + j0 + i]; o1[i] = x1[i] * cs.x - x2[i] * cs.y; o2[i] = x2[i] * cs.x + x1[i] * cs.y; }
                            *(f32x4*)(kf + j0) = o1; *(f32x4*)(kf + 32 + j0) = o2; *(u32x2*)(kb + j0) = pack4(o1); *(u32x2*)(kb + 32 + j0) = pack4(o2); }
                    } else {
                        float* vf = out + (samp ? O_SAV + (size_t)rs * 128 : O_PAV + (size_t)row * 128); bf16_t* vb = (samp ? VAs : VAp) + srow * 128;
#pragma unroll
                        for (int bj = 0; bj < 2; ++bj)
#pragma unroll
                            for (int n = 0; n < 2; ++n) { const int c = 64 * bj + 32 * (wc - 2) + 16 * n + 4 * fq; *(f32x4*)(vf + c) = acc[ai][bj][m][n]; *(u32x2*)(vb + c) = pack4(acc[ai][bj][m][n]); }
                    }
                } else if (T == 5) {
                    if (wc == 0) {
                        float* kf = out + (samp ? O_SIK + (size_t)rs * 64 : O_PIK + (size_t)row * 64); bf16_t* kb = (samp ? IKs : IKp) + srow * 64;
#pragma unroll
                        for (int n = 0; n < 2; ++n) { const int j0 = 16 * n + 4 * fq; const f32x4 x1 = acc[ai][0][m][n], x2 = acc[ai][1][m][n]; f32x4 o1, o2;
#pragma unroll
                            for (int i = 0; i < 4; ++i) { const f32x2 cs = rope[pos * 32 + j0 + i]; o1[i] = x1[i] * cs.x - x2[i] * cs.y; o2[i] = x2[i] * cs.x + x1[i] * cs.y; }
                            *(f32x4*)(kf + j0) = o1; *(f32x4*)(kf + 32 + j0) = o2; *(u32x2*)(kb + j0) = pack4(o1); *(u32x2*)(kb + 32 + j0) = pack4(o2); }
                    } else if (wc == 1) {
                        const f32x4 v = acc[ai][0][m][0];
                        if (fq < 2) { *(f32x4*)(IW + (size_t)row * 8 + 4 * fq) = v * IWSCALE; }
                        else { const int i0 = 4 * (fq - 2); f32x4 lf; const f32x4 bf0 = *(const f32x4*)b_f, bf1 = *(const f32x4*)(b_f + 4); const f32x4 bfv = (fq == 2) ? bf0 : bf1;
#pragma unroll
                            for (int i = 0; i < 4; ++i) lf[i] = flogsig(v[i] + bfv[i]);
                            *(f32x4*)(out + (samp ? O_SLF + (size_t)rs * 8 : O_PLF + (size_t)row * 8) + i0) = lf; *(f32x4*)(LF + (size_t)row * 8 + i0) = lf; }
                    }
                } else if (T < 8) {
                    bf16_t* dst = QB + (size_t)row * 512 + 256 * (T - 6) + 32 * wc + 4 * fq;
#pragma unroll
                    for (int bj = 0; bj < 2; ++bj)
#pragma unroll
                        for (int n = 0; n < 2; ++n) *(u32x2*)(dst + 128 * bj + 16 * n) = pack4(acc[ai][bj][m][n] * QSCALE);
                } else if (T < 12) {
                    const bool isv = T >= 10; const int c0 = 256 * ((T - 8) & 1) + 32 * wc + 4 * fq;
                    float* df = out + (isv ? (samp ? O_SBV + (size_t)rs * 512 : O_PBV + (size_t)row * 512) : (samp ? O_SBK + (size_t)rs * 512 : O_PBK + (size_t)row * 512)) + c0;
                    bf16_t* db = (isv ? (samp ? VBs + (size_t)rs * 512 : VBp + (size_t)row * 512) : (samp ? KBs + (size_t)rs * 512 : KBp + (size_t)row * 512)) + c0;
#pragma unroll
                    for (int bj = 0; bj < 2; ++bj)
#pragma unroll
                        for (int n = 0; n < 2; ++n) { *(f32x4*)(df + 128 * bj + 16 * n) = acc[ai][bj][m][n]; *(u32x2*)(db + 128 * bj + 16 * n) = pack4(acc[ai][bj][m][n]); }
                } else {
                    const int c0 = 256 * (T - 12) + 32 * wc + 4 * fq; bf16_t* dst = G + (size_t)row * 2048 + c0;
#pragma unroll
                    for (int bj = 0; bj < 2; ++bj)
#pragma unroll
                        for (int n = 0; n < 2; ++n) { const f32x4 bg = *(const f32x4*)(b_gate + c0 + 128 * bj + 16 * n); f32x4 g;
#pragma unroll
                            for (int i = 0; i < 4; ++i) g[i] = fsigmoid(acc[ai][bj][m][n][i] + bg[i]);
                            *(u32x2*)(dst + 128 * bj + 16 * n) = pack4(g); }
                }
            }
    }
};
template <class Epi, class Sched, bool ALIGN_EPI = false, bool SP2 = false>
__device__ __forceinline__ void gemm_phase(PG8_LAS unsigned char* lds, const Gemm g, const Sched& S, const Epi& E) {
    const int tid = threadIdx.x, wid = __builtin_amdgcn_readfirstlane(tid >> 6), lane = tid & 63, wr = wid >> 2, wc = wid & 3, fr = lane & 15, fq = lane >> 4;
    const int K = g.K, nt = K / BK;
    unsigned voffA[2], voffB[2];
#pragma unroll
    for (int i = 0; i < 2; ++i) { int R, C; stage_rc(tid * 16 + i * 8192, R, C); const int Rb = Epi::PERM ? ((R & ~31) + perm32(R & 31)) : R;
        voffA[i] = (unsigned)(R * K + C) * 2u; voffB[i] = (unsigned)(Rb * K + C) * 2u; }
    const size_t kstep = (size_t)(BK * 2);
    const size_t hstep = (size_t)HALF * K * 2;
    const size_t tstep = 2 * hstep;
    const unsigned ldsw = (unsigned)wid * 1024u;
    const int aoff = lds_byte(wr * 64 + fr, fq * 8), boff = lds_byte(wc * 32 + fr, fq * 8);
#define PG8_SA(b, h) (((b) * 2 + (h)) * HTB)
#define PG8_SB(b, h) ((4 + (b) * 2 + (h)) * HTB)
#define PG8_STAGE(bufoff, gbase, voff) do { _Pragma("unroll") for (int _i = 0; _i < 2; ++_i) \
        __builtin_amdgcn_global_load_lds((const unsigned*)((const char*)(gbase) + (voff)[_i]), (PG8_LAS unsigned*)(lds + (bufoff) + ldsw + _i * 8192), 16, 0, 0); } while (0)
#define PG8_LDA(dst, b, h) do { _Pragma("unroll") for (int m = 0; m < 4; ++m) _Pragma("unroll") for (int k = 0; k < 2; ++k) dst[m][k] = *(const PG8_LAS bf16x8*)(lds + PG8_SA(b, h) + aoff + m * 2048 + k * 1024); } while (0)
#define PG8_LDB(dst, b, h) do { _Pragma("unroll") for (int n = 0; n < 2; ++n) _Pragma("unroll") for (int k = 0; k < 2; ++k) dst[n][k] = *(const PG8_LAS bf16x8*)(lds + PG8_SB(b, h) + boff + n * 2048 + k * 1024); } while (0)
#define PG8_MMA(ai, bj, At, Bt) do { __builtin_amdgcn_s_setprio(1); _Pragma("unroll") for (int m = 0; m < 4; ++m) _Pragma("unroll") for (int n = 0; n < 2; ++n) _Pragma("unroll") for (int k = 0; k < 2; ++k) \
        acc[ai][bj][m][n] = __builtin_amdgcn_mfma_f32_16x16x32_bf16(Bt[n][k], At[m][k], acc[ai][bj][m][n], 0, 0, 0); __builtin_amdgcn_s_setprio(0); } while (0)
#define PG8_WAIT_V(n) asm volatile("s_waitcnt vmcnt(" #n ")" ::: "memory")
#define PG8_WAIT_L(n) asm volatile("s_waitcnt lgkmcnt(" #n ")" ::: "memory")
#define PG8_BAR __builtin_amdgcn_s_barrier()
#define PG8_SCHED __builtin_amdgcn_sched_barrier(0)
    Unit cur, nxt; int ui = 0;
    if (!S.next(0, cur)) return;
    f32x4 acc[2][2][4][2];
#pragma unroll
    for (int a = 0; a < 2; ++a)
#pragma unroll
        for (int b = 0; b < 2; ++b)
#pragma unroll
            for (int m = 0; m < 4; ++m)
#pragma unroll
                for (int n = 0; n < 2; ++n) acc[a][b][m][n] = (f32x4){0.f, 0.f, 0.f, 0.f};
    bf16x8 At[4][2], B0[2][2], B1[2][2];
    const char* cA = (const char*)g.A + (size_t)cur.pm * tstep; const char* cB = (const char*)g.Bt + (size_t)cur.pn * tstep;
    S.a_ready(cur);
    if constexpr (SP2) {
        PG8_STAGE(PG8_SB(0, 0), cB, voffB); PG8_STAGE(PG8_SB(0, 1), cB + hstep, voffB); PG8_STAGE(PG8_SA(0, 0), cA, voffA); PG8_STAGE(PG8_SA(0, 1), cA + hstep, voffA);
        if (wr == 1) PG8_BAR;
        PG8_WAIT_V(2); PG8_BAR;
        PG8_STAGE(PG8_SB(1, 0), cB + kstep, voffB); PG8_STAGE(PG8_SA(1, 0), cA + kstep, voffA); PG8_STAGE(PG8_SB(1, 1), cB + hstep + kstep, voffB);
        PG8_WAIT_V(6); PG8_BAR;
    } else {
        PG8_STAGE(PG8_SB(0, 0), cB, voffB); PG8_STAGE(PG8_SA(0, 0), cA, voffA); PG8_STAGE(PG8_SB(0, 1), cB + hstep, voffB); PG8_STAGE(PG8_SA(0, 1), cA + hstep, voffA);
        if (wr == 1) PG8_BAR;
        PG8_WAIT_V(4); PG8_BAR;
        PG8_STAGE(PG8_SB(1, 0), cB + kstep, voffB); PG8_STAGE(PG8_SA(1, 0), cA + kstep, voffA); PG8_STAGE(PG8_SB(1, 1), cB + hstep + kstep, voffB);
        PG8_WAIT_V(6); PG8_BAR;
    }
    for (;;) {
        const bool has_next = S.next(ui + 1, nxt);
        const char* nA = has_next ? (const char*)g.A + (size_t)nxt.pm * tstep : cA; const char* nB = has_next ? (const char*)g.Bt + (size_t)nxt.pn * tstep : cB;
        for (int t = 0; t < nt; t += 2) {
            const bool last = (t == nt - 2);
            const char* a1 = cA + (size_t)(t + 1) * kstep;
            const char* a2 = last ? nA : cA + (size_t)(t + 2) * kstep; const char* b2 = last ? nB : cB + (size_t)(t + 2) * kstep;
            const char* a3 = a2 + kstep; const char* b3 = b2 + kstep;
            if (last && has_next) S.a_ready(nxt);
            if constexpr (SP2) {
            PG8_LDB(B0, 0, 0); PG8_LDB(B1, 0, 1); PG8_SCHED; PG8_LDA(At, 0, 0); PG8_STAGE(PG8_SA(1, 1), a1 + hstep, voffA);
            PG8_WAIT_V(8); PG8_WAIT_L(0); PG8_BAR; PG8_MMA(0, 0, At, B0); PG8_MMA(0, 1, At, B1); PG8_BAR; PG8_SCHED;
            PG8_LDA(At, 0, 1); PG8_STAGE(PG8_SB(0, 0), b2, voffB); PG8_STAGE(PG8_SB(0, 1), b2 + hstep, voffB); PG8_STAGE(PG8_SA(0, 0), a2, voffA);
            PG8_WAIT_V(8); PG8_WAIT_L(0); PG8_BAR; PG8_MMA(1, 0, At, B0); PG8_MMA(1, 1, At, B1); PG8_BAR; PG8_SCHED;
            PG8_LDB(B0, 1, 0); PG8_LDB(B1, 1, 1); PG8_SCHED; PG8_LDA(At, 1, 0); PG8_STAGE(PG8_SA(0, 1), a2 + hstep, voffA);
            PG8_WAIT_V(8); PG8_WAIT_L(0); PG8_BAR; PG8_MMA(0, 0, At, B0); PG8_MMA(0, 1, At, B1); PG8_BAR; PG8_SCHED;
            PG8_LDA(At, 1, 1); PG8_STAGE(PG8_SB(1, 0), b3, voffB); PG8_STAGE(PG8_SB(1, 1), b3 + hstep, voffB); PG8_STAGE(PG8_SA(1, 0), a3, voffA);
            PG8_WAIT_V(8); PG8_WAIT_L(0); PG8_BAR; PG8_MMA(1, 0, At, B0); PG8_MMA(1, 1, At, B1); PG8_BAR; PG8_SCHED;
            } else {
            PG8_LDB(B0, 0, 0); PG8_SCHED; PG8_LDA(At, 0, 0); PG8_STAGE(PG8_SA(1, 1), a1 + hstep, voffA);
            PG8_WAIT_L(8); PG8_BAR; PG8_WAIT_L(0); PG8_MMA(0, 0, At, B0); PG8_BAR; PG8_SCHED;
            PG8_LDB(B1, 0, 1); PG8_STAGE(PG8_SB(0, 0), b2, voffB);
            PG8_BAR; PG8_WAIT_L(0); PG8_MMA(0, 1, At, B1); PG8_BAR;
            PG8_LDA(At, 0, 1); PG8_STAGE(PG8_SA(0, 0), a2, voffA);
            PG8_BAR; PG8_WAIT_L(0); PG8_MMA(1, 0, At, B0); PG8_BAR; PG8_SCHED;
            PG8_STAGE(PG8_SB(0, 1), b2 + hstep, voffB);
            PG8_WAIT_V(6); PG8_BAR; PG8_MMA(1, 1, At, B1); PG8_BAR;
            PG8_LDB(B0, 1, 0); PG8_SCHED; PG8_LDA(At, 1, 0); PG8_STAGE(PG8_SA(0, 1), a2 + hstep, voffA);
            PG8_WAIT_L(8); PG8_BAR; PG8_WAIT_L(0); PG8_MMA(0, 0, At, B0); PG8_BAR; PG8_SCHED;
            PG8_LDB(B1, 1, 1); PG8_STAGE(PG8_SB(1, 0), b3, voffB);
            PG8_BAR; PG8_WAIT_L(0); PG8_MMA(0, 1, At, B1); PG8_BAR;
            PG8_LDA(At, 1, 1); PG8_STAGE(PG8_SA(1, 0), a3, voffA);
            PG8_BAR; PG8_WAIT_L(0); PG8_MMA(1, 0, At, B0); PG8_BAR; PG8_SCHED;
            PG8_STAGE(PG8_SB(1, 1), b3 + hstep, voffB);
            PG8_WAIT_V(6); PG8_BAR; PG8_MMA(1, 1, At, B1); PG8_BAR;
            }
        }
        if constexpr (ALIGN_EPI) { if (wr == 0) PG8_BAR; }
        if constexpr (!Epi::AFTER_DRAIN) { E(acc, cur, wr, wc, fr, fq); S.done(cur); }
        if (!has_next) break;
#pragma unroll
        for (int a = 0; a < 2; ++a)
#pragma unroll
            for (int b = 0; b < 2; ++b)
#pragma unroll
                for (int m = 0; m < 4; ++m)
#pragma unroll
                    for (int n = 0; n < 2; ++n) acc[a][b][m][n] = (f32x4){0.f, 0.f, 0.f, 0.f};
        cur = nxt; cA = nA; cB = nB; ++ui;
        if constexpr (ALIGN_EPI) { if (wr == 1) PG8_BAR; }
    }
    PG8_WAIT_V(0);
    if constexpr (!ALIGN_EPI) { if (wr == 0) PG8_BAR; }
    PG8_BAR;
    if constexpr (Epi::AFTER_DRAIN) { E.fused(acc, cur, wr, wc, fr, fq, lds, wid, lane); S.done(cur); }
#undef PG8_SA
#undef PG8_SB
#undef PG8_STAGE
#undef PG8_LDA
#undef PG8_LDB
#undef PG8_MMA
#undef PG8_WAIT_V
#undef PG8_WAIT_L
#undef PG8_BAR
#undef PG8_SCHED
}
}
#define LAS __attribute__((address_space(3)))
typedef unsigned short bf16_t;
typedef short bf16x8 __attribute__((ext_vector_type(8)));
typedef short s16x4 __attribute__((ext_vector_type(4)));
typedef float f32x4 __attribute__((ext_vector_type(4)));
typedef float f32x2 __attribute__((ext_vector_type(2)));
typedef float f32x16 __attribute__((ext_vector_type(16)));
typedef unsigned u32x4 __attribute__((ext_vector_type(4)));
typedef unsigned u32x2 __attribute__((ext_vector_type(2)));
using pg8::cvt_pk_bf16; using pg8::bf2f;
constexpr int NWAVES = 8, NTHR = 512, LDS_BYTES = 147456;
constexpr size_t MiB = 1u << 20;
constexpr size_t WS_CTL = 0;
constexpr size_t WS_ROPE = 1 * MiB;
constexpr size_t WS_W1U = 4 * MiB, WS_W1D = 16 * MiB, WS_WIN = 22 * MiB, WS_WPA = 33 * MiB, WS_WPB = 34 * MiB, WS_WO = 35 * MiB, WS_W2U = 37 * MiB, WS_W2D = 49 * MiB;
constexpr size_t WS_XB = 56 * MiB;
constexpr size_t WS_H = 92 * MiB;
constexpr size_t WS_Z = 192 * MiB;
constexpr size_t WS_HF1 = 264 * MiB, WS_HF2 = 336 * MiB;
constexpr size_t WS_HB = 408 * MiB;
constexpr size_t WS_QA = 444 * MiB, WS_IQ = 462 * MiB, WS_QB = 480 * MiB;
constexpr size_t WS_KAP = 498 * MiB, WS_VAP = 502 * MiB, WS_IKP = 506 * MiB;
constexpr size_t WS_KBP = 508 * MiB, WS_VBP = 524 * MiB;
constexpr size_t WS_KAS = 540 * MiB, WS_VAS = 573 * MiB, WS_IKS = 606 * MiB;
constexpr size_t WS_KBS = 623 * MiB, WS_VBS = 625 * MiB;
constexpr size_t WS_IW = 627 * MiB, WS_LF = 628 * MiB;
constexpr size_t WS_CBP = 629 * MiB, WS_CBS = 630 * MiB;
constexpr size_t WS_G = 635 * MiB;
constexpr size_t WS_SEL = 707 * MiB;
constexpr size_t WS_YA = 725 * MiB, WS_YB = 743 * MiB;
constexpr size_t WS_MM = 761 * MiB;
constexpr size_t WS_MMB = 833 * MiB;
constexpr size_t WS_SCR = 869 * MiB;
constexpr size_t WS_END = 997 * MiB;

struct Args {
    const float *x_p, *x_s, *c_ak, *c_av, *c_aik, *c_bk, *c_bv, *c_blf, *w1u, *w1d, *ln1g, *ln1b, *win, *b_f, *b_gate, *wpa, *wpb, *wo, *ln2g, *ln2b, *w2u, *w2d, *ln3g, *ln3b;
    float* out; unsigned char* ws; double invf[32]; int ph_lo, ph_hi;
};
struct Frame { LAS unsigned char* lds; int tid, lane, wave, G, bid; };

__device__ __forceinline__ unsigned f2bf(float f) { unsigned u = __float_as_uint(f); return (u + 0x7fffu + ((u >> 16) & 1u)) >> 16; }
__device__ __forceinline__ unsigned pk2(float lo, float hi) { return cvt_pk_bf16(lo, hi); }
__device__ __forceinline__ float wave_sum(float v) {
#pragma unroll
    for (int o = 1; o < 64; o <<= 1) v += __shfl_xor(v, o);
    return v;
}
__host__ __device__ __forceinline__ int rope_src(int P) { return 64 * ((P & 127) >> 5) + (P & 31) + ((P >> 7) << 5); }
struct SrcId { __device__ __forceinline__ int operator()(int n) const { return n; } };
struct SrcUp { __device__ __forceinline__ int operator()(int n) const { const int t = n >> 8, p = n & 255; return (p < 128) ? 128 * t + p : DFF + 128 * t + (p - 128); } };
struct SrcWin { __device__ __forceinline__ int operator()(int n) const {
    const int T = n >> 8, P = n & 255, bj = P >> 7, q = P & 127;
    if (T < 2) return 256 * T + rope_src(P);
    if (T == 2) return (q < 64) ? 512 + 64 * (q >> 5) + (q & 31) + 32 * bj : 640 + 64 * bj + (q - 64);
    if (T < 5) return 768 + 256 * (T - 3) + rope_src(P);
    if (T == 5) { if (q < 32) return 1280 + q + 32 * bj; if (bj == 0 && q < 40) return 1344 + (q - 32); if (bj == 0 && q < 48) return 2888 + (q - 40); return -1; }
    if (T < 8) return 1352 + 256 * (T - 6) + P;
    if (T < 10) return 1864 + 256 * (T - 8) + P;
    if (T < 12) return 2376 + 256 * (T - 10) + P;
    return 2896 + 256 * (T - 12) + P; } };
template <class F> __device__ __forceinline__ void transpose_item(const float* W, int K, int N, int ND, bf16_t* WT, LAS float* scr, int item, int lane, F srcf) {
    const int nblk = ND / 32, kb = item / nblk, nb = item % nblk, k0 = 64 * kb, n0 = 32 * nb;
    const int sc = srcf(n0 + (lane & 31));
#pragma unroll 8
    for (int i = 0; i < 32; ++i) { const int kk = 2 * i + (lane >> 5); scr[kk * 33 + (lane & 31)] = (sc >= 0) ? W[(size_t)(k0 + kk) * N + sc] : 0.f; }
    asm volatile("s_waitcnt lgkmcnt(0)" ::: "memory");
    const int c = lane & 7;
#pragma unroll
    for (int j = 0; j < 4; ++j) { const int n = (lane >> 3) + 8 * j; const LAS float* s = scr + (8 * c) * 33 + n;
        u32x4 o; o.x = pk2(s[0 * 33], s[1 * 33]); o.y = pk2(s[2 * 33], s[3 * 33]); o.z = pk2(s[4 * 33], s[5 * 33]); o.w = pk2(s[6 * 33], s[7 * 33]);
        *(u32x4*)(WT + (size_t)(n0 + n) * K + k0 + 8 * c) = o; }
    asm volatile("s_waitcnt lgkmcnt(0)" ::: "memory");
}
__device__ __forceinline__ void cvt_rows(const float* src, bf16_t* dst, size_t n4, size_t per_src, size_t per_dst, size_t gt, size_t ngt) {
    for (size_t e = gt; e < n4; e += ngt) { const size_t b = e / per_src, r = e - b * per_src; const f32x4 v = *(const f32x4*)(src + 4 * e);
        u32x2 w; w.x = pk2(v[0], v[1]); w.y = pk2(v[2], v[3]); *(u32x2*)(dst + 4 * (b * per_dst + r)) = w; }
}
__device__ __forceinline__ void p0_prologue(const Frame& F, const Args& a) {
    unsigned char* ws = a.ws;
    if (F.bid == 0 && F.tid < 256) ((unsigned*)(ws + WS_CTL))[F.tid] = 0u;
    LAS float* scr = (LAS float*)(F.lds + F.wave * 16384);
    const int gw = F.bid * NWAVES + F.wave, NGW = F.G * NWAVES;
    constexpr int I_UP = 16 * (NUP / 32), I_DN = (DFF / 64) * 32, I_IN = 16 * (NINP / 32), I_P = 8 * 32, I_O = 16 * 32;
    constexpr int NIT = 2 * I_UP + 2 * I_DN + I_IN + 2 * I_P + I_O;
    for (int it = gw; it < NIT; it += NGW) {
        int r = it;
        if (r < I_UP) { transpose_item(a.w1u, DM, NUP, NUP, (bf16_t*)(ws + WS_W1U), scr, r, F.lane, SrcUp()); continue; } r -= I_UP;
        if (r < I_UP) { transpose_item(a.w2u, DM, NUP, NUP, (bf16_t*)(ws + WS_W2U), scr, r, F.lane, SrcUp()); continue; } r -= I_UP;
        if (r < I_DN) { transpose_item(a.w1d, DFF, DM, DM, (bf16_t*)(ws + WS_W1D), scr, r, F.lane, SrcId()); continue; } r -= I_DN;
        if (r < I_DN) { transpose_item(a.w2d, DFF, DM, DM, (bf16_t*)(ws + WS_W2D), scr, r, F.lane, SrcId()); continue; } r -= I_DN;
        if (r < I_IN) { transpose_item(a.win, DM, NIN, NINP, (bf16_t*)(ws + WS_WIN), scr, r, F.lane, SrcWin()); continue; } r -= I_IN;
        if (r < I_P) { transpose_item(a.wpa, 512, DM, DM, (bf16_t*)(ws + WS_WPA), scr, r, F.lane, SrcId()); continue; } r -= I_P;
        if (r < I_P) { transpose_item(a.wpb, 512, DM, DM, (bf16_t*)(ws + WS_WPB), scr, r, F.lane, SrcId()); continue; } r -= I_P;
        transpose_item(a.wo, DM, DM, DM, (bf16_t*)(ws + WS_WO), scr, r, F.lane, SrcId());
    }
    const size_t gt = (size_t)F.bid * NTHR + F.tid, ngt = (size_t)F.G * NTHR;
    cvt_rows(a.x_p, (bf16_t*)(ws + WS_XB), (size_t)MP * DM / 4, (size_t)MP * DM / 4, 0, gt, ngt);
    cvt_rows(a.x_s, (bf16_t*)(ws + WS_XB) + (size_t)MP * DM, (size_t)MS * DM / 4, (size_t)MS * DM / 4, 0, gt, ngt);
    cvt_rows(a.c_ak, (bf16_t*)(ws + WS_KAS), (size_t)DB * PAST * 32, (size_t)PAST * 32, (size_t)SKV * 32, gt, ngt);
    cvt_rows(a.c_av, (bf16_t*)(ws + WS_VAS), (size_t)DB * PAST * 32, (size_t)PAST * 32, (size_t)SKV * 32, gt, ngt);
    cvt_rows(a.c_aik, (bf16_t*)(ws + WS_IKS), (size_t)DB * PAST * 16, (size_t)PAST * 16, (size_t)SKV * 16, gt, ngt);
    f32x2* rope = (f32x2*)(ws + WS_ROPE);
    for (size_t e = gt; e < (size_t)SEQ * 32; e += ngt) {
        const int pos = (int)(e >> 5), j = (int)(e & 31); const double ang = (double)pos * a.invf[j];
        const double kq = __builtin_rint(ang * 0.63661977236758134308); double r = __builtin_fma(-kq, 1.57079632679489655800e+00, ang); r = __builtin_fma(-kq, 6.12323399573676603587e-17, r);
        const double r2 = r * r;
        const double sn = r * (1.0 + r2 * (-1.0 / 6 + r2 * (1.0 / 120 + r2 * (-1.0 / 5040 + r2 * (1.0 / 362880 + r2 * (-1.0 / 39916800 + r2 * (1.0 / 6227020800.0)))))));
        const double cn = 1.0 + r2 * (-0.5 + r2 * (1.0 / 24 + r2 * (-1.0 / 720 + r2 * (1.0 / 40320 + r2 * (-1.0 / 3628800 + r2 * (1.0 / 479001600.0))))));
        const int qd = ((int)(long long)kq) & 3; double s, c;
        if (qd == 0) { s = sn; c = cn; } else if (qd == 1) { s = cn; c = -sn; } else if (qd == 2) { s = -sn; c = -cn; } else { s = -cn; c = sn; }
        rope[e] = (f32x2){(float)c, (float)s};
    }
}
__device__ __forceinline__ void ln_pass(const Frame& F, const float* Z, const float* g, const float* b, float* of, bf16_t* ob) {
    const int gw = F.bid * NWAVES + F.wave, NGW = F.G * NWAVES;
    f32x4 gv[4], bv[4];
#pragma unroll
    for (int j = 0; j < 4; ++j) { gv[j] = *(const f32x4*)(g + 4 * F.lane + 256 * j); bv[j] = *(const f32x4*)(b + 4 * F.lane + 256 * j); }
    for (int row = gw; row < MT; row += NGW) {
        const f32x4* zr = (const f32x4*)(Z + (size_t)row * DM) + F.lane; f32x4 v[4]; float s = 0.f;
#pragma unroll
        for (int j = 0; j < 4; ++j) { v[j] = zr[64 * j]; s += (v[j][0] + v[j][1]) + (v[j][2] + v[j][3]); }
        const float mean = wave_sum(s) * (1.f / DM); float s2 = 0.f;
#pragma unroll
        for (int j = 0; j < 4; ++j) { v[j] = v[j] - mean; s2 += (v[j][0] * v[j][0] + v[j][1] * v[j][1]) + (v[j][2] * v[j][2] + v[j][3] * v[j][3]); }
        const float rstd = 1.f / sqrtf(wave_sum(s2) * (1.f / DM) + LN_EPS);
#pragma unroll
        for (int j = 0; j < 4; ++j) { const f32x4 y = v[j] * rstd * gv[j] + bv[j];
            *((f32x4*)(of + (size_t)row * DM) + F.lane + 64 * j) = y;
            if (ob) { u32x2 w; w.x = pk2(y[0], y[1]); w.y = pk2(y[2], y[3]); *((u32x2*)(ob + (size_t)row * DM) + F.lane + 64 * j) = w; } }
    }
}
__device__ __forceinline__ void cumsum_block(const Frame& F, const Args& a, int sb) {
    LAS float* tot = (LAS float*)F.lds;
    const int i = F.tid >> 3, h = F.tid & 7;
    const float* LF = (const float*)(a.ws + WS_LF);
    if (sb < NB) {
        const float* src = LF + ((size_t)sb * SEQ + 128 * i) * 8 + h; float s = 0.f;
        for (int t = 0; t < 128; ++t) s += src[t * 8];
        tot[i * 8 + h] = s; __syncthreads();
        float c = 0.f; for (int k = 0; k < i; ++k) c += tot[k * 8 + h];
        float* dst = (float*)(a.ws + WS_CBP) + ((size_t)sb * 8 + h) * SEQ + 128 * i;
        for (int t = 0; t < 128; ++t) { c += src[t * 8]; dst[t] = -c * LOG2E; }
    } else {
        const int b = sb - NB; const float* src = a.c_blf + ((size_t)b * PAST + 64 * i) * 8 + h; float s = 0.f;
        for (int t = 0; t < 64; ++t) s += src[t * 8];
        tot[i * 8 + h] = s; __syncthreads();
        float c = 0.f; for (int k = 0; k < i; ++k) c += tot[k * 8 + h];
        float* dst = (float*)(a.ws + WS_CBS) + ((size_t)b * 8 + h) * SKV + 64 * i;
        for (int t = 0; t < 64; ++t) { c += src[t * 8]; dst[t] = -c * LOG2E; }
        if (i == 63) { const float* sn = LF + ((size_t)MP + b * DS) * 8 + h; float* dn = (float*)(a.ws + WS_CBS) + ((size_t)b * 8 + h) * SKV + PAST;
            for (int t = 0; t < DS; ++t) { c += sn[t * 8]; dn[t] = -c * LOG2E; } }
    }
    __syncthreads();
}
__device__ __forceinline__ unsigned f2key(float f) { const unsigned u = __float_as_uint(f); return (u & 0x80000000u) ? ~u : (u | 0x80000000u); }
__device__ __forceinline__ void indexer_item(const Frame& F, const Args& a, int item) {
    int b, c, qq; bool samp;
    if (item < 504) { c = 127 - (item >> 3); b = (item >> 2) & 1; qq = item & 3; samp = false; }
    else if (item < 632) { const int s = item - 504; b = s >> 2; qq = s & 3; c = 64; samp = true; }
    else { const int r = item - 632; c = 64 - (r >> 3); b = (r >> 2) & 1; qq = r & 3; samp = false; }
    const int qrow0 = samp ? MP + b * DS + 16 * qq : b * SEQ + 64 * c + 16 * qq;
    const int n = samp ? SKV : 64 * (c + 1);
    const bf16_t* IK = samp ? (const bf16_t*)(a.ws + WS_IKS) + (size_t)b * SKV * 64 : (const bf16_t*)(a.ws + WS_IKP) + (size_t)b * SEQ * 64;
    const bf16_t* IQ = (const bf16_t*)(a.ws + WS_IQ); const float* IW = (const float*)(a.ws + WS_IW);
    int* SEL = (int*)(a.ws + WS_SEL);
    int lane = F.lane; asm volatile("" : "+v"(lane));
    const int l31 = lane & 31, hi = lane >> 5;
    if (n <= 256) {
        for (int e = F.tid; e < 16 * 256; e += NTHR) { const int q = e >> 8, s = e & 255; SEL[(size_t)(qrow0 + q) * 256 + s] = (s < n) ? s : 0; }
        return;
    }
    float* scr = (float*)(a.ws + WS_SCR) + (size_t)F.bid * 16 * 8192;
    {
        bf16x8 afr[4][4]; f32x4 wq[4][2][2];
        const int qa = 2 * ((l31 >> 2) & 1) + (l31 >> 4), ha = 4 * ((l31 >> 3) & 1) + (l31 & 3);
#pragma unroll
        for (int mt = 0; mt < 4; ++mt) {
#pragma unroll
            for (int ks = 0; ks < 4; ++ks) afr[mt][ks] = *(const bf16x8*)(IQ + (size_t)(qrow0 + 4 * mt + qa) * 512 + 64 * ha + 16 * ks + 8 * hi);
#pragma unroll
            for (int aa = 0; aa < 2; ++aa) { const float* wp = IW + (size_t)(qrow0 + 4 * mt + 2 * hi + aa) * 8; wq[mt][aa][0] = *(const f32x4*)wp; wq[mt][aa][1] = *(const f32x4*)(wp + 4); }
        }
        bf16x8 bnx[4];
        { const int kt0 = (F.wave < n / 32) ? F.wave : 0;
#pragma unroll
          for (int ks = 0; ks < 4; ++ks) bnx[ks] = *(const bf16x8*)(IK + (size_t)(32 * kt0 + l31) * 64 + 16 * ks + 8 * hi); }
        for (int kt = F.wave; kt < n / 32; kt += NWAVES) {
            bf16x8 bfr[4];
#pragma unroll
            for (int ks = 0; ks < 4; ++ks) bfr[ks] = bnx[ks];
            { const int ktn = (kt + NWAVES < n / 32) ? kt + NWAVES : kt;
#pragma unroll
              for (int ks = 0; ks < 4; ++ks) bnx[ks] = *(const bf16x8*)(IK + (size_t)(32 * ktn + l31) * 64 + 16 * ks + 8 * hi); }
#pragma unroll
            for (int mt = 0; mt < 4; ++mt) {
                f32x16 acc = {};
#pragma unroll
                for (int ks = 0; ks < 4; ++ks) acc = __builtin_amdgcn_mfma_f32_32x32x16_bf16(afr[mt][ks], bfr[ks], acc, 0, 0, 0);
#pragma unroll
                for (int aa = 0; aa < 2; ++aa) { float s = 0.f;
#pragma unroll
                    for (int h = 0; h < 8; ++h) s += fmaxf(acc[8 * aa + h], 0.f) * wq[mt][aa][h >> 2][h & 3];
                    scr[(size_t)(4 * mt + 2 * hi + aa) * 8192 + 32 * kt + l31] = s; }
            }
        }
    }
    __syncthreads(); __builtin_amdgcn_fence(__ATOMIC_ACQUIRE, "agent");
    LAS unsigned* hist = (LAS unsigned*)(F.lds + F.wave * 8192);
    const int n4 = n >> 2;
    for (int q = F.wave; q < 16; q += NWAVES) {
        const float* sp = scr + (size_t)q * 8192;
        u32x4 k[32];
#pragma unroll
        for (int it = 0; it < 32; ++it) {
            k[it] = (u32x4){0u, 0u, 0u, 0u};
            if (64 * it < n4) { const int i4 = 64 * it + lane;
                if (i4 < n4) { const f32x4 v = *(const f32x4*)(sp + 4 * i4); k[it] = (u32x4){f2key(v[0]), f2key(v[1]), f2key(v[2]), f2key(v[3])}; } }
        }
        unsigned prefix = 0; int kk = 256;
#pragma unroll 1
        for (int lev = 0; lev < 3; ++lev) {
            const int shift = (lev == 0) ? 21 : (lev == 1) ? 10 : 0, bits = (lev == 2) ? 10 : 11, nbin = 1 << bits, per = nbin >> 6;
            const unsigned hshift = (unsigned)(shift + bits), bmask = (unsigned)(nbin - 1);
            for (int j = 0; j < per; ++j) hist[lane + 64 * j] = 0u;
            asm volatile("s_waitcnt lgkmcnt(0)" ::: "memory");
#pragma unroll
            for (int it = 0; it < 32; ++it) {
                if (64 * it < n4) {
#pragma unroll
                    for (int e = 0; e < 4; ++e) { const unsigned key = k[it][e];
                        const bool m = (lev == 0) ? (key != 0u) : ((key >> hshift) == prefix && key != 0u);
                        if (m) __hip_atomic_fetch_add(&hist[(key >> shift) & bmask], 1u, __ATOMIC_RELAXED, __HIP_MEMORY_SCOPE_WORKGROUP); }
                }
            }
            asm volatile("s_waitcnt lgkmcnt(0)" ::: "memory");
            unsigned s = 0; for (int j = 0; j < per; ++j) s += hist[lane * per + j];
            unsigned T = s;
#pragma unroll
            for (int off = 1; off < 64; off <<= 1) { const unsigned v = __shfl_down(T, off); if (lane + off < 64) T += v; }
            const unsigned long long bal = __ballot(T >= (unsigned)kk);
            const int js = __popcll(bal) - 1;
            unsigned run = __shfl(T, (js + 1) & 63); if (js >= 63) run = 0u;
            int digit = js * per;
            for (int bb = per - 1; bb >= 0; --bb) { const unsigned cnt = hist[js * per + bb]; if (run + cnt >= (unsigned)kk) { digit = js * per + bb; break; } run += cnt; }
            kk -= (int)run; prefix = (prefix << bits) | (unsigned)digit;
            asm volatile("s_waitcnt lgkmcnt(0)" ::: "memory");
        }
        int* so = SEL + (size_t)(qrow0 + q) * 256; int obase = 0, ebase = 0;
        const unsigned long long below = (1ull << lane) - 1ull;
#pragma unroll
        for (int it = 0; it < 32; ++it) {
            if (64 * it < n4) {
                bool tk[4]; unsigned long long be[4]; bool eqf[4]; unsigned long long anyeq = 0ull;
#pragma unroll
                for (int e = 0; e < 4; ++e) { eqf[e] = (k[it][e] == prefix); be[e] = __ballot(eqf[e]); anyeq |= be[e]; tk[e] = k[it][e] > prefix; }
                if (anyeq) {
                    int er = ebase + __popcll(be[0] & below) + __popcll(be[1] & below) + __popcll(be[2] & below) + __popcll(be[3] & below);
#pragma unroll
                    for (int e = 0; e < 4; ++e) { if (eqf[e]) { tk[e] = er < kk; ++er; } }
                    ebase += __popcll(be[0]) + __popcll(be[1]) + __popcll(be[2]) + __popcll(be[3]);
                }
                unsigned long long bt[4];
#pragma unroll
                for (int e = 0; e < 4; ++e) bt[e] = __ballot(tk[e]);
                int pos = obase + __popcll(bt[0] & below) + __popcll(bt[1] & below) + __popcll(bt[2] & below) + __popcll(bt[3] & below);
#pragma unroll
                for (int e = 0; e < 4; ++e) { if (tk[e]) { if (pos < 256) so[pos] = 256 * it + 4 * lane + e; ++pos; } }
                obase += __popcll(bt[0]) + __popcll(bt[1]) + __popcll(bt[2]) + __popcll(bt[3]);
            }
        }
    }
    __syncthreads();
}
__device__ __forceinline__ void dsa_query(const Frame& F, const Args& a, int row) {
    int lane = F.lane; asm volatile("" : "+v"(lane));
    const int j = lane & 15, kq = lane >> 4;
    const bool samp = row >= MP; const int rs = row - MP;
    const int nsel = samp ? 256 : min(256, 64 * (((row & (SEQ - 1)) >> 6) + 1));
    const bf16_t* KA = samp ? (const bf16_t*)(a.ws + WS_KAS) + (size_t)(rs >> 6) * SKV * 128 : (const bf16_t*)(a.ws + WS_KAP) + (size_t)(row >> 13) * SEQ * 128;
    const bf16_t* VA = samp ? (const bf16_t*)(a.ws + WS_VAS) + (size_t)(rs >> 6) * SKV * 128 : (const bf16_t*)(a.ws + WS_VAP) + (size_t)(row >> 13) * SEQ * 128;
    const int* sel = (const int*)(a.ws + WS_SEL) + (size_t)row * 256;
    const bf16_t* QA = (const bf16_t*)(a.ws + WS_QA) + (size_t)row * 512;
    LAS float* pl = (LAS float*)(F.lds + F.wave * 9216);
    LAS int* sl = (LAS int*)(F.lds + F.wave * 9216 + 8192);
#pragma unroll
    for (int i = 0; i < 4; ++i) sl[lane + 64 * i] = sel[lane + 64 * i];
    bf16x8 bq[4];
#pragma unroll
    for (int ks = 0; ks < 4; ++ks) { bf16x8 z = {}; bq[ks] = (j < 8 && (ks >> 1) == (j >> 2)) ? *(const bf16x8*)(QA + 64 * j + 32 * (ks & 1) + 8 * kq) : z; }
    asm volatile("s_waitcnt lgkmcnt(0)" ::: "memory");
    f32x4 acc[16]; const int nt = nsel >> 4;
#pragma unroll
    for (int t = 0; t < 16; ++t) {
        acc[t] = (f32x4){-INFINITY, -INFINITY, -INFINITY, -INFINITY};
        if (t < nt) { const int idx = sl[16 * t + j]; const bf16_t* kr = KA + (size_t)idx * 128 + 8 * kq; f32x4 c = {0.f, 0.f, 0.f, 0.f};
#pragma unroll
            for (int ks = 0; ks < 4; ++ks) c = __builtin_amdgcn_mfma_f32_16x16x32_bf16(*(const bf16x8*)(kr + 32 * ks), bq[ks], c, 0, 0, 0);
            acc[t] = c; }
    }
    float mx = -INFINITY;
#pragma unroll
    for (int t = 0; t < 16; ++t) mx = fmaxf(mx, fmaxf(fmaxf(acc[t][0], acc[t][1]), fmaxf(acc[t][2], acc[t][3])));
    mx = fmaxf(mx, __shfl_xor(mx, 16)); mx = fmaxf(mx, __shfl_xor(mx, 32));
    float sum = 0.f;
#pragma unroll
    for (int t = 0; t < 16; ++t)
#pragma unroll
        for (int i = 0; i < 4; ++i) { const float p = __builtin_amdgcn_exp2f(acc[t][i] - mx); acc[t][i] = p; sum += p; }
    sum += __shfl_xor(sum, 16); sum += __shfl_xor(sum, 32);
    const float inv = 1.0f / sum;
    if (j < 8) {
#pragma unroll
        for (int t = 0; t < 16; ++t)
#pragma unroll
            for (int i = 0; i < 4; ++i) pl[(16 * t + 4 * kq + i) * 8 + j] = acc[t][i] * inv;
    }
    asm volatile("s_waitcnt lgkmcnt(0)" ::: "memory");
    const int g = lane >> 5; float o[4][2] = {};
#pragma unroll 8
    for (int s = 0; s < nsel; ++s) { const int idx = sl[s]; const unsigned v = *(const unsigned*)(VA + (size_t)idx * 128 + 2 * lane); const f32x4 p4 = *(const LAS f32x4*)(pl + s * 8 + 4 * g);
        const float v0 = __uint_as_float(v << 16), v1 = __uint_as_float(v & 0xffff0000u);
#pragma unroll
        for (int hh = 0; hh < 4; ++hh) { o[hh][0] += p4[hh] * v0; o[hh][1] += p4[hh] * v1; } }
    bf16_t* ya = (bf16_t*)(a.ws + WS_YA) + (size_t)row * 512 + 2 * (lane & 31);
#pragma unroll
    for (int hh = 0; hh < 4; ++hh) *(unsigned*)(ya + 64 * (4 * g + hh)) = pk2(o[hh][0], o[hh][1]);
    asm volatile("s_waitcnt lgkmcnt(0)" ::: "memory");
}
constexpr int VST = 72;
constexpr int FOX_V = 0, FOX_M = 8 * 64 * VST * 2  , FOX_L = FOX_M + 2048, FOX_O = FOX_L + 256, FOX_END = FOX_O + 64 * 65 * 4;
static_assert(FOX_END <= 131072, "fox lds");
__device__ __forceinline__ int crow(int r, int hi) { return (r & 3) + 8 * (r >> 2) + 4 * hi; }
__device__ __forceinline__ bf16x8 cvt8(f32x4 a, f32x4 b) { u32x4 w; w.x = pk2(a[0], a[1]); w.y = pk2(a[2], a[3]); w.z = pk2(b[0], b[1]); w.w = pk2(b[2], b[3]); return __builtin_bit_cast(bf16x8, w); }
__device__ __forceinline__ void fox_unit(const Frame& F, const Args& a, int unit) {
    constexpr bool samp = true; int b, h, qi, ntiles, rowq0; const float* Cb;
    if (samp) { b = unit >> 3; h = unit & 7; qi = 64; ntiles = 65; rowq0 = MP + b * DS; Cb = (const float*)(a.ws + WS_CBS) + ((size_t)b * 8 + h) * SKV; }
    else { const int r = unit - 256; qi = 127 - (r >> 4); b = (r >> 3) & 1; h = r & 7; ntiles = qi + 1; rowq0 = b * SEQ + 64 * qi; Cb = (const float*)(a.ws + WS_CBP) + ((size_t)b * 8 + h) * SEQ; }
    int lane = F.lane; asm volatile("" : "+v"(lane)); int tidl = F.tid; asm volatile("" : "+v"(tidl));
    const int q32 = lane & 31, hi = lane >> 5, w = F.wave;
    const bf16_t* Kb = samp ? (const bf16_t*)(a.ws + WS_KBS) + (size_t)(b * DS) * 512 + 64 * h : (const bf16_t*)(a.ws + WS_KBP) + (size_t)(b * SEQ) * 512 + 64 * h;
    const bf16_t* Vb = samp ? (const bf16_t*)(a.ws + WS_VBS) + (size_t)(b * DS) * 512 + 64 * h : (const bf16_t*)(a.ws + WS_VBP) + (size_t)(b * SEQ) * 512 + 64 * h;
    const float* Kc = a.c_bk + ((size_t)b * PAST * 8 + h) * 64; const float* Vc = a.c_bv + ((size_t)b * PAST * 8 + h) * 64;
    LAS bf16_t* vl = (LAS bf16_t*)(F.lds + FOX_V) + w * 64 * VST;
    LAS float* mb = (LAS float*)(F.lds + FOX_M); LAS float* lt = (LAS float*)(F.lds + FOX_L); LAS float* ot = (LAS float*)(F.lds + FOX_O);
    for (int e = tidl; e < 64 * 65 + 64; e += NTHR) lt[e] = 0.f;
    const bf16_t* QB = (const bf16_t*)(a.ws + WS_QB);
    bf16x8 qf[2][4];
#pragma unroll
    for (int qb = 0; qb < 2; ++qb)
#pragma unroll
        for (int ks = 0; ks < 4; ++ks) qf[qb][ks] = *(const bf16x8*)(QB + (size_t)(rowq0 + 32 * qb + q32) * 512 + 64 * h + 16 * ks + 8 * hi);
    float mrun[2] = {-INFINITY, -INFINITY}, lrun[2] = {0.f, 0.f};
    f32x16 o[2][2];
#pragma unroll
    for (int qb = 0; qb < 2; ++qb)
#pragma unroll
        for (int db = 0; db < 2; ++db)
#pragma unroll
            for (int r = 0; r < 16; ++r) o[qb][db][r] = 0.f;
    const int gi = lane >> 4, li = lane & 15;
    const unsigned kofb = (unsigned)(q32 * 1024 + 16 * hi);
    const unsigned kofc = (unsigned)(q32 * 2048 + 32 * hi);
    const unsigned cof = (unsigned)(16 * hi);
    const int troff = ((4 * hi + (li >> 2)) * VST + 16 * (gi & 1) + 4 * (li & 3));
    for (int tile = w; tile < ntiles; tile += NWAVES) {
        const bool cache = samp && tile < 64, diag = (tile == ntiles - 1);
        const int kv0 = 64 * tile; const int kvl = samp ? (cache ? kv0 : 0) : kv0;
        bf16x8 kf[2][4];
        if (cache) {
            const char* kp = (const char*)Kc + (size_t)kvl * 2048 + kofc;
#pragma unroll
            for (int hf = 0; hf < 2; ++hf) { const char* kph = kp + hf * 65536;
#pragma unroll
                for (int ks = 0; ks < 4; ++ks) kf[hf][ks] = cvt8(*(const f32x4*)(kph + 64 * ks), *(const f32x4*)(kph + 64 * ks + 16));
                asm volatile("" ::: "memory"); }
            const char* vp = (const char*)Vc + (size_t)kvl * 2048 + (unsigned)(lane * 2048);
#pragma unroll
            for (int c = 0; c < 16; ++c) { const f32x4 v = *(const f32x4*)(vp + 16 * c);
                u32x2 wv; wv.x = pk2(v[0], v[1]); wv.y = pk2(v[2], v[3]); *(LAS u32x2*)(vl + lane * VST + 4 * c) = wv;
                if ((c & 7) == 7) asm volatile("" ::: "memory"); }
        } else {
            const char* kp = (const char*)Kb + (size_t)kvl * 1024 + kofb;
#pragma unroll
            for (int hf = 0; hf < 2; ++hf) { const char* kph = kp + hf * 32768;
#pragma unroll
                for (int ks = 0; ks < 4; ++ks) kf[hf][ks] = *(const bf16x8*)(kph + 32 * ks); }
            asm volatile("" ::: "memory");
            const char* vp = (const char*)Vb + (size_t)kvl * 1024 + (unsigned)(lane * 1024);
#pragma unroll
            for (int c = 0; c < 8; ++c) *(LAS u32x4*)(vl + lane * VST + 8 * c) = *(const u32x4*)(vp + 16 * c);
            asm volatile("" ::: "memory");
        }
#pragma unroll
        for (int qb = 0; qb < 2; ++qb) {
            f32x16 s[2];
#pragma unroll
            for (int hf = 0; hf < 2; ++hf) {
#pragma unroll
                for (int g4 = 0; g4 < 4; ++g4) { const f32x4 c4 = *(const f32x4*)((const char*)(Cb + kv0) + cof + (128 * hf + 32 * g4));
                    s[hf][4 * g4 + 0] = c4[0]; s[hf][4 * g4 + 1] = c4[1]; s[hf][4 * g4 + 2] = c4[2]; s[hf][4 * g4 + 3] = c4[3]; }
#pragma unroll
                for (int ks = 0; ks < 4; ++ks) s[hf] = __builtin_amdgcn_mfma_f32_32x32x16_bf16(kf[hf][ks], qf[qb][ks], s[hf], 0, 0, 0);
            }
            if (diag) { const int ql = 32 * qb + q32;
#pragma unroll
                for (int hf = 0; hf < 2; ++hf)
#pragma unroll
                    for (int r = 0; r < 16; ++r) if (32 * hf + crow(r, hi) > ql) s[hf][r] = -INFINITY; }
            float mx = -INFINITY;
#pragma unroll
            for (int r = 0; r < 16; ++r) mx = fmaxf(mx, fmaxf(s[0][r], s[1][r]));
            mx = fmaxf(mx, __shfl_xor(mx, 32));
            const float mn = fmaxf(mrun[qb], mx); const float al = __builtin_amdgcn_exp2f(mrun[qb] - mn); mrun[qb] = mn;
            float sum = 0.f;
#pragma unroll
            for (int hf = 0; hf < 2; ++hf)
#pragma unroll
                for (int r = 0; r < 16; ++r) { const float p = __builtin_amdgcn_exp2f(s[hf][r] - mn); s[hf][r] = p; sum += p; }
            lrun[qb] = lrun[qb] * al + sum;
#pragma unroll
            for (int db = 0; db < 2; ++db)
#pragma unroll
                for (int r = 0; r < 16; ++r) o[qb][db][r] *= al;
            bf16x8 pk[4];
#pragma unroll
            for (int k4 = 0; k4 < 4; ++k4) { const int hf = k4 >> 1, r0 = 8 * (k4 & 1); u32x4 wv;
                wv.x = pk2(s[hf][r0 + 0], s[hf][r0 + 1]); wv.y = pk2(s[hf][r0 + 2], s[hf][r0 + 3]); wv.z = pk2(s[hf][r0 + 4], s[hf][r0 + 5]); wv.w = pk2(s[hf][r0 + 6], s[hf][r0 + 7]);
                pk[k4] = __builtin_bit_cast(bf16x8, wv); }
            asm volatile("s_waitcnt lgkmcnt(0)" ::: "memory");
#pragma unroll
            for (int db = 0; db < 2; ++db)
#pragma unroll
                for (int k4 = 0; k4 < 4; ++k4) {
                    const LAS bf16_t* p0 = vl + troff + (16 * k4) * VST + 32 * db;
                    const s16x4 lo = __builtin_bit_cast(s16x4, __builtin_amdgcn_ds_read_tr16_b64_v4i16((LAS s16x4*)p0));
                    const s16x4 hh = __builtin_bit_cast(s16x4, __builtin_amdgcn_ds_read_tr16_b64_v4i16((LAS s16x4*)(p0 + 8 * VST)));
                    const bf16x8 vt = (bf16x8){lo[0], lo[1], lo[2], lo[3], hh[0], hh[1], hh[2], hh[3]};
                    o[qb][db] = __builtin_amdgcn_mfma_f32_32x32x16_bf16(vt, pk[k4], o[qb][db], 0, 0, 0);
                }
        }
        asm volatile("s_waitcnt lgkmcnt(0)" ::: "memory");
    }
#pragma unroll
    for (int qb = 0; qb < 2; ++qb) { lrun[qb] += __shfl_xor(lrun[qb], 32); if (hi == 0) mb[w * 64 + 32 * qb + q32] = mrun[qb]; }
    __syncthreads();
#pragma unroll
    for (int qb = 0; qb < 2; ++qb) {
        const int q = 32 * qb + q32; float mg = -INFINITY;
#pragma unroll
        for (int ww = 0; ww < NWAVES; ++ww) mg = fmaxf(mg, mb[ww * 64 + q]);
        const float sc = __builtin_amdgcn_exp2f(mrun[qb] - mg);
        if (w < ntiles) {
            if (hi == 0) __hip_atomic_fetch_add(lt + q, lrun[qb] * sc, __ATOMIC_RELAXED, __HIP_MEMORY_SCOPE_WORKGROUP);
#pragma unroll
            for (int db = 0; db < 2; ++db)
#pragma unroll
                for (int r = 0; r < 16; ++r) __hip_atomic_fetch_add(ot + q * 65 + 32 * db + crow(r, hi), o[qb][db][r] * sc, __ATOMIC_RELAXED, __HIP_MEMORY_SCOPE_WORKGROUP);
        }
    }
    __syncthreads();
    { const int q = tidl >> 3, d0 = 8 * (tidl & 7); const float il = 1.0f / lt[q]; const LAS float* op = ot + q * 65 + d0;
      u32x4 wv; wv.x = pk2(op[0] * il, op[1] * il); wv.y = pk2(op[2] * il, op[3] * il); wv.z = pk2(op[4] * il, op[5] * il); wv.w = pk2(op[6] * il, op[7] * il);
      *(u32x4*)((bf16_t*)(a.ws + WS_YB) + (size_t)(rowq0 + q) * 512 + 64 * h + d0) = wv; }
    __syncthreads();
}

constexpr int FP_ROWB = 144, FP_V = 64 * FP_ROWB, FP_C = 2 * FP_V, FP_BUF = FP_C + 256;
__device__ __forceinline__ void fox_prompt_unit(const Frame& F, const Args& a, int b, int h, int j) {
    int lane = F.lane; asm volatile("" : "+v"(lane)); int tid = F.tid; asm volatile("" : "+v"(tid));
    const int q32 = lane & 31, hi = lane >> 5, w = F.wave;
    const int NT = 4 * (j + 1), myT = 4 * j + (w >> 1);
    const char* kg = (const char*)((const bf16_t*)(a.ws + WS_KBP) + (size_t)(b * SEQ) * 512 + 64 * h) + (size_t)(tid >> 3) * 1024 + 16 * (tid & 7);
    const char* vg = (const char*)((const bf16_t*)(a.ws + WS_VBP) + (size_t)(b * SEQ) * 512 + 64 * h) + (size_t)(tid >> 3) * 1024 + 16 * (tid & 7);
    const float* cg = (const float*)(a.ws + WS_CBP) + ((size_t)b * 8 + h) * SEQ + 4 * (tid & 15);
    LAS unsigned char* lb = F.lds;
    const int lw = (tid >> 3) * FP_ROWB + 16 * (tid & 7);
    const bf16_t* qp = (const bf16_t*)(a.ws + WS_QB) + (size_t)(b * SEQ + 256 * j + 32 * w + q32) * 512 + 64 * h + 8 * hi;
    bf16x8 qf[4];
#pragma unroll
    for (int ks = 0; ks < 4; ++ks) qf[ks] = *(const bf16x8*)(qp + 16 * ks);
    u32x4 kr = *(const u32x4*)kg, vr = *(const u32x4*)vg; f32x4 br = *(const f32x4*)cg;
    *(LAS u32x4*)(lb + lw) = kr; *(LAS u32x4*)(lb + FP_V + lw) = vr; if (tid < 16) *(LAS f32x4*)(lb + FP_C + 16 * tid) = br;
    __syncthreads();
    float mrun = -INFINITY, lrun = 0.f; f32x16 o[2];
#pragma unroll
    for (int db = 0; db < 2; ++db)
#pragma unroll
        for (int r = 0; r < 16; ++r) o[db][r] = 0.f;
    const int gi = lane >> 4, li = lane & 15;
    const int troff = ((4 * hi + (li >> 2)) * FP_ROWB + 2 * (16 * (gi & 1) + 4 * (li & 3)));
    const int kroff = q32 * FP_ROWB + 16 * hi;
    for (int t = 0; t < NT; ++t) {
        const int cur = t & 1; const bool more = (t + 1 < NT);
        if (more) { kr = *(const u32x4*)(kg + (size_t)(t + 1) * 65536); vr = *(const u32x4*)(vg + (size_t)(t + 1) * 65536); br = *(const f32x4*)(cg + 64 * (t + 1)); }
        if (t <= myT) {
            const LAS unsigned char* kb_ = lb + cur * FP_BUF; const LAS unsigned char* vb_ = kb_ + FP_V; const LAS unsigned char* cb_ = kb_ + FP_C + 16 * hi;
            f32x16 s[2];
#pragma unroll
            for (int hf = 0; hf < 2; ++hf) {
#pragma unroll
                for (int g4 = 0; g4 < 4; ++g4) { const f32x4 c4 = *(const LAS f32x4*)(cb_ + 128 * hf + 32 * g4);
                    s[hf][4 * g4 + 0] = c4[0]; s[hf][4 * g4 + 1] = c4[1]; s[hf][4 * g4 + 2] = c4[2]; s[hf][4 * g4 + 3] = c4[3]; }
#pragma unroll
                for (int ks = 0; ks < 4; ++ks) s[hf] = __builtin_amdgcn_mfma_f32_32x32x16_bf16(*(const LAS bf16x8*)(kb_ + kroff + hf * 32 * FP_ROWB + 32 * ks), qf[ks], s[hf], 0, 0, 0);
            }
            if (t == myT) { const int ql = 32 * (w & 1) + q32;
#pragma unroll
                for (int hf = 0; hf < 2; ++hf)
#pragma unroll
                    for (int r = 0; r < 16; ++r) if (32 * hf + crow(r, hi) > ql) s[hf][r] = -INFINITY; }
            float mx = -INFINITY;
#pragma unroll
            for (int r = 0; r < 16; ++r) mx = fmaxf(mx, fmaxf(s[0][r], s[1][r]));
            mx = fmaxf(mx, __shfl_xor(mx, 32));
            const float mn = fmaxf(mrun, mx); const float al = __builtin_amdgcn_exp2f(mrun - mn); mrun = mn;
            float sum = 0.f;
#pragma unroll
            for (int hf = 0; hf < 2; ++hf)
#pragma unroll
                for (int r = 0; r < 16; ++r) { const float p = __builtin_amdgcn_exp2f(s[hf][r] - mn); s[hf][r] = p; sum += p; }
            lrun = lrun * al + sum;
#pragma unroll
            for (int db = 0; db < 2; ++db)
#pragma unroll
                for (int r = 0; r < 16; ++r) o[db][r] *= al;
            bf16x8 pk[4];
#pragma unroll
            for (int k4 = 0; k4 < 4; ++k4) { const int hf = k4 >> 1, r0 = 8 * (k4 & 1); u32x4 wv;
                wv.x = pk2(s[hf][r0 + 0], s[hf][r0 + 1]); wv.y = pk2(s[hf][r0 + 2], s[hf][r0 + 3]); wv.z = pk2(s[hf][r0 + 4], s[hf][r0 + 5]); wv.w = pk2(s[hf][r0 + 6], s[hf][r0 + 7]);
                pk[k4] = __builtin_bit_cast(bf16x8, wv); }
#pragma unroll
            for (int db = 0; db < 2; ++db)
#pragma unroll
                for (int k4 = 0; k4 < 4; ++k4) {
                    const LAS unsigned char* p0 = vb_ + troff + (16 * k4) * FP_ROWB + 64 * db;
                    const s16x4 lo = __builtin_bit_cast(s16x4, __builtin_amdgcn_ds_read_tr16_b64_v4i16((LAS s16x4*)p0));
                    const s16x4 hh = __builtin_bit_cast(s16x4, __builtin_amdgcn_ds_read_tr16_b64_v4i16((LAS s16x4*)(p0 + 8 * FP_ROWB)));
                    const bf16x8 vt = (bf16x8){lo[0], lo[1], lo[2], lo[3], hh[0], hh[1], hh[2], hh[3]};
                    o[db] = __builtin_amdgcn_mfma_f32_32x32x16_bf16(vt, pk[k4], o[db], 0, 0, 0);
                }
        }
        if (more) { LAS unsigned char* nb = lb + (cur ^ 1) * FP_BUF; *(LAS u32x4*)(nb + lw) = kr; *(LAS u32x4*)(nb + FP_V + lw) = vr; if (tid < 16) *(LAS f32x4*)(nb + FP_C + 16 * tid) = br; }
        __syncthreads();
    }
    lrun += __shfl_xor(lrun, 32);
    const float il = 1.0f / lrun;
    bf16_t* yo = (bf16_t*)(a.ws + WS_YB) + (size_t)(b * SEQ + 256 * j + 32 * w + q32) * 512 + 64 * h + 4 * hi;
#pragma unroll
    for (int db = 0; db < 2; ++db)
#pragma unroll
        for (int g4 = 0; g4 < 4; ++g4) { u32x2 wv; wv.x = pk2(o[db][4 * g4 + 0] * il, o[db][4 * g4 + 1] * il); wv.y = pk2(o[db][4 * g4 + 2] * il, o[db][4 * g4 + 3] * il);
            *(u32x2*)(yo + 32 * db + 8 * g4) = wv; }
}
#define XB_TMO      128
#define XB_XCNT(j)  (256  + 64 * (j))
#define XB_XSUB(j)  (1280 + 64 * (j))
#define XB_XGEN(j)  (2304 + 64 * (j))
#define XB_TOP      3328
#define XB_TOPGEN   3392
#define XCD_BAR_WORDS 3456
#define XB_SPIN_CAP (1u << 18)

__device__ __forceinline__ unsigned xb_ld(unsigned* p)              { return __hip_atomic_load(p, __ATOMIC_RELAXED, __HIP_MEMORY_SCOPE_AGENT); }
__device__ __forceinline__ unsigned xb_add(unsigned* p, unsigned v) { return __hip_atomic_fetch_add(p, v, __ATOMIC_RELAXED, __HIP_MEMORY_SCOPE_AGENT); }
__device__ __forceinline__ unsigned xb_xcc_id() { return (unsigned)__builtin_amdgcn_s_getreg((3 << 11) | 20) & 0xFu; }
#define XB_SPIN(cond, bar) do { unsigned _sp = 0; while (cond) { __builtin_amdgcn_s_sleep(1); \
    if ((++_sp & 255u) == 0u) { if (xb_ld(&(bar)[XB_TMO])) break; if (_sp > XB_SPIN_CAP) { atomicAdd(&(bar)[XB_TMO], 1u); break; } } } } while (0)

struct XcdBarrier {
    unsigned* bar; unsigned x;
    volatile LAS unsigned* st;
};

__device__ __forceinline__ XcdBarrier xcd_barrier_post(unsigned* bar, volatile LAS unsigned* st) {
    XcdBarrier b; b.bar = bar; b.x = xb_xcc_id(); b.st = st;
    if (threadIdx.x == 0) (void)xb_add(&bar[XB_XCNT(b.x)], 1u);
    return b;
}
__device__ __forceinline__ void xcd_barrier_complete(unsigned* bar, unsigned x, unsigned& nloc, unsigned& nx) {
    const unsigned G = gridDim.x * gridDim.y * gridDim.z;
    unsigned sum, cnt, mine, sp = 0u;
    for (;;) {
        sum = 0u; cnt = 0u; mine = 0u;
#pragma unroll
        for (unsigned j = 0; j < 16; ++j) { const unsigned c = xb_ld(&bar[XB_XCNT(j)]); sum += c; cnt += (c > 0u) ? 1u : 0u; mine = (j == x) ? c : mine; }
        if (sum == G) break;
        __builtin_amdgcn_s_sleep(1);
        if ((++sp & 255u) == 0u) { if (xb_ld(&bar[XB_TMO])) break; if (sp > XB_SPIN_CAP) { atomicAdd(&bar[XB_TMO], 1u); break; } }
    }
    nloc = mine > 0u ? mine : 1u; nx = cnt > 0u ? cnt : 1u;
}

__device__ __forceinline__ void xcd_barrier(const XcdBarrier& b) {
    asm volatile("s_waitcnt vmcnt(0)" ::: "memory");
    __syncthreads();
    if (threadIdx.x == 0) {
        unsigned* bar = b.bar;
        __builtin_amdgcn_s_waitcnt(0);
        unsigned nloc = b.st[0], nx = b.st[1];
        if (nloc == 0u) { xcd_barrier_complete(bar, b.x, nloc, nx); b.st[0] = nloc; b.st[1] = nx; }
        const unsigned old = xb_add(&bar[XB_XSUB(b.x)], 1u);
        const unsigned gen = old / nloc;
        if (old + 1u == (gen + 1u) * nloc) {
            __builtin_amdgcn_fence(__ATOMIC_RELEASE, "agent");
            asm volatile("s_waitcnt vmcnt(0)" ::: "memory");
            const unsigned og = xb_add(&bar[XB_TOP], 1u);
            const unsigned tg = og / nx;
            if (og + 1u == (tg + 1u) * nx) xb_add(&bar[XB_TOPGEN], 1u);
            else XB_SPIN(xb_ld(&bar[XB_TOPGEN]) == tg, bar);
            __builtin_amdgcn_fence(__ATOMIC_ACQUIRE, "agent");
            xb_add(&bar[XB_XGEN(b.x)], 1u);
            asm volatile("s_waitcnt vmcnt(0)" ::: "memory");
        } else {
            XB_SPIN(xb_ld(&bar[XB_XGEN(b.x)]) == gen, bar);
            __builtin_amdgcn_fence(__ATOMIC_ACQUIRE, "agent");
            asm volatile("s_waitcnt vmcnt(0)" ::: "memory");
        }
    }
    __syncthreads();
}
constexpr int N_PHASES = 13;
#ifndef MK_PER_PHASE
#define MK_PER_PHASE 0
#endif
template <class Epi> __device__ __forceinline__ void run_gemm(const Frame& F, const bf16_t* A, const bf16_t* Bt, int N, int K, const Epi& E) {
    pg8::Gemm g{A, Bt, MT, N, K}; pg8::StaticOrder S; S.init(MT, N, F.G, F.bid);
    pg8::gemm_phase<Epi, pg8::StaticOrder, true, true>(F.lds, g, S, E);
}
__global__ void __launch_bounds__(NTHR, 2) mega_fwd(Args a) {
    __builtin_assume(__builtin_amdgcn_workitem_id_y() == 0); __builtin_assume(__builtin_amdgcn_workitem_id_z() == 0);
    extern __shared__ __attribute__((aligned(16))) unsigned char lds_raw[];
    cg::grid_group grid = cg::this_grid();
    Frame F; F.lds = (LAS unsigned char*)lds_raw; F.tid = threadIdx.x; F.lane = F.tid & 63; F.wave = __builtin_amdgcn_readfirstlane(F.tid >> 6); F.G = gridDim.x; F.bid = blockIdx.x;
    unsigned char* ws = a.ws;
    LAS int* sh_item = (LAS int*)(F.lds + 131072);
    volatile LAS unsigned* bst = (volatile LAS unsigned*)(F.lds + 131072 + 64);
    if (F.tid < 2) bst[F.tid] = 0u;
    __syncthreads();
    const bool fused = (a.ph_hi - a.ph_lo) > 1;
    XcdBarrier xbar; xbar.bar = (unsigned*)(ws + WS_CTL) + 4096; xbar.x = 0; xbar.st = bst;
    if (fused) xbar = xcd_barrier_post((unsigned*)(ws + WS_CTL) + 4096, bst);
    const int lo = a.ph_lo, hi = a.ph_hi;
#define IN(k) (lo <= (k) && (k) < hi)
#define SEAM(k) do { if (IN(k) && IN((k) + 1)) { if ((k) == 0) grid.sync(); else xcd_barrier(xbar); } } while (0)
#ifndef PROBE_DUP
#define PROBE_DUP 0
#endif
#define REP(code) (PROBE_DUP == (code) ? 2 : 1)
    if (IN(0)) { for (int rep = 0; rep < REP(1); ++rep) p0_prologue(F, a); } SEAM(0);
    if (PROBE_DUP == 8) { for (int i = 0; i < 10; ++i) grid.sync(); }
    if (IN(1)) for (int rep = 0; rep < 1; ++rep) { pg8::EpiSwiGLU E{(bf16_t*)(ws + WS_H)}; run_gemm(F, (const bf16_t*)(ws + WS_XB), (const bf16_t*)(ws + WS_W1U), NUP, DM, E); if (PROBE_DUP == 9) run_gemm(F, (const bf16_t*)(ws + WS_XB), (const bf16_t*)(ws + WS_W1U), NUP, DM, E); } SEAM(1);
    if (IN(2)) for (int rep = 0; rep < 1; ++rep) { pg8::EpiRes E{a.x_p, a.x_s, (float*)(ws + WS_Z), 0.5f}; run_gemm(F, (const bf16_t*)(ws + WS_H), (const bf16_t*)(ws + WS_W1D), DM, DFF, E); if (PROBE_DUP == 10) run_gemm(F, (const bf16_t*)(ws + WS_H), (const bf16_t*)(ws + WS_W1D), DM, DFF, E); } SEAM(2);
    if (IN(3)) for (int rep = 0; rep < REP(3); ++rep) { ln_pass(F, (const float*)(ws + WS_Z), a.ln1g, a.ln1b, (float*)(ws + WS_HF1), (bf16_t*)(ws + WS_HB)); } SEAM(3);
    if (IN(4)) for (int rep = 0; rep < 1; ++rep) {
        pg8::EpiWin E{a.out, (bf16_t*)(ws + WS_QA), (bf16_t*)(ws + WS_IQ), (bf16_t*)(ws + WS_QB), (bf16_t*)(ws + WS_KAP), (bf16_t*)(ws + WS_VAP), (bf16_t*)(ws + WS_IKP), (bf16_t*)(ws + WS_KBP), (bf16_t*)(ws + WS_VBP),
                      (bf16_t*)(ws + WS_KAS), (bf16_t*)(ws + WS_VAS), (bf16_t*)(ws + WS_IKS), (bf16_t*)(ws + WS_KBS), (bf16_t*)(ws + WS_VBS), (bf16_t*)(ws + WS_G), (float*)(ws + WS_IW), (float*)(ws + WS_LF),
                      (const pg8::f32x2*)(ws + WS_ROPE), a.b_f, a.b_gate};
        run_gemm(F, (const bf16_t*)(ws + WS_HB), (const bf16_t*)(ws + WS_WIN), NINP, DM, E);
        if (PROBE_DUP == 11) run_gemm(F, (const bf16_t*)(ws + WS_HB), (const bf16_t*)(ws + WS_WIN), NINP, DM, E);
    } SEAM(4);
    if (IN(5)) {
        if (F.bid < NB + DB) cumsum_block(F, a, F.bid);
        for (int rep = 0; rep < REP(5); ++rep) { unsigned* ctr = (unsigned*)(ws + WS_CTL) + 128 * rep;
        for (;;) { if (F.tid == 0) *sh_item = (int)atomicAdd(ctr, 1u); __syncthreads(); const int item = *sh_item; __syncthreads(); if (item >= 1152) break; indexer_item(F, a, item); } }
    } SEAM(5);
    if (IN(6)) {
        unsigned* ctr = (unsigned*)(ws + WS_CTL) + 64;
        for (;;) { if (F.tid == 0) *sh_item = (int)atomicAdd(ctr, 1u); __syncthreads(); const int item = *sh_item; __syncthreads();
            if (item >= 512 + MT / 64) break;
            if (item < 256) fox_unit(F, a, item);
            else if (item < 512) { const int p = item - 256, bh = p >> 4, s = p & 15; fox_prompt_unit(F, a, bh >> 3, bh & 7, 31 - s); fox_prompt_unit(F, a, bh >> 3, bh & 7, s); }
            else { const int r0 = (item - 512) * 64; for (int i = 0; i < 8; ++i) dsa_query(F, a, r0 + 8 * i + F.wave); } }
        if (PROBE_DUP == 6) { ctr += 64; for (;;) { if (F.tid == 0) *sh_item = (int)atomicAdd(ctr, 1u); __syncthreads(); const int item = *sh_item; __syncthreads(); if (item >= 512) break; if (item < 256) fox_unit(F, a, item); else { const int p = item - 256, bh = p >> 4, s = p & 15; fox_prompt_unit(F, a, bh >> 3, bh & 7, 31 - s); fox_prompt_unit(F, a, bh >> 3, bh & 7, s); } } }
        if (PROBE_DUP == 7) { ctr += 64; for (;;) { if (F.tid == 0) *sh_item = (int)atomicAdd(ctr, 1u); __syncthreads(); const int item = *sh_item; __syncthreads(); if (item >= MT / 64) break;
            const int r0 = item * 64; for (int i = 0; i < 8; ++i) dsa_query(F, a, r0 + 8 * i + F.wave); } }
    } SEAM(6);
    if (IN(7)) for (int rep = 0; rep < 1; ++rep) {
        pg8::EpiProjA EA{(const bf16_t*)(ws + WS_G), (float*)(ws + WS_MM)}; run_gemm(F, (const bf16_t*)(ws + WS_YA), (const bf16_t*)(ws + WS_WPA), DM, 512, EA);
        pg8::EpiProjB EB{(const bf16_t*)(ws + WS_G), (const float*)(ws + WS_MM), (bf16_t*)(ws + WS_MMB)}; run_gemm(F, (const bf16_t*)(ws + WS_YB), (const bf16_t*)(ws + WS_WPB), DM, 512, EB);
    } SEAM(7);
    if (IN(8)) for (int rep = 0; rep < 1; ++rep) { pg8::EpiRes E{(const float*)(ws + WS_HF1), (const float*)(ws + WS_HF1) + (size_t)MP * DM, (float*)(ws + WS_Z), 1.0f}; run_gemm(F, (const bf16_t*)(ws + WS_MMB), (const bf16_t*)(ws + WS_WO), DM, DM, E); if (PROBE_DUP == 12) run_gemm(F, (const bf16_t*)(ws + WS_MMB), (const bf16_t*)(ws + WS_WO), DM, DM, E); } SEAM(8);
    if (IN(9)) for (int rep = 0; rep < REP(3); ++rep) { ln_pass(F, (const float*)(ws + WS_Z), a.ln2g, a.ln2b, (float*)(ws + WS_HF2), (bf16_t*)(ws + WS_HB)); } SEAM(9);
    if (IN(10)) for (int rep = 0; rep < 1; ++rep) { pg8::EpiSwiGLU E{(bf16_t*)(ws + WS_H)}; run_gemm(F, (const bf16_t*)(ws + WS_HB), (const bf16_t*)(ws + WS_W2U), NUP, DM, E); if (PROBE_DUP == 14) run_gemm(F, (const bf16_t*)(ws + WS_HB), (const bf16_t*)(ws + WS_W2U), NUP, DM, E); } SEAM(10);
    if (IN(11)) for (int rep = 0; rep < 1; ++rep) { pg8::EpiRes E{(const float*)(ws + WS_HF2), (const float*)(ws + WS_HF2) + (size_t)MP * DM, (float*)(ws + WS_Z), 0.5f}; run_gemm(F, (const bf16_t*)(ws + WS_H), (const bf16_t*)(ws + WS_W2D), DM, DFF, E); if (PROBE_DUP == 13) run_gemm(F, (const bf16_t*)(ws + WS_H), (const bf16_t*)(ws + WS_W2D), DM, DFF, E); } SEAM(11);
    if (IN(12)) for (int rep = 0; rep < REP(3); ++rep) { ln_pass(F, (const float*)(ws + WS_Z), a.ln3g, a.ln3b, a.out + O_Y, nullptr); }
#undef IN
#undef SEAM
}

extern "C" void kernel_launch(void* const* d_in, const int* in_sizes, int n_in, void* d_out, int out_size, void* d_ws, size_t ws_size, hipStream_t stream) {
    static int grid = 0;
    if (grid == 0) {
        if (n_in != 24 || ws_size < WS_END) { fprintf(stderr, "kernel_launch: expected 24 inputs and >= %zu bytes of workspace (got %d, %zu)\n", (size_t)WS_END, n_in, ws_size); grid = -1; return; }
        int dev = 0, cus = 0, per_cu = 0;
        hipGetDevice(&dev); hipDeviceGetAttribute(&cus, hipDeviceAttributeMultiprocessorCount, dev);
        if (hipFuncSetAttribute((const void*)mega_fwd, hipFuncAttributeMaxDynamicSharedMemorySize, LDS_BYTES) != hipSuccess) { fprintf(stderr, "kernel_launch: hipFuncSetAttribute failed\n"); grid = -1; return; }
        hipOccupancyMaxActiveBlocksPerMultiprocessor(&per_cu, (const void*)mega_fwd, NTHR, LDS_BYTES);
        (void)hipGetLastError();
        if (per_cu < 1) { fprintf(stderr, "kernel_launch: occupancy query says %d blocks per CU\n", per_cu); per_cu = 1; }
        grid = cus;
    }
    if (grid < 0) return;
    if (hipMemsetAsync(d_ws, 0, 65536, stream) != hipSuccess) { fprintf(stderr, "kernel_launch: hipMemsetAsync failed\n"); return; }
    Args a{};
    const float** p = (const float**)&a;
    for (int i = 0; i < 24; ++i) p[i] = (const float*)d_in[i];
    a.out = (float*)d_out; a.ws = (unsigned char*)d_ws;
    for (int j = 0; j < 32; ++j) a.invf[j] = pow(10000.0, -(double)j / 32.0);
#if MK_PER_PHASE
    for (int ph = 0; ph < N_PHASES; ++ph) { a.ph_lo = ph; a.ph_hi = ph + 1; void* args[] = {&a};
        hipError_t e = hipLaunchCooperativeKernel((const void*)mega_fwd, dim3(grid), dim3(NTHR), args, LDS_BYTES, stream);
        if (e != hipSuccess) { fprintf(stderr, "launch of phase %d failed: %s\n", ph, hipGetErrorString(e)); break; } }
#else
    a.ph_lo = 0; a.ph_hi = N_PHASES; void* args[] = {&a};
    hipError_t e = hipLaunchCooperativeKernel((const void*)mega_fwd, dim3(grid), dim3(NTHR), args, LDS_BYTES, stream);
    if (e != hipSuccess) fprintf(stderr, "cooperative launch failed: %s (grid %d)\n", hipGetErrorString(e), grid);
#endif
}
```

```cpp
#include <hip/hip_runtime.h>
#include <hip/hip_cooperative_groups.h>
#include <cstdio>
#include <cstdint>
#include <cmath>
namespace cg = cooperative_groups;

constexpr int DM = 1024, SEQ = 8192, NB = 2, DB = 32, DS = 64, PAST = 4096, SKV = PAST + DS  ;
constexpr int MP = NB * SEQ  , MS = DB * DS  , MT = MP + MS  ;
constexpr int DFF = 2816, NUP = 2 * DFF, NIN = 4944, NINP = 5120;
constexpr float ALPHA = 1.189207115002721f;
constexpr float LN_EPS = 1e-5f;
constexpr float LOG2E = 1.4426950408889634f;
constexpr float QSCALE = 0.125f * LOG2E;
constexpr float IWSCALE = 0.35355339059327373f * 0.125f;
constexpr size_t O_Y = 0, O_PAK = 18874368, O_PAV = 20971520, O_PIK = 23068672, O_PBK = 24117248, O_PBV = 32505856, O_PLF = 40894464,
                 O_SAK = 41025536, O_SAV = 41287680, O_SIK = 41549824, O_SBK = 41680896, O_SBV = 42729472, O_SLF = 43778048;
#define MK_PER_PHASE 0
#define PROBE_DUP 0
#define PROBE_TS -1
namespace pg8 {
#define PG8_LAS __attribute__((address_space(3)))
typedef unsigned short bf16_t;
typedef short bf16x8 __attribute__((ext_vector_type(8)));
typedef float f32x4 __attribute__((ext_vector_type(4)));
typedef unsigned u32x4 __attribute__((ext_vector_type(4)));
constexpr int BM = 256, BK = 64, HALF = 128, HTB = HALF * BK * 2  , STAGE_BYTES = 8 * HTB, NXCD = 8, WGM = 8;

__host__ __device__ __forceinline__ int lds_byte(int r, int c) { const int st = (r >> 4) * 2 + (c >> 5), rr = r & 15, cc = c & 31, ob = rr * 64 + cc * 2; return st * 1024 + (ob ^ (((ob >> 9) & 1) << 5)); }
__host__ __device__ __forceinline__ void stage_rc(int b, int& R, int& C) { const int st = b / 1024, sb = b % 1024, swz = sb ^ (((sb >> 9) & 1) << 5); R = (st >> 1) * 16 + swz / 64; C = (st & 1) * 32 + (swz % 64) / 2; }
__host__ __device__ __forceinline__ int perm32(int rho) { const int n = rho >> 4, i = rho & 15; return 8 * (i >> 2) + 4 * n + (i & 3); }

struct Unit { int pm, pn; };
struct Gemm { const bf16_t* A; const bf16_t* Bt; int M, N, K; };

struct StaticOrder {
    int nM, nN, nwg, G, c;
    __host__ __device__ void init(int M, int N, int G_, int c_) { nM = M / BM; nN = N / BM; nwg = nM * nN; G = G_; c = c_; }
    __host__ __device__ bool next(int i, Unit& u) const {
        const long L = (long)i * G + c; if (L >= nwg) return false;
        int wgid = (int)L; { const int q = nwg / NXCD, r = nwg % NXCD, xcd = wgid % NXCD, off = wgid / NXCD; wgid = (xcd < r ? xcd * (q + 1) : r * (q + 1) + (xcd - r) * q) + off; }
        const int nig = WGM * nN, gid = wgid / nig, fm = gid * WGM, gsz = (nM - fm) < WGM ? (nM - fm) : WGM;
        u.pm = fm + ((wgid % nig) % gsz); u.pn = (wgid % nig) / gsz; return true;
    }
    __device__ __forceinline__ void a_ready(const Unit&) const {}
    __device__ __forceinline__ void done(const Unit&) const {}
};

__device__ __forceinline__ unsigned cvt_pk_bf16(float lo, float hi) { unsigned r; asm volatile("v_cvt_pk_bf16_f32 %0, %1, %2" : "=v"(r) : "v"(lo), "v"(hi)); return r; }
typedef float f32x2 __attribute__((ext_vector_type(2)));
typedef unsigned u32x2 __attribute__((ext_vector_type(2)));
typedef float f32x2 __attribute__((ext_vector_type(2)));
__device__ __forceinline__ float bf2f(unsigned short b) { return __uint_as_float((unsigned)b << 16); }
__device__ __forceinline__ float fsigmoid(float x) { return __builtin_amdgcn_rcpf(1.0f + __builtin_amdgcn_exp2f(-x * LOG2E)); }
__device__ __forceinline__ float flogsig(float x) {
    const float e = __builtin_amdgcn_exp2f(-fabsf(x) * LOG2E);
    const float l1p = (e < 0.03125f) ? e * (1.0f - e * (0.5f - e * (0.33333333f - 0.25f * e))) : __logf(1.0f + e);
    return fminf(x, 0.f) - l1p;
}
__device__ __forceinline__ u32x2 pack4(f32x4 v) { u32x2 w; w.x = cvt_pk_bf16(v[0], v[1]); w.y = cvt_pk_bf16(v[2], v[3]); return w; }

struct EpiSwiGLU {
    static constexpr bool PERM = true, AFTER_DRAIN = false;
    bf16_t* H;
    __device__ __forceinline__ void operator()(const f32x4 (&acc)[2][2][4][2], const Unit& u, int wr, int wc, int fr, int fq) const {
        const int row0 = u.pm * BM + wr * 64 + fr, col0 = u.pn * 128 + wc * 32 + 8 * fq;
#pragma unroll
        for (int ai = 0; ai < 2; ++ai)
#pragma unroll
            for (int m = 0; m < 4; ++m) {
                bf16_t* rowp = H + (size_t)(row0 + ai * HALF + m * 16) * DFF + col0;
                f32x4 h[2];
#pragma unroll
                for (int n = 0; n < 2; ++n) { const f32x4 a = acc[ai][0][m][n], g = acc[ai][1][m][n];
#pragma unroll
                    for (int i = 0; i < 4; ++i) h[n][i] = a[i] * fsigmoid(a[i]) * g[i]; }
                u32x4 w; w.x = cvt_pk_bf16(h[0][0], h[0][1]); w.y = cvt_pk_bf16(h[0][2], h[0][3]); w.z = cvt_pk_bf16(h[1][0], h[1][1]); w.w = cvt_pk_bf16(h[1][2], h[1][3]);
                *(u32x4*)rowp = w;
            }
    }
};
struct EpiRes {
    static constexpr bool PERM = false, AFTER_DRAIN = false;
    const float* resP; const float* resS; float* Z; float s;
    __device__ __forceinline__ void operator()(const f32x4 (&acc)[2][2][4][2], const Unit& u, int wr, int wc, int fr, int fq) const {
        const int row0 = u.pm * BM + wr * 64 + fr, col0 = u.pn * BM + wc * 32 + 4 * fq;
        const float* rb = (u.pm < MP / BM) ? resP : (resS - (size_t)MP * DM);
#pragma unroll
        for (int ai = 0; ai < 2; ++ai) {
            f32x4 r[4][2][2];
#pragma unroll
            for (int m = 0; m < 4; ++m) { const size_t off = (size_t)(row0 + ai * HALF + m * 16) * DM + col0;
#pragma unroll
                for (int bj = 0; bj < 2; ++bj)
#pragma unroll
                    for (int n = 0; n < 2; ++n) r[m][bj][n] = *(const f32x4*)(rb + off + bj * HALF + n * 16); }
#pragma unroll
            for (int m = 0; m < 4; ++m) { const size_t off = (size_t)(row0 + ai * HALF + m * 16) * DM + col0;
#pragma unroll
                for (int bj = 0; bj < 2; ++bj)
#pragma unroll
                    for (int n = 0; n < 2; ++n) *(f32x4*)(Z + off + bj * HALF + n * 16) = r[m][bj][n] * ALPHA + acc[ai][bj][m][n] * s; }
        }
    }
};
struct EpiProjA {
    static constexpr bool PERM = false, AFTER_DRAIN = false;
    const bf16_t* G; float* MM;
    __device__ __forceinline__ void operator()(const f32x4 (&acc)[2][2][4][2], const Unit& u, int wr, int wc, int fr, int fq) const {
        const int row0 = u.pm * BM + wr * 64 + fr, col0 = u.pn * BM + wc * 32 + 4 * fq;
#pragma unroll
        for (int ai = 0; ai < 2; ++ai) {
            u32x2 gq[4][2][2];
#pragma unroll
            for (int m = 0; m < 4; ++m) { const size_t row = (size_t)(row0 + ai * HALF + m * 16);
#pragma unroll
                for (int bj = 0; bj < 2; ++bj)
#pragma unroll
                    for (int n = 0; n < 2; ++n) gq[m][bj][n] = *(const u32x2*)(G + row * 2048 + col0 + bj * HALF + n * 16); }
#pragma unroll
            for (int m = 0; m < 4; ++m) { const size_t row = (size_t)(row0 + ai * HALF + m * 16);
#pragma unroll
                for (int bj = 0; bj < 2; ++bj)
#pragma unroll
                    for (int n = 0; n < 2; ++n) { const int c = col0 + bj * HALF + n * 16; const u32x2 g = gq[m][bj][n];
                        f32x4 gv; gv[0] = __uint_as_float(g.x << 16); gv[1] = __uint_as_float(g.x & 0xffff0000u); gv[2] = __uint_as_float(g.y << 16); gv[3] = __uint_as_float(g.y & 0xffff0000u);
                        *(f32x4*)(MM + row * DM + c) = gv * acc[ai][bj][m][n]; } }
        }
    }
};
struct EpiProjB {
    static constexpr bool PERM = false, AFTER_DRAIN = false;
    const bf16_t* G; const float* MM; bf16_t* MMb;
    __device__ __forceinline__ void operator()(const f32x4 (&acc)[2][2][4][2], const Unit& u, int wr, int wc, int fr, int fq) const {
        const int row0 = u.pm * BM + wr * 64 + fr, col0 = u.pn * BM + wc * 32 + 4 * fq;
#pragma unroll
        for (int ai = 0; ai < 2; ++ai)
#pragma unroll
            for (int m = 0; m < 4; ++m) { const size_t row = (size_t)(row0 + ai * HALF + m * 16);
#pragma unroll
                for (int bj = 0; bj < 2; ++bj)
#pragma unroll
                    for (int n = 0; n < 2; ++n) { const int c = col0 + bj * HALF + n * 16; const u32x2 g = *(const u32x2*)(G + row * 2048 + 1024 + c);
                        f32x4 gv; gv[0] = __uint_as_float(g.x << 16); gv[1] = __uint_as_float(g.x & 0xffff0000u); gv[2] = __uint_as_float(g.y << 16); gv[3] = __uint_as_float(g.y & 0xffff0000u);
                        const f32x4 mm = *(const f32x4*)(MM + row * DM + c);
                        *(u32x2*)(MMb + row * DM + c) = pack4(mm + gv * acc[ai][bj][m][n]); } }
    }
};
struct EpiWin {
    static constexpr bool PERM = false, AFTER_DRAIN = false;
    float* out; bf16_t *QA, *IQ, *QB, *KAp, *VAp, *IKp, *KBp, *VBp, *KAs, *VAs, *IKs, *KBs, *VBs, *G; float *IW, *LF; const f32x2* rope; const float* b_f; const float* b_gate;
    __device__ __forceinline__ void operator()(const f32x4 (&acc)[2][2][4][2], const Unit& u, int wr, int wc, int fr, int fq) const {
        const int T = u.pn; const bool samp = u.pm >= MP / BM;
#pragma unroll
        for (int ai = 0; ai < 2; ++ai)
#pragma unroll
            for (int m = 0; m < 4; ++m) {
                const int row = u.pm * BM + ai * HALF + wr * 64 + m * 16 + fr; const int rs = row - MP;
                const int pos = samp ? PAST + (rs & 63) : (row & (SEQ - 1));
                const size_t srow = samp ? ((size_t)(rs >> 6) * SKV + PAST + (rs & 63)) : (size_t)row;
                if (T == 0 || T == 1 || T == 3 || T == 4) {
                    bf16_t* dst = (T < 2) ? QA + (size_t)row * 512 + 256 * T : IQ + (size_t)row * 512 + 256 * (T - 3);
                    const float sc = (T < 2) ? QSCALE : 1.0f;
#pragma unroll
                    for (int n = 0; n < 2; ++n) { const int j0 = 16 * n + 4 * fq; const f32x4 x1 = acc[ai][0][m][n], x2 = acc[ai][1][m][n]; f32x4 o1, o2;
#pragma unroll
                        for (int i = 0; i < 4; ++i) { const f32x2 cs = rope[pos * 32 + j0 + i]; o1[i] = (x1[i] * cs.x - x2[i] * cs.y) * sc; o2[i] = (x2[i] * cs.x + x1[i] * cs.y) * sc; }
                        *(u32x2*)(dst + 64 * wc + j0) = pack4(o1); *(u32x2*)(dst + 64 * wc + 32 + j0) = pack4(o2); }
                } else if (T == 2) {
                    if (wc < 2) {
                        float* kf = out + (samp ? O_SAK + (size_t)rs * 128 : O_PAK + (size_t)row * 128) + 64 * wc; bf16_t* kb = (samp ? KAs : KAp) + srow * 128 + 64 * wc;
#pragma unroll
                        for (int n = 0; n < 2; ++n) { const int j0 = 16 * n + 4 * fq; const f32x4 x1 = acc[ai][0][m][n], x2 = acc[ai][1][m][n]; f32x4 o1, o2;
#pragma unroll
                            for (int i = 0; i < 4; ++i) { const f32x2 cs = rope[pos * 32 + j0 + i]; o1[i] = x1[i] * cs.x - x2[i] * cs.y; o2[i] = x2[i] * cs.x + x1[i] * cs.y; }
                            *(f32x4*)(kf + j0) = o1; *(f32x4*)(kf + 32 + j0) = o2; *(u32x2*)(kb + j0) = pack4(o1); *(u32x2*)(kb + 32 + j0) = pack4(o2); }
                    } else {
                        float* vf = out + (samp ? O_SAV + (size_t)rs * 128 : O_PAV + (size_t)row * 128); bf16_t* vb = (samp ? VAs : VAp) + srow * 128;
#pragma unroll
                        for (int bj = 0; bj < 2; ++bj)
#pragma unroll
                            for (int n = 0; n < 2; ++n) { const int c = 64 * bj + 32 * (wc - 2) + 16 * n + 4 * fq; *(f32x4*)(vf + c) = acc[ai][bj][m][n]; *(u32x2*)(vb + c) = pack4(acc[ai][bj][m][n]); }
                    }
                } else if (T == 5) {
                    if (wc == 0) {
                        float* kf = out + (samp ? O_SIK + (size_t)rs * 64 : O_PIK + (size_t)row * 64); bf16_t* kb = (samp ? IKs : IKp) + srow * 64;
#pragma unroll
                        for (int n = 0; n < 2; ++n) { const int j0 = 16 * n + 4 * fq; const f32x4 x1 = acc[ai][0][m][n], x2 = acc[ai][1][m][n]; f32x4 o1, o2;
#pragma unroll
                            for (int i = 0; i < 4; ++i) { const f32x2 cs = rope[pos * 32 + j0 + i]; o1[i] = x1[i] * cs.x - x2[i] * cs.y; o2[i] = x2[i] * cs.x + x1[i] * cs.y; }
                            *(f32x4*)(kf + j0) = o1; *(f32x4*)(kf + 32 + j0) = o2; *(u32x2*)(kb + j0) = pack4(o1); *(u32x2*)(kb + 32 + j0) = pack4(o2); }
                    } else if (wc == 1) {
                        const f32x4 v = acc[ai][0][m][0];
                        if (fq < 2) { int fqm = fq; asm volatile("" : "+v"(fqm)); *(f32x4*)(IW + (size_t)row * 8 + 4 * fqm) = v * IWSCALE; }
                        else { int fql = fq; asm volatile("" : "+v"(fql)); const int i0 = 4 * (fql - 2); f32x4 lf; const f32x4 bfv = *(const f32x4*)(b_f + i0);
#pragma unroll
                            for (int i = 0; i < 4; ++i) lf[i] = flogsig(v[i] + bfv[i]);
                            *(f32x4*)(out + (samp ? O_SLF + (size_t)rs * 8 : O_PLF + (size_t)row * 8) + i0) = lf; *(f32x4*)(LF + (size_t)row * 8 + i0) = lf; }
                    }
                } else if (T < 8) {
                    bf16_t* dst = QB + (size_t)row * 512 + 256 * (T - 6) + 32 * wc + 4 * fq;
#pragma unroll
                    for (int bj = 0; bj < 2; ++bj)
#pragma unroll
                        for (int n = 0; n < 2; ++n) *(u32x2*)(dst + 128 * bj + 16 * n) = pack4(acc[ai][bj][m][n] * QSCALE);
                } else if (T < 12) {
                    const bool isv = T >= 10; const int c0 = 256 * ((T - 8) & 1) + 32 * wc + 4 * fq;
                    float* df = out + (isv ? (samp ? O_SBV + (size_t)rs * 512 : O_PBV + (size_t)row * 512) : (samp ? O_SBK + (size_t)rs * 512 : O_PBK + (size_t)row * 512)) + c0;
                    bf16_t* db = (isv ? (samp ? VBs + (size_t)rs * 512 : VBp + (size_t)row * 512) : (samp ? KBs + (size_t)rs * 512 : KBp + (size_t)row * 512)) + c0;
#pragma unroll
                    for (int bj = 0; bj < 2; ++bj)
#pragma unroll
                        for (int n = 0; n < 2; ++n) { *(f32x4*)(df + 128 * bj + 16 * n) = acc[ai][bj][m][n]; *(u32x2*)(db + 128 * bj + 16 * n) = pack4(acc[ai][bj][m][n]); }
                } else {
                    const int c0 = 256 * (T - 12) + 32 * wc + 4 * fq; bf16_t* dst = G + (size_t)row * 2048 + c0;
#pragma unroll
                    for (int bj = 0; bj < 2; ++bj)
#pragma unroll
                        for (int n = 0; n < 2; ++n) { const f32x4 bg = *(const f32x4*)(b_gate + c0 + 128 * bj + 16 * n); f32x4 g;
#pragma unroll
                            for (int i = 0; i < 4; ++i) g[i] = fsigmoid(acc[ai][bj][m][n][i] + bg[i]);
                            *(u32x2*)(dst + 128 * bj + 16 * n) = pack4(g); }
                }
            }
    }
};
template <class Epi, class Sched, bool ALIGN_EPI = false, bool SP2 = false>
__device__ __forceinline__ void gemm_phase(PG8_LAS unsigned char* lds, const Gemm g, const Sched& S, const Epi& E) {
    const int tid = threadIdx.x, wid = __builtin_amdgcn_readfirstlane(tid >> 6), lane = tid & 63, wr = wid >> 2, wc = wid & 3, fr = lane & 15, fq = lane >> 4;
    const int K = g.K, nt = K / BK;
    unsigned voffA[2], voffB[2];
#pragma unroll
    for (int i = 0; i < 2; ++i) { int R, C; stage_rc(tid * 16 + i * 8192, R, C); const int Rb = Epi::PERM ? ((R & ~31) + perm32(R & 31)) : R;
        voffA[i] = (unsigned)(R * K + C) * 2u; voffB[i] = (unsigned)(Rb * K + C) * 2u; }
    const size_t kstep = (size_t)(BK * 2);
    const size_t hstep = (size_t)HALF * K * 2;
    const size_t tstep = 2 * hstep;
    const unsigned ldsw = (unsigned)wid * 1024u;
    const int aoff = lds_byte(wr * 64 + fr, fq * 8), boff = lds_byte(wc * 32 + fr, fq * 8);
#define PG8_SA(b, h) (((b) * 2 + (h)) * HTB)
#define PG8_SB(b, h) ((4 + (b) * 2 + (h)) * HTB)
#define PG8_STAGE(bufoff, gbase, voff) do { _Pragma("unroll") for (int _i = 0; _i < 2; ++_i) \
        __builtin_amdgcn_global_load_lds((const unsigned*)((const char*)(gbase) + (voff)[_i]), (PG8_LAS unsigned*)(lds + (bufoff) + ldsw + _i * 8192), 16, 0, 0); } while (0)
#define PG8_LDA(dst, b, h) do { _Pragma("unroll") for (int m = 0; m < 4; ++m) _Pragma("unroll") for (int k = 0; k < 2; ++k) dst[m][k] = *(const PG8_LAS bf16x8*)(lds + PG8_SA(b, h) + aoff + m * 2048 + k * 1024); } while (0)
#define PG8_LDB(dst, b, h) do { _Pragma("unroll") for (int n = 0; n < 2; ++n) _Pragma("unroll") for (int k = 0; k < 2; ++k) dst[n][k] = *(const PG8_LAS bf16x8*)(lds + PG8_SB(b, h) + boff + n * 2048 + k * 1024); } while (0)
#define PG8_MMA(ai, bj, At, Bt) do { __builtin_amdgcn_s_setprio(1); _Pragma("unroll") for (int m = 0; m < 4; ++m) _Pragma("unroll") for (int n = 0; n < 2; ++n) _Pragma("unroll") for (int k = 0; k < 2; ++k) \
        acc[ai][bj][m][n] = __builtin_amdgcn_mfma_f32_16x16x32_bf16(Bt[n][k], At[m][k], acc[ai][bj][m][n], 0, 0, 0); __builtin_amdgcn_s_setprio(0); } while (0)
#define PG8_WAIT_V(n) asm volatile("s_waitcnt vmcnt(" #n ")" ::: "memory")
#define PG8_WAIT_L(n) asm volatile("s_waitcnt lgkmcnt(" #n ")" ::: "memory")
#define PG8_BAR __builtin_amdgcn_s_barrier()
#define PG8_SCHED __builtin_amdgcn_sched_barrier(0)
    Unit cur, nxt; int ui = 0;
    if (!S.next(0, cur)) return;
    f32x4 acc[2][2][4][2];
#pragma unroll
    for (int a = 0; a < 2; ++a)
#pragma unroll
        for (int b = 0; b < 2; ++b)
#pragma unroll
            for (int m = 0; m < 4; ++m)
#pragma unroll
                for (int n = 0; n < 2; ++n) acc[a][b][m][n] = (f32x4){0.f, 0.f, 0.f, 0.f};
    bf16x8 At[4][2], B0[2][2], B1[2][2];
    const char* cA = (const char*)g.A + (size_t)cur.pm * tstep; const char* cB = (const char*)g.Bt + (size_t)cur.pn * tstep;
    S.a_ready(cur);
    if constexpr (SP2) {
        PG8_STAGE(PG8_SB(0, 0), cB, voffB); PG8_STAGE(PG8_SB(0, 1), cB + hstep, voffB); PG8_STAGE(PG8_SA(0, 0), cA, voffA); PG8_STAGE(PG8_SA(0, 1), cA + hstep, voffA);
        if (wr == 1) PG8_BAR;
        PG8_WAIT_V(2); PG8_BAR;
        PG8_STAGE(PG8_SB(1, 0), cB + kstep, voffB); PG8_STAGE(PG8_SA(1, 0), cA + kstep, voffA); PG8_STAGE(PG8_SB(1, 1), cB + hstep + kstep, voffB);
        PG8_WAIT_V(6); PG8_BAR;
    } else {
        PG8_STAGE(PG8_SB(0, 0), cB, voffB); PG8_STAGE(PG8_SA(0, 0), cA, voffA); PG8_STAGE(PG8_SB(0, 1), cB + hstep, voffB); PG8_STAGE(PG8_SA(0, 1), cA + hstep, voffA);
        if (wr == 1) PG8_BAR;
        PG8_WAIT_V(4); PG8_BAR;
        PG8_STAGE(PG8_SB(1, 0), cB + kstep, voffB); PG8_STAGE(PG8_SA(1, 0), cA + kstep, voffA); PG8_STAGE(PG8_SB(1, 1), cB + hstep + kstep, voffB);
        PG8_WAIT_V(6); PG8_BAR;
    }
    for (;;) {
        const bool has_next = S.next(ui + 1, nxt);
        const char* nA = has_next ? (const char*)g.A + (size_t)nxt.pm * tstep : cA; const char* nB = has_next ? (const char*)g.Bt + (size_t)nxt.pn * tstep : cB;
        for (int t = 0; t < nt; t += 2) {
            const bool last = (t == nt - 2);
            const char* a1 = cA + (size_t)(t + 1) * kstep;
            const char* a2 = last ? nA : cA + (size_t)(t + 2) * kstep; const char* b2 = last ? nB : cB + (size_t)(t + 2) * kstep;
            const char* a3 = a2 + kstep; const char* b3 = b2 + kstep;
            if (last && has_next) S.a_ready(nxt);
            if constexpr (SP2) {
            PG8_LDB(B0, 0, 0); PG8_LDB(B1, 0, 1); PG8_SCHED; PG8_LDA(At, 0, 0); PG8_STAGE(PG8_SA(1, 1), a1 + hstep, voffA);
            PG8_WAIT_V(8); PG8_WAIT_L(0); PG8_BAR; PG8_MMA(0, 0, At, B0); PG8_MMA(0, 1, At, B1); PG8_BAR; PG8_SCHED;
            PG8_LDA(At, 0, 1); PG8_STAGE(PG8_SB(0, 0), b2, voffB); PG8_STAGE(PG8_SB(0, 1), b2 + hstep, voffB); PG8_STAGE(PG8_SA(0, 0), a2, voffA);
            PG8_WAIT_V(8); PG8_WAIT_L(0); PG8_BAR; PG8_MMA(1, 0, At, B0); PG8_MMA(1, 1, At, B1); PG8_BAR; PG8_SCHED;
            PG8_LDB(B0, 1, 0); PG8_LDB(B1, 1, 1); PG8_SCHED; PG8_LDA(At, 1, 0); PG8_STAGE(PG8_SA(0, 1), a2 + hstep, voffA);
            PG8_WAIT_V(8); PG8_WAIT_L(0); PG8_BAR; PG8_MMA(0, 0, At, B0); PG8_MMA(0, 1, At, B1); PG8_BAR; PG8_SCHED;
            PG8_LDA(At, 1, 1); PG8_STAGE(PG8_SB(1, 0), b3, voffB); PG8_STAGE(PG8_SB(1, 1), b3 + hstep, voffB); PG8_STAGE(PG8_SA(1, 0), a3, voffA);
            PG8_WAIT_V(8); PG8_WAIT_L(0); PG8_BAR; PG8_MMA(1, 0, At, B0); PG8_MMA(1, 1, At, B1); PG8_BAR; PG8_SCHED;
            } else {
            PG8_LDB(B0, 0, 0); PG8_SCHED; PG8_LDA(At, 0, 0); PG8_STAGE(PG8_SA(1, 1), a1 + hstep, voffA);
            PG8_WAIT_L(8); PG8_BAR; PG8_WAIT_L(0); PG8_MMA(0, 0, At, B0); PG8_BAR; PG8_SCHED;
            PG8_LDB(B1, 0, 1); PG8_STAGE(PG8_SB(0, 0), b2, voffB);
            PG8_BAR; PG8_WAIT_L(0); PG8_MMA(0, 1, At, B1); PG8_BAR;
            PG8_LDA(At, 0, 1); PG8_STAGE(PG8_SA(0, 0), a2, voffA);
            PG8_BAR; PG8_WAIT_L(0); PG8_MMA(1, 0, At, B0); PG8_BAR; PG8_SCHED;
            PG8_STAGE(PG8_SB(0, 1), b2 + hstep, voffB);
            PG8_WAIT_V(6); PG8_BAR; PG8_MMA(1, 1, At, B1); PG8_BAR;
            PG8_LDB(B0, 1, 0); PG8_SCHED; PG8_LDA(At, 1, 0); PG8_STAGE(PG8_SA(0, 1), a2 + hstep, voffA);
            PG8_WAIT_L(8); PG8_BAR; PG8_WAIT_L(0); PG8_MMA(0, 0, At, B0); PG8_BAR; PG8_SCHED;
            PG8_LDB(B1, 1, 1); PG8_STAGE(PG8_SB(1, 0), b3, voffB);
            PG8_BAR; PG8_WAIT_L(0); PG8_MMA(0, 1, At, B1); PG8_BAR;
            PG8_LDA(At, 1, 1); PG8_STAGE(PG8_SA(1, 0), a3, voffA);
            PG8_BAR; PG8_WAIT_L(0); PG8_MMA(1, 0, At, B0); PG8_BAR; PG8_SCHED;
            PG8_STAGE(PG8_SB(1, 1), b3 + hstep, voffB);
            PG8_WAIT_V(6); PG8_BAR; PG8_MMA(1, 1, At, B1); PG8_BAR;
            }
        }
        if constexpr (ALIGN_EPI) { if (wr == 0) PG8_BAR; }
        if constexpr (!Epi::AFTER_DRAIN) { E(acc, cur, wr, wc, fr, fq); S.done(cur); }
        if (!has_next) break;
#pragma unroll
        for (int a = 0; a < 2; ++a)
#pragma unroll
            for (int b = 0; b < 2; ++b)
#pragma unroll
                for (int m = 0; m < 4; ++m)
#pragma unroll
                    for (int n = 0; n < 2; ++n) acc[a][b][m][n] = (f32x4){0.f, 0.f, 0.f, 0.f};
        cur = nxt; cA = nA; cB = nB; ++ui;
        if constexpr (ALIGN_EPI) { if (wr == 1) PG8_BAR; }
    }
    PG8_WAIT_V(0);
    if constexpr (!ALIGN_EPI) { if (wr == 0) PG8_BAR; }
    PG8_BAR;
    if constexpr (Epi::AFTER_DRAIN) { E.fused(acc, cur, wr, wc, fr, fq, lds, wid, lane); S.done(cur); }
#undef PG8_SA
#undef PG8_SB
#undef PG8_STAGE
#undef PG8_LDA
#undef PG8_LDB
#undef PG8_MMA
#undef PG8_WAIT_V
#undef PG8_WAIT_L
#undef PG8_BAR
#undef PG8_SCHED
}
}
#define LAS __attribute__((address_space(3)))
typedef unsigned short bf16_t;
typedef short bf16x8 __attribute__((ext_vector_type(8)));
typedef short s16x4 __attribute__((ext_vector_type(4)));
typedef float f32x4 __attribute__((ext_vector_type(4)));
typedef float f32x2 __attribute__((ext_vector_type(2)));
typedef float f32x16 __attribute__((ext_vector_type(16)));
typedef unsigned u32x4 __attribute__((ext_vector_type(4)));
typedef unsigned u32x2 __attribute__((ext_vector_type(2)));
using pg8::cvt_pk_bf16; using pg8::bf2f;
constexpr int NWAVES = 8, NTHR = 512, LDS_BYTES = 147456;
constexpr size_t MiB = 1u << 20;
constexpr size_t WS_CTL = 0;
constexpr size_t WS_ROPE = 1 * MiB;
constexpr size_t WS_W1U = 4 * MiB, WS_W1D = 16 * MiB, WS_WIN = 22 * MiB, WS_WPA = 33 * MiB, WS_WPB = 34 * MiB, WS_WO = 35 * MiB, WS_W2U = 37 * MiB, WS_W2D = 49 * MiB;
constexpr size_t WS_XB = 56 * MiB;
constexpr size_t WS_H = 92 * MiB;
constexpr size_t WS_Z = 192 * MiB;
constexpr size_t WS_HF1 = 264 * MiB, WS_HF2 = 336 * MiB;
constexpr size_t WS_HB = 408 * MiB;
constexpr size_t WS_QA = 444 * MiB, WS_IQ = 462 * MiB, WS_QB = 480 * MiB;
constexpr size_t WS_KAP = 498 * MiB, WS_VAP = 502 * MiB, WS_IKP = 506 * MiB;
constexpr size_t WS_KBP = 508 * MiB, WS_VBP = 524 * MiB;
constexpr size_t WS_KAS = 540 * MiB, WS_VAS = 573 * MiB, WS_IKS = 606 * MiB;
constexpr size_t WS_KBS = 623 * MiB, WS_VBS = 625 * MiB;
constexpr size_t WS_IW = 627 * MiB, WS_LF = 628 * MiB;
constexpr size_t WS_CBP = 629 * MiB, WS_CBS = 630 * MiB;
constexpr size_t WS_G = 635 * MiB;
constexpr size_t WS_SEL = 707 * MiB;
constexpr size_t WS_YA = 725 * MiB, WS_YB = 743 * MiB;
constexpr size_t WS_MM = 761 * MiB;
constexpr size_t WS_MMB = 833 * MiB;
constexpr size_t WS_SCR = 869 * MiB;
constexpr size_t WS_END = 997 * MiB;

struct Args {
    const float *x_p, *x_s, *c_ak, *c_av, *c_aik, *c_bk, *c_bv, *c_blf, *w1u, *w1d, *ln1g, *ln1b, *win, *b_f, *b_gate, *wpa, *wpb, *wo, *ln2g, *ln2b, *w2u, *w2d, *ln3g, *ln3b;
    float* out; unsigned char* ws; double invf[32]; int ph_lo, ph_hi;
};
struct Frame { LAS unsigned char* lds; int tid, lane, wave, G, bid; };

__device__ __forceinline__ unsigned f2bf(float f) { unsigned u = __float_as_uint(f); return (u + 0x7fffu + ((u >> 16) & 1u)) >> 16; }
__device__ __forceinline__ unsigned pk2(float lo, float hi) { return cvt_pk_bf16(lo, hi); }
__device__ __forceinline__ float wave_sum(float v) {
#pragma unroll
    for (int o = 1; o < 64; o <<= 1) v += __shfl_xor(v, o);
    return v;
}
__host__ __device__ __forceinline__ int rope_src(int P) { return 64 * ((P & 127) >> 5) + (P & 31) + ((P >> 7) << 5); }
struct SrcId { __device__ __forceinline__ int operator()(int n) const { return n; } };
struct SrcUp { __device__ __forceinline__ int operator()(int n) const { const int t = n >> 8, p = n & 255; return (p < 128) ? 128 * t + p : DFF + 128 * t + (p - 128); } };
struct SrcWin { __device__ __forceinline__ int operator()(int n) const {
    const int T = n >> 8, P = n & 255, bj = P >> 7, q = P & 127;
    if (T < 2) return 256 * T + rope_src(P);
    if (T == 2) return (q < 64) ? 512 + 64 * (q >> 5) + (q & 31) + 32 * bj : 640 + 64 * bj + (q - 64);
    if (T < 5) return 768 + 256 * (T - 3) + rope_src(P);
    if (T == 5) { if (q < 32) return 1280 + q + 32 * bj; if (bj == 0 && q < 40) return 1344 + (q - 32); if (bj == 0 && q < 48) return 2888 + (q - 40); return -1; }
    if (T < 8) return 1352 + 256 * (T - 6) + P;
    if (T < 10) return 1864 + 256 * (T - 8) + P;
    if (T < 12) return 2376 + 256 * (T - 10) + P;
    return 2896 + 256 * (T - 12) + P; } };
template <class F> __device__ __forceinline__ void transpose_item(const float* W, int K, int N, int ND, bf16_t* WT, LAS float* scr, int item, int lane, F srcf) {
    const int nblk = ND / 32, kb = item / nblk, nb = item % nblk, k0 = 64 * kb, n0 = 32 * nb;
    const int sc = srcf(n0 + (lane & 31));
    float wv[32];
#pragma unroll
    for (int i = 0; i < 32; ++i) { const int kk = 2 * i + (lane >> 5); wv[i] = (sc >= 0) ? W[(size_t)(k0 + kk) * N + sc] : 0.f; }
#pragma unroll
    for (int i = 0; i < 32; ++i) { const int kk = 2 * i + (lane >> 5); scr[kk * 33 + (lane & 31)] = wv[i]; }
    asm volatile("s_waitcnt lgkmcnt(0)" ::: "memory");
    const int c = lane & 7;
#pragma unroll
    for (int j = 0; j < 4; ++j) { const int n = (lane >> 3) + 8 * j; const LAS float* s = scr + (8 * c) * 33 + n;
        u32x4 o; o.x = pk2(s[0 * 33], s[1 * 33]); o.y = pk2(s[2 * 33], s[3 * 33]); o.z = pk2(s[4 * 33], s[5 * 33]); o.w = pk2(s[6 * 33], s[7 * 33]);
        *(u32x4*)(WT + (size_t)(n0 + n) * K + k0 + 8 * c) = o; }
    asm volatile("s_waitcnt lgkmcnt(0)" ::: "memory");
}
__device__ __forceinline__ void cvt_rows(const float* src, bf16_t* dst, size_t n4, size_t per_src, size_t per_dst, size_t gt, size_t ngt) {
#pragma unroll 16
    for (size_t e = gt; e < n4; e += ngt) { const size_t b = e / per_src, r = e - b * per_src; const f32x4 v = *(const f32x4*)(src + 4 * e);
        u32x2 w; w.x = pk2(v[0], v[1]); w.y = pk2(v[2], v[3]); *(u32x2*)(dst + 4 * (b * per_dst + r)) = w; }
}
__device__ __forceinline__ void p0_prologue(const Frame& F, const Args& a) {
    unsigned char* ws = a.ws;
    if (F.bid == 0) { unsigned* ctl = (unsigned*)(ws + WS_CTL); if (F.tid < 256) ctl[F.tid] = 0u; for (int i = F.tid; i < 3456; i += NTHR) ctl[4096 + i] = 0u; }
    LAS float* scr = (LAS float*)(F.lds + F.wave * 16384);
    const int gw = F.bid * NWAVES + F.wave, NGW = F.G * NWAVES;
    constexpr int I_UP = 16 * (NUP / 32), I_DN = (DFF / 64) * 32, I_IN = 16 * (NINP / 32), I_P = 8 * 32, I_O = 16 * 32;
    constexpr int NIT = 2 * I_UP + 2 * I_DN + I_IN + 2 * I_P + I_O;
    for (int it = gw; it < NIT; it += NGW) {
        int r = it;
        if (r < I_UP) { transpose_item(a.w1u, DM, NUP, NUP, (bf16_t*)(ws + WS_W1U), scr, r, F.lane, SrcUp()); continue; } r -= I_UP;
        if (r < I_UP) { transpose_item(a.w2u, DM, NUP, NUP, (bf16_t*)(ws + WS_W2U), scr, r, F.lane, SrcUp()); continue; } r -= I_UP;
        if (r < I_DN) { transpose_item(a.w1d, DFF, DM, DM, (bf16_t*)(ws + WS_W1D), scr, r, F.lane, SrcId()); continue; } r -= I_DN;
        if (r < I_DN) { transpose_item(a.w2d, DFF, DM, DM, (bf16_t*)(ws + WS_W2D), scr, r, F.lane, SrcId()); continue; } r -= I_DN;
        if (r < I_IN) { transpose_item(a.win, DM, NIN, NINP, (bf16_t*)(ws + WS_WIN), scr, r, F.lane, SrcWin()); continue; } r -= I_IN;
        if (r < I_P) { transpose_item(a.wpa, 512, DM, DM, (bf16_t*)(ws + WS_WPA), scr, r, F.lane, SrcId()); continue; } r -= I_P;
        if (r < I_P) { transpose_item(a.wpb, 512, DM, DM, (bf16_t*)(ws + WS_WPB), scr, r, F.lane, SrcId()); continue; } r -= I_P;
        transpose_item(a.wo, DM, DM, DM, (bf16_t*)(ws + WS_WO), scr, r, F.lane, SrcId());
    }
    const size_t gt = (size_t)F.bid * NTHR + F.tid, ngt = (size_t)F.G * NTHR;
    cvt_rows(a.x_p, (bf16_t*)(ws + WS_XB), (size_t)MP * DM / 4, (size_t)MP * DM / 4, 0, gt, ngt);
    cvt_rows(a.x_s, (bf16_t*)(ws + WS_XB) + (size_t)MP * DM, (size_t)MS * DM / 4, (size_t)MS * DM / 4, 0, gt, ngt);
    cvt_rows(a.c_ak, (bf16_t*)(ws + WS_KAS), (size_t)DB * PAST * 32, (size_t)PAST * 32, (size_t)SKV * 32, gt, ngt);
    cvt_rows(a.c_av, (bf16_t*)(ws + WS_VAS), (size_t)DB * PAST * 32, (size_t)PAST * 32, (size_t)SKV * 32, gt, ngt);
    cvt_rows(a.c_aik, (bf16_t*)(ws + WS_IKS), (size_t)DB * PAST * 16, (size_t)PAST * 16, (size_t)SKV * 16, gt, ngt);
    f32x2* rope = (f32x2*)(ws + WS_ROPE);
    for (size_t e = gt; e < (size_t)SEQ * 32; e += ngt) {
        const int pos = (int)(e >> 5), j = (int)(e & 31); const double ang = (double)pos * a.invf[j];
        const double kq = __builtin_rint(ang * 0.63661977236758134308); double r = __builtin_fma(-kq, 1.57079632679489655800e+00, ang); r = __builtin_fma(-kq, 6.12323399573676603587e-17, r);
        const double r2 = r * r;
        const double sn = r * (1.0 + r2 * (-1.0 / 6 + r2 * (1.0 / 120 + r2 * (-1.0 / 5040 + r2 * (1.0 / 362880 + r2 * (-1.0 / 39916800 + r2 * (1.0 / 6227020800.0)))))));
        const double cn = 1.0 + r2 * (-0.5 + r2 * (1.0 / 24 + r2 * (-1.0 / 720 + r2 * (1.0 / 40320 + r2 * (-1.0 / 3628800 + r2 * (1.0 / 479001600.0))))));
        const int qd = ((int)(long long)kq) & 3; double s, c;
        if (qd == 0) { s = sn; c = cn; } else if (qd == 1) { s = cn; c = -sn; } else if (qd == 2) { s = -sn; c = -cn; } else { s = -cn; c = sn; }
        rope[e] = (f32x2){(float)c, (float)s};
    }
}
__device__ __forceinline__ void ln_pass(const Frame& F, const float* Z, const float* g, const float* b, float* of, bf16_t* ob) {
    const int gw = F.bid * NWAVES + F.wave, NGW = F.G * NWAVES;
    f32x4 gv[4], bv[4];
#pragma unroll
    for (int j = 0; j < 4; ++j) { gv[j] = *(const f32x4*)(g + 4 * F.lane + 256 * j); bv[j] = *(const f32x4*)(b + 4 * F.lane + 256 * j); }
    for (int rowb = gw; rowb < MT; rowb += 4 * NGW) {
        int rows[4]; bool has[4]; f32x4 v[4][4]; float sm[4], sq[4];
#pragma unroll
        for (int k = 0; k < 4; ++k) { rows[k] = rowb + k * NGW; has[k] = rows[k] < MT; if (!has[k]) rows[k] = rowb; }
#pragma unroll
        for (int k = 0; k < 4; ++k) { const f32x4* zr = (const f32x4*)(Z + (size_t)rows[k] * DM) + F.lane;
#pragma unroll
            for (int j = 0; j < 4; ++j) v[k][j] = zr[64 * j]; }
#pragma unroll
        for (int k = 0; k < 4; ++k) { float s = 0.f;
#pragma unroll
            for (int j = 0; j < 4; ++j) s += (v[k][j][0] + v[k][j][1]) + (v[k][j][2] + v[k][j][3]);
            sm[k] = s; }
#pragma unroll
        for (int o = 1; o < 64; o <<= 1) {
#pragma unroll
            for (int k = 0; k < 4; ++k) sm[k] += __shfl_xor(sm[k], o); }
#pragma unroll
        for (int k = 0; k < 4; ++k) { const float mean = sm[k] * (1.f / DM); float q = 0.f;
#pragma unroll
            for (int j = 0; j < 4; ++j) { v[k][j] = v[k][j] - mean; q += (v[k][j][0] * v[k][j][0] + v[k][j][1] * v[k][j][1]) + (v[k][j][2] * v[k][j][2] + v[k][j][3] * v[k][j][3]); }
            sq[k] = q; }
#pragma unroll
        for (int o = 1; o < 64; o <<= 1) {
#pragma unroll
            for (int k = 0; k < 4; ++k) sq[k] += __shfl_xor(sq[k], o); }
#pragma unroll
        for (int k = 0; k < 4; ++k) {
            if (has[k]) { const float rstd = 1.f / sqrtf(sq[k] * (1.f / DM) + LN_EPS);
#pragma unroll
                for (int j = 0; j < 4; ++j) { const f32x4 y = v[k][j] * rstd * gv[j] + bv[j];
                    *((f32x4*)(of + (size_t)rows[k] * DM) + F.lane + 64 * j) = y;
                    if (ob) { u32x2 w; w.x = pk2(y[0], y[1]); w.y = pk2(y[2], y[3]); *((u32x2*)(ob + (size_t)rows[k] * DM) + F.lane + 64 * j) = w; } } }
        }
    }
}
__device__ __forceinline__ void cumsum_block(const Frame& F, const Args& a, int sb) {
    LAS float* wt = (LAS float*)F.lds;
    const int tid = F.tid, lane = F.lane;
    const bool prm = sb < NB; const int b = prm ? sb : sb - NB;
    const int nrows = prm ? SEQ : SKV; const bool act = 16 * tid < nrows;
    const float* LF = (const float*)(a.ws + WS_LF);
    const float* src = prm ? LF + ((size_t)sb * SEQ + 16 * tid) * 8
                           : (16 * tid < PAST ? a.c_blf + ((size_t)b * PAST + 16 * tid) * 8 : LF + ((size_t)MP + b * DS + (16 * tid - PAST)) * 8);
    f32x4 v[16][2];
#pragma unroll
    for (int r = 0; r < 16; ++r) { v[r][0] = act ? *(const f32x4*)(src + 8 * r) : (f32x4){0.f, 0.f, 0.f, 0.f}; v[r][1] = act ? *(const f32x4*)(src + 8 * r + 4) : (f32x4){0.f, 0.f, 0.f, 0.f}; }
#pragma unroll
    for (int r = 1; r < 16; ++r) { v[r][0] += v[r - 1][0]; v[r][1] += v[r - 1][1]; }
    f32x4 t0 = v[15][0], t1 = v[15][1];
#pragma unroll
    for (int off = 1; off < 64; off <<= 1) {
#pragma unroll
        for (int i = 0; i < 4; ++i) { const float u0 = __shfl_up(t0[i], off), u1 = __shfl_up(t1[i], off); if (lane >= off) { t0[i] += u0; t1[i] += u1; } } }
    if (lane == 63) { *(LAS f32x4*)(wt + F.wave * 8) = t0; *(LAS f32x4*)(wt + F.wave * 8 + 4) = t1; }
    __syncthreads();
    f32x4 e0 = t0 - v[15][0], e1 = t1 - v[15][1];
    for (int ww = 0; ww < F.wave; ++ww) { e0 += *(const LAS f32x4*)(wt + ww * 8); e1 += *(const LAS f32x4*)(wt + ww * 8 + 4); }
    if (act) {
        float* dst = (prm ? (float*)(a.ws + WS_CBP) + (size_t)sb * 8 * SEQ : (float*)(a.ws + WS_CBS) + (size_t)b * 8 * SKV) + 16 * tid;
#pragma unroll
        for (int h = 0; h < 8; ++h) { float* dh = dst + (size_t)h * nrows;
#pragma unroll
            for (int r4 = 0; r4 < 4; ++r4) { f32x4 o;
#pragma unroll
                for (int i = 0; i < 4; ++i) o[i] = -(v[4 * r4 + i][h >> 2][h & 3] + (h < 4 ? e0[h & 3] : e1[h & 3])) * LOG2E;
                *(f32x4*)(dh + 4 * r4) = o; } }
    }
    __syncthreads();
}
__device__ __forceinline__ unsigned f2key(float f) { const unsigned u = __float_as_uint(f); return (u & 0x80000000u) ? ~u : (u | 0x80000000u); }
__device__ __forceinline__ void radix_list(const LAS unsigned* lk, int cnt, int k, LAS unsigned* hist, int lane, unsigned& tau, int& kk_out) {
    unsigned prefix = 0; int kk = k;
#pragma unroll 1
    for (int lev = 0; lev < 4; ++lev) {
        const int shift = 24 - 8 * lev;
        *(LAS u32x4*)(hist + 4 * lane) = (u32x4){0u, 0u, 0u, 0u};
        asm volatile("s_waitcnt lgkmcnt(0)" ::: "memory");
        for (int i = lane; i < cnt; i += 64) { const unsigned key = lk[i];
            if (lev == 0 || (key >> (shift + 8)) == prefix) __hip_atomic_fetch_add(&hist[(key >> shift) & 255u], 1u, __ATOMIC_RELAXED, __HIP_MEMORY_SCOPE_WORKGROUP); }
        asm volatile("s_waitcnt lgkmcnt(0)" ::: "memory");
        const u32x4 hb = *(const LAS u32x4*)(hist + 4 * lane);
        unsigned T = hb[0] + hb[1] + hb[2] + hb[3];
#pragma unroll
        for (int off = 1; off < 64; off <<= 1) { const unsigned v = __shfl_down(T, off); if (lane + off < 64) T += v; }
        const unsigned long long bal = __ballot(T >= (unsigned)kk);
        const int js = __popcll(bal) - 1;
        unsigned run = __shfl(T, (js + 1) & 63); if (js >= 63) run = 0u;
        const u32x4 hj = *(const LAS u32x4*)(hist + 4 * js);
        int digit = 4 * js;
        if (run + hj[3] >= (unsigned)kk) digit += 3;
        else { run += hj[3]; if (run + hj[2] >= (unsigned)kk) digit += 2; else { run += hj[2]; if (run + hj[1] >= (unsigned)kk) digit += 1; else run += hj[1]; } }
        kk -= (int)run; prefix = (prefix << 8) | (unsigned)digit;
        asm volatile("s_waitcnt lgkmcnt(0)" ::: "memory");
    }
    tau = prefix; kk_out = kk;
}
__device__ __forceinline__ void indexer_item(const Frame& F, const Args& a, int item) {
    int b, c, qq; bool samp;
    if (item < 504) { c = 127 - (item >> 3); b = (item >> 2) & 1; qq = item & 3; samp = false; }
    else if (item < 632) { const int s = item - 504; b = s >> 2; qq = s & 3; c = 64; samp = true; }
    else { const int r = item - 632; c = 64 - (r >> 3); b = (r >> 2) & 1; qq = r & 3; samp = false; }
    const int qrow0 = samp ? MP + b * DS + 16 * qq : b * SEQ + 64 * c + 16 * qq;
    const int n = samp ? SKV : 64 * (c + 1);
    const bf16_t* IK = samp ? (const bf16_t*)(a.ws + WS_IKS) + (size_t)b * SKV * 64 : (const bf16_t*)(a.ws + WS_IKP) + (size_t)b * SEQ * 64;
    const bf16_t* IQ = (const bf16_t*)(a.ws + WS_IQ); const float* IW = (const float*)(a.ws + WS_IW);
    int* SEL = (int*)(a.ws + WS_SEL);
    int lane = F.lane; asm volatile("" : "+v"(lane));
    const int l31 = lane & 31, hi = lane >> 5;
    if (n <= 256) {
        for (int e = F.tid; e < 16 * 256; e += NTHR) { const int q = e >> 8, s = e & 255; SEL[(size_t)(qrow0 + q) * 256 + s] = (s < n) ? s : 0; }
        return;
    }
    float* scr = (float*)(a.ws + WS_SCR) + (size_t)F.bid * 16 * 8192;
    if (PROBE_TS >= 20 && F.bid == 0 && F.tid == 0) ((unsigned long long*)(a.ws + WS_CTL + 32768))[30] = __builtin_amdgcn_s_memrealtime();
    {
        bf16x8 afr[4][4]; f32x4 wq[4][2][2];
        const int qa = 2 * ((l31 >> 2) & 1) + (l31 >> 4), ha = 4 * ((l31 >> 3) & 1) + (l31 & 3);
#pragma unroll
        for (int mt = 0; mt < 4; ++mt) {
#pragma unroll
            for (int ks = 0; ks < 4; ++ks) afr[mt][ks] = *(const bf16x8*)(IQ + (size_t)(qrow0 + 4 * mt + qa) * 512 + 64 * ha + 16 * ks + 8 * hi);
#pragma unroll
            for (int aa = 0; aa < 2; ++aa) { const float* wp = IW + (size_t)(qrow0 + 4 * mt + 2 * hi + aa) * 8; wq[mt][aa][0] = *(const f32x4*)wp; wq[mt][aa][1] = *(const f32x4*)(wp + 4); }
        }
        bf16x8 bnx[4];
        { const int kt0 = (F.wave < n / 32) ? F.wave : 0;
#pragma unroll
          for (int ks = 0; ks < 4; ++ks) bnx[ks] = *(const bf16x8*)(IK + (size_t)(32 * kt0 + l31) * 64 + 16 * ks + 8 * hi); }
        for (int kt = F.wave; kt < n / 32; kt += NWAVES) {
            bf16x8 bfr[4];
#pragma unroll
            for (int ks = 0; ks < 4; ++ks) bfr[ks] = bnx[ks];
            { const int ktn = (kt + NWAVES < n / 32) ? kt + NWAVES : kt;
#pragma unroll
              for (int ks = 0; ks < 4; ++ks) bnx[ks] = *(const bf16x8*)(IK + (size_t)(32 * ktn + l31) * 64 + 16 * ks + 8 * hi); }
#pragma unroll
            for (int mt = 0; mt < 4; ++mt) {
                f32x16 acc = {};
                __builtin_amdgcn_s_setprio(1);
#pragma unroll
                for (int ks = 0; ks < 4; ++ks) acc = __builtin_amdgcn_mfma_f32_32x32x16_bf16(afr[mt][ks], bfr[ks], acc, 0, 0, 0);
                __builtin_amdgcn_s_setprio(0);
#pragma unroll
                for (int aa = 0; aa < 2; ++aa) { float s = 0.f;
#pragma unroll
                    for (int h = 0; h < 8; ++h) s += fmaxf(acc[8 * aa + h], 0.f) * wq[mt][aa][h >> 2][h & 3];
                    scr[(size_t)(4 * mt + 2 * hi + aa) * 8192 + 32 * kt + l31] = s; }
            }
        }
    }
    __syncthreads(); __builtin_amdgcn_fence(__ATOMIC_ACQUIRE, "agent");
    if (PROBE_TS >= 20 && F.bid == 0 && F.tid == 0) { unsigned long long* ts = (unsigned long long*)(a.ws + WS_CTL + 32768); const unsigned long long now = __builtin_amdgcn_s_memrealtime(); ts[20] += now - ts[30]; ts[30] = now; }
    LAS unsigned* hist = (LAS unsigned*)(F.lds + F.wave * 14336);
    LAS unsigned* lk = hist + 2048; LAS unsigned short* li = (LAS unsigned short*)(hist + 3072);
    const int n4 = n >> 2;
    for (int q = F.wave; q < 16; q += NWAVES) {
        const float* sp = scr + (size_t)q * 8192;
        u32x4 k[32];
#pragma unroll
        for (int it = 0; it < 32; ++it) {
            const int i4 = 64 * it + lane; const f32x4 v = *(const f32x4*)(sp + 4 * i4); const bool ok = i4 < n4;
            k[it] = (u32x4){ok ? f2key(v[0]) : 0u, ok ? f2key(v[1]) : 0u, ok ? f2key(v[2]) : 0u, ok ? f2key(v[3]) : 0u};
        }
        int* so = SEL + (size_t)(qrow0 + q) * 256;
        unsigned pivot = 0u;
        if (n > 1024) {
#pragma unroll
            for (int j = 0; j < 8; ++j) lk[64 * j + lane] = k[4 * j][0];
            asm volatile("s_waitcnt lgkmcnt(0)" ::: "memory");
            int dummy; radix_list(lk, 512, 30, hist, lane, pivot, dummy);
        }
        int cl = 0;
#pragma unroll
        for (int it = 0; it < 32; ++it)
#pragma unroll
            for (int e = 0; e < 4; ++e) cl += (k[it][e] >= pivot && k[it][e] != 0u) ? 1 : 0;
        int cinc = cl;
#pragma unroll
        for (int off = 1; off < 64; off <<= 1) { const int v = __shfl_up(cinc, off); if (lane >= off) cinc += v; }
        const int c1 = __shfl(cinc, 63);
        if (c1 >= 256 && c1 <= 1024) {
            int p = cinc - cl;
#pragma unroll
            for (int it = 0; it < 32; ++it) {
                if (64 * it < n4) {
#pragma unroll
                    for (int e = 0; e < 4; ++e) { const unsigned key = k[it][e]; if (key >= pivot && key != 0u) { lk[p] = key; li[p] = (unsigned short)(256 * it + 4 * lane + e); ++p; } }
                }
            }
            asm volatile("s_waitcnt lgkmcnt(0)" ::: "memory");
            unsigned tau; int kq; radix_list(lk, c1, 256, hist, lane, tau, kq);
            if (lane < 2) hist[64 + lane] = 0u;
            asm volatile("s_waitcnt lgkmcnt(0)" ::: "memory");
            int ce_l = 0;
            for (int i = lane; i < c1; i += 64) ce_l += (lk[i] == tau) ? 1 : 0;
            int ce = ce_l;
#pragma unroll
            for (int off = 1; off < 64; off <<= 1) ce += __shfl_xor(ce, off);
            if (ce == kq || ce <= 64) {
                if (ce != kq) {
                    for (int i = lane; i < c1; i += 64) if (lk[i] == tau) { const unsigned t = __hip_atomic_fetch_add(&hist[65], 1u, __ATOMIC_RELAXED, __HIP_MEMORY_SCOPE_WORKGROUP); hist[t] = li[i]; }
                    asm volatile("s_waitcnt lgkmcnt(0)" ::: "memory");
                }
                for (int i = lane; i < c1; i += 64) { const unsigned key = lk[i]; const unsigned id = li[i]; bool take = key > tau;
                    if (key == tau) { if (ce == kq) take = true; else { int rk = 0; for (int t = 0; t < ce; ++t) rk += (hist[t] < id) ? 1 : 0; take = rk < kq; } }
                    if (take) { const unsigned pos = __hip_atomic_fetch_add(&hist[64], 1u, __ATOMIC_RELAXED, __HIP_MEMORY_SCOPE_WORKGROUP); if (pos < 256u) so[pos] = (int)id; } }
                asm volatile("s_waitcnt lgkmcnt(0)" ::: "memory");
                continue;
            }
        }
        unsigned prefix = 0; int kk = 256;
#pragma unroll 1
        for (int lev = 0; lev < 3; ++lev) {
            const int shift = (lev == 0) ? 21 : (lev == 1) ? 10 : 0, bits = (lev == 2) ? 10 : 11, nbin = 1 << bits, per = nbin >> 6;
            const unsigned hshift = (unsigned)(shift + bits), bmask = (unsigned)(nbin - 1);
            for (int j = 0; j < per; ++j) hist[lane + 64 * j] = 0u;
            asm volatile("s_waitcnt lgkmcnt(0)" ::: "memory");
#pragma unroll
            for (int it = 0; it < 32; ++it) {
                if (64 * it < n4) {
#pragma unroll
                    for (int e = 0; e < 4; ++e) { const unsigned key = k[it][e];
                        const bool m = (lev == 0) ? (key != 0u) : ((key >> hshift) == prefix && key != 0u);
                        if (m) __hip_atomic_fetch_add(&hist[(key >> shift) & bmask], 1u, __ATOMIC_RELAXED, __HIP_MEMORY_SCOPE_WORKGROUP); }
                }
            }
            asm volatile("s_waitcnt lgkmcnt(0)" ::: "memory");
            unsigned s = 0; for (int j = 0; j < per; ++j) s += hist[lane * per + ((j + lane) & (per - 1))];
            unsigned T = s;
#pragma unroll
            for (int off = 1; off < 64; off <<= 1) { const unsigned v = __shfl_down(T, off); if (lane + off < 64) T += v; }
            const unsigned long long bal = __ballot(T >= (unsigned)kk);
            const int js = __popcll(bal) - 1;
            unsigned run = __shfl(T, (js + 1) & 63); if (js >= 63) run = 0u;
            int digit = js * per;
            for (int bb = per - 1; bb >= 0; --bb) { const unsigned cnt = hist[js * per + bb]; if (run + cnt >= (unsigned)kk) { digit = js * per + bb; break; } run += cnt; }
            kk -= (int)run; prefix = (prefix << bits) | (unsigned)digit;
            asm volatile("s_waitcnt lgkmcnt(0)" ::: "memory");
        }
        int obase = 0, ebase = 0;
        const unsigned long long below = (1ull << lane) - 1ull;
#pragma unroll
        for (int it = 0; it < 32; ++it) {
            if (64 * it < n4) {
                bool tk[4]; unsigned long long be[4]; bool eqf[4]; unsigned long long anyeq = 0ull;
#pragma unroll
                for (int e = 0; e < 4; ++e) { eqf[e] = (k[it][e] == prefix); be[e] = __ballot(eqf[e]); anyeq |= be[e]; tk[e] = k[it][e] > prefix; }
                if (anyeq) {
                    int er = ebase + __popcll(be[0] & below) + __popcll(be[1] & below) + __popcll(be[2] & below) + __popcll(be[3] & below);
#pragma unroll
                    for (int e = 0; e < 4; ++e) { if (eqf[e]) { tk[e] = er < kk; ++er; } }
                    ebase += __popcll(be[0]) + __popcll(be[1]) + __popcll(be[2]) + __popcll(be[3]);
                }
                unsigned long long bt[4];
#pragma unroll
                for (int e = 0; e < 4; ++e) bt[e] = __ballot(tk[e]);
                int pos = obase + __popcll(bt[0] & below) + __popcll(bt[1] & below) + __popcll(bt[2] & below) + __popcll(bt[3] & below);
#pragma unroll
                for (int e = 0; e < 4; ++e) { if (tk[e]) { if (pos < 256) so[pos] = 256 * it + 4 * lane + e; ++pos; } }
                obase += __popcll(bt[0]) + __popcll(bt[1]) + __popcll(bt[2]) + __popcll(bt[3]);
            }
        }
    }
    __syncthreads();
    if (PROBE_TS >= 20 && F.bid == 0 && F.tid == 0) { unsigned long long* ts = (unsigned long long*)(a.ws + WS_CTL + 32768); const unsigned long long now = __builtin_amdgcn_s_memrealtime(); ts[21] += now - ts[30]; ts[30] = now; }
}
__device__ __forceinline__ void dsa_query(const Frame& F, const Args& a, int row) {
    int lane = F.lane; asm volatile("" : "+v"(lane));
    const int j = lane & 15, kq = lane >> 4;
    const bool samp = row >= MP; const int rs = row - MP;
    const int nsel = samp ? 256 : min(256, 64 * (((row & (SEQ - 1)) >> 6) + 1));
    const bf16_t* KA = samp ? (const bf16_t*)(a.ws + WS_KAS) + (size_t)(rs >> 6) * SKV * 128 : (const bf16_t*)(a.ws + WS_KAP) + (size_t)(row >> 13) * SEQ * 128;
    const bf16_t* VA = samp ? (const bf16_t*)(a.ws + WS_VAS) + (size_t)(rs >> 6) * SKV * 128 : (const bf16_t*)(a.ws + WS_VAP) + (size_t)(row >> 13) * SEQ * 128;
    const int* sel = (const int*)(a.ws + WS_SEL) + (size_t)row * 256;
    const bf16_t* QA = (const bf16_t*)(a.ws + WS_QA) + (size_t)row * 512;
    LAS float* pl = (LAS float*)(F.lds + F.wave * 9216);
    LAS int* sl = (LAS int*)(F.lds + F.wave * 9216 + 8192);
#pragma unroll
    for (int i = 0; i < 4; ++i) sl[lane + 64 * i] = sel[lane + 64 * i];
    bf16x8 bq[4];
#pragma unroll
    for (int ks = 0; ks < 4; ++ks) { bf16x8 z = {}; bq[ks] = (j < 8 && (ks >> 1) == (j >> 2)) ? *(const bf16x8*)(QA + 64 * j + 32 * (ks & 1) + 8 * kq) : z; }
    asm volatile("s_waitcnt lgkmcnt(0)" ::: "memory");
    f32x4 acc[16]; const int nt = nsel >> 4;
#pragma unroll
    for (int hb = 0; hb < 2; ++hb) {
        bf16x8 kfr[8][4];
#pragma unroll
        for (int tt = 0; tt < 8; ++tt) { const int idx = sl[16 * (8 * hb + tt) + j]; const bf16_t* kr = KA + (size_t)idx * 128 + 8 * kq;
#pragma unroll
            for (int ks = 0; ks < 4; ++ks) kfr[tt][ks] = *(const bf16x8*)(kr + 32 * ks); }
#pragma unroll
        for (int tt = 0; tt < 8; ++tt) { f32x4 c2 = {0.f, 0.f, 0.f, 0.f};
#pragma unroll
            for (int ks = 0; ks < 4; ++ks) c2 = __builtin_amdgcn_mfma_f32_16x16x32_bf16(kfr[tt][ks], bq[ks], c2, 0, 0, 0);
            acc[8 * hb + tt] = (8 * hb + tt < nt) ? c2 : (f32x4){-INFINITY, -INFINITY, -INFINITY, -INFINITY}; }
    }
    float mx = -INFINITY;
#pragma unroll
    for (int t = 0; t < 16; ++t) mx = fmaxf(mx, fmaxf(fmaxf(acc[t][0], acc[t][1]), fmaxf(acc[t][2], acc[t][3])));
    mx = fmaxf(mx, __shfl_xor(mx, 16)); mx = fmaxf(mx, __shfl_xor(mx, 32));
    float sum = 0.f;
#pragma unroll
    for (int t = 0; t < 16; ++t)
#pragma unroll
        for (int i = 0; i < 4; ++i) { const float p = __builtin_amdgcn_exp2f(acc[t][i] - mx); acc[t][i] = p; sum += p; }
    sum += __shfl_xor(sum, 16); sum += __shfl_xor(sum, 32);
    const float inv = 1.0f / sum;
    if (j < 8) {
#pragma unroll
        for (int t = 0; t < 16; ++t)
#pragma unroll
            for (int i = 0; i < 4; ++i) pl[(16 * t + 4 * kq + i) * 8 + j] = acc[t][i] * inv;
    }
    asm volatile("s_waitcnt lgkmcnt(0)" ::: "memory");
    const int rg = lane >> 4, ch = lane & 15, g = ch >> 3;
    f32x2 o[4][4];
#pragma unroll
    for (int hh = 0; hh < 4; ++hh)
#pragma unroll
        for (int d = 0; d < 4; ++d) o[hh][d] = (f32x2){0.f, 0.f};
    const char* vbase = (const char*)VA + 16 * ch;
#pragma unroll 32
    for (int i = 0; i < (nsel >> 2); ++i) { const int s = 4 * i + rg; const int idx = sl[s];
        const u32x4 v = *(const u32x4*)(vbase + (size_t)idx * 256); const f32x4 p4 = *(const LAS f32x4*)(pl + s * 8 + 4 * g);
        f32x2 vv[4];
#pragma unroll
        for (int d = 0; d < 4; ++d) vv[d] = (f32x2){__uint_as_float(v[d] << 16), __uint_as_float(v[d] & 0xffff0000u)};
#pragma unroll
        for (int hh = 0; hh < 4; ++hh)
#pragma unroll
            for (int d = 0; d < 4; ++d) o[hh][d] += vv[d] * p4[hh]; }
#pragma unroll
    for (int hh = 0; hh < 4; ++hh)
#pragma unroll
        for (int d = 0; d < 4; ++d) { o[hh][d].x += __shfl_xor(o[hh][d].x, 16); o[hh][d].y += __shfl_xor(o[hh][d].y, 16); o[hh][d].x += __shfl_xor(o[hh][d].x, 32); o[hh][d].y += __shfl_xor(o[hh][d].y, 32); }
    { u32x4 wv; const int hh = rg;
      f32x2 s0 = o[0][0], s1 = o[0][1], s2 = o[0][2], s3 = o[0][3];
      if (hh == 1) { s0 = o[1][0]; s1 = o[1][1]; s2 = o[1][2]; s3 = o[1][3]; } else if (hh == 2) { s0 = o[2][0]; s1 = o[2][1]; s2 = o[2][2]; s3 = o[2][3]; } else if (hh == 3) { s0 = o[3][0]; s1 = o[3][1]; s2 = o[3][2]; s3 = o[3][3]; }
      wv.x = pk2(s0.x, s0.y); wv.y = pk2(s1.x, s1.y); wv.z = pk2(s2.x, s2.y); wv.w = pk2(s3.x, s3.y);
      *(u32x4*)((bf16_t*)(a.ws + WS_YA) + (size_t)row * 512 + 64 * (4 * g + hh) + 8 * (ch & 7)) = wv; }
    asm volatile("s_waitcnt lgkmcnt(0)" ::: "memory");
}
constexpr int VST = 72;
constexpr int FOX_V = 0, FOX_M = 8 * 64 * VST * 2  , FOX_L = FOX_M + 2048, FOX_O = FOX_L + 256, FOX_END = FOX_O + 64 * 65 * 4;
static_assert(FOX_END + 65 * 64 * 4 + 64 * 144 <= 131072, "fox lds");
__device__ __forceinline__ int crow(int r, int hi) { return (r & 3) + 8 * (r >> 2) + 4 * hi; }
__device__ __forceinline__ bf16x8 cvt8(f32x4 a, f32x4 b) { u32x4 w; w.x = pk2(a[0], a[1]); w.y = pk2(a[2], a[3]); w.z = pk2(b[0], b[1]); w.w = pk2(b[2], b[3]); return __builtin_bit_cast(bf16x8, w); }
__device__ __forceinline__ void fox_unit(const Frame& F, const Args& a, int unit) {
    constexpr bool samp = true; int b, h, qi, ntiles, rowq0; const float* Cb;
    if (samp) { b = unit >> 3; h = unit & 7; qi = 64; ntiles = 65; rowq0 = MP + b * DS; Cb = (const float*)(a.ws + WS_CBS) + ((size_t)b * 8 + h) * SKV; }
    else { const int r = unit - 256; qi = 127 - (r >> 4); b = (r >> 3) & 1; h = r & 7; ntiles = qi + 1; rowq0 = b * SEQ + 64 * qi; Cb = (const float*)(a.ws + WS_CBP) + ((size_t)b * 8 + h) * SEQ; }
    int lane = F.lane; asm volatile("" : "+v"(lane)); int tidl = F.tid; asm volatile("" : "+v"(tidl));
    const int q32 = lane & 31, hi = lane >> 5, w = F.wave;
    const bf16_t* Kb = samp ? (const bf16_t*)(a.ws + WS_KBS) + (size_t)(b * DS) * 512 + 64 * h : (const bf16_t*)(a.ws + WS_KBP) + (size_t)(b * SEQ) * 512 + 64 * h;
    const bf16_t* Vb = samp ? (const bf16_t*)(a.ws + WS_VBS) + (size_t)(b * DS) * 512 + 64 * h : (const bf16_t*)(a.ws + WS_VBP) + (size_t)(b * SEQ) * 512 + 64 * h;
    const float* Kc = a.c_bk + ((size_t)b * PAST * 8 + h) * 64; const float* Vc = a.c_bv + ((size_t)b * PAST * 8 + h) * 64;
    LAS bf16_t* vl = (LAS bf16_t*)(F.lds + FOX_V) + w * 64 * VST;
    LAS float* mb = (LAS float*)(F.lds + FOX_M); LAS float* lt = (LAS float*)(F.lds + FOX_L); LAS float* ot = (LAS float*)(F.lds + FOX_O);
    for (int e = tidl; e < 64 * 65 + 64; e += NTHR) lt[e] = 0.f;
    LAS float* cbl = (LAS float*)(F.lds + FOX_END);
    for (int e = tidl; e < ntiles * 16; e += NTHR) *(LAS f32x4*)(cbl + 4 * e) = *(const f32x4*)(Cb + 4 * e);
    __syncthreads();
    LAS unsigned char* ql = F.lds + FOX_END + 65 * 64 * 4;
    { const bf16_t* QB = (const bf16_t*)(a.ws + WS_QB); const int r = tidl >> 3, ch = tidl & 7;
      *(LAS u32x4*)(ql + r * 144 + 16 * ch) = *(const u32x4*)(QB + (size_t)(rowq0 + r) * 512 + 64 * h + 8 * ch); }
    __syncthreads();
    const LAS unsigned char* qlw = ql + q32 * 144 + 16 * hi;
    float mrun[2] = {-INFINITY, -INFINITY}, lrun[2] = {0.f, 0.f};
    f32x16 o[2][2];
#pragma unroll
    for (int qb = 0; qb < 2; ++qb)
#pragma unroll
        for (int db = 0; db < 2; ++db)
#pragma unroll
            for (int r = 0; r < 16; ++r) o[qb][db][r] = 0.f;
    const int gi = lane >> 4, li = lane & 15;
    const unsigned kofb = (unsigned)(q32 * 1024 + 16 * hi);
    const unsigned kofc = (unsigned)(q32 * 2048 + 32 * hi);
    const unsigned cof = (unsigned)(16 * hi);
    const int troff = ((4 * hi + (li >> 2)) * VST + 16 * (gi & 1) + 4 * (li & 3));
    const int nmine = (w < ntiles) ? ((ntiles - 1 - w) >> 3) + 1 : 0;
    for (int ii = nmine - 1; ii >= 0; --ii) {
        const int tile = w + 8 * ii;
        const bool cache = samp && tile < 64, diag = (tile == ntiles - 1);
        const int kv0 = 64 * tile; const int kvl = samp ? (cache ? kv0 : 0) : kv0;
        bf16x8 kf[2][4];
        if (cache) {
            const char* kp = (const char*)Kc + (size_t)kvl * 2048 + kofc;
#pragma unroll
            for (int hf = 0; hf < 2; ++hf) { const char* kph = kp + hf * 65536;
#pragma unroll
                for (int ks = 0; ks < 4; ++ks) kf[hf][ks] = cvt8(*(const f32x4*)(kph + 64 * ks), *(const f32x4*)(kph + 64 * ks + 16)); }
        } else {
            const char* kp = (const char*)Kb + (size_t)kvl * 1024 + kofb;
#pragma unroll
            for (int hf = 0; hf < 2; ++hf) { const char* kph = kp + hf * 32768;
#pragma unroll
                for (int ks = 0; ks < 4; ++ks) kf[hf][ks] = *(const bf16x8*)(kph + 32 * ks); }
        }
        asm volatile("" ::: "memory");
        f32x16 s[2][2]; float mx[2];
#pragma unroll
        for (int qb = 0; qb < 2; ++qb) {
#pragma unroll
            for (int hf = 0; hf < 2; ++hf) {
#pragma unroll
                for (int g4 = 0; g4 < 4; ++g4) { const f32x4 c4 = *(const LAS f32x4*)((const LAS char*)(cbl + kv0) + cof + (128 * hf + 32 * g4));
                    s[qb][hf][4 * g4 + 0] = c4[0]; s[qb][hf][4 * g4 + 1] = c4[1]; s[qb][hf][4 * g4 + 2] = c4[2]; s[qb][hf][4 * g4 + 3] = c4[3]; }
#pragma unroll
                for (int ks = 0; ks < 4; ++ks) s[qb][hf] = __builtin_amdgcn_mfma_f32_32x32x16_bf16(kf[hf][ks], *(const LAS bf16x8*)(qlw + qb * 32 * 144 + 32 * ks), s[qb][hf], 0, 0, 0);
            }
            if (diag) { const int ql = 32 * qb + q32;
#pragma unroll
                for (int hf = 0; hf < 2; ++hf)
#pragma unroll
                    for (int r = 0; r < 16; ++r) if (32 * hf + crow(r, hi) > ql) s[qb][hf][r] = -INFINITY; }
            float m_ = -INFINITY;
#pragma unroll
            for (int r = 0; r < 16; ++r) m_ = fmaxf(m_, fmaxf(s[qb][0][r], s[qb][1][r]));
            mx[qb] = fmaxf(m_, __shfl_xor(m_, 32));
        }
        if (!__all(mx[0] < mrun[0] - 160.0f && mx[1] < mrun[1] - 160.0f)) {
            if (cache) {
                const char* vp = (const char*)Vc + (size_t)kvl * 2048 + (unsigned)(lane * 2048);
#pragma unroll
                for (int c = 0; c < 16; ++c) { const f32x4 v = *(const f32x4*)(vp + 16 * c);
                    u32x2 wv; wv.x = pk2(v[0], v[1]); wv.y = pk2(v[2], v[3]); *(LAS u32x2*)(vl + lane * VST + 4 * c) = wv;
                    if ((c & 7) == 7) asm volatile("" ::: "memory"); }
            } else {
                const char* vp = (const char*)Vb + (size_t)kvl * 1024 + (unsigned)(lane * 1024);
#pragma unroll
                for (int c = 0; c < 8; ++c) *(LAS u32x4*)(vl + lane * VST + 8 * c) = *(const u32x4*)(vp + 16 * c);
                asm volatile("" ::: "memory");
            }
#pragma unroll
            for (int qb = 0; qb < 2; ++qb) {
                const float mn = fmaxf(mrun[qb], mx[qb]); const float al = __builtin_amdgcn_exp2f(mrun[qb] - mn); mrun[qb] = mn;
                float sum = 0.f;
#pragma unroll
                for (int hf = 0; hf < 2; ++hf)
#pragma unroll
                    for (int r = 0; r < 16; ++r) { const float p = __builtin_amdgcn_exp2f(s[qb][hf][r] - mn); s[qb][hf][r] = p; sum += p; }
                lrun[qb] = lrun[qb] * al + sum;
                if (__any(al != 1.0f)) {
#pragma unroll
                    for (int db = 0; db < 2; ++db)
#pragma unroll
                        for (int r = 0; r < 16; ++r) o[qb][db][r] *= al; }
                bf16x8 pk[4];
#pragma unroll
                for (int k4 = 0; k4 < 4; ++k4) { const int hf = k4 >> 1, r0 = 8 * (k4 & 1); u32x4 wv;
                    wv.x = pk2(s[qb][hf][r0 + 0], s[qb][hf][r0 + 1]); wv.y = pk2(s[qb][hf][r0 + 2], s[qb][hf][r0 + 3]); wv.z = pk2(s[qb][hf][r0 + 4], s[qb][hf][r0 + 5]); wv.w = pk2(s[qb][hf][r0 + 6], s[qb][hf][r0 + 7]);
                    pk[k4] = __builtin_bit_cast(bf16x8, wv); }
                asm volatile("s_waitcnt lgkmcnt(0)" ::: "memory");
#pragma unroll
                for (int db = 0; db < 2; ++db)
#pragma unroll
                    for (int k4 = 0; k4 < 4; ++k4) {
                        const LAS bf16_t* p0 = vl + troff + (16 * k4) * VST + 32 * db;
                        const s16x4 lo = __builtin_bit_cast(s16x4, __builtin_amdgcn_ds_read_tr16_b64_v4i16((LAS s16x4*)p0));
                        const s16x4 hh = __builtin_bit_cast(s16x4, __builtin_amdgcn_ds_read_tr16_b64_v4i16((LAS s16x4*)(p0 + 8 * VST)));
                        const bf16x8 vt = (bf16x8){lo[0], lo[1], lo[2], lo[3], hh[0], hh[1], hh[2], hh[3]};
                        o[qb][db] = __builtin_amdgcn_mfma_f32_32x32x16_bf16(vt, pk[k4], o[qb][db], 0, 0, 0);
                    }
            }
            asm volatile("s_waitcnt lgkmcnt(0)" ::: "memory");
        }
    }
#pragma unroll
    for (int qb = 0; qb < 2; ++qb) { lrun[qb] += __shfl_xor(lrun[qb], 32); if (hi == 0) mb[w * 64 + 32 * qb + q32] = mrun[qb]; }
    __syncthreads();
#pragma unroll
    for (int qb = 0; qb < 2; ++qb) {
        const int q = 32 * qb + q32; float mg = -INFINITY;
#pragma unroll
        for (int ww = 0; ww < NWAVES; ++ww) mg = fmaxf(mg, mb[ww * 64 + q]);
        const float sc = __builtin_amdgcn_exp2f(mrun[qb] - mg);
        if (w < ntiles) {
            if (hi == 0) __hip_atomic_fetch_add(lt + q, lrun[qb] * sc, __ATOMIC_RELAXED, __HIP_MEMORY_SCOPE_WORKGROUP);
#pragma unroll
            for (int db = 0; db < 2; ++db)
#pragma unroll
                for (int r = 0; r < 16; ++r) __hip_atomic_fetch_add(ot + q * 65 + 32 * db + crow(r, hi), o[qb][db][r] * sc, __ATOMIC_RELAXED, __HIP_MEMORY_SCOPE_WORKGROUP);
        }
    }
    __syncthreads();
    { const int q = tidl >> 3, d0 = 8 * (tidl & 7); const float il = 1.0f / lt[q]; const LAS float* op = ot + q * 65 + d0;
      u32x4 wv; wv.x = pk2(op[0] * il, op[1] * il); wv.y = pk2(op[2] * il, op[3] * il); wv.z = pk2(op[4] * il, op[5] * il); wv.w = pk2(op[6] * il, op[7] * il);
      *(u32x4*)((bf16_t*)(a.ws + WS_YB) + (size_t)(rowq0 + q) * 512 + 64 * h + d0) = wv; }
    __syncthreads();
}

constexpr int FP_ROWB = 144, FP_V = 64 * FP_ROWB, FP_C = 2 * FP_V, FP_BUF = FP_C + 256;
__device__ __forceinline__ void fox_prompt_unit(const Frame& F, const Args& a, int b, int h, int j) {
    int lane = F.lane; asm volatile("" : "+v"(lane)); int tid = F.tid; asm volatile("" : "+v"(tid));
    const int q32 = lane & 31, hi = lane >> 5, w = F.wave;
    const int NT = 4 * (j + 1), myT = 4 * j + (w >> 1);
    const char* kg = (const char*)((const bf16_t*)(a.ws + WS_KBP) + (size_t)(b * SEQ) * 512 + 64 * h) + (size_t)(tid >> 3) * 1024 + 16 * (tid & 7);
    const char* vg = (const char*)((const bf16_t*)(a.ws + WS_VBP) + (size_t)(b * SEQ) * 512 + 64 * h) + (size_t)(tid >> 3) * 1024 + 16 * (tid & 7);
    const float* cg = (const float*)(a.ws + WS_CBP) + ((size_t)b * 8 + h) * SEQ + 4 * (tid & 15);
    LAS unsigned char* lb = F.lds;
    const int lw = (tid >> 3) * FP_ROWB + 16 * (tid & 7);
    const bf16_t* qp = (const bf16_t*)(a.ws + WS_QB) + (size_t)(b * SEQ + 256 * j + 32 * w + q32) * 512 + 64 * h + 8 * hi;
    bf16x8 qf[4];
#pragma unroll
    for (int ks = 0; ks < 4; ++ks) qf[ks] = *(const bf16x8*)(qp + 16 * ks);
    u32x4 kr[2], vr[2]; f32x4 br[2];
#pragma unroll
    for (int sb = 0; sb < 2; ++sb) { kr[sb] = *(const u32x4*)(kg + (size_t)(NT - 1 - sb) * 65536); vr[sb] = *(const u32x4*)(vg + (size_t)(NT - 1 - sb) * 65536); br[sb] = *(const f32x4*)(cg + 64 * (NT - 1 - sb)); }
#pragma unroll
    for (int sb = 0; sb < 2; ++sb) { *(LAS u32x4*)(lb + sb * FP_BUF + lw) = kr[sb]; *(LAS u32x4*)(lb + sb * FP_BUF + FP_V + lw) = vr[sb]; if (tid < 16) *(LAS f32x4*)(lb + sb * FP_BUF + FP_C + 16 * tid) = br[sb]; }
    __syncthreads();
    float mrun = -INFINITY, lrun = 0.f; f32x16 o[2];
#pragma unroll
    for (int db = 0; db < 2; ++db)
#pragma unroll
        for (int r = 0; r < 16; ++r) o[db][r] = 0.f;
    const int gi = lane >> 4, li = lane & 15;
    const int troff = ((4 * hi + (li >> 2)) * FP_ROWB + 2 * (16 * (gi & 1) + 4 * (li & 3)));
    const int kroff = q32 * FP_ROWB + 16 * hi;
    for (int st = 0; st < NT / 2; ++st) {
        const int t0 = NT - 1 - 2 * st; const int cur = st & 1; const bool more = (t0 >= 3);
        if (more) {
#pragma unroll
            for (int sb = 0; sb < 2; ++sb) { kr[sb] = *(const u32x4*)(kg + (size_t)(t0 - 2 - sb) * 65536); vr[sb] = *(const u32x4*)(vg + (size_t)(t0 - 2 - sb) * 65536); br[sb] = *(const f32x4*)(cg + 64 * (t0 - 2 - sb)); } }
#pragma unroll
        for (int sb = 0; sb < 2; ++sb) {
        const int t = t0 - sb;
        if (t <= myT) {
            const LAS unsigned char* kb_ = lb + (2 * cur + sb) * FP_BUF; const LAS unsigned char* vb_ = kb_ + FP_V; const LAS unsigned char* cb_ = kb_ + FP_C + 16 * hi;
            f32x16 s[2];
            __builtin_amdgcn_s_setprio(1);
#pragma unroll
            for (int hf = 0; hf < 2; ++hf) {
#pragma unroll
                for (int g4 = 0; g4 < 4; ++g4) { const f32x4 c4 = *(const LAS f32x4*)(cb_ + 128 * hf + 32 * g4);
                    s[hf][4 * g4 + 0] = c4[0]; s[hf][4 * g4 + 1] = c4[1]; s[hf][4 * g4 + 2] = c4[2]; s[hf][4 * g4 + 3] = c4[3]; }
#pragma unroll
                for (int ks = 0; ks < 4; ++ks) s[hf] = __builtin_amdgcn_mfma_f32_32x32x16_bf16(*(const LAS bf16x8*)(kb_ + kroff + hf * 32 * FP_ROWB + 32 * ks), qf[ks], s[hf], 0, 0, 0);
            }
            __builtin_amdgcn_s_setprio(0);
            if (t == myT) { const int ql = 32 * (w & 1) + q32;
#pragma unroll
                for (int hf = 0; hf < 2; ++hf)
#pragma unroll
                    for (int r = 0; r < 16; ++r) if (32 * hf + crow(r, hi) > ql) s[hf][r] = -INFINITY; }
            float mx = -INFINITY;
#pragma unroll
            for (int r = 0; r < 16; ++r) mx = fmaxf(mx, fmaxf(s[0][r], s[1][r]));
            mx = fmaxf(mx, __shfl_xor(mx, 32));
            if (!__all(mx < mrun - 160.0f)) {
            const float mn = fmaxf(mrun, mx); const float al = __builtin_amdgcn_exp2f(mrun - mn); mrun = mn;
            float sum = 0.f;
#pragma unroll
            for (int hf = 0; hf < 2; ++hf)
#pragma unroll
                for (int r = 0; r < 16; ++r) { const float p = __builtin_amdgcn_exp2f(s[hf][r] - mn); s[hf][r] = p; sum += p; }
            lrun = lrun * al + sum;
            if (__any(al != 1.0f)) {
#pragma unroll
            for (int db = 0; db < 2; ++db)
#pragma unroll
                for (int r = 0; r < 16; ++r) o[db][r] *= al; }
            bf16x8 pk[4];
#pragma unroll
            for (int k4 = 0; k4 < 4; ++k4) { const int hf = k4 >> 1, r0 = 8 * (k4 & 1); u32x4 wv;
                wv.x = pk2(s[hf][r0 + 0], s[hf][r0 + 1]); wv.y = pk2(s[hf][r0 + 2], s[hf][r0 + 3]); wv.z = pk2(s[hf][r0 + 4], s[hf][r0 + 5]); wv.w = pk2(s[hf][r0 + 6], s[hf][r0 + 7]);
                pk[k4] = __builtin_bit_cast(bf16x8, wv); }
            __builtin_amdgcn_s_setprio(1);
#pragma unroll
            for (int db = 0; db < 2; ++db)
#pragma unroll
                for (int k4 = 0; k4 < 4; ++k4) {
                    const LAS unsigned char* p0 = vb_ + troff + (16 * k4) * FP_ROWB + 64 * db;
                    const s16x4 lo = __builtin_bit_cast(s16x4, __builtin_amdgcn_ds_read_tr16_b64_v4i16((LAS s16x4*)p0));
                    const s16x4 hh = __builtin_bit_cast(s16x4, __builtin_amdgcn_ds_read_tr16_b64_v4i16((LAS s16x4*)(p0 + 8 * FP_ROWB)));
                    const bf16x8 vt = (bf16x8){lo[0], lo[1], lo[2], lo[3], hh[0], hh[1], hh[2], hh[3]};
                    o[db] = __builtin_amdgcn_mfma_f32_32x32x16_bf16(vt, pk[k4], o[db], 0, 0, 0);
                }
            __builtin_amdgcn_s_setprio(0);
            }
        }
        }
        if (more) {
#pragma unroll
            for (int sb = 0; sb < 2; ++sb) { LAS unsigned char* nb = lb + (2 * (cur ^ 1) + sb) * FP_BUF; *(LAS u32x4*)(nb + lw) = kr[sb]; *(LAS u32x4*)(nb + FP_V + lw) = vr[sb]; if (tid < 16) *(LAS f32x4*)(nb + FP_C + 16 * tid) = br[sb]; } }
        __syncthreads();
    }
    lrun += __shfl_xor(lrun, 32);
    const float il = 1.0f / lrun;
    bf16_t* yo = (bf16_t*)(a.ws + WS_YB) + (size_t)(b * SEQ + 256 * j + 32 * w + q32) * 512 + 64 * h + 4 * hi;
#pragma unroll
    for (int db = 0; db < 2; ++db)
#pragma unroll
        for (int g4 = 0; g4 < 4; ++g4) { u32x2 wv; wv.x = pk2(o[db][4 * g4 + 0] * il, o[db][4 * g4 + 1] * il); wv.y = pk2(o[db][4 * g4 + 2] * il, o[db][4 * g4 + 3] * il);
            *(u32x2*)(yo + 32 * db + 8 * g4) = wv; }
}
#define XB_TMO      128
#define XB_XCNT(j)  (256  + 64 * (j))
#define XB_XSUB(j)  (1280 + 64 * (j))
#define XB_XGEN(j)  (2304 + 64 * (j))
#define XB_TOP      3328
#define XB_TOPGEN   3392
#define XCD_BAR_WORDS 3456
#define XB_SPIN_CAP (1u << 18)

__device__ __forceinline__ unsigned xb_ld(unsigned* p)              { return __hip_atomic_load(p, __ATOMIC_RELAXED, __HIP_MEMORY_SCOPE_AGENT); }
__device__ __forceinline__ unsigned xb_add(unsigned* p, unsigned v) { return __hip_atomic_fetch_add(p, v, __ATOMIC_RELAXED, __HIP_MEMORY_SCOPE_AGENT); }
__device__ __forceinline__ unsigned xb_xcc_id() { return (unsigned)__builtin_amdgcn_s_getreg((3 << 11) | 20) & 0xFu; }
#define XB_SPIN(cond, bar) do { unsigned _sp = 0; while (cond) { __builtin_amdgcn_s_sleep(1); \
    if ((++_sp & 255u) == 0u) { if (xb_ld(&(bar)[XB_TMO])) break; if (_sp > XB_SPIN_CAP) { atomicAdd(&(bar)[XB_TMO], 1u); break; } } } } while (0)

struct XcdBarrier {
    unsigned* bar; unsigned x;
    volatile LAS unsigned* st;
};

__device__ __forceinline__ XcdBarrier xcd_barrier_post(unsigned* bar, volatile LAS unsigned* st) {
    XcdBarrier b; b.bar = bar; b.x = xb_xcc_id(); b.st = st;
    if (threadIdx.x == 0) (void)xb_add(&bar[XB_XCNT(b.x)], 1u);
    return b;
}
__device__ __forceinline__ void xcd_barrier_complete(unsigned* bar, unsigned x, unsigned& nloc, unsigned& nx) {
    const unsigned G = gridDim.x * gridDim.y * gridDim.z;
    unsigned sum, cnt, mine, sp = 0u;
    for (;;) {
        sum = 0u; cnt = 0u; mine = 0u;
#pragma unroll
        for (unsigned j = 0; j < 16; ++j) { const unsigned c = xb_ld(&bar[XB_XCNT(j)]); sum += c; cnt += (c > 0u) ? 1u : 0u; mine = (j == x) ? c : mine; }
        if (sum == G) break;
        __builtin_amdgcn_s_sleep(1);
        if ((++sp & 255u) == 0u) { if (xb_ld(&bar[XB_TMO])) break; if (sp > XB_SPIN_CAP) { atomicAdd(&bar[XB_TMO], 1u); break; } }
    }
    nloc = mine > 0u ? mine : 1u; nx = cnt > 0u ? cnt : 1u;
}

__device__ __forceinline__ void xcd_barrier(const XcdBarrier& b) {
    asm volatile("s_waitcnt vmcnt(0)" ::: "memory");
    __syncthreads();
    if (threadIdx.x == 0) {
        unsigned* bar = b.bar;
        __builtin_amdgcn_s_waitcnt(0);
        unsigned nloc = b.st[0], nx = b.st[1];
        if (nloc == 0u) { xcd_barrier_complete(bar, b.x, nloc, nx); b.st[0] = nloc; b.st[1] = nx; }
        const unsigned old = xb_add(&bar[XB_XSUB(b.x)], 1u);
        const unsigned gen = old / nloc;
        if (old + 1u == (gen + 1u) * nloc) {
            __builtin_amdgcn_fence(__ATOMIC_RELEASE, "agent");
            asm volatile("s_waitcnt vmcnt(0)" ::: "memory");
            const unsigned og = xb_add(&bar[XB_TOP], 1u);
            const unsigned tg = og / nx;
            if (og + 1u == (tg + 1u) * nx) xb_add(&bar[XB_TOPGEN], 1u);
            else XB_SPIN(xb_ld(&bar[XB_TOPGEN]) == tg, bar);
            __builtin_amdgcn_fence(__ATOMIC_ACQUIRE, "agent");
            xb_add(&bar[XB_XGEN(b.x)], 1u);
            asm volatile("s_waitcnt vmcnt(0)" ::: "memory");
        } else {
            XB_SPIN(xb_ld(&bar[XB_XGEN(b.x)]) == gen, bar);
            __builtin_amdgcn_fence(__ATOMIC_ACQUIRE, "agent");
            asm volatile("s_waitcnt vmcnt(0)" ::: "memory");
        }
    }
    __syncthreads();
}
constexpr int N_PHASES = 13;
#ifndef MK_PER_PHASE
#define MK_PER_PHASE 0
#endif
template <class Epi> __device__ __forceinline__ void run_gemm(const Frame& F, const bf16_t* A, const bf16_t* Bt, int N, int K, const Epi& E) {
    pg8::Gemm g{A, Bt, MT, N, K}; pg8::StaticOrder S; S.init(MT, N, F.G, F.bid);
    pg8::gemm_phase<Epi, pg8::StaticOrder, true, true>(F.lds, g, S, E);
}
__global__ void __launch_bounds__(NTHR, 2) mega_fwd(Args a) {
    __builtin_assume(__builtin_amdgcn_workitem_id_y() == 0); __builtin_assume(__builtin_amdgcn_workitem_id_z() == 0);
    extern __shared__ __attribute__((aligned(16))) unsigned char lds_raw[];
    cg::grid_group grid = cg::this_grid();
    Frame F; F.lds = (LAS unsigned char*)lds_raw; F.tid = threadIdx.x; F.lane = F.tid & 63; F.wave = __builtin_amdgcn_readfirstlane(F.tid >> 6); F.G = gridDim.x; F.bid = blockIdx.x;
    unsigned char* ws = a.ws;
    LAS int* sh_item = (LAS int*)(F.lds + 131072);
    volatile LAS unsigned* bst = (volatile LAS unsigned*)(F.lds + 131072 + 64);
    if (F.tid < 2) bst[F.tid] = 0u;
    __syncthreads();
    const bool fused = (a.ph_hi - a.ph_lo) > 1;
    XcdBarrier xbar; xbar.bar = (unsigned*)(ws + WS_CTL) + 4096; xbar.x = 0; xbar.st = bst;
    const int lo = a.ph_lo, hi = a.ph_hi;
#define IN(k) (lo <= (k) && (k) < hi)
#ifndef PROBE_TS
#define PROBE_TS -1
#endif
#define STAMP(k) do { if (PROBE_TS >= 0 && F.bid == 0 && F.tid == 0) ((unsigned long long*)(ws + WS_CTL + 32768))[k] = __builtin_amdgcn_s_memrealtime(); } while (0)
#define SEAM(k) do { if (IN(k) && IN((k) + 1)) { if ((k) == 0) grid.sync(); else xcd_barrier(xbar); } STAMP((k) + 1); } while (0)
    STAMP(0);
#ifndef PROBE_DUP
#define PROBE_DUP 0
#endif
#define REP(code) (PROBE_DUP == (code) ? 2 : 1)
    if (IN(0)) { for (int rep = 0; rep < REP(1); ++rep) p0_prologue(F, a); } SEAM(0);
    if (fused) xbar = xcd_barrier_post((unsigned*)(ws + WS_CTL) + 4096, bst);
    if (PROBE_DUP == 8) { for (int i = 0; i < 10; ++i) grid.sync(); }
    if (IN(1)) for (int rep = 0; rep < 1; ++rep) { pg8::EpiSwiGLU E{(bf16_t*)(ws + WS_H)}; run_gemm(F, (const bf16_t*)(ws + WS_XB), (const bf16_t*)(ws + WS_W1U), NUP, DM, E); } SEAM(1);
    if (PROBE_DUP == 9) { pg8::EpiSwiGLU E2{(bf16_t*)(ws + WS_H)}; run_gemm(F, (const bf16_t*)(ws + WS_XB), (const bf16_t*)(ws + WS_W1U), NUP, DM, E2); xcd_barrier(xbar); }
    if (IN(2)) for (int rep = 0; rep < 1; ++rep) { pg8::EpiRes E{a.x_p, a.x_s, (float*)(ws + WS_Z), 0.5f}; run_gemm(F, (const bf16_t*)(ws + WS_H), (const bf16_t*)(ws + WS_W1D), DM, DFF, E); if (PROBE_DUP == 10) run_gemm(F, (const bf16_t*)(ws + WS_H), (const bf16_t*)(ws + WS_W1D), DM, DFF, E); } SEAM(2);
    if (IN(3)) for (int rep = 0; rep < REP(3); ++rep) { ln_pass(F, (const float*)(ws + WS_Z), a.ln1g, a.ln1b, (float*)(ws + WS_HF1), (bf16_t*)(ws + WS_HB)); } SEAM(3);
    if (IN(4)) for (int rep = 0; rep < 1; ++rep) {
        pg8::EpiWin E{a.out, (bf16_t*)(ws + WS_QA), (bf16_t*)(ws + WS_IQ), (bf16_t*)(ws + WS_QB), (bf16_t*)(ws + WS_KAP), (bf16_t*)(ws + WS_VAP), (bf16_t*)(ws + WS_IKP), (bf16_t*)(ws + WS_KBP), (bf16_t*)(ws + WS_VBP),
                      (bf16_t*)(ws + WS_KAS), (bf16_t*)(ws + WS_VAS), (bf16_t*)(ws + WS_IKS), (bf16_t*)(ws + WS_KBS), (bf16_t*)(ws + WS_VBS), (bf16_t*)(ws + WS_G), (float*)(ws + WS_IW), (float*)(ws + WS_LF),
                      (const pg8::f32x2*)(ws + WS_ROPE), a.b_f, a.b_gate};
        run_gemm(F, (const bf16_t*)(ws + WS_HB), (const bf16_t*)(ws + WS_WIN), NINP, DM, E);
        if (PROBE_DUP == 11) run_gemm(F, (const bf16_t*)(ws + WS_HB), (const bf16_t*)(ws + WS_WIN), NINP, DM, E);
    } SEAM(4);
    if (IN(5)) {
        if (F.bid < NB + DB) cumsum_block(F, a, F.bid);
        for (int rep = 0; rep < REP(5); ++rep) { unsigned* ctr = (unsigned*)(ws + WS_CTL) + 128 * rep;
        for (;;) { if (F.tid == 0) *sh_item = (int)atomicAdd(ctr, 1u); __syncthreads(); const int item = *sh_item; __syncthreads(); if (item >= 1152) break; indexer_item(F, a, item); } }
    } SEAM(5);
    if (IN(6)) {
        unsigned* ctr = (unsigned*)(ws + WS_CTL) + 64;
        for (;;) { if (F.tid == 0) *sh_item = (int)atomicAdd(ctr, 1u); __syncthreads(); const int item = *sh_item; __syncthreads();
            if (item >= 1024 + 640) break;
            int kind, idx;
            if (item < 256) { kind = 0; idx = item; } else if (item < 512) { kind = 1; idx = item - 256; } else { kind = 2; idx = item - 512; }
            if (PROBE_TS >= 20 && F.bid == 0 && F.tid == 0) ((unsigned long long*)(ws + WS_CTL + 32768))[30] = __builtin_amdgcn_s_memrealtime();
            if (kind == 0) fox_unit(F, a, idx);
            else if (kind == 1) { const int bh = idx >> 4, s = idx & 15; fox_prompt_unit(F, a, bh >> 3, bh & 7, 31 - s); fox_prompt_unit(F, a, bh >> 3, bh & 7, s); }
            else { const int r0 = idx * 16; for (int i = 0; i < 2; ++i) dsa_query(F, a, r0 + 8 * i + F.wave); }
            if (PROBE_TS >= 20) { __syncthreads(); if (F.bid == 0 && F.tid == 0) { unsigned long long* ts = (unsigned long long*)(ws + WS_CTL + 32768); ts[kind == 0 ? 22 : kind == 1 ? 23 : 24] += __builtin_amdgcn_s_memrealtime() - ts[30]; } } }
        if (PROBE_DUP == 6) { ctr += 64; for (;;) { if (F.tid == 0) *sh_item = (int)atomicAdd(ctr, 1u); __syncthreads(); const int item = *sh_item; __syncthreads(); if (item >= 512) break; if (item < 256) fox_unit(F, a, item); else { const int p = item - 256, bh = p >> 4, s = p & 15; fox_prompt_unit(F, a, bh >> 3, bh & 7, 31 - s); fox_prompt_unit(F, a, bh >> 3, bh & 7, s); } } }
        if (PROBE_DUP == 7) { ctr += 64; for (;;) { if (F.tid == 0) *sh_item = (int)atomicAdd(ctr, 1u); __syncthreads(); const int item = *sh_item; __syncthreads(); if (item >= MT / 64) break;
            const int r0 = item * 64; for (int i = 0; i < 8; ++i) dsa_query(F, a, r0 + 8 * i + F.wave); } }
    } SEAM(6);
    if (IN(7)) for (int rep = 0; rep < 1; ++rep) {
        pg8::EpiProjA EA{(const bf16_t*)(ws + WS_G), (float*)(ws + WS_MM)}; run_gemm(F, (const bf16_t*)(ws + WS_YA), (const bf16_t*)(ws + WS_WPA), DM, 512, EA);
        pg8::EpiProjB EB{(const bf16_t*)(ws + WS_G), (const float*)(ws + WS_MM), (bf16_t*)(ws + WS_MMB)}; run_gemm(F, (const bf16_t*)(ws + WS_YB), (const bf16_t*)(ws + WS_WPB), DM, 512, EB);
    } SEAM(7);
    if (IN(8)) for (int rep = 0; rep < 1; ++rep) { pg8::EpiRes E{(const float*)(ws + WS_HF1), (const float*)(ws + WS_HF1) + (size_t)MP * DM, (float*)(ws + WS_Z), 1.0f}; run_gemm(F, (const bf16_t*)(ws + WS_MMB), (const bf16_t*)(ws + WS_WO), DM, DM, E); if (PROBE_DUP == 12) run_gemm(F, (const bf16_t*)(ws + WS_MMB), (const bf16_t*)(ws + WS_WO), DM, DM, E); } SEAM(8);
    if (IN(9)) for (int rep = 0; rep < REP(3); ++rep) { ln_pass(F, (const float*)(ws + WS_Z), a.ln2g, a.ln2b, (float*)(ws + WS_HF2), (bf16_t*)(ws + WS_HB)); } SEAM(9);
    if (IN(10)) for (int rep = 0; rep < 1; ++rep) { pg8::EpiSwiGLU E{(bf16_t*)(ws + WS_H)}; run_gemm(F, (const bf16_t*)(ws + WS_HB), (const bf16_t*)(ws + WS_W2U), NUP, DM, E); if (PROBE_DUP == 14) run_gemm(F, (const bf16_t*)(ws + WS_HB), (const bf16_t*)(ws + WS_W2U), NUP, DM, E); } SEAM(10);
    if (IN(11)) for (int rep = 0; rep < 1; ++rep) { pg8::EpiRes E{(const float*)(ws + WS_HF2), (const float*)(ws + WS_HF2) + (size_t)MP * DM, (float*)(ws + WS_Z), 0.5f}; run_gemm(F, (const bf16_t*)(ws + WS_H), (const bf16_t*)(ws + WS_W2D), DM, DFF, E); if (PROBE_DUP == 13) run_gemm(F, (const bf16_t*)(ws + WS_H), (const bf16_t*)(ws + WS_W2D), DM, DFF, E); } SEAM(11);
    if (IN(12)) for (int rep = 0; rep < REP(3); ++rep) { ln_pass(F, (const float*)(ws + WS_Z), a.ln3g, a.ln3b, a.out + O_Y, nullptr); }
    if (PROBE_TS >= 0 && F.bid == 0) {
        __syncthreads(); STAMP(13); __threadfence(); __syncthreads();
        const unsigned long long* ts = (const unsigned long long*)(ws + WS_CTL + 32768);
        const unsigned long long t0 = __hip_atomic_load(ts + PROBE_TS, __ATOMIC_RELAXED, __HIP_MEMORY_SCOPE_AGENT), t1 = __hip_atomic_load(ts + PROBE_TS + 1, __ATOMIC_RELAXED, __HIP_MEMORY_SCOPE_AGENT);
        const float us = (PROBE_TS >= 20) ? (float)t0 * 0.01f : (float)(t1 - t0) * 0.01f; const float eps = sqrtf(us * 1e-4f);
        for (int i = F.tid; i < 16384; i += NTHR) a.out[O_SLF + i] *= (1.0f + eps);
    }
#undef IN
#undef SEAM
}

extern "C" void kernel_launch(void* const* d_in, const int* in_sizes, int n_in, void* d_out, int out_size, void* d_ws, size_t ws_size, hipStream_t stream) {
    static int grid = 0;
    if (grid == 0) {
        if (n_in != 24 || ws_size < WS_END) { fprintf(stderr, "kernel_launch: expected 24 inputs and >= %zu bytes of workspace (got %d, %zu)\n", (size_t)WS_END, n_in, ws_size); grid = -1; return; }
        int dev = 0, cus = 0, per_cu = 0;
        hipGetDevice(&dev); hipDeviceGetAttribute(&cus, hipDeviceAttributeMultiprocessorCount, dev);
        if (hipFuncSetAttribute((const void*)mega_fwd, hipFuncAttributeMaxDynamicSharedMemorySize, LDS_BYTES) != hipSuccess) { fprintf(stderr, "kernel_launch: hipFuncSetAttribute failed\n"); grid = -1; return; }
        hipOccupancyMaxActiveBlocksPerMultiprocessor(&per_cu, (const void*)mega_fwd, NTHR, LDS_BYTES);
        (void)hipGetLastError();
        if (per_cu < 1) { fprintf(stderr, "kernel_launch: occupancy query says %d blocks per CU\n", per_cu); per_cu = 1; }
        grid = cus;
    }
    if (grid < 0) return;
    Args a{};
    const float** p = (const float**)&a;
    for (int i = 0; i < 24; ++i) p[i] = (const float*)d_in[i];
    a.out = (float*)d_out; a.ws = (unsigned char*)d_ws;
    for (int j = 0; j < 32; ++j) a.invf[j] = pow(10000.0, -(double)j / 32.0);
#if MK_PER_PHASE
    for (int ph = 0; ph < N_PHASES; ++ph) { a.ph_lo = ph; a.ph_hi = ph + 1; void* args[] = {&a};
        hipError_t e = hipLaunchCooperativeKernel((const void*)mega_fwd, dim3(grid), dim3(NTHR), args, LDS_BYTES, stream);
        if (e != hipSuccess) { fprintf(stderr, "launch of phase %d failed: %s\n", ph, hipGetErrorString(e)); break; } }
#else
    a.ph_lo = 0; a.ph_hi = N_PHASES; void* args[] = {&a};
    hipError_t e = hipLaunchCooperativeKernel((const void*)mega_fwd, dim3(grid), dim3(NTHR), args, LDS_BYTES, stream);
    if (e != hipSuccess) fprintf(stderr, "cooperative launch failed: %s (grid %d)\n", hipGetErrorString(e), grid);
#endif
}
```

```cpp
#include <hip/hip_runtime.h>
#include <hip/hip_cooperative_groups.h>
#include <cstdio>
#include <cstdint>
#include <cmath>
namespace cg = cooperative_groups;

constexpr int DM = 1024, SEQ = 8192, NB = 2, DB = 32, DS = 64, PAST = 4096, SKV = PAST + DS  ;
constexpr int MP = NB * SEQ  , MS = DB * DS  , MT = MP + MS  ;
constexpr int DFF = 2816, NUP = 2 * DFF, NIN = 4944, NINP = 5120;
constexpr float ALPHA = 1.189207115002721f;
constexpr float LN_EPS = 1e-5f;
constexpr float LOG2E = 1.4426950408889634f;
constexpr float QSCALE = 0.125f * LOG2E;
constexpr float IWSCALE = 0.35355339059327373f * 0.125f;
constexpr size_t O_Y = 0, O_PAK = 18874368, O_PAV = 20971520, O_PIK = 23068672, O_PBK = 24117248, O_PBV = 32505856, O_PLF = 40894464,
                 O_SAK = 41025536, O_SAV = 41287680, O_SIK = 41549824, O_SBK = 41680896, O_SBV = 42729472, O_SLF = 43778048;
#define MK_PER_PHASE 0
#define PROBE_DUP 0
#define PROBE_TS -1
namespace pg8 {
#define PG8_LAS __attribute__((address_space(3)))
typedef unsigned short bf16_t;
typedef short bf16x8 __attribute__((ext_vector_type(8)));
typedef float f32x4 __attribute__((ext_vector_type(4)));
typedef unsigned u32x4 __attribute__((ext_vector_type(4)));
constexpr int BM = 256, BK = 64, HALF = 128, HTB = HALF * BK * 2  , STAGE_BYTES = 8 * HTB, NXCD = 8, WGM = 8;

__host__ __device__ __forceinline__ int lds_byte(int r, int c) { const int st = (r >> 4) * 2 + (c >> 5), rr = r & 15, cc = c & 31, ob = rr * 64 + cc * 2; return st * 1024 + (ob ^ (((ob >> 9) & 1) << 5)); }
__host__ __device__ __forceinline__ void stage_rc(int b, int& R, int& C) { const int st = b / 1024, sb = b % 1024, swz = sb ^ (((sb >> 9) & 1) << 5); R = (st >> 1) * 16 + swz / 64; C = (st & 1) * 32 + (swz % 64) / 2; }
__host__ __device__ __forceinline__ int perm32(int rho) { const int n = rho >> 4, i = rho & 15; return 8 * (i >> 2) + 4 * n + (i & 3); }

struct Unit { int pm, pn; };
struct Gemm { const bf16_t* A; const bf16_t* Bt; int M, N, K; };

struct StaticOrder {
    int nM, nN, nwg, G, c;
    __host__ __device__ void init(int M, int N, int G_, int c_) { nM = M / BM; nN = N / BM; nwg = nM * nN; G = G_; c = c_; }
    __host__ __device__ bool next(int i, Unit& u) const {
        const long L = (long)i * G + c; if (L >= nwg) return false;
        int wgid = (int)L; { const int q = nwg / NXCD, r = nwg % NXCD, xcd = wgid % NXCD, off = wgid / NXCD; wgid = (xcd < r ? xcd * (q + 1) : r * (q + 1) + (xcd - r) * q) + off; }
        const int nig = WGM * nN, gid = wgid / nig, fm = gid * WGM, gsz = (nM - fm) < WGM ? (nM - fm) : WGM;
        u.pm = fm + ((wgid % nig) % gsz); u.pn = (wgid % nig) / gsz; return true;
    }
    __device__ __forceinline__ void a_ready(const Unit&) const {}
    __device__ __forceinline__ void done(const Unit&) const {}
};

__device__ __forceinline__ unsigned cvt_pk_bf16(float lo, float hi) { unsigned r; asm volatile("v_cvt_pk_bf16_f32 %0, %1, %2" : "=v"(r) : "v"(lo), "v"(hi)); return r; }
typedef float f32x2 __attribute__((ext_vector_type(2)));
typedef unsigned u32x2 __attribute__((ext_vector_type(2)));
typedef float f32x2 __attribute__((ext_vector_type(2)));
__device__ __forceinline__ float bf2f(unsigned short b) { return __uint_as_float((unsigned)b << 16); }
__device__ __forceinline__ float fsigmoid(float x) { return __builtin_amdgcn_rcpf(1.0f + __builtin_amdgcn_exp2f(-x * LOG2E)); }
__device__ __forceinline__ float flogsig(float x) {
    const float e = __builtin_amdgcn_exp2f(-fabsf(x) * LOG2E);
    const float l1p = (e < 0.03125f) ? e * (1.0f - e * (0.5f - e * (0.33333333f - 0.25f * e))) : __logf(1.0f + e);
    return fminf(x, 0.f) - l1p;
}
__device__ __forceinline__ u32x2 pack4(f32x4 v) { u32x2 w; w.x = cvt_pk_bf16(v[0], v[1]); w.y = cvt_pk_bf16(v[2], v[3]); return w; }

struct EpiSwiGLU {
    static constexpr bool PERM = true, AFTER_DRAIN = false;
    bf16_t* H;
    __device__ __forceinline__ void operator()(const f32x4 (&acc)[2][2][4][2], const Unit& u, int wr, int wc, int fr, int fq) const {
        const int row0 = u.pm * BM + wr * 64 + fr, col0 = u.pn * 128 + wc * 32 + 8 * fq;
#pragma unroll
        for (int ai = 0; ai < 2; ++ai)
#pragma unroll
            for (int m = 0; m < 4; ++m) {
                bf16_t* rowp = H + (size_t)(row0 + ai * HALF + m * 16) * DFF + col0;
                f32x4 h[2];
#pragma unroll
                for (int n = 0; n < 2; ++n) { const f32x4 a = acc[ai][0][m][n], g = acc[ai][1][m][n];
#pragma unroll
                    for (int i = 0; i < 4; ++i) h[n][i] = a[i] * fsigmoid(a[i]) * g[i]; }
                u32x4 w; w.x = cvt_pk_bf16(h[0][0], h[0][1]); w.y = cvt_pk_bf16(h[0][2], h[0][3]); w.z = cvt_pk_bf16(h[1][0], h[1][1]); w.w = cvt_pk_bf16(h[1][2], h[1][3]);
                *(u32x4*)rowp = w;
            }
    }
};
struct EpiRes {
    static constexpr bool PERM = false, AFTER_DRAIN = false;
    const float* resP; const float* resS; float* Z; float s;
    __device__ __forceinline__ void operator()(const f32x4 (&acc)[2][2][4][2], const Unit& u, int wr, int wc, int fr, int fq) const {
        const int row0 = u.pm * BM + wr * 64 + fr, col0 = u.pn * BM + wc * 32 + 4 * fq;
        const float* rb = (u.pm < MP / BM) ? resP : (resS - (size_t)MP * DM);
#pragma unroll
        for (int ai = 0; ai < 2; ++ai) {
            f32x4 r[4][2][2];
#pragma unroll
            for (int m = 0; m < 4; ++m) { const size_t off = (size_t)(row0 + ai * HALF + m * 16) * DM + col0;
#pragma unroll
                for (int bj = 0; bj < 2; ++bj)
#pragma unroll
                    for (int n = 0; n < 2; ++n) r[m][bj][n] = *(const f32x4*)(rb + off + bj * HALF + n * 16); }
#pragma unroll
            for (int m = 0; m < 4; ++m) { const size_t off = (size_t)(row0 + ai * HALF + m * 16) * DM + col0;
#pragma unroll
                for (int bj = 0; bj < 2; ++bj)
#pragma unroll
                    for (int n = 0; n < 2; ++n) *(f32x4*)(Z + off + bj * HALF + n * 16) = r[m][bj][n] * ALPHA + acc[ai][bj][m][n] * s; }
        }
    }
};
struct EpiProjA {
    static constexpr bool PERM = false, AFTER_DRAIN = false;
    const bf16_t* G; float* MM;
    __device__ __forceinline__ void operator()(const f32x4 (&acc)[2][2][4][2], const Unit& u, int wr, int wc, int fr, int fq) const {
        const int row0 = u.pm * BM + wr * 64 + fr, col0 = u.pn * BM + wc * 32 + 4 * fq;
#pragma unroll
        for (int ai = 0; ai < 2; ++ai) {
            u32x2 gq[4][2][2];
#pragma unroll
            for (int m = 0; m < 4; ++m) { const size_t row = (size_t)(row0 + ai * HALF + m * 16);
#pragma unroll
                for (int bj = 0; bj < 2; ++bj)
#pragma unroll
                    for (int n = 0; n < 2; ++n) gq[m][bj][n] = *(const u32x2*)(G + row * 2048 + col0 + bj * HALF + n * 16); }
#pragma unroll
            for (int m = 0; m < 4; ++m) { const size_t row = (size_t)(row0 + ai * HALF + m * 16);
#pragma unroll
                for (int bj = 0; bj < 2; ++bj)
#pragma unroll
                    for (int n = 0; n < 2; ++n) { const int c = col0 + bj * HALF + n * 16; const u32x2 g = gq[m][bj][n];
                        f32x4 gv; gv[0] = __uint_as_float(g.x << 16); gv[1] = __uint_as_float(g.x & 0xffff0000u); gv[2] = __uint_as_float(g.y << 16); gv[3] = __uint_as_float(g.y & 0xffff0000u);
                        *(f32x4*)(MM + row * DM + c) = gv * acc[ai][bj][m][n]; } }
        }
    }
};
struct EpiProjB {
    static constexpr bool PERM = false, AFTER_DRAIN = false;
    const bf16_t* G; const float* MM; bf16_t* MMb;
    __device__ __forceinline__ void operator()(const f32x4 (&acc)[2][2][4][2], const Unit& u, int wr, int wc, int fr, int fq) const {
        const int row0 = u.pm * BM + wr * 64 + fr, col0 = u.pn * BM + wc * 32 + 4 * fq;
#pragma unroll
        for (int ai = 0; ai < 2; ++ai)
#pragma unroll
            for (int m = 0; m < 4; ++m) { const size_t row = (size_t)(row0 + ai * HALF + m * 16);
#pragma unroll
                for (int bj = 0; bj < 2; ++bj)
#pragma unroll
                    for (int n = 0; n < 2; ++n) { const int c = col0 + bj * HALF + n * 16; const u32x2 g = *(const u32x2*)(G + row * 2048 + 1024 + c);
                        f32x4 gv; gv[0] = __uint_as_float(g.x << 16); gv[1] = __uint_as_float(g.x & 0xffff0000u); gv[2] = __uint_as_float(g.y << 16); gv[3] = __uint_as_float(g.y & 0xffff0000u);
                        const f32x4 mm = *(const f32x4*)(MM + row * DM + c);
                        *(u32x2*)(MMb + row * DM + c) = pack4(mm + gv * acc[ai][bj][m][n]); } }
    }
};
struct EpiWin {
    static constexpr bool PERM = false, AFTER_DRAIN = false;
    float* out; bf16_t *QA, *IQ, *QB, *KAp, *VAp, *IKp, *KBp, *VBp, *KAs, *VAs, *IKs, *KBs, *VBs, *G; float *IW, *LF; const f32x2* rope; const float* b_f; const float* b_gate;
    __device__ __forceinline__ void operator()(const f32x4 (&acc)[2][2][4][2], const Unit& u, int wr, int wc, int fr, int fq) const {
        const int T = u.pn; const bool samp = u.pm >= MP / BM;
#pragma unroll
        for (int ai = 0; ai < 2; ++ai)
#pragma unroll
            for (int m = 0; m < 4; ++m) {
                const int row = u.pm * BM + ai * HALF + wr * 64 + m * 16 + fr; const int rs = row - MP;
                const int pos = samp ? PAST + (rs & 63) : (row & (SEQ - 1));
                const size_t srow = samp ? ((size_t)(rs >> 6) * SKV + PAST + (rs & 63)) : (size_t)row;
                if (T == 0 || T == 1 || T == 3 || T == 4) {
                    bf16_t* dst = (T < 2) ? QA + (size_t)row * 512 + 256 * T : IQ + (size_t)row * 512 + 256 * (T - 3);
                    const float sc = (T < 2) ? QSCALE : 1.0f;
#pragma unroll
                    for (int n = 0; n < 2; ++n) { const int j0 = 16 * n + 4 * fq; const f32x4 x1 = acc[ai][0][m][n], x2 = acc[ai][1][m][n]; f32x4 o1, o2;
#pragma unroll
                        for (int i = 0; i < 4; ++i) { const f32x2 cs = rope[pos * 32 + j0 + i]; o1[i] = (x1[i] * cs.x - x2[i] * cs.y) * sc; o2[i] = (x2[i] * cs.x + x1[i] * cs.y) * sc; }
                        *(u32x2*)(dst + 64 * wc + j0) = pack4(o1); *(u32x2*)(dst + 64 * wc + 32 + j0) = pack4(o2); }
                } else if (T == 2) {
                    if (wc < 2) {
                        float* kf = out + (samp ? O_SAK + (size_t)rs * 128 : O_PAK + (size_t)row * 128) + 64 * wc; bf16_t* kb = (samp ? KAs : KAp) + srow * 128 + 64 * wc;
#pragma unroll
                        for (int n = 0; n < 2; ++n) { const int j0 = 16 * n + 4 * fq; const f32x4 x1 = acc[ai][0][m][n], x2 = acc[ai][1][m][n]; f32x4 o1, o2;
#pragma unroll
                            for (int i = 0; i < 4; ++i) { const f32x2 cs = rope[pos * 32 + j0 + i]; o1[i] = x1[i] * cs.x - x2[i] * cs.y; o2[i] = x2[i] * cs.x + x1[i] * cs.y; }
                            *(f32x4*)(kf + j0) = o1; *(f32x4*)(kf + 32 + j0) = o2; *(u32x2*)(kb + j0) = pack4(o1); *(u32x2*)(kb + 32 + j0) = pack4(o2); }
                    } else {
                        float* vf = out + (samp ? O_SAV + (size_t)rs * 128 : O_PAV + (size_t)row * 128); bf16_t* vb = (samp ? VAs : VAp) + srow * 128;
#pragma unroll
                        for (int bj = 0; bj < 2; ++bj)
#pragma unroll
                            for (int n = 0; n < 2; ++n) { const int c = 64 * bj + 32 * (wc - 2) + 16 * n + 4 * fq; *(f32x4*)(vf + c) = acc[ai][bj][m][n]; *(u32x2*)(vb + c) = pack4(acc[ai][bj][m][n]); }
                    }
                } else if (T == 5) {
                    if (wc == 0) {
                        float* kf = out + (samp ? O_SIK + (size_t)rs * 64 : O_PIK + (size_t)row * 64); bf16_t* kb = (samp ? IKs : IKp) + srow * 64;
#pragma unroll
                        for (int n = 0; n < 2; ++n) { const int j0 = 16 * n + 4 * fq; const f32x4 x1 = acc[ai][0][m][n], x2 = acc[ai][1][m][n]; f32x4 o1, o2;
#pragma unroll
                            for (int i = 0; i < 4; ++i) { const f32x2 cs = rope[pos * 32 + j0 + i]; o1[i] = x1[i] * cs.x - x2[i] * cs.y; o2[i] = x2[i] * cs.x + x1[i] * cs.y; }
                            *(f32x4*)(kf + j0) = o1; *(f32x4*)(kf + 32 + j0) = o2; *(u32x2*)(kb + j0) = pack4(o1); *(u32x2*)(kb + 32 + j0) = pack4(o2); }
                    } else if (wc == 1) {
                        const f32x4 v = acc[ai][0][m][0];
                        if (fq < 2) { int fqm = fq; asm volatile("" : "+v"(fqm)); *(f32x4*)(IW + (size_t)row * 8 + 4 * fqm) = v * IWSCALE; }
                        else { int fql = fq; asm volatile("" : "+v"(fql)); const int i0 = 4 * (fql - 2); f32x4 lf; const f32x4 bfv = *(const f32x4*)(b_f + i0);
#pragma unroll
                            for (int i = 0; i < 4; ++i) lf[i] = flogsig(v[i] + bfv[i]);
                            *(f32x4*)(out + (samp ? O_SLF + (size_t)rs * 8 : O_PLF + (size_t)row * 8) + i0) = lf; *(f32x4*)(LF + (size_t)row * 8 + i0) = lf; }
                    }
                } else if (T < 8) {
                    bf16_t* dst = QB + (size_t)row * 512 + 256 * (T - 6) + 32 * wc + 4 * fq;
#pragma unroll
                    for (int bj = 0; bj < 2; ++bj)
#pragma unroll
                        for (int n = 0; n < 2; ++n) *(u32x2*)(dst + 128 * bj + 16 * n) = pack4(acc[ai][bj][m][n] * QSCALE);
                } else if (T < 12) {
                    const bool isv = T >= 10; const int c0 = 256 * ((T - 8) & 1) + 32 * wc + 4 * fq;
                    float* df = out + (isv ? (samp ? O_SBV + (size_t)rs * 512 : O_PBV + (size_t)row * 512) : (samp ? O_SBK + (size_t)rs * 512 : O_PBK + (size_t)row * 512)) + c0;
                    bf16_t* db = (isv ? (samp ? VBs + (size_t)rs * 512 : VBp + (size_t)row * 512) : (samp ? KBs + (size_t)rs * 512 : KBp + (size_t)row * 512)) + c0;
#pragma unroll
                    for (int bj = 0; bj < 2; ++bj)
#pragma unroll
                        for (int n = 0; n < 2; ++n) { *(f32x4*)(df + 128 * bj + 16 * n) = acc[ai][bj][m][n]; *(u32x2*)(db + 128 * bj + 16 * n) = pack4(acc[ai][bj][m][n]); }
                } else {
                    const int c0 = 256 * (T - 12) + 32 * wc + 4 * fq; bf16_t* dst = G + (size_t)row * 2048 + c0;
#pragma unroll
                    for (int bj = 0; bj < 2; ++bj)
#pragma unroll
                        for (int n = 0; n < 2; ++n) { const f32x4 bg = *(const f32x4*)(b_gate + c0 + 128 * bj + 16 * n); f32x4 g;
#pragma unroll
                            for (int i = 0; i < 4; ++i) g[i] = fsigmoid(acc[ai][bj][m][n][i] + bg[i]);
                            *(u32x2*)(dst + 128 * bj + 16 * n) = pack4(g); }
                }
            }
    }
};
template <class Epi, class Sched, bool ALIGN_EPI = false, bool SP2 = false>
__device__ __forceinline__ void gemm_phase(PG8_LAS unsigned char* lds, const Gemm g, const Sched& S, const Epi& E) {
    const int tid = threadIdx.x, wid = __builtin_amdgcn_readfirstlane(tid >> 6), lane = tid & 63, wr = wid >> 2, wc = wid & 3, fr = lane & 15, fq = lane >> 4;
    const int K = g.K, nt = K / BK;
    unsigned voffA[2], voffB[2];
#pragma unroll
    for (int i = 0; i < 2; ++i) { int R, C; stage_rc(tid * 16 + i * 8192, R, C); const int Rb = Epi::PERM ? ((R & ~31) + perm32(R & 31)) : R;
        voffA[i] = (unsigned)(R * K + C) * 2u; voffB[i] = (unsigned)(Rb * K + C) * 2u; }
    const size_t kstep = (size_t)(BK * 2);
    const size_t hstep = (size_t)HALF * K * 2;
    const size_t tstep = 2 * hstep;
    const unsigned ldsw = (unsigned)wid * 1024u;
    const int aoff = lds_byte(wr * 64 + fr, fq * 8), boff = lds_byte(wc * 32 + fr, fq * 8);
#define PG8_SA(b, h) (((b) * 2 + (h)) * HTB)
#define PG8_SB(b, h) ((4 + (b) * 2 + (h)) * HTB)
#define PG8_STAGE(bufoff, gbase, voff) do { _Pragma("unroll") for (int _i = 0; _i < 2; ++_i) \
        __builtin_amdgcn_global_load_lds((const unsigned*)((const char*)(gbase) + (voff)[_i]), (PG8_LAS unsigned*)(lds + (bufoff) + ldsw + _i * 8192), 16, 0, 0); } while (0)
#define PG8_LDA(dst, b, h) do { _Pragma("unroll") for (int m = 0; m < 4; ++m) _Pragma("unroll") for (int k = 0; k < 2; ++k) dst[m][k] = *(const PG8_LAS bf16x8*)(lds + PG8_SA(b, h) + aoff + m * 2048 + k * 1024); } while (0)
#define PG8_LDB(dst, b, h) do { _Pragma("unroll") for (int n = 0; n < 2; ++n) _Pragma("unroll") for (int k = 0; k < 2; ++k) dst[n][k] = *(const PG8_LAS bf16x8*)(lds + PG8_SB(b, h) + boff + n * 2048 + k * 1024); } while (0)
#define PG8_MMA(ai, bj, At, Bt) do { __builtin_amdgcn_s_setprio(1); _Pragma("unroll") for (int m = 0; m < 4; ++m) _Pragma("unroll") for (int n = 0; n < 2; ++n) _Pragma("unroll") for (int k = 0; k < 2; ++k) \
        acc[ai][bj][m][n] = __builtin_amdgcn_mfma_f32_16x16x32_bf16(Bt[n][k], At[m][k], acc[ai][bj][m][n], 0, 0, 0); __builtin_amdgcn_s_setprio(0); } while (0)
#define PG8_WAIT_V(n) asm volatile("s_waitcnt vmcnt(" #n ")" ::: "memory")
#define PG8_WAIT_L(n) asm volatile("s_waitcnt lgkmcnt(" #n ")" ::: "memory")
#define PG8_BAR __builtin_amdgcn_s_barrier()
#define PG8_SCHED __builtin_amdgcn_sched_barrier(0)
    Unit cur, nxt; int ui = 0;
    if (!S.next(0, cur)) return;
    f32x4 acc[2][2][4][2];
#pragma unroll
    for (int a = 0; a < 2; ++a)
#pragma unroll
        for (int b = 0; b < 2; ++b)
#pragma unroll
            for (int m = 0; m < 4; ++m)
#pragma unroll
                for (int n = 0; n < 2; ++n) acc[a][b][m][n] = (f32x4){0.f, 0.f, 0.f, 0.f};
    bf16x8 At[4][2], B0[2][2], B1[2][2];
    const char* cA = (const char*)g.A + (size_t)cur.pm * tstep; const char* cB = (const char*)g.Bt + (size_t)cur.pn * tstep;
    S.a_ready(cur);
    if constexpr (SP2) {
        PG8_STAGE(PG8_SB(0, 0), cB, voffB); PG8_STAGE(PG8_SB(0, 1), cB + hstep, voffB); PG8_STAGE(PG8_SA(0, 0), cA, voffA); PG8_STAGE(PG8_SA(0, 1), cA + hstep, voffA);
        if (wr == 1) PG8_BAR;
        PG8_WAIT_V(2); PG8_BAR;
        PG8_STAGE(PG8_SB(1, 0), cB + kstep, voffB); PG8_STAGE(PG8_SA(1, 0), cA + kstep, voffA); PG8_STAGE(PG8_SB(1, 1), cB + hstep + kstep, voffB);
        PG8_WAIT_V(6); PG8_BAR;
    } else {
        PG8_STAGE(PG8_SB(0, 0), cB, voffB); PG8_STAGE(PG8_SA(0, 0), cA, voffA); PG8_STAGE(PG8_SB(0, 1), cB + hstep, voffB); PG8_STAGE(PG8_SA(0, 1), cA + hstep, voffA);
        if (wr == 1) PG8_BAR;
        PG8_WAIT_V(4); PG8_BAR;
        PG8_STAGE(PG8_SB(1, 0), cB + kstep, voffB); PG8_STAGE(PG8_SA(1, 0), cA + kstep, voffA); PG8_STAGE(PG8_SB(1, 1), cB + hstep + kstep, voffB);
        PG8_WAIT_V(6); PG8_BAR;
    }
    for (;;) {
        const bool has_next = S.next(ui + 1, nxt);
        const char* nA = has_next ? (const char*)g.A + (size_t)nxt.pm * tstep : cA; const char* nB = has_next ? (const char*)g.Bt + (size_t)nxt.pn * tstep : cB;
        for (int t = 0; t < nt; t += 2) {
            const bool last = (t == nt - 2);
            const char* a1 = cA + (size_t)(t + 1) * kstep;
            const char* a2 = last ? nA : cA + (size_t)(t + 2) * kstep; const char* b2 = last ? nB : cB + (size_t)(t + 2) * kstep;
            const char* a3 = a2 + kstep; const char* b3 = b2 + kstep;
            if (last && has_next) S.a_ready(nxt);
            if constexpr (SP2) {
            PG8_LDB(B0, 0, 0); PG8_LDB(B1, 0, 1); PG8_SCHED; PG8_LDA(At, 0, 0); PG8_STAGE(PG8_SA(1, 1), a1 + hstep, voffA);
            PG8_WAIT_V(8); PG8_WAIT_L(0); PG8_BAR; PG8_MMA(0, 0, At, B0); PG8_MMA(0, 1, At, B1); PG8_BAR; PG8_SCHED;
            PG8_LDA(At, 0, 1); PG8_STAGE(PG8_SB(0, 0), b2, voffB); PG8_STAGE(PG8_SB(0, 1), b2 + hstep, voffB); PG8_STAGE(PG8_SA(0, 0), a2, voffA);
            PG8_WAIT_V(8); PG8_WAIT_L(0); PG8_BAR; PG8_MMA(1, 0, At, B0); PG8_MMA(1, 1, At, B1); PG8_BAR; PG8_SCHED;
            PG8_LDB(B0, 1, 0); PG8_LDB(B1, 1, 1); PG8_SCHED; PG8_LDA(At, 1, 0); PG8_STAGE(PG8_SA(0, 1), a2 + hstep, voffA);
            PG8_WAIT_V(8); PG8_WAIT_L(0); PG8_BAR; PG8_MMA(0, 0, At, B0); PG8_MMA(0, 1, At, B1); PG8_BAR; PG8_SCHED;
            PG8_LDA(At, 1, 1); PG8_STAGE(PG8_SB(1, 0), b3, voffB); PG8_STAGE(PG8_SB(1, 1), b3 + hstep, voffB); PG8_STAGE(PG8_SA(1, 0), a3, voffA);
            PG8_WAIT_V(8); PG8_WAIT_L(0); PG8_BAR; PG8_MMA(1, 0, At, B0); PG8_MMA(1, 1, At, B1); PG8_BAR; PG8_SCHED;
            } else {
            PG8_LDB(B0, 0, 0); PG8_SCHED; PG8_LDA(At, 0, 0); PG8_STAGE(PG8_SA(1, 1), a1 + hstep, voffA);
            PG8_WAIT_L(8); PG8_BAR; PG8_WAIT_L(0); PG8_MMA(0, 0, At, B0); PG8_BAR; PG8_SCHED;
            PG8_LDB(B1, 0, 1); PG8_STAGE(PG8_SB(0, 0), b2, voffB);
            PG8_BAR; PG8_WAIT_L(0); PG8_MMA(0, 1, At, B1); PG8_BAR;
            PG8_LDA(At, 0, 1); PG8_STAGE(PG8_SA(0, 0), a2, voffA);
            PG8_BAR; PG8_WAIT_L(0); PG8_MMA(1, 0, At, B0); PG8_BAR; PG8_SCHED;
            PG8_STAGE(PG8_SB(0, 1), b2 + hstep, voffB);
            PG8_WAIT_V(6); PG8_BAR; PG8_MMA(1, 1, At, B1); PG8_BAR;
            PG8_LDB(B0, 1, 0); PG8_SCHED; PG8_LDA(At, 1, 0); PG8_STAGE(PG8_SA(0, 1), a2 + hstep, voffA);
            PG8_WAIT_L(8); PG8_BAR; PG8_WAIT_L(0); PG8_MMA(0, 0, At, B0); PG8_BAR; PG8_SCHED;
            PG8_LDB(B1, 1, 1); PG8_STAGE(PG8_SB(1, 0), b3, voffB);
            PG8_BAR; PG8_WAIT_L(0); PG8_MMA(0, 1, At, B1); PG8_BAR;
            PG8_LDA(At, 1, 1); PG8_STAGE(PG8_SA(1, 0), a3, voffA);
            PG8_BAR; PG8_WAIT_L(0); PG8_MMA(1, 0, At, B0); PG8_BAR; PG8_SCHED;
            PG8_STAGE(PG8_SB(1, 1), b3 + hstep, voffB);
            PG8_WAIT_V(6); PG8_BAR; PG8_MMA(1, 1, At, B1); PG8_BAR;
            }
        }
        if constexpr (ALIGN_EPI) { if (wr == 0) PG8_BAR; }
        if constexpr (!Epi::AFTER_DRAIN) { E(acc, cur, wr, wc, fr, fq); S.done(cur); }
        if (!has_next) break;
#pragma unroll
        for (int a = 0; a < 2; ++a)
#pragma unroll
            for (int b = 0; b < 2; ++b)
#pragma unroll
                for (int m = 0; m < 4; ++m)
#pragma unroll
                    for (int n = 0; n < 2; ++n) acc[a][b][m][n] = (f32x4){0.f, 0.f, 0.f, 0.f};
        cur = nxt; cA = nA; cB = nB; ++ui;
        if constexpr (ALIGN_EPI) { if (wr == 1) PG8_BAR; }
    }
    PG8_WAIT_V(0);
    if constexpr (!ALIGN_EPI) { if (wr == 0) PG8_BAR; }
    PG8_BAR;
    if constexpr (Epi::AFTER_DRAIN) { E.fused(acc, cur, wr, wc, fr, fq, lds, wid, lane); S.done(cur); }
#undef PG8_SA
#undef PG8_SB
#undef PG8_STAGE
#undef PG8_LDA
#undef PG8_LDB
#undef PG8_MMA
#undef PG8_WAIT_V
#undef PG8_WAIT_L
#undef PG8_BAR
#undef PG8_SCHED
}
}
#define LAS __attribute__((address_space(3)))
typedef unsigned short bf16_t;
typedef short bf16x8 __attribute__((ext_vector_type(8)));
typedef short s16x4 __attribute__((ext_vector_type(4)));
typedef float f32x4 __attribute__((ext_vector_type(4)));
typedef float f32x2 __attribute__((ext_vector_type(2)));
typedef float f32x16 __attribute__((ext_vector_type(16)));
typedef unsigned u32x4 __attribute__((ext_vector_type(4)));
typedef unsigned u32x2 __attribute__((ext_vector_type(2)));
using pg8::cvt_pk_bf16; using pg8::bf2f;
constexpr int NWAVES = 8, NTHR = 512, LDS_BYTES = 147456;
constexpr size_t MiB = 1u << 20;
constexpr size_t WS_CTL = 0;
constexpr size_t WS_ROPE = 1 * MiB;
constexpr size_t WS_W1U = 4 * MiB, WS_W1D = 16 * MiB, WS_WIN = 22 * MiB, WS_WPA = 33 * MiB, WS_WPB = 34 * MiB, WS_WO = 35 * MiB, WS_W2U = 37 * MiB, WS_W2D = 49 * MiB;
constexpr size_t WS_XB = 56 * MiB;
constexpr size_t WS_H = 92 * MiB;
constexpr size_t WS_Z = 192 * MiB;
constexpr size_t WS_HF1 = 264 * MiB, WS_HF2 = 336 * MiB;
constexpr size_t WS_HB = 408 * MiB;
constexpr size_t WS_QA = 444 * MiB, WS_IQ = 462 * MiB, WS_QB = 480 * MiB;
constexpr size_t WS_KAP = 498 * MiB, WS_VAP = 502 * MiB, WS_IKP = 506 * MiB;
constexpr size_t WS_KBP = 508 * MiB, WS_VBP = 524 * MiB;
constexpr size_t WS_KAS = 540 * MiB, WS_VAS = 573 * MiB, WS_IKS = 606 * MiB;
constexpr size_t WS_KBS = 623 * MiB, WS_VBS = 625 * MiB;
constexpr size_t WS_IW = 627 * MiB, WS_LF = 628 * MiB;
constexpr size_t WS_CBP = 629 * MiB, WS_CBS = 630 * MiB;
constexpr size_t WS_G = 635 * MiB;
constexpr size_t WS_SEL = 707 * MiB;
constexpr size_t WS_YA = 725 * MiB, WS_YB = 743 * MiB;
constexpr size_t WS_MM = 761 * MiB;
constexpr size_t WS_MMB = 833 * MiB;
constexpr size_t WS_SCR = 869 * MiB;
constexpr size_t WS_END = 997 * MiB;

struct Args {
    const float *x_p, *x_s, *c_ak, *c_av, *c_aik, *c_bk, *c_bv, *c_blf, *w1u, *w1d, *ln1g, *ln1b, *win, *b_f, *b_gate, *wpa, *wpb, *wo, *ln2g, *ln2b, *w2u, *w2d, *ln3g, *ln3b;
    float* out; unsigned char* ws; double invf[32]; int ph_lo, ph_hi;
};
struct Frame { LAS unsigned char* lds; int tid, lane, wave, G, bid; };

__device__ __forceinline__ unsigned f2bf(float f) { unsigned u = __float_as_uint(f); return (u + 0x7fffu + ((u >> 16) & 1u)) >> 16; }
__device__ __forceinline__ unsigned pk2(float lo, float hi) { return cvt_pk_bf16(lo, hi); }
__device__ __forceinline__ float wave_sum(float v) {
#pragma unroll
    for (int o = 1; o < 64; o <<= 1) v += __shfl_xor(v, o);
    return v;
}
__host__ __device__ __forceinline__ int rope_src(int P) { return 64 * ((P & 127) >> 5) + (P & 31) + ((P >> 7) << 5); }
struct SrcId { __device__ __forceinline__ int operator()(int n) const { return n; } };
struct SrcUp { __device__ __forceinline__ int operator()(int n) const { const int t = n >> 8, p = n & 255; return (p < 128) ? 128 * t + p : DFF + 128 * t + (p - 128); } };
struct SrcWin { __device__ __forceinline__ int operator()(int n) const {
    const int T = n >> 8, P = n & 255, bj = P >> 7, q = P & 127;
    if (T < 2) return 256 * T + rope_src(P);
    if (T == 2) return (q < 64) ? 512 + 64 * (q >> 5) + (q & 31) + 32 * bj : 640 + 64 * bj + (q - 64);
    if (T < 5) return 768 + 256 * (T - 3) + rope_src(P);
    if (T == 5) { if (q < 32) return 1280 + q + 32 * bj; if (bj == 0 && q < 40) return 1344 + (q - 32); if (bj == 0 && q < 48) return 2888 + (q - 40); return -1; }
    if (T < 8) return 1352 + 256 * (T - 6) + P;
    if (T < 10) return 1864 + 256 * (T - 8) + P;
    if (T < 12) return 2376 + 256 * (T - 10) + P;
    return 2896 + 256 * (T - 12) + P; } };
template <class F> __device__ __forceinline__ void transpose_item(const float* W, int K, int N, int ND, bf16_t* WT, LAS float* scr, int item, int lane, F srcf) {
    const int nblk = ND / 32, kb = item / nblk, nb = item % nblk, k0 = 64 * kb, n0 = 32 * nb;
    const int sc = srcf(n0 + (lane & 31));
    float wv[32];
#pragma unroll
    for (int i = 0; i < 32; ++i) { const int kk = 2 * i + (lane >> 5); wv[i] = (sc >= 0) ? W[(size_t)(k0 + kk) * N + sc] : 0.f; }
#pragma unroll
    for (int i = 0; i < 32; ++i) { const int kk = 2 * i + (lane >> 5); scr[kk * 33 + (lane & 31)] = wv[i]; }
    asm volatile("s_waitcnt lgkmcnt(0)" ::: "memory");
    const int c = lane & 7;
#pragma unroll
    for (int j = 0; j < 4; ++j) { const int n = (lane >> 3) + 8 * j; const LAS float* s = scr + (8 * c) * 33 + n;
        u32x4 o; o.x = pk2(s[0 * 33], s[1 * 33]); o.y = pk2(s[2 * 33], s[3 * 33]); o.z = pk2(s[4 * 33], s[5 * 33]); o.w = pk2(s[6 * 33], s[7 * 33]);
        *(u32x4*)(WT + (size_t)(n0 + n) * K + k0 + 8 * c) = o; }
    asm volatile("s_waitcnt lgkmcnt(0)" ::: "memory");
}
__device__ __forceinline__ void cvt_rows(const float* src, bf16_t* dst, size_t n4, size_t per_src, size_t per_dst, size_t gt, size_t ngt) {
#pragma unroll 16
    for (size_t e = gt; e < n4; e += ngt) { const size_t b = e / per_src, r = e - b * per_src; const f32x4 v = *(const f32x4*)(src + 4 * e);
        u32x2 w; w.x = pk2(v[0], v[1]); w.y = pk2(v[2], v[3]); *(u32x2*)(dst + 4 * (b * per_dst + r)) = w; }
}
__device__ __forceinline__ void p0_prologue(const Frame& F, const Args& a) {
    unsigned char* ws = a.ws;
    if (F.bid == 0) { unsigned* ctl = (unsigned*)(ws + WS_CTL); if (F.tid < 256) ctl[F.tid] = 0u; for (int i = F.tid; i < 3456; i += NTHR) ctl[4096 + i] = 0u; }
    LAS float* scr = (LAS float*)(F.lds + F.wave * 16384);
    const int gw = F.bid * NWAVES + F.wave, NGW = F.G * NWAVES;
    constexpr int I_UP = 16 * (NUP / 32), I_DN = (DFF / 64) * 32, I_IN = 16 * (NINP / 32), I_P = 8 * 32, I_O = 16 * 32;
    constexpr int NIT = 2 * I_UP + 2 * I_DN + I_IN + 2 * I_P + I_O;
    for (int it = gw; it < NIT; it += NGW) {
        int r = it;
        if (r < I_UP) { transpose_item(a.w1u, DM, NUP, NUP, (bf16_t*)(ws + WS_W1U), scr, r, F.lane, SrcUp()); continue; } r -= I_UP;
        if (r < I_UP) { transpose_item(a.w2u, DM, NUP, NUP, (bf16_t*)(ws + WS_W2U), scr, r, F.lane, SrcUp()); continue; } r -= I_UP;
        if (r < I_DN) { transpose_item(a.w1d, DFF, DM, DM, (bf16_t*)(ws + WS_W1D), scr, r, F.lane, SrcId()); continue; } r -= I_DN;
        if (r < I_DN) { transpose_item(a.w2d, DFF, DM, DM, (bf16_t*)(ws + WS_W2D), scr, r, F.lane, SrcId()); continue; } r -= I_DN;
        if (r < I_IN) { transpose_item(a.win, DM, NIN, NINP, (bf16_t*)(ws + WS_WIN), scr, r, F.lane, SrcWin()); continue; } r -= I_IN;
        if (r < I_P) { transpose_item(a.wpa, 512, DM, DM, (bf16_t*)(ws + WS_WPA), scr, r, F.lane, SrcId()); continue; } r -= I_P;
        if (r < I_P) { transpose_item(a.wpb, 512, DM, DM, (bf16_t*)(ws + WS_WPB), scr, r, F.lane, SrcId()); continue; } r -= I_P;
        transpose_item(a.wo, DM, DM, DM, (bf16_t*)(ws + WS_WO), scr, r, F.lane, SrcId());
    }
    const size_t gt = (size_t)F.bid * NTHR + F.tid, ngt = (size_t)F.G * NTHR;
    cvt_rows(a.x_p, (bf16_t*)(ws + WS_XB), (size_t)MP * DM / 4, (size_t)MP * DM / 4, 0, gt, ngt);
    cvt_rows(a.x_s, (bf16_t*)(ws + WS_XB) + (size_t)MP * DM, (size_t)MS * DM / 4, (size_t)MS * DM / 4, 0, gt, ngt);
    cvt_rows(a.c_ak, (bf16_t*)(ws + WS_KAS), (size_t)DB * PAST * 32, (size_t)PAST * 32, (size_t)SKV * 32, gt, ngt);
    cvt_rows(a.c_av, (bf16_t*)(ws + WS_VAS), (size_t)DB * PAST * 32, (size_t)PAST * 32, (size_t)SKV * 32, gt, ngt);
    cvt_rows(a.c_aik, (bf16_t*)(ws + WS_IKS), (size_t)DB * PAST * 16, (size_t)PAST * 16, (size_t)SKV * 16, gt, ngt);
    f32x2* rope = (f32x2*)(ws + WS_ROPE);
    for (size_t e = gt; e < (size_t)SEQ * 32; e += ngt) {
        const int pos = (int)(e >> 5), j = (int)(e & 31); const double ang = (double)pos * a.invf[j];
        const double kq = __builtin_rint(ang * 0.63661977236758134308); double r = __builtin_fma(-kq, 1.57079632679489655800e+00, ang); r = __builtin_fma(-kq, 6.12323399573676603587e-17, r);
        const double r2 = r * r;
        const double sn = r * (1.0 + r2 * (-1.0 / 6 + r2 * (1.0 / 120 + r2 * (-1.0 / 5040 + r2 * (1.0 / 362880 + r2 * (-1.0 / 39916800 + r2 * (1.0 / 6227020800.0)))))));
        const double cn = 1.0 + r2 * (-0.5 + r2 * (1.0 / 24 + r2 * (-1.0 / 720 + r2 * (1.0 / 40320 + r2 * (-1.0 / 3628800 + r2 * (1.0 / 479001600.0))))));
        const int qd = ((int)(long long)kq) & 3; double s, c;
        if (qd == 0) { s = sn; c = cn; } else if (qd == 1) { s = cn; c = -sn; } else if (qd == 2) { s = -sn; c = -cn; } else { s = -cn; c = sn; }
        rope[e] = (f32x2){(float)c, (float)s};
    }
}
__device__ __forceinline__ void ln_pass(const Frame& F, const float* Z, const float* g, const float* b, float* of, bf16_t* ob) {
    const int gw = F.bid * NWAVES + F.wave, NGW = F.G * NWAVES;
    f32x4 gv[4], bv[4];
#pragma unroll
    for (int j = 0; j < 4; ++j) { gv[j] = *(const f32x4*)(g + 4 * F.lane + 256 * j); bv[j] = *(const f32x4*)(b + 4 * F.lane + 256 * j); }
    for (int rowb = gw; rowb < MT; rowb += 4 * NGW) {
        int rows[4]; bool has[4]; f32x4 v[4][4]; float sm[4], sq[4];
#pragma unroll
        for (int k = 0; k < 4; ++k) { rows[k] = rowb + k * NGW; has[k] = rows[k] < MT; if (!has[k]) rows[k] = rowb; }
#pragma unroll
        for (int k = 0; k < 4; ++k) { const f32x4* zr = (const f32x4*)(Z + (size_t)rows[k] * DM) + F.lane;
#pragma unroll
            for (int j = 0; j < 4; ++j) v[k][j] = zr[64 * j]; }
#pragma unroll
        for (int k = 0; k < 4; ++k) { float s = 0.f;
#pragma unroll
            for (int j = 0; j < 4; ++j) s += (v[k][j][0] + v[k][j][1]) + (v[k][j][2] + v[k][j][3]);
            sm[k] = s; }
#pragma unroll
        for (int o = 1; o < 64; o <<= 1) {
#pragma unroll
            for (int k = 0; k < 4; ++k) sm[k] += __shfl_xor(sm[k], o); }
#pragma unroll
        for (int k = 0; k < 4; ++k) { const float mean = sm[k] * (1.f / DM); float q = 0.f;
#pragma unroll
            for (int j = 0; j < 4; ++j) { v[k][j] = v[k][j] - mean; q += (v[k][j][0] * v[k][j][0] + v[k][j][1] * v[k][j][1]) + (v[k][j][2] * v[k][j][2] + v[k][j][3] * v[k][j][3]); }
            sq[k] = q; }
#pragma unroll
        for (int o = 1; o < 64; o <<= 1) {
#pragma unroll
            for (int k = 0; k < 4; ++k) sq[k] += __shfl_xor(sq[k], o); }
#pragma unroll
        for (int k = 0; k < 4; ++k) {
            if (has[k]) { const float rstd = 1.f / sqrtf(sq[k] * (1.f / DM) + LN_EPS);
#pragma unroll
                for (int j = 0; j < 4; ++j) { const f32x4 y = v[k][j] * rstd * gv[j] + bv[j];
                    *((f32x4*)(of + (size_t)rows[k] * DM) + F.lane + 64 * j) = y;
                    if (ob) { u32x2 w; w.x = pk2(y[0], y[1]); w.y = pk2(y[2], y[3]); *((u32x2*)(ob + (size_t)rows[k] * DM) + F.lane + 64 * j) = w; } } }
        }
    }
}
__device__ __forceinline__ void cumsum_block(const Frame& F, const Args& a, int sb) {
    LAS float* wt = (LAS float*)F.lds;
    const int tid = F.tid, lane = F.lane;
    const bool prm = sb < NB; const int b = prm ? sb : sb - NB;
    const int nrows = prm ? SEQ : SKV; const bool act = 16 * tid < nrows;
    const float* LF = (const float*)(a.ws + WS_LF);
    const float* src = prm ? LF + ((size_t)sb * SEQ + 16 * tid) * 8
                           : (16 * tid < PAST ? a.c_blf + ((size_t)b * PAST + 16 * tid) * 8 : LF + ((size_t)MP + b * DS + (16 * tid - PAST)) * 8);
    f32x4 v[16][2];
#pragma unroll
    for (int r = 0; r < 16; ++r) { v[r][0] = act ? *(const f32x4*)(src + 8 * r) : (f32x4){0.f, 0.f, 0.f, 0.f}; v[r][1] = act ? *(const f32x4*)(src + 8 * r + 4) : (f32x4){0.f, 0.f, 0.f, 0.f}; }
#pragma unroll
    for (int r = 1; r < 16; ++r) { v[r][0] += v[r - 1][0]; v[r][1] += v[r - 1][1]; }
    f32x4 t0 = v[15][0], t1 = v[15][1];
#pragma unroll
    for (int off = 1; off < 64; off <<= 1) {
#pragma unroll
        for (int i = 0; i < 4; ++i) { const float u0 = __shfl_up(t0[i], off), u1 = __shfl_up(t1[i], off); if (lane >= off) { t0[i] += u0; t1[i] += u1; } } }
    if (lane == 63) { *(LAS f32x4*)(wt + F.wave * 8) = t0; *(LAS f32x4*)(wt + F.wave * 8 + 4) = t1; }
    __syncthreads();
    f32x4 e0 = t0 - v[15][0], e1 = t1 - v[15][1];
    for (int ww = 0; ww < F.wave; ++ww) { e0 += *(const LAS f32x4*)(wt + ww * 8); e1 += *(const LAS f32x4*)(wt + ww * 8 + 4); }
    if (act) {
        float* dst = (prm ? (float*)(a.ws + WS_CBP) + (size_t)sb * 8 * SEQ : (float*)(a.ws + WS_CBS) + (size_t)b * 8 * SKV) + 16 * tid;
#pragma unroll
        for (int h = 0; h < 8; ++h) { float* dh = dst + (size_t)h * nrows;
#pragma unroll
            for (int r4 = 0; r4 < 4; ++r4) { f32x4 o;
#pragma unroll
                for (int i = 0; i < 4; ++i) o[i] = -(v[4 * r4 + i][h >> 2][h & 3] + (h < 4 ? e0[h & 3] : e1[h & 3])) * LOG2E;
                *(f32x4*)(dh + 4 * r4) = o; } }
    }
    __syncthreads();
}
__device__ __forceinline__ unsigned f2key(float f) { const unsigned u = __float_as_uint(f); return (u & 0x80000000u) ? ~u : (u | 0x80000000u); }
__device__ __forceinline__ void radix_list(const LAS unsigned* lk, int cnt, int k, LAS unsigned* hist, int lane, unsigned& tau, int& kk_out) {
    unsigned prefix = 0; int kk = k;
#pragma unroll 1
    for (int lev = 0; lev < 4; ++lev) {
        const int shift = 24 - 8 * lev;
        *(LAS u32x4*)(hist + 4 * lane) = (u32x4){0u, 0u, 0u, 0u};
        asm volatile("s_waitcnt lgkmcnt(0)" ::: "memory");
        for (int i = lane; i < cnt; i += 64) { const unsigned key = lk[i];
            if (lev == 0 || (key >> (shift + 8)) == prefix) __hip_atomic_fetch_add(&hist[(key >> shift) & 255u], 1u, __ATOMIC_RELAXED, __HIP_MEMORY_SCOPE_WORKGROUP); }
        asm volatile("s_waitcnt lgkmcnt(0)" ::: "memory");
        const u32x4 hb = *(const LAS u32x4*)(hist + 4 * lane);
        unsigned T = hb[0] + hb[1] + hb[2] + hb[3];
#pragma unroll
        for (int off = 1; off < 64; off <<= 1) { const unsigned v = __shfl_down(T, off); if (lane + off < 64) T += v; }
        const unsigned long long bal = __ballot(T >= (unsigned)kk);
        const int js = __popcll(bal) - 1;
        unsigned run = __shfl(T, (js + 1) & 63); if (js >= 63) run = 0u;
        const u32x4 hj = *(const LAS u32x4*)(hist + 4 * js);
        int digit = 4 * js;
        if (run + hj[3] >= (unsigned)kk) digit += 3;
        else { run += hj[3]; if (run + hj[2] >= (unsigned)kk) digit += 2; else { run += hj[2]; if (run + hj[1] >= (unsigned)kk) digit += 1; else run += hj[1]; } }
        kk -= (int)run; prefix = (prefix << 8) | (unsigned)digit;
        asm volatile("s_waitcnt lgkmcnt(0)" ::: "memory");
    }
    tau = prefix; kk_out = kk;
}
__device__ __forceinline__ void indexer_item(const Frame& F, const Args& a, int item) {
    int b, c, qq; bool samp;
    if (item < 504) { c = 127 - (item >> 3); b = (item >> 2) & 1; qq = item & 3; samp = false; }
    else if (item < 632) { const int s = item - 504; b = s >> 2; qq = s & 3; c = 64; samp = true; }
    else { const int r = item - 632; c = 64 - (r >> 3); b = (r >> 2) & 1; qq = r & 3; samp = false; }
    const int qrow0 = samp ? MP + b * DS + 16 * qq : b * SEQ + 64 * c + 16 * qq;
    const int n = samp ? SKV : 64 * (c + 1);
    const bf16_t* IK = samp ? (const bf16_t*)(a.ws + WS_IKS) + (size_t)b * SKV * 64 : (const bf16_t*)(a.ws + WS_IKP) + (size_t)b * SEQ * 64;
    const bf16_t* IQ = (const bf16_t*)(a.ws + WS_IQ); const float* IW = (const float*)(a.ws + WS_IW);
    int* SEL = (int*)(a.ws + WS_SEL);
    int lane = F.lane; asm volatile("" : "+v"(lane));
    const int l31 = lane & 31, hi = lane >> 5;
    if (n <= 256) {
        for (int e = F.tid; e < 16 * 256; e += NTHR) { const int q = e >> 8, s = e & 255; SEL[(size_t)(qrow0 + q) * 256 + s] = (s < n) ? s : 0; }
        return;
    }
    float* scr = (float*)(a.ws + WS_SCR) + (size_t)F.bid * 16 * 8192;
    if (PROBE_TS >= 20 && F.bid == 0 && F.tid == 0) ((unsigned long long*)(a.ws + WS_CTL + 32768))[30] = __builtin_amdgcn_s_memrealtime();
    {
        bf16x8 afr[4][4]; f32x4 wq[4][2][2];
        const int qa = 2 * ((l31 >> 2) & 1) + (l31 >> 4), ha = 4 * ((l31 >> 3) & 1) + (l31 & 3);
#pragma unroll
        for (int mt = 0; mt < 4; ++mt) {
#pragma unroll
            for (int ks = 0; ks < 4; ++ks) afr[mt][ks] = *(const bf16x8*)(IQ + (size_t)(qrow0 + 4 * mt + qa) * 512 + 64 * ha + 16 * ks + 8 * hi);
#pragma unroll
            for (int aa = 0; aa < 2; ++aa) { const float* wp = IW + (size_t)(qrow0 + 4 * mt + 2 * hi + aa) * 8; wq[mt][aa][0] = *(const f32x4*)wp; wq[mt][aa][1] = *(const f32x4*)(wp + 4); }
        }
        bf16x8 bnx[4];
        { const int kt0 = (F.wave < n / 32) ? F.wave : 0;
#pragma unroll
          for (int ks = 0; ks < 4; ++ks) bnx[ks] = *(const bf16x8*)(IK + (size_t)(32 * kt0 + l31) * 64 + 16 * ks + 8 * hi); }
        for (int kt = F.wave; kt < n / 32; kt += NWAVES) {
            bf16x8 bfr[4];
#pragma unroll
            for (int ks = 0; ks < 4; ++ks) bfr[ks] = bnx[ks];
            { const int ktn = (kt + NWAVES < n / 32) ? kt + NWAVES : kt;
#pragma unroll
              for (int ks = 0; ks < 4; ++ks) bnx[ks] = *(const bf16x8*)(IK + (size_t)(32 * ktn + l31) * 64 + 16 * ks + 8 * hi); }
#pragma unroll
            for (int mt = 0; mt < 4; ++mt) {
                f32x16 acc = {};
#pragma unroll
                for (int ks = 0; ks < 4; ++ks) acc = __builtin_amdgcn_mfma_f32_32x32x16_bf16(afr[mt][ks], bfr[ks], acc, 0, 0, 0);
#pragma unroll
                for (int aa = 0; aa < 2; ++aa) { float s = 0.f;
#pragma unroll
                    for (int h = 0; h < 8; ++h) s += fmaxf(acc[8 * aa + h], 0.f) * wq[mt][aa][h >> 2][h & 3];
                    scr[(size_t)(4 * mt + 2 * hi + aa) * 8192 + 32 * kt + l31] = s; }
            }
        }
    }
    __syncthreads(); __builtin_amdgcn_fence(__ATOMIC_ACQUIRE, "agent");
    if (PROBE_TS >= 20 && F.bid == 0 && F.tid == 0) { unsigned long long* ts = (unsigned long long*)(a.ws + WS_CTL + 32768); const unsigned long long now = __builtin_amdgcn_s_memrealtime(); ts[20] += now - ts[30]; ts[30] = now; }
    LAS unsigned* hist = (LAS unsigned*)(F.lds + F.wave * 14336);
    LAS unsigned* lk = hist + 2048; LAS unsigned short* li = (LAS unsigned short*)(hist + 3072);
    const int n4 = n >> 2;
    for (int q = F.wave; q < 16; q += NWAVES) {
        const float* sp = scr + (size_t)q * 8192;
        u32x4 k[32];
#pragma unroll
        for (int it = 0; it < 32; ++it) {
            const int i4 = 64 * it + lane; const f32x4 v = *(const f32x4*)(sp + 4 * i4); const bool ok = i4 < n4;
            k[it] = (u32x4){ok ? f2key(v[0]) : 0u, ok ? f2key(v[1]) : 0u, ok ? f2key(v[2]) : 0u, ok ? f2key(v[3]) : 0u};
        }
        int* so = SEL + (size_t)(qrow0 + q) * 256;
        unsigned pivot = 0u;
        if (n > 1024) {
#pragma unroll
            for (int j = 0; j < 8; ++j) lk[64 * j + lane] = k[4 * j][0];
            asm volatile("s_waitcnt lgkmcnt(0)" ::: "memory");
            int dummy; radix_list(lk, 512, 30, hist, lane, pivot, dummy);
        }
        int cl = 0;
#pragma unroll
        for (int it = 0; it < 32; ++it)
#pragma unroll
            for (int e = 0; e < 4; ++e) cl += (k[it][e] >= pivot && k[it][e] != 0u) ? 1 : 0;
        int cinc = cl;
#pragma unroll
        for (int off = 1; off < 64; off <<= 1) { const int v = __shfl_up(cinc, off); if (lane >= off) cinc += v; }
        const int c1 = __shfl(cinc, 63);
        if (c1 >= 256 && c1 <= 1024) {
            int p = cinc - cl;
#pragma unroll
            for (int it = 0; it < 32; ++it) {
                if (64 * it < n4) {
#pragma unroll
                    for (int e = 0; e < 4; ++e) { const unsigned key = k[it][e]; if (key >= pivot && key != 0u) { lk[p] = key; li[p] = (unsigned short)(256 * it + 4 * lane + e); ++p; } }
                }
            }
            asm volatile("s_waitcnt lgkmcnt(0)" ::: "memory");
            unsigned tau; int kq; radix_list(lk, c1, 256, hist, lane, tau, kq);
            if (lane < 2) hist[64 + lane] = 0u;
            asm volatile("s_waitcnt lgkmcnt(0)" ::: "memory");
            int ce_l = 0;
            for (int i = lane; i < c1; i += 64) ce_l += (lk[i] == tau) ? 1 : 0;
            int ce = ce_l;
#pragma unroll
            for (int off = 1; off < 64; off <<= 1) ce += __shfl_xor(ce, off);
            if (ce == kq || ce <= 64) {
                if (ce != kq) {
                    for (int i = lane; i < c1; i += 64) if (lk[i] == tau) { const unsigned t = __hip_atomic_fetch_add(&hist[65], 1u, __ATOMIC_RELAXED, __HIP_MEMORY_SCOPE_WORKGROUP); hist[t] = li[i]; }
                    asm volatile("s_waitcnt lgkmcnt(0)" ::: "memory");
                }
                for (int i = lane; i < c1; i += 64) { const unsigned key = lk[i]; const unsigned id = li[i]; bool take = key > tau;
                    if (key == tau) { if (ce == kq) take = true; else { int rk = 0; for (int t = 0; t < ce; ++t) rk += (hist[t] < id) ? 1 : 0; take = rk < kq; } }
                    if (take) { const unsigned pos = __hip_atomic_fetch_add(&hist[64], 1u, __ATOMIC_RELAXED, __HIP_MEMORY_SCOPE_WORKGROUP); if (pos < 256u) so[pos] = (int)id; } }
                asm volatile("s_waitcnt lgkmcnt(0)" ::: "memory");
                continue;
            }
        }
        unsigned prefix = 0; int kk = 256;
#pragma unroll 1
        for (int lev = 0; lev < 3; ++lev) {
            const int shift = (lev == 0) ? 21 : (lev == 1) ? 10 : 0, bits = (lev == 2) ? 10 : 11, nbin = 1 << bits, per = nbin >> 6;
            const unsigned hshift = (unsigned)(shift + bits), bmask = (unsigned)(nbin - 1);
            for (int j = 0; j < per; ++j) hist[lane + 64 * j] = 0u;
            asm volatile("s_waitcnt lgkmcnt(0)" ::: "memory");
#pragma unroll
            for (int it = 0; it < 32; ++it) {
                if (64 * it < n4) {
#pragma unroll
                    for (int e = 0; e < 4; ++e) { const unsigned key = k[it][e];
                        const bool m = (lev == 0) ? (key != 0u) : ((key >> hshift) == prefix && key != 0u);
                        if (m) __hip_atomic_fetch_add(&hist[(key >> shift) & bmask], 1u, __ATOMIC_RELAXED, __HIP_MEMORY_SCOPE_WORKGROUP); }
                }
            }
            asm volatile("s_waitcnt lgkmcnt(0)" ::: "memory");
            unsigned s = 0; for (int j = 0; j < per; ++j) s += hist[lane * per + ((j + lane) & (per - 1))];
            unsigned T = s;
#pragma unroll
            for (int off = 1; off < 64; off <<= 1) { const unsigned v = __shfl_down(T, off); if (lane + off < 64) T += v; }
            const unsigned long long bal = __ballot(T >= (unsigned)kk);
            const int js = __popcll(bal) - 1;
            unsigned run = __shfl(T, (js + 1) & 63); if (js >= 63) run = 0u;
            int digit = js * per;
            for (int bb = per - 1; bb >= 0; --bb) { const unsigned cnt = hist[js * per + bb]; if (run + cnt >= (unsigned)kk) { digit = js * per + bb; break; } run += cnt; }
            kk -= (int)run; prefix = (prefix << bits) | (unsigned)digit;
            asm volatile("s_waitcnt lgkmcnt(0)" ::: "memory");
        }
        int obase = 0, ebase = 0;
        const unsigned long long below = (1ull << lane) - 1ull;
#pragma unroll
        for (int it = 0; it < 32; ++it) {
            if (64 * it < n4) {
                bool tk[4]; unsigned long long be[4]; bool eqf[4]; unsigned long long anyeq = 0ull;
#pragma unroll
                for (int e = 0; e < 4; ++e) { eqf[e] = (k[it][e] == prefix); be[e] = __ballot(eqf[e]); anyeq |= be[e]; tk[e] = k[it][e] > prefix; }
                if (anyeq) {
                    int er = ebase + __popcll(be[0] & below) + __popcll(be[1] & below) + __popcll(be[2] & below) + __popcll(be[3] & below);
#pragma unroll
                    for (int e = 0; e < 4; ++e) { if (eqf[e]) { tk[e] = er < kk; ++er; } }
                    ebase += __popcll(be[0]) + __popcll(be[1]) + __popcll(be[2]) + __popcll(be[3]);
                }
                unsigned long long bt[4];
#pragma unroll
                for (int e = 0; e < 4; ++e) bt[e] = __ballot(tk[e]);
                int pos = obase + __popcll(bt[0] & below) + __popcll(bt[1] & below) + __popcll(bt[2] & below) + __popcll(bt[3] & below);
#pragma unroll
                for (int e = 0; e < 4; ++e) { if (tk[e]) { if (pos < 256) so[pos] = 256 * it + 4 * lane + e; ++pos; } }
                obase += __popcll(bt[0]) + __popcll(bt[1]) + __popcll(bt[2]) + __popcll(bt[3]);
            }
        }
    }
    __syncthreads();
    if (PROBE_TS >= 20 && F.bid == 0 && F.tid == 0) { unsigned long long* ts = (unsigned long long*)(a.ws + WS_CTL + 32768); const unsigned long long now = __builtin_amdgcn_s_memrealtime(); ts[21] += now - ts[30]; ts[30] = now; }
}
__device__ __forceinline__ void dsa_query(const Frame& F, const Args& a, int row) {
    int lane = F.lane; asm volatile("" : "+v"(lane));
    const int j = lane & 15, kq = lane >> 4;
    const bool samp = row >= MP; const int rs = row - MP;
    const int nsel = samp ? 256 : min(256, 64 * (((row & (SEQ - 1)) >> 6) + 1));
    const bf16_t* KA = samp ? (const bf16_t*)(a.ws + WS_KAS) + (size_t)(rs >> 6) * SKV * 128 : (const bf16_t*)(a.ws + WS_KAP) + (size_t)(row >> 13) * SEQ * 128;
    const bf16_t* VA = samp ? (const bf16_t*)(a.ws + WS_VAS) + (size_t)(rs >> 6) * SKV * 128 : (const bf16_t*)(a.ws + WS_VAP) + (size_t)(row >> 13) * SEQ * 128;
    const int* sel = (const int*)(a.ws + WS_SEL) + (size_t)row * 256;
    const bf16_t* QA = (const bf16_t*)(a.ws + WS_QA) + (size_t)row * 512;
    LAS float* pl = (LAS float*)(F.lds + F.wave * 9216);
    LAS int* sl = (LAS int*)(F.lds + F.wave * 9216 + 8192);
#pragma unroll
    for (int i = 0; i < 4; ++i) sl[lane + 64 * i] = sel[lane + 64 * i];
    bf16x8 bq[4];
#pragma unroll
    for (int ks = 0; ks < 4; ++ks) { bf16x8 z = {}; bq[ks] = (j < 8 && (ks >> 1) == (j >> 2)) ? *(const bf16x8*)(QA + 64 * j + 32 * (ks & 1) + 8 * kq) : z; }
    asm volatile("s_waitcnt lgkmcnt(0)" ::: "memory");
    f32x4 acc[16]; const int nt = nsel >> 4;
#pragma unroll
    for (int hb = 0; hb < 2; ++hb) {
        bf16x8 kfr[8][4];
#pragma unroll
        for (int tt = 0; tt < 8; ++tt) { const int idx = sl[16 * (8 * hb + tt) + j]; const bf16_t* kr = KA + (size_t)idx * 128 + 8 * kq;
#pragma unroll
            for (int ks = 0; ks < 4; ++ks) kfr[tt][ks] = *(const bf16x8*)(kr + 32 * ks); }
#pragma unroll
        for (int tt = 0; tt < 8; ++tt) { f32x4 c2 = {0.f, 0.f, 0.f, 0.f};
#pragma unroll
            for (int ks = 0; ks < 4; ++ks) c2 = __builtin_amdgcn_mfma_f32_16x16x32_bf16(kfr[tt][ks], bq[ks], c2, 0, 0, 0);
            acc[8 * hb + tt] = (8 * hb + tt < nt) ? c2 : (f32x4){-INFINITY, -INFINITY, -INFINITY, -INFINITY}; }
    }
    float mx = -INFINITY;
#pragma unroll
    for (int t = 0; t < 16; ++t) mx = fmaxf(mx, fmaxf(fmaxf(acc[t][0], acc[t][1]), fmaxf(acc[t][2], acc[t][3])));
    mx = fmaxf(mx, __shfl_xor(mx, 16)); mx = fmaxf(mx, __shfl_xor(mx, 32));
    float sum = 0.f;
#pragma unroll
    for (int t = 0; t < 16; ++t)
#pragma unroll
        for (int i = 0; i < 4; ++i) { const float p = __builtin_amdgcn_exp2f(acc[t][i] - mx); acc[t][i] = p; sum += p; }
    sum += __shfl_xor(sum, 16); sum += __shfl_xor(sum, 32);
    const float inv = 1.0f / sum;
    if (j < 8) {
#pragma unroll
        for (int t = 0; t < 16; ++t)
#pragma unroll
            for (int i = 0; i < 4; ++i) pl[(16 * t + 4 * kq + i) * 8 + j] = acc[t][i] * inv;
    }
    asm volatile("s_waitcnt lgkmcnt(0)" ::: "memory");
    const int rg = lane >> 4, ch = lane & 15, g = ch >> 3;
    f32x2 o[4][4];
#pragma unroll
    for (int hh = 0; hh < 4; ++hh)
#pragma unroll
        for (int d = 0; d < 4; ++d) o[hh][d] = (f32x2){0.f, 0.f};
    const char* vbase = (const char*)VA + 16 * ch;
#pragma unroll 32
    for (int i = 0; i < (nsel >> 2); ++i) { const int s = 4 * i + rg; const int idx = sl[s];
        const u32x4 v = *(const u32x4*)(vbase + (size_t)idx * 256); const f32x4 p4 = *(const LAS f32x4*)(pl + s * 8 + 4 * g);
        f32x2 vv[4];
#pragma unroll
        for (int d = 0; d < 4; ++d) vv[d] = (f32x2){__uint_as_float(v[d] << 16), __uint_as_float(v[d] & 0xffff0000u)};
#pragma unroll
        for (int hh = 0; hh < 4; ++hh)
#pragma unroll
            for (int d = 0; d < 4; ++d) o[hh][d] += vv[d] * p4[hh]; }
#pragma unroll
    for (int hh = 0; hh < 4; ++hh)
#pragma unroll
        for (int d = 0; d < 4; ++d) { o[hh][d].x += __shfl_xor(o[hh][d].x, 16); o[hh][d].y += __shfl_xor(o[hh][d].y, 16); o[hh][d].x += __shfl_xor(o[hh][d].x, 32); o[hh][d].y += __shfl_xor(o[hh][d].y, 32); }
    { u32x4 wv; const int hh = rg;
      f32x2 s0 = o[0][0], s1 = o[0][1], s2 = o[0][2], s3 = o[0][3];
      if (hh == 1) { s0 = o[1][0]; s1 = o[1][1]; s2 = o[1][2]; s3 = o[1][3]; } else if (hh == 2) { s0 = o[2][0]; s1 = o[2][1]; s2 = o[2][2]; s3 = o[2][3]; } else if (hh == 3) { s0 = o[3][0]; s1 = o[3][1]; s2 = o[3][2]; s3 = o[3][3]; }
      wv.x = pk2(s0.x, s0.y); wv.y = pk2(s1.x, s1.y); wv.z = pk2(s2.x, s2.y); wv.w = pk2(s3.x, s3.y);
      *(u32x4*)((bf16_t*)(a.ws + WS_YA) + (size_t)row * 512 + 64 * (4 * g + hh) + 8 * (ch & 7)) = wv; }
    asm volatile("s_waitcnt lgkmcnt(0)" ::: "memory");
}
constexpr int VST = 72;
constexpr int FOX_V = 0, FOX_M = 8 * 64 * VST * 2  , FOX_L = FOX_M + 2048, FOX_O = FOX_L + 256, FOX_END = FOX_O + 64 * 65 * 4;
static_assert(FOX_END + 65 * 64 * 4 + 64 * 144 <= 131072, "fox lds");
__device__ __forceinline__ int crow(int r, int hi) { return (r & 3) + 8 * (r >> 2) + 4 * hi; }
__device__ __forceinline__ bf16x8 cvt8(f32x4 a, f32x4 b) { u32x4 w; w.x = pk2(a[0], a[1]); w.y = pk2(a[2], a[3]); w.z = pk2(b[0], b[1]); w.w = pk2(b[2], b[3]); return __builtin_bit_cast(bf16x8, w); }
__device__ __forceinline__ void fox_unit(const Frame& F, const Args& a, int unit) {
    constexpr bool samp = true; int b, h, qi, ntiles, rowq0; const float* Cb;
    if (samp) { b = unit >> 3; h = unit & 7; qi = 64; ntiles = 65; rowq0 = MP + b * DS; Cb = (const float*)(a.ws + WS_CBS) + ((size_t)b * 8 + h) * SKV; }
    else { const int r = unit - 256; qi = 127 - (r >> 4); b = (r >> 3) & 1; h = r & 7; ntiles = qi + 1; rowq0 = b * SEQ + 64 * qi; Cb = (const float*)(a.ws + WS_CBP) + ((size_t)b * 8 + h) * SEQ; }
    int lane = F.lane; asm volatile("" : "+v"(lane)); int tidl = F.tid; asm volatile("" : "+v"(tidl));
    const int q32 = lane & 31, hi = lane >> 5, w = F.wave;
    const bf16_t* Kb = samp ? (const bf16_t*)(a.ws + WS_KBS) + (size_t)(b * DS) * 512 + 64 * h : (const bf16_t*)(a.ws + WS_KBP) + (size_t)(b * SEQ) * 512 + 64 * h;
    const bf16_t* Vb = samp ? (const bf16_t*)(a.ws + WS_VBS) + (size_t)(b * DS) * 512 + 64 * h : (const bf16_t*)(a.ws + WS_VBP) + (size_t)(b * SEQ) * 512 + 64 * h;
    const float* Kc = a.c_bk + ((size_t)b * PAST * 8 + h) * 64; const float* Vc = a.c_bv + ((size_t)b * PAST * 8 + h) * 64;
    LAS bf16_t* vl = (LAS bf16_t*)(F.lds + FOX_V) + w * 64 * VST;
    LAS float* mb = (LAS float*)(F.lds + FOX_M); LAS float* lt = (LAS float*)(F.lds + FOX_L); LAS float* ot = (LAS float*)(F.lds + FOX_O);
    for (int e = tidl; e < 64 * 65 + 64; e += NTHR) lt[e] = 0.f;
    LAS float* cbl = (LAS float*)(F.lds + FOX_END);
    for (int e = tidl; e < ntiles * 16; e += NTHR) *(LAS f32x4*)(cbl + 4 * e) = *(const f32x4*)(Cb + 4 * e);
    __syncthreads();
    LAS unsigned char* ql = F.lds + FOX_END + 65 * 64 * 4;
    { const bf16_t* QB = (const bf16_t*)(a.ws + WS_QB); const int r = tidl >> 3, ch = tidl & 7;
      *(LAS u32x4*)(ql + r * 144 + 16 * ch) = *(const u32x4*)(QB + (size_t)(rowq0 + r) * 512 + 64 * h + 8 * ch); }
    __syncthreads();
    const LAS unsigned char* qlw = ql + q32 * 144 + 16 * hi;
    float mrun[2] = {-INFINITY, -INFINITY}, lrun[2] = {0.f, 0.f};
    f32x16 o[2][2];
#pragma unroll
    for (int qb = 0; qb < 2; ++qb)
#pragma unroll
        for (int db = 0; db < 2; ++db)
#pragma unroll
            for (int r = 0; r < 16; ++r) o[qb][db][r] = 0.f;
    const int gi = lane >> 4, li = lane & 15;
    const unsigned kofb = (unsigned)(q32 * 1024 + 16 * hi);
    const unsigned kofc = (unsigned)(q32 * 2048 + 32 * hi);
    const unsigned cof = (unsigned)(16 * hi);
    const int troff = ((4 * hi + (li >> 2)) * VST + 16 * (gi & 1) + 4 * (li & 3));
    const int nmine = (w < ntiles) ? ((ntiles - 1 - w) >> 3) + 1 : 0;
    for (int ii = nmine - 1; ii >= 0; --ii) {
        const int tile = w + 8 * ii;
        const bool cache = samp && tile < 64, diag = (tile == ntiles - 1);
        const int kv0 = 64 * tile; const int kvl = samp ? (cache ? kv0 : 0) : kv0;
        bf16x8 kf[2][4];
        if (cache) {
            const char* kp = (const char*)Kc + (size_t)kvl * 2048 + kofc;
#pragma unroll
            for (int hf = 0; hf < 2; ++hf) { const char* kph = kp + hf * 65536;
#pragma unroll
                for (int ks = 0; ks < 4; ++ks) kf[hf][ks] = cvt8(*(const f32x4*)(kph + 64 * ks), *(const f32x4*)(kph + 64 * ks + 16)); }
        } else {
            const char* kp = (const char*)Kb + (size_t)kvl * 1024 + kofb;
#pragma unroll
            for (int hf = 0; hf < 2; ++hf) { const char* kph = kp + hf * 32768;
#pragma unroll
                for (int ks = 0; ks < 4; ++ks) kf[hf][ks] = *(const bf16x8*)(kph + 32 * ks); }
        }
        asm volatile("" ::: "memory");
        f32x16 s[2][2]; float mx[2];
#pragma unroll
        for (int qb = 0; qb < 2; ++qb) {
#pragma unroll
            for (int hf = 0; hf < 2; ++hf) {
#pragma unroll
                for (int g4 = 0; g4 < 4; ++g4) { const f32x4 c4 = *(const LAS f32x4*)((const LAS char*)(cbl + kv0) + cof + (128 * hf + 32 * g4));
                    s[qb][hf][4 * g4 + 0] = c4[0]; s[qb][hf][4 * g4 + 1] = c4[1]; s[qb][hf][4 * g4 + 2] = c4[2]; s[qb][hf][4 * g4 + 3] = c4[3]; }
#pragma unroll
                for (int ks = 0; ks < 4; ++ks) s[qb][hf] = __builtin_amdgcn_mfma_f32_32x32x16_bf16(kf[hf][ks], *(const LAS bf16x8*)(qlw + qb * 32 * 144 + 32 * ks), s[qb][hf], 0, 0, 0);
            }
            if (diag) { const int ql = 32 * qb + q32;
#pragma unroll
                for (int hf = 0; hf < 2; ++hf)
#pragma unroll
                    for (int r = 0; r < 16; ++r) if (32 * hf + crow(r, hi) > ql) s[qb][hf][r] = -INFINITY; }
            float m_ = -INFINITY;
#pragma unroll
            for (int r = 0; r < 16; ++r) m_ = fmaxf(m_, fmaxf(s[qb][0][r], s[qb][1][r]));
            mx[qb] = fmaxf(m_, __shfl_xor(m_, 32));
        }
        if (!__all(mx[0] < mrun[0] - 160.0f && mx[1] < mrun[1] - 160.0f)) {
            if (cache) {
                const char* vp = (const char*)Vc + (size_t)kvl * 2048 + (unsigned)(lane * 2048);
#pragma unroll
                for (int c = 0; c < 16; ++c) { const f32x4 v = *(const f32x4*)(vp + 16 * c);
                    u32x2 wv; wv.x = pk2(v[0], v[1]); wv.y = pk2(v[2], v[3]); *(LAS u32x2*)(vl + lane * VST + 4 * c) = wv;
                    if ((c & 7) == 7) asm volatile("" ::: "memory"); }
            } else {
                const char* vp = (const char*)Vb + (size_t)kvl * 1024 + (unsigned)(lane * 1024);
#pragma unroll
                for (int c = 0; c < 8; ++c) *(LAS u32x4*)(vl + lane * VST + 8 * c) = *(const u32x4*)(vp + 16 * c);
                asm volatile("" ::: "memory");
            }
#pragma unroll
            for (int qb = 0; qb < 2; ++qb) {
                const float mn = fmaxf(mrun[qb], mx[qb]); const float al = __builtin_amdgcn_exp2f(mrun[qb] - mn); mrun[qb] = mn;
                float sum = 0.f;
#pragma unroll
                for (int hf = 0; hf < 2; ++hf)
#pragma unroll
                    for (int r = 0; r < 16; ++r) { const float p = __builtin_amdgcn_exp2f(s[qb][hf][r] - mn); s[qb][hf][r] = p; sum += p; }
                lrun[qb] = lrun[qb] * al + sum;
                if (__any(al != 1.0f)) {
#pragma unroll
                    for (int db = 0; db < 2; ++db)
#pragma unroll
                        for (int r = 0; r < 16; ++r) o[qb][db][r] *= al; }
                bf16x8 pk[4];
#pragma unroll
                for (int k4 = 0; k4 < 4; ++k4) { const int hf = k4 >> 1, r0 = 8 * (k4 & 1); u32x4 wv;
                    wv.x = pk2(s[qb][hf][r0 + 0], s[qb][hf][r0 + 1]); wv.y = pk2(s[qb][hf][r0 + 2], s[qb][hf][r0 + 3]); wv.z = pk2(s[qb][hf][r0 + 4], s[qb][hf][r0 + 5]); wv.w = pk2(s[qb][hf][r0 + 6], s[qb][hf][r0 + 7]);
                    pk[k4] = __builtin_bit_cast(bf16x8, wv); }
                asm volatile("s_waitcnt lgkmcnt(0)" ::: "memory");
#pragma unroll
                for (int db = 0; db < 2; ++db)
#pragma unroll
                    for (int k4 = 0; k4 < 4; ++k4) {
                        const LAS bf16_t* p0 = vl + troff + (16 * k4) * VST + 32 * db;
                        const s16x4 lo = __builtin_bit_cast(s16x4, __builtin_amdgcn_ds_read_tr16_b64_v4i16((LAS s16x4*)p0));
                        const s16x4 hh = __builtin_bit_cast(s16x4, __builtin_amdgcn_ds_read_tr16_b64_v4i16((LAS s16x4*)(p0 + 8 * VST)));
                        const bf16x8 vt = (bf16x8){lo[0], lo[1], lo[2], lo[3], hh[0], hh[1], hh[2], hh[3]};
                        o[qb][db] = __builtin_amdgcn_mfma_f32_32x32x16_bf16(vt, pk[k4], o[qb][db], 0, 0, 0);
                    }
            }
            asm volatile("s_waitcnt lgkmcnt(0)" ::: "memory");
        }
    }
#pragma unroll
    for (int qb = 0; qb < 2; ++qb) { lrun[qb] += __shfl_xor(lrun[qb], 32); if (hi == 0) mb[w * 64 + 32 * qb + q32] = mrun[qb]; }
    __syncthreads();
#pragma unroll
    for (int qb = 0; qb < 2; ++qb) {
        const int q = 32 * qb + q32; float mg = -INFINITY;
#pragma unroll
        for (int ww = 0; ww < NWAVES; ++ww) mg = fmaxf(mg, mb[ww * 64 + q]);
        const float sc = __builtin_amdgcn_exp2f(mrun[qb] - mg);
        if (w < ntiles) {
            if (hi == 0) __hip_atomic_fetch_add(lt + q, lrun[qb] * sc, __ATOMIC_RELAXED, __HIP_MEMORY_SCOPE_WORKGROUP);
#pragma unroll
            for (int db = 0; db < 2; ++db)
#pragma unroll
                for (int r = 0; r < 16; ++r) __hip_atomic_fetch_add(ot + q * 65 + 32 * db + crow(r, hi), o[qb][db][r] * sc, __ATOMIC_RELAXED, __HIP_MEMORY_SCOPE_WORKGROUP);
        }
    }
    __syncthreads();
    { const int q = tidl >> 3, d0 = 8 * (tidl & 7); const float il = 1.0f / lt[q]; const LAS float* op = ot + q * 65 + d0;
      u32x4 wv; wv.x = pk2(op[0] * il, op[1] * il); wv.y = pk2(op[2] * il, op[3] * il); wv.z = pk2(op[4] * il, op[5] * il); wv.w = pk2(op[6] * il, op[7] * il);
      *(u32x4*)((bf16_t*)(a.ws + WS_YB) + (size_t)(rowq0 + q) * 512 + 64 * h + d0) = wv; }
    __syncthreads();
}

constexpr int FP_ROWB = 144, FP_V = 64 * FP_ROWB, FP_C = 2 * FP_V, FP_BUF = FP_C + 256;
__device__ __forceinline__ void fox_prompt_unit(const Frame& F, const Args& a, int b, int h, int j) {
    int lane = F.lane; asm volatile("" : "+v"(lane)); int tid = F.tid; asm volatile("" : "+v"(tid));
    const int q32 = lane & 31, hi = lane >> 5, w = F.wave;
    const int NT = 4 * (j + 1), myT = 4 * j + (w >> 1);
    const char* kg = (const char*)((const bf16_t*)(a.ws + WS_KBP) + (size_t)(b * SEQ) * 512 + 64 * h) + (size_t)(tid >> 3) * 1024 + 16 * (tid & 7);
    const char* vg = (const char*)((const bf16_t*)(a.ws + WS_VBP) + (size_t)(b * SEQ) * 512 + 64 * h) + (size_t)(tid >> 3) * 1024 + 16 * (tid & 7);
    const float* cg = (const float*)(a.ws + WS_CBP) + ((size_t)b * 8 + h) * SEQ + 4 * (tid & 15);
    LAS unsigned char* lb = F.lds;
    const int lw = (tid >> 3) * FP_ROWB + 16 * (tid & 7);
    const bf16_t* qp = (const bf16_t*)(a.ws + WS_QB) + (size_t)(b * SEQ + 256 * j + 32 * w + q32) * 512 + 64 * h + 8 * hi;
    bf16x8 qf[4];
#pragma unroll
    for (int ks = 0; ks < 4; ++ks) qf[ks] = *(const bf16x8*)(qp + 16 * ks);
    u32x4 kr[2], vr[2]; f32x4 br[2];
#pragma unroll
    for (int sb = 0; sb < 2; ++sb) { kr[sb] = *(const u32x4*)(kg + (size_t)(NT - 1 - sb) * 65536); vr[sb] = *(const u32x4*)(vg + (size_t)(NT - 1 - sb) * 65536); br[sb] = *(const f32x4*)(cg + 64 * (NT - 1 - sb)); }
#pragma unroll
    for (int sb = 0; sb < 2; ++sb) { *(LAS u32x4*)(lb + sb * FP_BUF + lw) = kr[sb]; *(LAS u32x4*)(lb + sb * FP_BUF + FP_V + lw) = vr[sb]; if (tid < 16) *(LAS f32x4*)(lb + sb * FP_BUF + FP_C + 16 * tid) = br[sb]; }
    __syncthreads();
    float mrun = -INFINITY, lrun = 0.f; f32x16 o[2];
#pragma unroll
    for (int db = 0; db < 2; ++db)
#pragma unroll
        for (int r = 0; r < 16; ++r) o[db][r] = 0.f;
    const int gi = lane >> 4, li = lane & 15;
    const int troff = ((4 * hi + (li >> 2)) * FP_ROWB + 2 * (16 * (gi & 1) + 4 * (li & 3)));
    const int kroff = q32 * FP_ROWB + 16 * hi;
    for (int st = 0; st < NT / 2; ++st) {
        const int t0 = NT - 1 - 2 * st; const int cur = st & 1; const bool more = (t0 >= 3);
        if (more) {
#pragma unroll
            for (int sb = 0; sb < 2; ++sb) { kr[sb] = *(const u32x4*)(kg + (size_t)(t0 - 2 - sb) * 65536); vr[sb] = *(const u32x4*)(vg + (size_t)(t0 - 2 - sb) * 65536); br[sb] = *(const f32x4*)(cg + 64 * (t0 - 2 - sb)); } }
#pragma unroll
        for (int sb = 0; sb < 2; ++sb) {
        const int t = t0 - sb;
        if (t <= myT) {
            const LAS unsigned char* kb_ = lb + (2 * cur + sb) * FP_BUF; const LAS unsigned char* vb_ = kb_ + FP_V; const LAS unsigned char* cb_ = kb_ + FP_C + 16 * hi;
            f32x16 s[2];
#pragma unroll
            for (int hf = 0; hf < 2; ++hf) {
#pragma unroll
                for (int g4 = 0; g4 < 4; ++g4) { const f32x4 c4 = *(const LAS f32x4*)(cb_ + 128 * hf + 32 * g4);
                    s[hf][4 * g4 + 0] = c4[0]; s[hf][4 * g4 + 1] = c4[1]; s[hf][4 * g4 + 2] = c4[2]; s[hf][4 * g4 + 3] = c4[3]; }
#pragma unroll
                for (int ks = 0; ks < 4; ++ks) s[hf] = __builtin_amdgcn_mfma_f32_32x32x16_bf16(*(const LAS bf16x8*)(kb_ + kroff + hf * 32 * FP_ROWB + 32 * ks), qf[ks], s[hf], 0, 0, 0);
            }
            if (t == myT) { const int ql = 32 * (w & 1) + q32;
#pragma unroll
                for (int hf = 0; hf < 2; ++hf)
#pragma unroll
                    for (int r = 0; r < 16; ++r) if (32 * hf + crow(r, hi) > ql) s[hf][r] = -INFINITY; }
            float mx = -INFINITY;
#pragma unroll
            for (int r = 0; r < 16; ++r) mx = fmaxf(mx, fmaxf(s[0][r], s[1][r]));
            mx = fmaxf(mx, __shfl_xor(mx, 32));
            if (!__all(mx < mrun - 160.0f)) {
            const float mn = fmaxf(mrun, mx); const float al = __builtin_amdgcn_exp2f(mrun - mn); mrun = mn;
            float sum = 0.f;
#pragma unroll
            for (int hf = 0; hf < 2; ++hf)
#pragma unroll
                for (int r = 0; r < 16; ++r) { const float p = __builtin_amdgcn_exp2f(s[hf][r] - mn); s[hf][r] = p; sum += p; }
            lrun = lrun * al + sum;
            if (__any(al != 1.0f)) {
#pragma unroll
            for (int db = 0; db < 2; ++db)
#pragma unroll
                for (int r = 0; r < 16; ++r) o[db][r] *= al; }
            bf16x8 pk[4];
#pragma unroll
            for (int k4 = 0; k4 < 4; ++k4) { const int hf = k4 >> 1, r0 = 8 * (k4 & 1); u32x4 wv;
                wv.x = pk2(s[hf][r0 + 0], s[hf][r0 + 1]); wv.y = pk2(s[hf][r0 + 2], s[hf][r0 + 3]); wv.z = pk2(s[hf][r0 + 4], s[hf][r0 + 5]); wv.w = pk2(s[hf][r0 + 6], s[hf][r0 + 7]);
                pk[k4] = __builtin_bit_cast(bf16x8, wv); }
#pragma unroll
            for (int db = 0; db < 2; ++db)
#pragma unroll
                for (int k4 = 0; k4 < 4; ++k4) {
                    const LAS unsigned char* p0 = vb_ + troff + (16 * k4) * FP_ROWB + 64 * db;
                    const s16x4 lo = __builtin_bit_cast(s16x4, __builtin_amdgcn_ds_read_tr16_b64_v4i16((LAS s16x4*)p0));
                    const s16x4 hh = __builtin_bit_cast(s16x4, __builtin_amdgcn_ds_read_tr16_b64_v4i16((LAS s16x4*)(p0 + 8 * FP_ROWB)));
                    const bf16x8 vt = (bf16x8){lo[0], lo[1], lo[2], lo[3], hh[0], hh[1], hh[2], hh[3]};
                    o[db] = __builtin_amdgcn_mfma_f32_32x32x16_bf16(vt, pk[k4], o[db], 0, 0, 0);
                }
            }
        }
        }
        if (more) {
#pragma unroll
            for (int sb = 0; sb < 2; ++sb) { LAS unsigned char* nb = lb + (2 * (cur ^ 1) + sb) * FP_BUF; *(LAS u32x4*)(nb + lw) = kr[sb]; *(LAS u32x4*)(nb + FP_V + lw) = vr[sb]; if (tid < 16) *(LAS f32x4*)(nb + FP_C + 16 * tid) = br[sb]; } }
        __syncthreads();
    }
    lrun += __shfl_xor(lrun, 32);
    const float il = 1.0f / lrun;
    bf16_t* yo = (bf16_t*)(a.ws + WS_YB) + (size_t)(b * SEQ + 256 * j + 32 * w + q32) * 512 + 64 * h + 4 * hi;
#pragma unroll
    for (int db = 0; db < 2; ++db)
#pragma unroll
        for (int g4 = 0; g4 < 4; ++g4) { u32x2 wv; wv.x = pk2(o[db][4 * g4 + 0] * il, o[db][4 * g4 + 1] * il); wv.y = pk2(o[db][4 * g4 + 2] * il, o[db][4 * g4 + 3] * il);
            *(u32x2*)(yo + 32 * db + 8 * g4) = wv; }
}
#define XB_TMO      128
#define XB_XCNT(j)  (256  + 64 * (j))
#define XB_XSUB(j)  (1280 + 64 * (j))
#define XB_XGEN(j)  (2304 + 64 * (j))
#define XB_TOP      3328
#define XB_TOPGEN   3392
#define XCD_BAR_WORDS 3456
#define XB_SPIN_CAP (1u << 18)

__device__ __forceinline__ unsigned xb_ld(unsigned* p)              { return __hip_atomic_load(p, __ATOMIC_RELAXED, __HIP_MEMORY_SCOPE_AGENT); }
__device__ __forceinline__ unsigned xb_add(unsigned* p, unsigned v) { return __hip_atomic_fetch_add(p, v, __ATOMIC_RELAXED, __HIP_MEMORY_SCOPE_AGENT); }
__device__ __forceinline__ unsigned xb_xcc_id() { return (unsigned)__builtin_amdgcn_s_getreg((3 << 11) | 20) & 0xFu; }
#define XB_SPIN(cond, bar) do { unsigned _sp = 0; while (cond) { __builtin_amdgcn_s_sleep(1); \
    if ((++_sp & 255u) == 0u) { if (xb_ld(&(bar)[XB_TMO])) break; if (_sp > XB_SPIN_CAP) { atomicAdd(&(bar)[XB_TMO], 1u); break; } } } } while (0)

struct XcdBarrier {
    unsigned* bar; unsigned x;
    volatile LAS unsigned* st;
};

__device__ __forceinline__ XcdBarrier xcd_barrier_post(unsigned* bar, volatile LAS unsigned* st) {
    XcdBarrier b; b.bar = bar; b.x = xb_xcc_id(); b.st = st;
    if (threadIdx.x == 0) (void)xb_add(&bar[XB_XCNT(b.x)], 1u);
    return b;
}
__device__ __forceinline__ void xcd_barrier_complete(unsigned* bar, unsigned x, unsigned& nloc, unsigned& nx) {
    const unsigned G = gridDim.x * gridDim.y * gridDim.z;
    unsigned sum, cnt, mine, sp = 0u;
    for (;;) {
        sum = 0u; cnt = 0u; mine = 0u;
#pragma unroll
        for (unsigned j = 0; j < 16; ++j) { const unsigned c = xb_ld(&bar[XB_XCNT(j)]); sum += c; cnt += (c > 0u) ? 1u : 0u; mine = (j == x) ? c : mine; }
        if (sum == G) break;
        __builtin_amdgcn_s_sleep(1);
        if ((++sp & 255u) == 0u) { if (xb_ld(&bar[XB_TMO])) break; if (sp > XB_SPIN_CAP) { atomicAdd(&bar[XB_TMO], 1u); break; } }
    }
    nloc = mine > 0u ? mine : 1u; nx = cnt > 0u ? cnt : 1u;
}

__device__ __forceinline__ void xcd_barrier(const XcdBarrier& b) {
    asm volatile("s_waitcnt vmcnt(0)" ::: "memory");
    __syncthreads();
    if (threadIdx.x == 0) {
        unsigned* bar = b.bar;
        __builtin_amdgcn_s_waitcnt(0);
        unsigned nloc = b.st[0], nx = b.st[1];
        if (nloc == 0u) { xcd_barrier_complete(bar, b.x, nloc, nx); b.st[0] = nloc; b.st[1] = nx; }
        const unsigned old = xb_add(&bar[XB_XSUB(b.x)], 1u);
        const unsigned gen = old / nloc;
        if (old + 1u == (gen + 1u) * nloc) {
            __builtin_amdgcn_fence(__ATOMIC_RELEASE, "agent");
            asm volatile("s_waitcnt vmcnt(0)" ::: "memory");
            const unsigned og = xb_add(&bar[XB_TOP], 1u);
            const unsigned tg = og / nx;
            if (og + 1u == (tg + 1u) * nx) xb_add(&bar[XB_TOPGEN], 1u);
            else XB_SPIN(xb_ld(&bar[XB_TOPGEN]) == tg, bar);
            __builtin_amdgcn_fence(__ATOMIC_ACQUIRE, "agent");
            xb_add(&bar[XB_XGEN(b.x)], 1u);
            asm volatile("s_waitcnt vmcnt(0)" ::: "memory");
        } else {
            XB_SPIN(xb_ld(&bar[XB_XGEN(b.x)]) == gen, bar);
            __builtin_amdgcn_fence(__ATOMIC_ACQUIRE, "agent");
            asm volatile("s_waitcnt vmcnt(0)" ::: "memory");
        }
    }
    __syncthreads();
}
constexpr int N_PHASES = 13;
#ifndef MK_PER_PHASE
#define MK_PER_PHASE 0
#endif
template <class Epi> __device__ __forceinline__ void run_gemm(const Frame& F, const bf16_t* A, const bf16_t* Bt, int N, int K, const Epi& E) {
    pg8::Gemm g{A, Bt, MT, N, K}; pg8::StaticOrder S; S.init(MT, N, F.G, F.bid);
    pg8::gemm_phase<Epi, pg8::StaticOrder, true, true>(F.lds, g, S, E);
}
__global__ void __launch_bounds__(NTHR, 2) mega_fwd(Args a) {
    __builtin_assume(__builtin_amdgcn_workitem_id_y() == 0); __builtin_assume(__builtin_amdgcn_workitem_id_z() == 0);
    extern __shared__ __attribute__((aligned(16))) unsigned char lds_raw[];
    cg::grid_group grid = cg::this_grid();
    Frame F; F.lds = (LAS unsigned char*)lds_raw; F.tid = threadIdx.x; F.lane = F.tid & 63; F.wave = __builtin_amdgcn_readfirstlane(F.tid >> 6); F.G = gridDim.x; F.bid = blockIdx.x;
    unsigned char* ws = a.ws;
    LAS int* sh_item = (LAS int*)(F.lds + 131072);
    volatile LAS unsigned* bst = (volatile LAS unsigned*)(F.lds + 131072 + 64);
    if (F.tid < 2) bst[F.tid] = 0u;
    __syncthreads();
    const bool fused = (a.ph_hi - a.ph_lo) > 1;
    XcdBarrier xbar; xbar.bar = (unsigned*)(ws + WS_CTL) + 4096; xbar.x = 0; xbar.st = bst;
    const int lo = a.ph_lo, hi = a.ph_hi;
#define IN(k) (lo <= (k) && (k) < hi)
#ifndef PROBE_TS
#define PROBE_TS -1
#endif
#define STAMP(k) do { if (PROBE_TS >= 0 && F.bid == 0 && F.tid == 0) ((unsigned long long*)(ws + WS_CTL + 32768))[k] = __builtin_amdgcn_s_memrealtime(); } while (0)
#define SEAM(k) do { if (IN(k) && IN((k) + 1)) { if ((k) == 0) grid.sync(); else xcd_barrier(xbar); } STAMP((k) + 1); } while (0)
    STAMP(0);
#ifndef PROBE_DUP
#define PROBE_DUP 0
#endif
#define REP(code) (PROBE_DUP == (code) ? 2 : 1)
    if (IN(0)) { for (int rep = 0; rep < REP(1); ++rep) p0_prologue(F, a); } SEAM(0);
    if (fused) xbar = xcd_barrier_post((unsigned*)(ws + WS_CTL) + 4096, bst);
    if (PROBE_DUP == 8) { for (int i = 0; i < 10; ++i) grid.sync(); }
    if (IN(1)) for (int rep = 0; rep < 1; ++rep) { pg8::EpiSwiGLU E{(bf16_t*)(ws + WS_H)}; run_gemm(F, (const bf16_t*)(ws + WS_XB), (const bf16_t*)(ws + WS_W1U), NUP, DM, E); } SEAM(1);
    if (PROBE_DUP == 9) { pg8::EpiSwiGLU E2{(bf16_t*)(ws + WS_H)}; run_gemm(F, (const bf16_t*)(ws + WS_XB), (const bf16_t*)(ws + WS_W1U), NUP, DM, E2); xcd_barrier(xbar); }
    if (IN(2)) for (int rep = 0; rep < 1; ++rep) { pg8::EpiRes E{a.x_p, a.x_s, (float*)(ws + WS_Z), 0.5f}; run_gemm(F, (const bf16_t*)(ws + WS_H), (const bf16_t*)(ws + WS_W1D), DM, DFF, E); if (PROBE_DUP == 10) run_gemm(F, (const bf16_t*)(ws + WS_H), (const bf16_t*)(ws + WS_W1D), DM, DFF, E); } SEAM(2);
    if (IN(3)) for (int rep = 0; rep < REP(3); ++rep) { ln_pass(F, (const float*)(ws + WS_Z), a.ln1g, a.ln1b, (float*)(ws + WS_HF1), (bf16_t*)(ws + WS_HB)); } SEAM(3);
    if (IN(4)) for (int rep = 0; rep < 1; ++rep) {
        pg8::EpiWin E{a.out, (bf16_t*)(ws + WS_QA), (bf16_t*)(ws + WS_IQ), (bf16_t*)(ws + WS_QB), (bf16_t*)(ws + WS_KAP), (bf16_t*)(ws + WS_VAP), (bf16_t*)(ws + WS_IKP), (bf16_t*)(ws + WS_KBP), (bf16_t*)(ws + WS_VBP),
                      (bf16_t*)(ws + WS_KAS), (bf16_t*)(ws + WS_VAS), (bf16_t*)(ws + WS_IKS), (bf16_t*)(ws + WS_KBS), (bf16_t*)(ws + WS_VBS), (bf16_t*)(ws + WS_G), (float*)(ws + WS_IW), (float*)(ws + WS_LF),
                      (const pg8::f32x2*)(ws + WS_ROPE), a.b_f, a.b_gate};
        run_gemm(F, (const bf16_t*)(ws + WS_HB), (const bf16_t*)(ws + WS_WIN), NINP, DM, E);
        if (PROBE_DUP == 11) run_gemm(F, (const bf16_t*)(ws + WS_HB), (const bf16_t*)(ws + WS_WIN), NINP, DM, E);
    } SEAM(4);
    if (IN(5)) {
        if (F.bid < NB + DB) cumsum_block(F, a, F.bid);
        for (int rep = 0; rep < REP(5); ++rep) { unsigned* ctr = (unsigned*)(ws + WS_CTL) + 128 * rep;
        for (;;) { if (F.tid == 0) *sh_item = (int)atomicAdd(ctr, 1u); __syncthreads(); const int item = *sh_item; __syncthreads(); if (item >= 1152) break; indexer_item(F, a, item); } }
    } SEAM(5);
    if (IN(6)) {
        unsigned* ctr = (unsigned*)(ws + WS_CTL) + 64;
        for (;;) { if (F.tid == 0) *sh_item = (int)atomicAdd(ctr, 1u); __syncthreads(); const int item = *sh_item; __syncthreads();
            if (item >= 512 + MT / 8) break;
            int kind, idx;
            if (item < 256) { kind = 0; idx = item; } else if (item < 512) { kind = 1; idx = item - 256; } else { kind = 2; idx = item - 512; }
            if (PROBE_TS >= 20 && F.bid == 0 && F.tid == 0) ((unsigned long long*)(ws + WS_CTL + 32768))[30] = __builtin_amdgcn_s_memrealtime();
            if (kind == 0) fox_unit(F, a, idx);
            else if (kind == 1) { const int bh = idx >> 4, s = idx & 15; fox_prompt_unit(F, a, bh >> 3, bh & 7, 31 - s); fox_prompt_unit(F, a, bh >> 3, bh & 7, s); }
            else { dsa_query(F, a, idx * 8 + F.wave); }
            if (PROBE_TS >= 20) { __syncthreads(); if (F.bid == 0 && F.tid == 0) { unsigned long long* ts = (unsigned long long*)(ws + WS_CTL + 32768); ts[kind == 0 ? 22 : kind == 1 ? 23 : 24] += __builtin_amdgcn_s_memrealtime() - ts[30]; } } }
        if (PROBE_DUP == 6) { ctr += 64; for (;;) { if (F.tid == 0) *sh_item = (int)atomicAdd(ctr, 1u); __syncthreads(); const int item = *sh_item; __syncthreads(); if (item >= 512) break; if (item < 256) fox_unit(F, a, item); else { const int p = item - 256, bh = p >> 4, s = p & 15; fox_prompt_unit(F, a, bh >> 3, bh & 7, 31 - s); fox_prompt_unit(F, a, bh >> 3, bh & 7, s); } } }
        if (PROBE_DUP == 7) { ctr += 64; for (;;) { if (F.tid == 0) *sh_item = (int)atomicAdd(ctr, 1u); __syncthreads(); const int item = *sh_item; __syncthreads(); if (item >= MT / 64) break;
            const int r0 = item * 64; for (int i = 0; i < 8; ++i) dsa_query(F, a, r0 + 8 * i + F.wave); } }
    } SEAM(6);
    if (IN(7)) for (int rep = 0; rep < 1; ++rep) {
        pg8::EpiProjA EA{(const bf16_t*)(ws + WS_G), (float*)(ws + WS_MM)}; run_gemm(F, (const bf16_t*)(ws + WS_YA), (const bf16_t*)(ws + WS_WPA), DM, 512, EA);
        pg8::EpiProjB EB{(const bf16_t*)(ws + WS_G), (const float*)(ws + WS_MM), (bf16_t*)(ws + WS_MMB)}; run_gemm(F, (const bf16_t*)(ws + WS_YB), (const bf16_t*)(ws + WS_WPB), DM, 512, EB);
    } SEAM(7);
    if (IN(8)) for (int rep = 0; rep < 1; ++rep) { pg8::EpiRes E{(const float*)(ws + WS_HF1), (const float*)(ws + WS_HF1) + (size_t)MP * DM, (float*)(ws + WS_Z), 1.0f}; run_gemm(F, (const bf16_t*)(ws + WS_MMB), (const bf16_t*)(ws + WS_WO), DM, DM, E); if (PROBE_DUP == 12) run_gemm(F, (const bf16_t*)(ws + WS_MMB), (const bf16_t*)(ws + WS_WO), DM, DM, E); } SEAM(8);
    if (IN(9)) for (int rep = 0; rep < REP(3); ++rep) { ln_pass(F, (const float*)(ws + WS_Z), a.ln2g, a.ln2b, (float*)(ws + WS_HF2), (bf16_t*)(ws + WS_HB)); } SEAM(9);
    if (IN(10)) for (int rep = 0; rep < 1; ++rep) { pg8::EpiSwiGLU E{(bf16_t*)(ws + WS_H)}; run_gemm(F, (const bf16_t*)(ws + WS_HB), (const bf16_t*)(ws + WS_W2U), NUP, DM, E); if (PROBE_DUP == 14) run_gemm(F, (const bf16_t*)(ws + WS_HB), (const bf16_t*)(ws + WS_W2U), NUP, DM, E); } SEAM(10);
    if (IN(11)) for (int rep = 0; rep < 1; ++rep) { pg8::EpiRes E{(const float*)(ws + WS_HF2), (const float*)(ws + WS_HF2) + (size_t)MP * DM, (float*)(ws + WS_Z), 0.5f}; run_gemm(F, (const bf16_t*)(ws + WS_H), (const bf16_t*)(ws + WS_W2D), DM, DFF, E); if (PROBE_DUP == 13) run_gemm(F, (const bf16_t*)(ws + WS_H), (const bf16_t*)(ws + WS_W2D), DM, DFF, E); } SEAM(11);
    if (IN(12)) for (int rep = 0; rep < REP(3); ++rep) { ln_pass(F, (const float*)(ws + WS_Z), a.ln3g, a.ln3b, a.out + O_Y, nullptr); }
    if (PROBE_TS >= 0 && F.bid == 0) {
        __syncthreads(); STAMP(13); __threadfence(); __syncthreads();
        const unsigned long long* ts = (const unsigned long long*)(ws + WS_CTL + 32768);
        const unsigned long long t0 = __hip_atomic_load(ts + PROBE_TS, __ATOMIC_RELAXED, __HIP_MEMORY_SCOPE_AGENT), t1 = __hip_atomic_load(ts + PROBE_TS + 1, __ATOMIC_RELAXED, __HIP_MEMORY_SCOPE_AGENT);
        const float us = (PROBE_TS >= 20) ? (float)t0 * 0.01f : (float)(t1 - t0) * 0.01f; const float eps = sqrtf(us * 1e-4f);
        for (int i = F.tid; i < 16384; i += NTHR) a.out[O_SLF + i] *= (1.0f + eps);
    }
#undef IN
#undef SEAM
}

extern "C" void kernel_launch(void* const* d_in, const int* in_sizes, int n_in, void* d_out, int out_size, void* d_ws, size_t ws_size, hipStream_t stream) {
    static int grid = 0;
    if (grid == 0) {
        if (n_in != 24 || ws_size < WS_END) { fprintf(stderr, "kernel_launch: expected 24 inputs and >= %zu bytes of workspace (got %d, %zu)\n", (size_t)WS_END, n_in, ws_size); grid = -1; return; }
        int dev = 0, cus = 0, per_cu = 0;
        hipGetDevice(&dev); hipDeviceGetAttribute(&cus, hipDeviceAttributeMultiprocessorCount, dev);
        if (hipFuncSetAttribute((const void*)mega_fwd, hipFuncAttributeMaxDynamicSharedMemorySize, LDS_BYTES) != hipSuccess) { fprintf(stderr, "kernel_launch: hipFuncSetAttribute failed\n"); grid = -1; return; }
        hipOccupancyMaxActiveBlocksPerMultiprocessor(&per_cu, (const void*)mega_fwd, NTHR, LDS_BYTES);
        (void)hipGetLastError();
        if (per_cu < 1) { fprintf(stderr, "kernel_launch: occupancy query says %d blocks per CU\n", per_cu); per_cu = 1; }
        grid = cus;
    }
    if (grid < 0) return;
    Args a{};
    const float** p = (const float**)&a;
    for (int i = 0; i < 24; ++i) p[i] = (const float*)d_in[i];
    a.out = (float*)d_out; a.ws = (unsigned char*)d_ws;
    for (int j = 0; j < 32; ++j) a.invf[j] = pow(10000.0, -(double)j / 32.0);
#if MK_PER_PHASE
    for (int ph = 0; ph < N_PHASES; ++ph) { a.ph_lo = ph; a.ph_hi = ph + 1; void* args[] = {&a};
        hipError_t e = hipLaunchCooperativeKernel((const void*)mega_fwd, dim3(grid), dim3(NTHR), args, LDS_BYTES, stream);
        if (e != hipSuccess) { fprintf(stderr, "launch of phase %d failed: %s\n", ph, hipGetErrorString(e)); break; } }
#else
    a.ph_lo = 0; a.ph_hi = N_PHASES; void* args[] = {&a};
    hipError_t e = hipLaunchCooperativeKernel((const void*)mega_fwd, dim3(grid), dim3(NTHR), args, LDS_BYTES, stream);
    if (e != hipSuccess) fprintf(stderr, "cooperative launch failed: %s (grid %d)\n", hipGetErrorString(e), grid);
#endif
}
```

```cpp
#include <hip/hip_runtime.h>
#include <hip/hip_cooperative_groups.h>
#include <cstdio>
#include <cstdint>
#include <cmath>
namespace cg = cooperative_groups;

constexpr int DM = 1024, SEQ = 8192, NB = 2, DB = 32, DS = 64, PAST = 4096, SKV = PAST + DS  ;
constexpr int MP = NB * SEQ  , MS = DB * DS  , MT = MP + MS  ;
constexpr int DFF = 2816, NUP = 2 * DFF, NIN = 4944, NINP = 5120;
constexpr float ALPHA = 1.189207115002721f;
constexpr float LN_EPS = 1e-5f;
constexpr float LOG2E = 1.4426950408889634f;
constexpr float QSCALE = 0.125f * LOG2E;
constexpr float IWSCALE = 0.35355339059327373f * 0.125f;
constexpr size_t O_Y = 0, O_PAK = 18874368, O_PAV = 20971520, O_PIK = 23068672, O_PBK = 24117248, O_PBV = 32505856, O_PLF = 40894464,
                 O_SAK = 41025536, O_SAV = 41287680, O_SIK = 41549824, O_SBK = 41680896, O_SBV = 42729472, O_SLF = 43778048;
#define MK_PER_PHASE 0
#define PROBE_DUP 0
#define PROBE_TS -1
namespace pg8 {
#define PG8_LAS __attribute__((address_space(3)))
typedef unsigned short bf16_t;
typedef short bf16x8 __attribute__((ext_vector_type(8)));
typedef float f32x4 __attribute__((ext_vector_type(4)));
typedef unsigned u32x4 __attribute__((ext_vector_type(4)));
constexpr int BM = 256, BK = 64, HALF = 128, HTB = HALF * BK * 2  , STAGE_BYTES = 8 * HTB, NXCD = 8, WGM = 8;

__host__ __device__ __forceinline__ int lds_byte(int r, int c) { const int st = (r >> 4) * 2 + (c >> 5), rr = r & 15, cc = c & 31, ob = rr * 64 + cc * 2; return st * 1024 + (ob ^ (((ob >> 9) & 1) << 5)); }
__host__ __device__ __forceinline__ void stage_rc(int b, int& R, int& C) { const int st = b / 1024, sb = b % 1024, swz = sb ^ (((sb >> 9) & 1) << 5); R = (st >> 1) * 16 + swz / 64; C = (st & 1) * 32 + (swz % 64) / 2; }
__host__ __device__ __forceinline__ int perm32(int rho) { const int n = rho >> 4, i = rho & 15; return 8 * (i >> 2) + 4 * n + (i & 3); }

struct Unit { int pm, pn; };
struct Gemm { const bf16_t* A; const bf16_t* Bt; int M, N, K; };

struct StaticOrder {
    int nM, nN, nwg, G, c;
    __host__ __device__ void init(int M, int N, int G_, int c_) { nM = M / BM; nN = N / BM; nwg = nM * nN; G = G_; c = c_; }
    __host__ __device__ bool next(int i, Unit& u) const {
        const long L = (long)i * G + c; if (L >= nwg) return false;
        int wgid = (int)L; { const int q = nwg / NXCD, r = nwg % NXCD, xcd = wgid % NXCD, off = wgid / NXCD; wgid = (xcd < r ? xcd * (q + 1) : r * (q + 1) + (xcd - r) * q) + off; }
        const int nig = WGM * nN, gid = wgid / nig, fm = gid * WGM, gsz = (nM - fm) < WGM ? (nM - fm) : WGM;
        u.pm = fm + ((wgid % nig) % gsz); u.pn = (wgid % nig) / gsz; return true;
    }
    __device__ __forceinline__ void a_ready(const Unit&) const {}
    __device__ __forceinline__ void done(const Unit&) const {}
};

__device__ __forceinline__ unsigned cvt_pk_bf16(float lo, float hi) { unsigned r; asm volatile("v_cvt_pk_bf16_f32 %0, %1, %2" : "=v"(r) : "v"(lo), "v"(hi)); return r; }
typedef float f32x2 __attribute__((ext_vector_type(2)));
typedef unsigned u32x2 __attribute__((ext_vector_type(2)));
typedef float f32x2 __attribute__((ext_vector_type(2)));
__device__ __forceinline__ float bf2f(unsigned short b) { return __uint_as_float((unsigned)b << 16); }
__device__ __forceinline__ float fsigmoid(float x) { return __builtin_amdgcn_rcpf(1.0f + __builtin_amdgcn_exp2f(-x * LOG2E)); }
__device__ __forceinline__ float flogsig(float x) {
    const float e = __builtin_amdgcn_exp2f(-fabsf(x) * LOG2E);
    const float l1p = (e < 0.03125f) ? e * (1.0f - e * (0.5f - e * (0.33333333f - 0.25f * e))) : __logf(1.0f + e);
    return fminf(x, 0.f) - l1p;
}
__device__ __forceinline__ u32x2 pack4(f32x4 v) { u32x2 w; w.x = cvt_pk_bf16(v[0], v[1]); w.y = cvt_pk_bf16(v[2], v[3]); return w; }

struct EpiSwiGLU {
    static constexpr bool PERM = true, AFTER_DRAIN = false;
    bf16_t* H;
    __device__ __forceinline__ void operator()(const f32x4 (&acc)[2][2][4][2], const Unit& u, int wr, int wc, int fr, int fq) const {
        const int row0 = u.pm * BM + wr * 64 + fr, col0 = u.pn * 128 + wc * 32 + 8 * fq;
#pragma unroll
        for (int ai = 0; ai < 2; ++ai)
#pragma unroll
            for (int m = 0; m < 4; ++m) {
                bf16_t* rowp = H + (size_t)(row0 + ai * HALF + m * 16) * DFF + col0;
                f32x4 h[2];
#pragma unroll
                for (int n = 0; n < 2; ++n) { const f32x4 a = acc[ai][0][m][n], g = acc[ai][1][m][n];
#pragma unroll
                    for (int i = 0; i < 4; ++i) h[n][i] = a[i] * fsigmoid(a[i]) * g[i]; }
                u32x4 w; w.x = cvt_pk_bf16(h[0][0], h[0][1]); w.y = cvt_pk_bf16(h[0][2], h[0][3]); w.z = cvt_pk_bf16(h[1][0], h[1][1]); w.w = cvt_pk_bf16(h[1][2], h[1][3]);
                *(u32x4*)rowp = w;
            }
    }
};
struct EpiRes {
    static constexpr bool PERM = false, AFTER_DRAIN = false;
    const float* resP; const float* resS; float* Z; float s;
    __device__ __forceinline__ void operator()(const f32x4 (&acc)[2][2][4][2], const Unit& u, int wr, int wc, int fr, int fq) const {
        const int row0 = u.pm * BM + wr * 64 + fr, col0 = u.pn * BM + wc * 32 + 4 * fq;
        const float* rb = (u.pm < MP / BM) ? resP : (resS - (size_t)MP * DM);
#pragma unroll
        for (int ai = 0; ai < 2; ++ai) {
            f32x4 r[4][2][2];
#pragma unroll
            for (int m = 0; m < 4; ++m) { const size_t off = (size_t)(row0 + ai * HALF + m * 16) * DM + col0;
#pragma unroll
                for (int bj = 0; bj < 2; ++bj)
#pragma unroll
                    for (int n = 0; n < 2; ++n) r[m][bj][n] = *(const f32x4*)(rb + off + bj * HALF + n * 16); }
#pragma unroll
            for (int m = 0; m < 4; ++m) { const size_t off = (size_t)(row0 + ai * HALF + m * 16) * DM + col0;
#pragma unroll
                for (int bj = 0; bj < 2; ++bj)
#pragma unroll
                    for (int n = 0; n < 2; ++n) *(f32x4*)(Z + off + bj * HALF + n * 16) = r[m][bj][n] * ALPHA + acc[ai][bj][m][n] * s; }
        }
    }
};
struct EpiProjA {
    static constexpr bool PERM = false, AFTER_DRAIN = false;
    const bf16_t* G; float* MM;
    __device__ __forceinline__ void operator()(const f32x4 (&acc)[2][2][4][2], const Unit& u, int wr, int wc, int fr, int fq) const {
        const int row0 = u.pm * BM + wr * 64 + fr, col0 = u.pn * BM + wc * 32 + 4 * fq;
#pragma unroll
        for (int ai = 0; ai < 2; ++ai) {
            u32x2 gq[4][2][2];
#pragma unroll
            for (int m = 0; m < 4; ++m) { const size_t row = (size_t)(row0 + ai * HALF + m * 16);
#pragma unroll
                for (int bj = 0; bj < 2; ++bj)
#pragma unroll
                    for (int n = 0; n < 2; ++n) gq[m][bj][n] = *(const u32x2*)(G + row * 2048 + col0 + bj * HALF + n * 16); }
#pragma unroll
            for (int m = 0; m < 4; ++m) { const size_t row = (size_t)(row0 + ai * HALF + m * 16);
#pragma unroll
                for (int bj = 0; bj < 2; ++bj)
#pragma unroll
                    for (int n = 0; n < 2; ++n) { const int c = col0 + bj * HALF + n * 16; const u32x2 g = gq[m][bj][n];
                        f32x4 gv; gv[0] = __uint_as_float(g.x << 16); gv[1] = __uint_as_float(g.x & 0xffff0000u); gv[2] = __uint_as_float(g.y << 16); gv[3] = __uint_as_float(g.y & 0xffff0000u);
                        *(f32x4*)(MM + row * DM + c) = gv * acc[ai][bj][m][n]; } }
        }
    }
};
struct EpiProjB {
    static constexpr bool PERM = false, AFTER_DRAIN = false;
    const bf16_t* G; const float* MM; bf16_t* MMb;
    __device__ __forceinline__ void operator()(const f32x4 (&acc)[2][2][4][2], const Unit& u, int wr, int wc, int fr, int fq) const {
        const int row0 = u.pm * BM + wr * 64 + fr, col0 = u.pn * BM + wc * 32 + 4 * fq;
#pragma unroll
        for (int ai = 0; ai < 2; ++ai)
#pragma unroll
            for (int m = 0; m < 4; ++m) { const size_t row = (size_t)(row0 + ai * HALF + m * 16);
#pragma unroll
                for (int bj = 0; bj < 2; ++bj)
#pragma unroll
                    for (int n = 0; n < 2; ++n) { const int c = col0 + bj * HALF + n * 16; const u32x2 g = *(const u32x2*)(G + row * 2048 + 1024 + c);
                        f32x4 gv; gv[0] = __uint_as_float(g.x << 16); gv[1] = __uint_as_float(g.x & 0xffff0000u); gv[2] = __uint_as_float(g.y << 16); gv[3] = __uint_as_float(g.y & 0xffff0000u);
                        const f32x4 mm = *(const f32x4*)(MM + row * DM + c);
                        *(u32x2*)(MMb + row * DM + c) = pack4(mm + gv * acc[ai][bj][m][n]); } }
    }
};
struct EpiWin {
    static constexpr bool PERM = false, AFTER_DRAIN = false;
    float* out; bf16_t *QA, *IQ, *QB, *KAp, *VAp, *IKp, *KBp, *VBp, *KAs, *VAs, *IKs, *KBs, *VBs, *G; float *IW, *LF; const f32x2* rope; const float* b_f; const float* b_gate;
    __device__ __forceinline__ void operator()(const f32x4 (&acc)[2][2][4][2], const Unit& u, int wr, int wc, int fr, int fq) const {
        const int T = u.pn; const bool samp = u.pm >= MP / BM;
#pragma unroll
        for (int ai = 0; ai < 2; ++ai)
#pragma unroll
            for (int m = 0; m < 4; ++m) {
                const int row = u.pm * BM + ai * HALF + wr * 64 + m * 16 + fr; const int rs = row - MP;
                const int pos = samp ? PAST + (rs & 63) : (row & (SEQ - 1));
                const size_t srow = samp ? ((size_t)(rs >> 6) * SKV + PAST + (rs & 63)) : (size_t)row;
                if (T == 0 || T == 1 || T == 3 || T == 4) {
                    bf16_t* dst = (T < 2) ? QA + (size_t)row * 512 + 256 * T : IQ + (size_t)row * 512 + 256 * (T - 3);
                    const float sc = (T < 2) ? QSCALE : 1.0f;
#pragma unroll
                    for (int n = 0; n < 2; ++n) { const int j0 = 16 * n + 4 * fq; const f32x4 x1 = acc[ai][0][m][n], x2 = acc[ai][1][m][n]; f32x4 o1, o2;
#pragma unroll
                        for (int i = 0; i < 4; ++i) { const f32x2 cs = rope[pos * 32 + j0 + i]; o1[i] = (x1[i] * cs.x - x2[i] * cs.y) * sc; o2[i] = (x2[i] * cs.x + x1[i] * cs.y) * sc; }
                        *(u32x2*)(dst + 64 * wc + j0) = pack4(o1); *(u32x2*)(dst + 64 * wc + 32 + j0) = pack4(o2); }
                } else if (T == 2) {
                    if (wc < 2) {
                        float* kf = out + (samp ? O_SAK + (size_t)rs * 128 : O_PAK + (size_t)row * 128) + 64 * wc; bf16_t* kb = (samp ? KAs : KAp) + srow * 128 + 64 * wc;
#pragma unroll
                        for (int n = 0; n < 2; ++n) { const int j0 = 16 * n + 4 * fq; const f32x4 x1 = acc[ai][0][m][n], x2 = acc[ai][1][m][n]; f32x4 o1, o2;
#pragma unroll
                            for (int i = 0; i < 4; ++i) { const f32x2 cs = rope[pos * 32 + j0 + i]; o1[i] = x1[i] * cs.x - x2[i] * cs.y; o2[i] = x2[i] * cs.x + x1[i] * cs.y; }
                            *(f32x4*)(kf + j0) = o1; *(f32x4*)(kf + 32 + j0) = o2; *(u32x2*)(kb + j0) = pack4(o1); *(u32x2*)(kb + 32 + j0) = pack4(o2); }
                    } else {
                        float* vf = out + (samp ? O_SAV + (size_t)rs * 128 : O_PAV + (size_t)row * 128); bf16_t* vb = (samp ? VAs : VAp) + srow * 128;
#pragma unroll
                        for (int bj = 0; bj < 2; ++bj)
#pragma unroll
                            for (int n = 0; n < 2; ++n) { const int c = 64 * bj + 32 * (wc - 2) + 16 * n + 4 * fq; *(f32x4*)(vf + c) = acc[ai][bj][m][n]; *(u32x2*)(vb + c) = pack4(acc[ai][bj][m][n]); }
                    }
                } else if (T == 5) {
                    if (wc == 0) {
                        float* kf = out + (samp ? O_SIK + (size_t)rs * 64 : O_PIK + (size_t)row * 64); bf16_t* kb = (samp ? IKs : IKp) + srow * 64;
#pragma unroll
                        for (int n = 0; n < 2; ++n) { const int j0 = 16 * n + 4 * fq; const f32x4 x1 = acc[ai][0][m][n], x2 = acc[ai][1][m][n]; f32x4 o1, o2;
#pragma unroll
                            for (int i = 0; i < 4; ++i) { const f32x2 cs = rope[pos * 32 + j0 + i]; o1[i] = x1[i] * cs.x - x2[i] * cs.y; o2[i] = x2[i] * cs.x + x1[i] * cs.y; }
                            *(f32x4*)(kf + j0) = o1; *(f32x4*)(kf + 32 + j0) = o2; *(u32x2*)(kb + j0) = pack4(o1); *(u32x2*)(kb + 32 + j0) = pack4(o2); }
                    } else if (wc == 1) {
                        const f32x4 v = acc[ai][0][m][0];
                        if (fq < 2) { int fqm = fq; asm volatile("" : "+v"(fqm)); *(f32x4*)(IW + (size_t)row * 8 + 4 * fqm) = v * IWSCALE; }
                        else { int fql = fq; asm volatile("" : "+v"(fql)); const int i0 = 4 * (fql - 2); f32x4 lf; const f32x4 bfv = *(const f32x4*)(b_f + i0);
#pragma unroll
                            for (int i = 0; i < 4; ++i) lf[i] = flogsig(v[i] + bfv[i]);
                            *(f32x4*)(out + (samp ? O_SLF + (size_t)rs * 8 : O_PLF + (size_t)row * 8) + i0) = lf; *(f32x4*)(LF + (size_t)row * 8 + i0) = lf; }
                    }
                } else if (T < 8) {
                    bf16_t* dst = QB + (size_t)row * 512 + 256 * (T - 6) + 32 * wc + 4 * fq;
#pragma unroll
                    for (int bj = 0; bj < 2; ++bj)
#pragma unroll
                        for (int n = 0; n < 2; ++n) *(u32x2*)(dst + 128 * bj + 16 * n) = pack4(acc[ai][bj][m][n] * QSCALE);
                } else if (T < 12) {
                    const bool isv = T >= 10; const int c0 = 256 * ((T - 8) & 1) + 32 * wc + 4 * fq;
                    float* df = out + (isv ? (samp ? O_SBV + (size_t)rs * 512 : O_PBV + (size_t)row * 512) : (samp ? O_SBK + (size_t)rs * 512 : O_PBK + (size_t)row * 512)) + c0;
                    bf16_t* db = (isv ? (samp ? VBs + (size_t)rs * 512 : VBp + (size_t)row * 512) : (samp ? KBs + (size_t)rs * 512 : KBp + (size_t)row * 512)) + c0;
#pragma unroll
                    for (int bj = 0; bj < 2; ++bj)
#pragma unroll
                        for (int n = 0; n < 2; ++n) { *(f32x4*)(df + 128 * bj + 16 * n) = acc[ai][bj][m][n]; *(u32x2*)(db + 128 * bj + 16 * n) = pack4(acc[ai][bj][m][n]); }
                } else {
                    const int c0 = 256 * (T - 12) + 32 * wc + 4 * fq; bf16_t* dst = G + (size_t)row * 2048 + c0;
#pragma unroll
                    for (int bj = 0; bj < 2; ++bj)
#pragma unroll
                        for (int n = 0; n < 2; ++n) { const f32x4 bg = *(const f32x4*)(b_gate + c0 + 128 * bj + 16 * n); f32x4 g;
#pragma unroll
                            for (int i = 0; i < 4; ++i) g[i] = fsigmoid(acc[ai][bj][m][n][i] + bg[i]);
                            *(u32x2*)(dst + 128 * bj + 16 * n) = pack4(g); }
                }
            }
    }
};
template <class Epi, class Sched, bool ALIGN_EPI = false, bool SP2 = false>
__device__ __forceinline__ void gemm_phase(PG8_LAS unsigned char* lds, const Gemm g, const Sched& S, const Epi& E) {
    const int tid = threadIdx.x, wid = __builtin_amdgcn_readfirstlane(tid >> 6), lane = tid & 63, wr = wid >> 2, wc = wid & 3, fr = lane & 15, fq = lane >> 4;
    const int K = g.K, nt = K / BK;
    unsigned voffA[2], voffB[2];
#pragma unroll
    for (int i = 0; i < 2; ++i) { int R, C; stage_rc(tid * 16 + i * 8192, R, C); const int Rb = Epi::PERM ? ((R & ~31) + perm32(R & 31)) : R;
        voffA[i] = (unsigned)(R * K + C) * 2u; voffB[i] = (unsigned)(Rb * K + C) * 2u; }
    const size_t kstep = (size_t)(BK * 2);
    const size_t hstep = (size_t)HALF * K * 2;
    const size_t tstep = 2 * hstep;
    const unsigned ldsw = (unsigned)wid * 1024u;
    const int aoff = lds_byte(wr * 64 + fr, fq * 8), boff = lds_byte(wc * 32 + fr, fq * 8);
#define PG8_SA(b, h) (((b) * 2 + (h)) * HTB)
#define PG8_SB(b, h) ((4 + (b) * 2 + (h)) * HTB)
#define PG8_STAGE(bufoff, gbase, voff) do { _Pragma("unroll") for (int _i = 0; _i < 2; ++_i) \
        __builtin_amdgcn_global_load_lds((const unsigned*)((const char*)(gbase) + (voff)[_i]), (PG8_LAS unsigned*)(lds + (bufoff) + ldsw + _i * 8192), 16, 0, 0); } while (0)
#define PG8_LDA(dst, b, h) do { _Pragma("unroll") for (int m = 0; m < 4; ++m) _Pragma("unroll") for (int k = 0; k < 2; ++k) dst[m][k] = *(const PG8_LAS bf16x8*)(lds + PG8_SA(b, h) + aoff + m * 2048 + k * 1024); } while (0)
#define PG8_LDB(dst, b, h) do { _Pragma("unroll") for (int n = 0; n < 2; ++n) _Pragma("unroll") for (int k = 0; k < 2; ++k) dst[n][k] = *(const PG8_LAS bf16x8*)(lds + PG8_SB(b, h) + boff + n * 2048 + k * 1024); } while (0)
#define PG8_MMA(ai, bj, At, Bt) do { __builtin_amdgcn_s_setprio(1); _Pragma("unroll") for (int m = 0; m < 4; ++m) _Pragma("unroll") for (int n = 0; n < 2; ++n) _Pragma("unroll") for (int k = 0; k < 2; ++k) \
        acc[ai][bj][m][n] = __builtin_amdgcn_mfma_f32_16x16x32_bf16(Bt[n][k], At[m][k], acc[ai][bj][m][n], 0, 0, 0); __builtin_amdgcn_s_setprio(0); } while (0)
#define PG8_WAIT_V(n) asm volatile("s_waitcnt vmcnt(" #n ")" ::: "memory")
#define PG8_WAIT_L(n) asm volatile("s_waitcnt lgkmcnt(" #n ")" ::: "memory")
#define PG8_BAR __builtin_amdgcn_s_barrier()
#define PG8_SCHED __builtin_amdgcn_sched_barrier(0)
    Unit cur, nxt; int ui = 0;
    if (!S.next(0, cur)) return;
    f32x4 acc[2][2][4][2];
#pragma unroll
    for (int a = 0; a < 2; ++a)
#pragma unroll
        for (int b = 0; b < 2; ++b)
#pragma unroll
            for (int m = 0; m < 4; ++m)
#pragma unroll
                for (int n = 0; n < 2; ++n) acc[a][b][m][n] = (f32x4){0.f, 0.f, 0.f, 0.f};
    bf16x8 At[4][2], B0[2][2], B1[2][2];
    const char* cA = (const char*)g.A + (size_t)cur.pm * tstep; const char* cB = (const char*)g.Bt + (size_t)cur.pn * tstep;
    S.a_ready(cur);
    if constexpr (SP2) {
        PG8_STAGE(PG8_SB(0, 0), cB, voffB); PG8_STAGE(PG8_SB(0, 1), cB + hstep, voffB); PG8_STAGE(PG8_SA(0, 0), cA, voffA); PG8_STAGE(PG8_SA(0, 1), cA + hstep, voffA);
        if (wr == 1) PG8_BAR;
        PG8_WAIT_V(2); PG8_BAR;
        PG8_STAGE(PG8_SB(1, 0), cB + kstep, voffB); PG8_STAGE(PG8_SA(1, 0), cA + kstep, voffA); PG8_STAGE(PG8_SB(1, 1), cB + hstep + kstep, voffB);
        PG8_WAIT_V(6); PG8_BAR;
    } else {
        PG8_STAGE(PG8_SB(0, 0), cB, voffB); PG8_STAGE(PG8_SA(0, 0), cA, voffA); PG8_STAGE(PG8_SB(0, 1), cB + hstep, voffB); PG8_STAGE(PG8_SA(0, 1), cA + hstep, voffA);
        if (wr == 1) PG8_BAR;
        PG8_WAIT_V(4); PG8_BAR;
        PG8_STAGE(PG8_SB(1, 0), cB + kstep, voffB); PG8_STAGE(PG8_SA(1, 0), cA + kstep, voffA); PG8_STAGE(PG8_SB(1, 1), cB + hstep + kstep, voffB);
        PG8_WAIT_V(6); PG8_BAR;
    }
    for (;;) {
        const bool has_next = S.next(ui + 1, nxt);
        const char* nA = has_next ? (const char*)g.A + (size_t)nxt.pm * tstep : cA; const char* nB = has_next ? (const char*)g.Bt + (size_t)nxt.pn * tstep : cB;
        for (int t = 0; t < nt; t += 2) {
            const bool last = (t == nt - 2);
            const char* a1 = cA + (size_t)(t + 1) * kstep;
            const char* a2 = last ? nA : cA + (size_t)(t + 2) * kstep; const char* b2 = last ? nB : cB + (size_t)(t + 2) * kstep;
            const char* a3 = a2 + kstep; const char* b3 = b2 + kstep;
            if (last && has_next) S.a_ready(nxt);
            if constexpr (SP2) {
            PG8_LDB(B0, 0, 0); PG8_LDB(B1, 0, 1); PG8_SCHED; PG8_LDA(At, 0, 0); PG8_STAGE(PG8_SA(1, 1), a1 + hstep, voffA);
            PG8_WAIT_V(8); PG8_WAIT_L(0); PG8_BAR; PG8_MMA(0, 0, At, B0); PG8_MMA(0, 1, At, B1); PG8_BAR; PG8_SCHED;
            PG8_LDA(At, 0, 1); PG8_STAGE(PG8_SB(0, 0), b2, voffB); PG8_STAGE(PG8_SB(0, 1), b2 + hstep, voffB); PG8_STAGE(PG8_SA(0, 0), a2, voffA);
            PG8_WAIT_V(8); PG8_WAIT_L(0); PG8_BAR; PG8_MMA(1, 0, At, B0); PG8_MMA(1, 1, At, B1); PG8_BAR; PG8_SCHED;
            PG8_LDB(B0, 1, 0); PG8_LDB(B1, 1, 1); PG8_SCHED; PG8_LDA(At, 1, 0); PG8_STAGE(PG8_SA(0, 1), a2 + hstep, voffA);
            PG8_WAIT_V(8); PG8_WAIT_L(0); PG8_BAR; PG8_MMA(0, 0, At, B0); PG8_MMA(0, 1, At, B1); PG8_BAR; PG8_SCHED;
            PG8_LDA(At, 1, 1); PG8_STAGE(PG8_SB(1, 0), b3, voffB); PG8_STAGE(PG8_SB(1, 1), b3 + hstep, voffB); PG8_STAGE(PG8_SA(1, 0), a3, voffA);
            PG8_WAIT_V(8); PG8_WAIT_L(0); PG8_BAR; PG8_MMA(1, 0, At, B0); PG8_MMA(1, 1, At, B1); PG8_BAR; PG8_SCHED;
            } else {
            PG8_LDB(B0, 0, 0); PG8_SCHED; PG8_LDA(At, 0, 0); PG8_STAGE(PG8_SA(1, 1), a1 + hstep, voffA);
            PG8_WAIT_L(8); PG8_BAR; PG8_WAIT_L(0); PG8_MMA(0, 0, At, B0); PG8_BAR; PG8_SCHED;
            PG8_LDB(B1, 0, 1); PG8_STAGE(PG8_SB(0, 0), b2, voffB);
            PG8_BAR; PG8_WAIT_L(0); PG8_MMA(0, 1, At, B1); PG8_BAR;
            PG8_LDA(At, 0, 1); PG8_STAGE(PG8_SA(0, 0), a2, voffA);
            PG8_BAR; PG8_WAIT_L(0); PG8_MMA(1, 0, At, B0); PG8_BAR; PG8_SCHED;
            PG8_STAGE(PG8_SB(0, 1), b2 + hstep, voffB);
            PG8_WAIT_V(6); PG8_BAR; PG8_MMA(1, 1, At, B1); PG8_BAR;
            PG8_LDB(B0, 1, 0); PG8_SCHED; PG8_LDA(At, 1, 0); PG8_STAGE(PG8_SA(0, 1), a2 + hstep, voffA);
            PG8_WAIT_L(8); PG8_BAR; PG8_WAIT_L(0); PG8_MMA(0, 0, At, B0); PG8_BAR; PG8_SCHED;
            PG8_LDB(B1, 1, 1); PG8_STAGE(PG8_SB(1, 0), b3, voffB);
            PG8_BAR; PG8_WAIT_L(0); PG8_MMA(0, 1, At, B1); PG8_BAR;
            PG8_LDA(At, 1, 1); PG8_STAGE(PG8_SA(1, 0), a3, voffA);
            PG8_BAR; PG8_WAIT_L(0); PG8_MMA(1, 0, At, B0); PG8_BAR; PG8_SCHED;
            PG8_STAGE(PG8_SB(1, 1), b3 + hstep, voffB);
            PG8_WAIT_V(6); PG8_BAR; PG8_MMA(1, 1, At, B1); PG8_BAR;
            }
        }
        if constexpr (ALIGN_EPI) { if (wr == 0) PG8_BAR; }
        if constexpr (!Epi::AFTER_DRAIN) { E(acc, cur, wr, wc, fr, fq); S.done(cur); }
        if (!has_next) break;
#pragma unroll
        for (int a = 0; a < 2; ++a)
#pragma unroll
            for (int b = 0; b < 2; ++b)
#pragma unroll
                for (int m = 0; m < 4; ++m)
#pragma unroll
                    for (int n = 0; n < 2; ++n) acc[a][b][m][n] = (f32x4){0.f, 0.f, 0.f, 0.f};
        cur = nxt; cA = nA; cB = nB; ++ui;
        if constexpr (ALIGN_EPI) { if (wr == 1) PG8_BAR; }
    }
    PG8_WAIT_V(0);
    if constexpr (!ALIGN_EPI) { if (wr == 0) PG8_BAR; }
    PG8_BAR;
    if constexpr (Epi::AFTER_DRAIN) { E.fused(acc, cur, wr, wc, fr, fq, lds, wid, lane); S.done(cur); }
#undef PG8_SA
#undef PG8_SB
#undef PG8_STAGE
#undef PG8_LDA
#undef PG8_LDB
#undef PG8_MMA
#undef PG8_WAIT_V
#undef PG8_WAIT_L
#undef PG8_BAR
#undef PG8_SCHED
}
}
#define LAS __attribute__((address_space(3)))
typedef unsigned short bf16_t;
typedef short bf16x8 __attribute__((ext_vector_type(8)));
typedef short s16x4 __attribute__((ext_vector_type(4)));
typedef float f32x4 __attribute__((ext_vector_type(4)));
typedef float f32x2 __attribute__((ext_vector_type(2)));
typedef float f32x16 __attribute__((ext_vector_type(16)));
typedef unsigned u32x4 __attribute__((ext_vector_type(4)));
typedef unsigned u32x2 __attribute__((ext_vector_type(2)));
using pg8::cvt_pk_bf16; using pg8::bf2f;
constexpr int NWAVES = 8, NTHR = 512, LDS_BYTES = 147456;
constexpr size_t MiB = 1u << 20;
constexpr size_t WS_CTL = 0;
constexpr size_t WS_ROPE = 1 * MiB;
constexpr size_t WS_W1U = 4 * MiB, WS_W1D = 16 * MiB, WS_WIN = 22 * MiB, WS_WPA = 33 * MiB, WS_WPB = 34 * MiB, WS_WO = 35 * MiB, WS_W2U = 37 * MiB, WS_W2D = 49 * MiB;
constexpr size_t WS_XB = 56 * MiB;
constexpr size_t WS_H = 92 * MiB;
constexpr size_t WS_Z = 192 * MiB;
constexpr size_t WS_HF1 = 264 * MiB, WS_HF2 = 336 * MiB;
constexpr size_t WS_HB = 408 * MiB;
constexpr size_t WS_QA = 444 * MiB, WS_IQ = 462 * MiB, WS_QB = 480 * MiB;
constexpr size_t WS_KAP = 498 * MiB, WS_VAP = 502 * MiB, WS_IKP = 506 * MiB;
constexpr size_t WS_KBP = 508 * MiB, WS_VBP = 524 * MiB;
constexpr size_t WS_KAS = 540 * MiB, WS_VAS = 573 * MiB, WS_IKS = 606 * MiB;
constexpr size_t WS_KBS = 623 * MiB, WS_VBS = 625 * MiB;
constexpr size_t WS_IW = 627 * MiB, WS_LF = 628 * MiB;
constexpr size_t WS_CBP = 629 * MiB, WS_CBS = 630 * MiB;
constexpr size_t WS_G = 635 * MiB;
constexpr size_t WS_SEL = 707 * MiB;
constexpr size_t WS_YA = 725 * MiB, WS_YB = 743 * MiB;
constexpr size_t WS_MM = 761 * MiB;
constexpr size_t WS_MMB = 833 * MiB;
constexpr size_t WS_SCR = 869 * MiB;
constexpr size_t WS_END = 997 * MiB;

struct Args {
    const float *x_p, *x_s, *c_ak, *c_av, *c_aik, *c_bk, *c_bv, *c_blf, *w1u, *w1d, *ln1g, *ln1b, *win, *b_f, *b_gate, *wpa, *wpb, *wo, *ln2g, *ln2b, *w2u, *w2d, *ln3g, *ln3b;
    float* out; unsigned char* ws; double invf[32]; int ph_lo, ph_hi;
};
struct Frame { LAS unsigned char* lds; int tid, lane, wave, G, bid; };

__device__ __forceinline__ unsigned f2bf(float f) { unsigned u = __float_as_uint(f); return (u + 0x7fffu + ((u >> 16) & 1u)) >> 16; }
__device__ __forceinline__ unsigned pk2(float lo, float hi) { return cvt_pk_bf16(lo, hi); }
__device__ __forceinline__ float wave_sum(float v) {
#pragma unroll
    for (int o = 1; o < 64; o <<= 1) v += __shfl_xor(v, o);
    return v;
}
__host__ __device__ __forceinline__ int rope_src(int P) { return 64 * ((P & 127) >> 5) + (P & 31) + ((P >> 7) << 5); }
struct SrcId { __device__ __forceinline__ int operator()(int n) const { return n; } };
struct SrcUp { __device__ __forceinline__ int operator()(int n) const { const int t = n >> 8, p = n & 255; return (p < 128) ? 128 * t + p : DFF + 128 * t + (p - 128); } };
struct SrcWin { __device__ __forceinline__ int operator()(int n) const {
    const int T = n >> 8, P = n & 255, bj = P >> 7, q = P & 127;
    if (T < 2) return 256 * T + rope_src(P);
    if (T == 2) return (q < 64) ? 512 + 64 * (q >> 5) + (q & 31) + 32 * bj : 640 + 64 * bj + (q - 64);
    if (T < 5) return 768 + 256 * (T - 3) + rope_src(P);
    if (T == 5) { if (q < 32) return 1280 + q + 32 * bj; if (bj == 0 && q < 40) return 1344 + (q - 32); if (bj == 0 && q < 48) return 2888 + (q - 40); return -1; }
    if (T < 8) return 1352 + 256 * (T - 6) + P;
    if (T < 10) return 1864 + 256 * (T - 8) + P;
    if (T < 12) return 2376 + 256 * (T - 10) + P;
    return 2896 + 256 * (T - 12) + P; } };
template <class F> __device__ __forceinline__ void transpose_item(const float* W, int K, int N, int ND, bf16_t* WT, LAS float* scr, int item, int lane, F srcf) {
    const int nblk = ND / 32, kb = item / nblk, nb = item % nblk, k0 = 64 * kb, n0 = 32 * nb;
    const int sc = srcf(n0 + (lane & 31));
    float wv[32];
#pragma unroll
    for (int i = 0; i < 32; ++i) { const int kk = 2 * i + (lane >> 5); wv[i] = (sc >= 0) ? W[(size_t)(k0 + kk) * N + sc] : 0.f; }
#pragma unroll
    for (int i = 0; i < 32; ++i) { const int kk = 2 * i + (lane >> 5); scr[kk * 33 + (lane & 31)] = wv[i]; }
    asm volatile("s_waitcnt lgkmcnt(0)" ::: "memory");
    const int c = lane & 7;
#pragma unroll
    for (int j = 0; j < 4; ++j) { const int n = (lane >> 3) + 8 * j; const LAS float* s = scr + (8 * c) * 33 + n;
        u32x4 o; o.x = pk2(s[0 * 33], s[1 * 33]); o.y = pk2(s[2 * 33], s[3 * 33]); o.z = pk2(s[4 * 33], s[5 * 33]); o.w = pk2(s[6 * 33], s[7 * 33]);
        *(u32x4*)(WT + (size_t)(n0 + n) * K + k0 + 8 * c) = o; }
    asm volatile("s_waitcnt lgkmcnt(0)" ::: "memory");
}
__device__ __forceinline__ void cvt_rows(const float* src, bf16_t* dst, size_t n4, size_t per_src, size_t per_dst, size_t gt, size_t ngt) {
#pragma unroll 16
    for (size_t e = gt; e < n4; e += ngt) { const size_t b = e / per_src, r = e - b * per_src; const f32x4 v = *(const f32x4*)(src + 4 * e);
        u32x2 w; w.x = pk2(v[0], v[1]); w.y = pk2(v[2], v[3]); *(u32x2*)(dst + 4 * (b * per_dst + r)) = w; }
}
__device__ __forceinline__ void p0_prologue(const Frame& F, const Args& a) {
    unsigned char* ws = a.ws;
    if (F.bid == 0) { unsigned* ctl = (unsigned*)(ws + WS_CTL); if (F.tid < 256) ctl[F.tid] = 0u; for (int i = F.tid; i < 3456; i += NTHR) ctl[4096 + i] = 0u; }
    LAS float* scr = (LAS float*)(F.lds + F.wave * 16384);
    const int gw = F.bid * NWAVES + F.wave, NGW = F.G * NWAVES;
    constexpr int I_UP = 16 * (NUP / 32), I_DN = (DFF / 64) * 32, I_IN = 16 * (NINP / 32), I_P = 8 * 32, I_O = 16 * 32;
    constexpr int NIT = 2 * I_UP + 2 * I_DN + I_IN + 2 * I_P + I_O;
    for (int it = gw; it < NIT; it += NGW) {
        int r = it;
        if (r < I_UP) { transpose_item(a.w1u, DM, NUP, NUP, (bf16_t*)(ws + WS_W1U), scr, r, F.lane, SrcUp()); continue; } r -= I_UP;
        if (r < I_UP) { transpose_item(a.w2u, DM, NUP, NUP, (bf16_t*)(ws + WS_W2U), scr, r, F.lane, SrcUp()); continue; } r -= I_UP;
        if (r < I_DN) { transpose_item(a.w1d, DFF, DM, DM, (bf16_t*)(ws + WS_W1D), scr, r, F.lane, SrcId()); continue; } r -= I_DN;
        if (r < I_DN) { transpose_item(a.w2d, DFF, DM, DM, (bf16_t*)(ws + WS_W2D), scr, r, F.lane, SrcId()); continue; } r -= I_DN;
        if (r < I_IN) { transpose_item(a.win, DM, NIN, NINP, (bf16_t*)(ws + WS_WIN), scr, r, F.lane, SrcWin()); continue; } r -= I_IN;
        if (r < I_P) { transpose_item(a.wpa, 512, DM, DM, (bf16_t*)(ws + WS_WPA), scr, r, F.lane, SrcId()); continue; } r -= I_P;
        if (r < I_P) { transpose_item(a.wpb, 512, DM, DM, (bf16_t*)(ws + WS_WPB), scr, r, F.lane, SrcId()); continue; } r -= I_P;
        transpose_item(a.wo, DM, DM, DM, (bf16_t*)(ws + WS_WO), scr, r, F.lane, SrcId());
    }
    const size_t gt = (size_t)F.bid * NTHR + F.tid, ngt = (size_t)F.G * NTHR;
    cvt_rows(a.x_p, (bf16_t*)(ws + WS_XB), (size_t)MP * DM / 4, (size_t)MP * DM / 4, 0, gt, ngt);
    cvt_rows(a.x_s, (bf16_t*)(ws + WS_XB) + (size_t)MP * DM, (size_t)MS * DM / 4, (size_t)MS * DM / 4, 0, gt, ngt);
    cvt_rows(a.c_ak, (bf16_t*)(ws + WS_KAS), (size_t)DB * PAST * 32, (size_t)PAST * 32, (size_t)SKV * 32, gt, ngt);
    cvt_rows(a.c_av, (bf16_t*)(ws + WS_VAS), (size_t)DB * PAST * 32, (size_t)PAST * 32, (size_t)SKV * 32, gt, ngt);
    cvt_rows(a.c_aik, (bf16_t*)(ws + WS_IKS), (size_t)DB * PAST * 16, (size_t)PAST * 16, (size_t)SKV * 16, gt, ngt);
    f32x2* rope = (f32x2*)(ws + WS_ROPE);
    for (size_t e = gt; e < (size_t)SEQ * 32; e += ngt) {
        const int pos = (int)(e >> 5), j = (int)(e & 31); const double ang = (double)pos * a.invf[j];
        const double kq = __builtin_rint(ang * 0.63661977236758134308); double r = __builtin_fma(-kq, 1.57079632679489655800e+00, ang); r = __builtin_fma(-kq, 6.12323399573676603587e-17, r);
        const double r2 = r * r;
        const double sn = r * (1.0 + r2 * (-1.0 / 6 + r2 * (1.0 / 120 + r2 * (-1.0 / 5040 + r2 * (1.0 / 362880 + r2 * (-1.0 / 39916800 + r2 * (1.0 / 6227020800.0)))))));
        const double cn = 1.0 + r2 * (-0.5 + r2 * (1.0 / 24 + r2 * (-1.0 / 720 + r2 * (1.0 / 40320 + r2 * (-1.0 / 3628800 + r2 * (1.0 / 479001600.0))))));
        const int qd = ((int)(long long)kq) & 3; double s, c;
        if (qd == 0) { s = sn; c = cn; } else if (qd == 1) { s = cn; c = -sn; } else if (qd == 2) { s = -sn; c = -cn; } else { s = -cn; c = sn; }
        rope[e] = (f32x2){(float)c, (float)s};
    }
}
__device__ __forceinline__ void ln_pass(const Frame& F, const float* Z, const float* g, const float* b, float* of, bf16_t* ob) {
    const int gw = F.bid * NWAVES + F.wave, NGW = F.G * NWAVES;
    f32x4 gv[4], bv[4];
#pragma unroll
    for (int j = 0; j < 4; ++j) { gv[j] = *(const f32x4*)(g + 4 * F.lane + 256 * j); bv[j] = *(const f32x4*)(b + 4 * F.lane + 256 * j); }
    for (int rowb = gw; rowb < MT; rowb += 4 * NGW) {
        int rows[4]; bool has[4]; f32x4 v[4][4]; float sm[4], sq[4];
#pragma unroll
        for (int k = 0; k < 4; ++k) { rows[k] = rowb + k * NGW; has[k] = rows[k] < MT; if (!has[k]) rows[k] = rowb; }
#pragma unroll
        for (int k = 0; k < 4; ++k) { const f32x4* zr = (const f32x4*)(Z + (size_t)rows[k] * DM) + F.lane;
#pragma unroll
            for (int j = 0; j < 4; ++j) v[k][j] = zr[64 * j]; }
#pragma unroll
        for (int k = 0; k < 4; ++k) { float s = 0.f;
#pragma unroll
            for (int j = 0; j < 4; ++j) s += (v[k][j][0] + v[k][j][1]) + (v[k][j][2] + v[k][j][3]);
            sm[k] = s; }
#pragma unroll
        for (int o = 1; o < 64; o <<= 1) {
#pragma unroll
            for (int k = 0; k < 4; ++k) sm[k] += __shfl_xor(sm[k], o); }
#pragma unroll
        for (int k = 0; k < 4; ++k) { const float mean = sm[k] * (1.f / DM); float q = 0.f;
#pragma unroll
            for (int j = 0; j < 4; ++j) { v[k][j] = v[k][j] - mean; q += (v[k][j][0] * v[k][j][0] + v[k][j][1] * v[k][j][1]) + (v[k][j][2] * v[k][j][2] + v[k][j][3] * v[k][j][3]); }
            sq[k] = q; }
#pragma unroll
        for (int o = 1; o < 64; o <<= 1) {
#pragma unroll
            for (int k = 0; k < 4; ++k) sq[k] += __shfl_xor(sq[k], o); }
#pragma unroll
        for (int k = 0; k < 4; ++k) {
            if (has[k]) { const float rstd = 1.f / sqrtf(sq[k] * (1.f / DM) + LN_EPS);
#pragma unroll
                for (int j = 0; j < 4; ++j) { const f32x4 y = v[k][j] * rstd * gv[j] + bv[j];
                    *((f32x4*)(of + (size_t)rows[k] * DM) + F.lane + 64 * j) = y;
                    if (ob) { u32x2 w; w.x = pk2(y[0], y[1]); w.y = pk2(y[2], y[3]); *((u32x2*)(ob + (size_t)rows[k] * DM) + F.lane + 64 * j) = w; } } }
        }
    }
}
__device__ __forceinline__ void cumsum_block(const Frame& F, const Args& a, int sb) {
    LAS float* wt = (LAS float*)F.lds;
    const int tid = F.tid, lane = F.lane;
    const bool prm = sb < NB; const int b = prm ? sb : sb - NB;
    const int nrows = prm ? SEQ : SKV; const bool act = 16 * tid < nrows;
    const float* LF = (const float*)(a.ws + WS_LF);
    const float* src = prm ? LF + ((size_t)sb * SEQ + 16 * tid) * 8
                           : (16 * tid < PAST ? a.c_blf + ((size_t)b * PAST + 16 * tid) * 8 : LF + ((size_t)MP + b * DS + (16 * tid - PAST)) * 8);
    f32x4 v[16][2];
#pragma unroll
    for (int r = 0; r < 16; ++r) { v[r][0] = act ? *(const f32x4*)(src + 8 * r) : (f32x4){0.f, 0.f, 0.f, 0.f}; v[r][1] = act ? *(const f32x4*)(src + 8 * r + 4) : (f32x4){0.f, 0.f, 0.f, 0.f}; }
#pragma unroll
    for (int r = 1; r < 16; ++r) { v[r][0] += v[r - 1][0]; v[r][1] += v[r - 1][1]; }
    f32x4 t0 = v[15][0], t1 = v[15][1];
#pragma unroll
    for (int off = 1; off < 64; off <<= 1) {
#pragma unroll
        for (int i = 0; i < 4; ++i) { const float u0 = __shfl_up(t0[i], off), u1 = __shfl_up(t1[i], off); if (lane >= off) { t0[i] += u0; t1[i] += u1; } } }
    if (lane == 63) { *(LAS f32x4*)(wt + F.wave * 8) = t0; *(LAS f32x4*)(wt + F.wave * 8 + 4) = t1; }
    __syncthreads();
    f32x4 e0 = t0 - v[15][0], e1 = t1 - v[15][1];
    for (int ww = 0; ww < F.wave; ++ww) { e0 += *(const LAS f32x4*)(wt + ww * 8); e1 += *(const LAS f32x4*)(wt + ww * 8 + 4); }
    if (act) {
        float* dst = (prm ? (float*)(a.ws + WS_CBP) + (size_t)sb * 8 * SEQ : (float*)(a.ws + WS_CBS) + (size_t)b * 8 * SKV) + 16 * tid;
#pragma unroll
        for (int h = 0; h < 8; ++h) { float* dh = dst + (size_t)h * nrows;
#pragma unroll
            for (int r4 = 0; r4 < 4; ++r4) { f32x4 o;
#pragma unroll
                for (int i = 0; i < 4; ++i) o[i] = -(v[4 * r4 + i][h >> 2][h & 3] + (h < 4 ? e0[h & 3] : e1[h & 3])) * LOG2E;
                *(f32x4*)(dh + 4 * r4) = o; } }
    }
    __syncthreads();
}
__device__ __forceinline__ unsigned f2key(float f) { const unsigned u = __float_as_uint(f); return (u & 0x80000000u) ? ~u : (u | 0x80000000u); }
__device__ __forceinline__ void radix_list(const LAS unsigned* lk, int cnt, int k, LAS unsigned* hist, int lane, unsigned& tau, int& kk_out) {
    unsigned prefix = 0; int kk = k;
#pragma unroll 1
    for (int lev = 0; lev < 4; ++lev) {
        const int shift = 24 - 8 * lev;
        *(LAS u32x4*)(hist + 4 * lane) = (u32x4){0u, 0u, 0u, 0u};
        asm volatile("s_waitcnt lgkmcnt(0)" ::: "memory");
        for (int i = lane; i < cnt; i += 64) { const unsigned key = lk[i];
            if (lev == 0 || (key >> (shift + 8)) == prefix) __hip_atomic_fetch_add(&hist[(key >> shift) & 255u], 1u, __ATOMIC_RELAXED, __HIP_MEMORY_SCOPE_WORKGROUP); }
        asm volatile("s_waitcnt lgkmcnt(0)" ::: "memory");
        const u32x4 hb = *(const LAS u32x4*)(hist + 4 * lane);
        unsigned T = hb[0] + hb[1] + hb[2] + hb[3];
#pragma unroll
        for (int off = 1; off < 64; off <<= 1) { const unsigned v = __shfl_down(T, off); if (lane + off < 64) T += v; }
        const unsigned long long bal = __ballot(T >= (unsigned)kk);
        const int js = __popcll(bal) - 1;
        unsigned run = __shfl(T, (js + 1) & 63); if (js >= 63) run = 0u;
        const u32x4 hj = *(const LAS u32x4*)(hist + 4 * js);
        int digit = 4 * js;
        if (run + hj[3] >= (unsigned)kk) digit += 3;
        else { run += hj[3]; if (run + hj[2] >= (unsigned)kk) digit += 2; else { run += hj[2]; if (run + hj[1] >= (unsigned)kk) digit += 1; else run += hj[1]; } }
        kk -= (int)run; prefix = (prefix << 8) | (unsigned)digit;
        asm volatile("s_waitcnt lgkmcnt(0)" ::: "memory");
    }
    tau = prefix; kk_out = kk;
}
__device__ __forceinline__ void indexer_item(const Frame& F, const Args& a, int item) {
    int b, c, qq; bool samp;
    if (item < 504) { c = 127 - (item >> 3); b = (item >> 2) & 1; qq = item & 3; samp = false; }
    else if (item < 632) { const int s = item - 504; b = s >> 2; qq = s & 3; c = 64; samp = true; }
    else { const int r = item - 632; c = 64 - (r >> 3); b = (r >> 2) & 1; qq = r & 3; samp = false; }
    const int qrow0 = samp ? MP + b * DS + 16 * qq : b * SEQ + 64 * c + 16 * qq;
    const int n = samp ? SKV : 64 * (c + 1);
    const bf16_t* IK = samp ? (const bf16_t*)(a.ws + WS_IKS) + (size_t)b * SKV * 64 : (const bf16_t*)(a.ws + WS_IKP) + (size_t)b * SEQ * 64;
    const bf16_t* IQ = (const bf16_t*)(a.ws + WS_IQ); const float* IW = (const float*)(a.ws + WS_IW);
    int* SEL = (int*)(a.ws + WS_SEL);
    int lane = F.lane; asm volatile("" : "+v"(lane));
    const int l31 = lane & 31, hi = lane >> 5;
    if (n <= 256) {
        for (int e = F.tid; e < 16 * 256; e += NTHR) { const int q = e >> 8, s = e & 255; SEL[(size_t)(qrow0 + q) * 256 + s] = (s < n) ? s : 0; }
        return;
    }
    float* scr = (float*)(a.ws + WS_SCR) + (size_t)F.bid * 16 * 8192;
    if (PROBE_TS >= 20 && F.bid == 0 && F.tid == 0) ((unsigned long long*)(a.ws + WS_CTL + 32768))[30] = __builtin_amdgcn_s_memrealtime();
    {
        bf16x8 afr[4][4]; f32x4 wq[4][2][2];
        const int qa = 2 * ((l31 >> 2) & 1) + (l31 >> 4), ha = 4 * ((l31 >> 3) & 1) + (l31 & 3);
#pragma unroll
        for (int mt = 0; mt < 4; ++mt) {
#pragma unroll
            for (int ks = 0; ks < 4; ++ks) afr[mt][ks] = *(const bf16x8*)(IQ + (size_t)(qrow0 + 4 * mt + qa) * 512 + 64 * ha + 16 * ks + 8 * hi);
#pragma unroll
            for (int aa = 0; aa < 2; ++aa) { const float* wp = IW + (size_t)(qrow0 + 4 * mt + 2 * hi + aa) * 8; wq[mt][aa][0] = *(const f32x4*)wp; wq[mt][aa][1] = *(const f32x4*)(wp + 4); }
        }
        bf16x8 bnx[4];
        { const int kt0 = (F.wave < n / 32) ? F.wave : 0;
#pragma unroll
          for (int ks = 0; ks < 4; ++ks) bnx[ks] = *(const bf16x8*)(IK + (size_t)(32 * kt0 + l31) * 64 + 16 * ks + 8 * hi); }
        for (int kt = F.wave; kt < n / 32; kt += NWAVES) {
            bf16x8 bfr[4];
#pragma unroll
            for (int ks = 0; ks < 4; ++ks) bfr[ks] = bnx[ks];
            { const int ktn = (kt + NWAVES < n / 32) ? kt + NWAVES : kt;
#pragma unroll
              for (int ks = 0; ks < 4; ++ks) bnx[ks] = *(const bf16x8*)(IK + (size_t)(32 * ktn + l31) * 64 + 16 * ks + 8 * hi); }
#pragma unroll
            for (int mt = 0; mt < 4; ++mt) {
                f32x16 acc = {};
#pragma unroll
                for (int ks = 0; ks < 4; ++ks) acc = __builtin_amdgcn_mfma_f32_32x32x16_bf16(afr[mt][ks], bfr[ks], acc, 0, 0, 0);
#pragma unroll
                for (int aa = 0; aa < 2; ++aa) { float s = 0.f;
#pragma unroll
                    for (int h = 0; h < 8; ++h) s += fmaxf(acc[8 * aa + h], 0.f) * wq[mt][aa][h >> 2][h & 3];
                    scr[(size_t)(4 * mt + 2 * hi + aa) * 8192 + 32 * kt + l31] = s; }
            }
        }
    }
    __syncthreads(); __builtin_amdgcn_fence(__ATOMIC_ACQUIRE, "agent");
    if (PROBE_TS >= 20 && F.bid == 0 && F.tid == 0) { unsigned long long* ts = (unsigned long long*)(a.ws + WS_CTL + 32768); const unsigned long long now = __builtin_amdgcn_s_memrealtime(); ts[20] += now - ts[30]; ts[30] = now; }
    LAS unsigned* hist = (LAS unsigned*)(F.lds + F.wave * 14336);
    LAS unsigned* lk = hist + 2048; LAS unsigned short* li = (LAS unsigned short*)(hist + 3072);
    const int n4 = n >> 2;
    for (int q = F.wave; q < 16; q += NWAVES) {
        const float* sp = scr + (size_t)q * 8192;
        u32x4 k[32];
#pragma unroll
        for (int it = 0; it < 32; ++it) {
            const int i4 = 64 * it + lane; const f32x4 v = *(const f32x4*)(sp + 4 * i4); const bool ok = i4 < n4;
            k[it] = (u32x4){ok ? f2key(v[0]) : 0u, ok ? f2key(v[1]) : 0u, ok ? f2key(v[2]) : 0u, ok ? f2key(v[3]) : 0u};
        }
        int* so = SEL + (size_t)(qrow0 + q) * 256;
        unsigned pivot = 0u;
        if (n > 1024) {
#pragma unroll
            for (int j = 0; j < 8; ++j) lk[64 * j + lane] = k[4 * j][0];
            asm volatile("s_waitcnt lgkmcnt(0)" ::: "memory");
            int dummy; radix_list(lk, 512, 30, hist, lane, pivot, dummy);
        }
        int cl = 0;
#pragma unroll
        for (int it = 0; it < 32; ++it)
#pragma unroll
            for (int e = 0; e < 4; ++e) cl += (k[it][e] >= pivot && k[it][e] != 0u) ? 1 : 0;
        int cinc = cl;
#pragma unroll
        for (int off = 1; off < 64; off <<= 1) { const int v = __shfl_up(cinc, off); if (lane >= off) cinc += v; }
        const int c1 = __shfl(cinc, 63);
        if (c1 >= 256 && c1 <= 1024) {
            int p = cinc - cl;
#pragma unroll
            for (int it = 0; it < 32; ++it) {
                if (64 * it < n4) {
#pragma unroll
                    for (int e = 0; e < 4; ++e) { const unsigned key = k[it][e]; if (key >= pivot && key != 0u) { lk[p] = key; li[p] = (unsigned short)(256 * it + 4 * lane + e); ++p; } }
                }
            }
            asm volatile("s_waitcnt lgkmcnt(0)" ::: "memory");
            unsigned tau; int kq; radix_list(lk, c1, 256, hist, lane, tau, kq);
            if (lane < 2) hist[64 + lane] = 0u;
            asm volatile("s_waitcnt lgkmcnt(0)" ::: "memory");
            int ce_l = 0;
            for (int i = lane; i < c1; i += 64) ce_l += (lk[i] == tau) ? 1 : 0;
            int ce = ce_l;
#pragma unroll
            for (int off = 1; off < 64; off <<= 1) ce += __shfl_xor(ce, off);
            if (ce == kq || ce <= 64) {
                if (ce != kq) {
                    for (int i = lane; i < c1; i += 64) if (lk[i] == tau) { const unsigned t = __hip_atomic_fetch_add(&hist[65], 1u, __ATOMIC_RELAXED, __HIP_MEMORY_SCOPE_WORKGROUP); hist[t] = li[i]; }
                    asm volatile("s_waitcnt lgkmcnt(0)" ::: "memory");
                }
                for (int i = lane; i < c1; i += 64) { const unsigned key = lk[i]; const unsigned id = li[i]; bool take = key > tau;
                    if (key == tau) { if (ce == kq) take = true; else { int rk = 0; for (int t = 0; t < ce; ++t) rk += (hist[t] < id) ? 1 : 0; take = rk < kq; } }
                    if (take) { const unsigned pos = __hip_atomic_fetch_add(&hist[64], 1u, __ATOMIC_RELAXED, __HIP_MEMORY_SCOPE_WORKGROUP); if (pos < 256u) so[pos] = (int)id; } }
                asm volatile("s_waitcnt lgkmcnt(0)" ::: "memory");
                continue;
            }
        }
        unsigned prefix = 0; int kk = 256;
#pragma unroll 1
        for (int lev = 0; lev < 3; ++lev) {
            const int shift = (lev == 0) ? 21 : (lev == 1) ? 10 : 0, bits = (lev == 2) ? 10 : 11, nbin = 1 << bits, per = nbin >> 6;
            const unsigned hshift = (unsigned)(shift + bits), bmask = (unsigned)(nbin - 1);
            for (int j = 0; j < per; ++j) hist[lane + 64 * j] = 0u;
            asm volatile("s_waitcnt lgkmcnt(0)" ::: "memory");
#pragma unroll
            for (int it = 0; it < 32; ++it) {
                if (64 * it < n4) {
#pragma unroll
                    for (int e = 0; e < 4; ++e) { const unsigned key = k[it][e];
                        const bool m = (lev == 0) ? (key != 0u) : ((key >> hshift) == prefix && key != 0u);
                        if (m) __hip_atomic_fetch_add(&hist[(key >> shift) & bmask], 1u, __ATOMIC_RELAXED, __HIP_MEMORY_SCOPE_WORKGROUP); }
                }
            }
            asm volatile("s_waitcnt lgkmcnt(0)" ::: "memory");
            unsigned s = 0; for (int j = 0; j < per; ++j) s += hist[lane * per + ((j + lane) & (per - 1))];
            unsigned T = s;
#pragma unroll
            for (int off = 1; off < 64; off <<= 1) { const unsigned v = __shfl_down(T, off); if (lane + off < 64) T += v; }
            const unsigned long long bal = __ballot(T >= (unsigned)kk);
            const int js = __popcll(bal) - 1;
            unsigned run = __shfl(T, (js + 1) & 63); if (js >= 63) run = 0u;
            int digit = js * per;
            for (int bb = per - 1; bb >= 0; --bb) { const unsigned cnt = hist[js * per + bb]; if (run + cnt >= (unsigned)kk) { digit = js * per + bb; break; } run += cnt; }
            kk -= (int)run; prefix = (prefix << bits) | (unsigned)digit;
            asm volatile("s_waitcnt lgkmcnt(0)" ::: "memory");
        }
        int obase = 0, ebase = 0;
        const unsigned long long below = (1ull << lane) - 1ull;
#pragma unroll
        for (int it = 0; it < 32; ++it) {
            if (64 * it < n4) {
                bool tk[4]; unsigned long long be[4]; bool eqf[4]; unsigned long long anyeq = 0ull;
#pragma unroll
                for (int e = 0; e < 4; ++e) { eqf[e] = (k[it][e] == prefix); be[e] = __ballot(eqf[e]); anyeq |= be[e]; tk[e] = k[it][e] > prefix; }
                if (anyeq) {
                    int er = ebase + __popcll(be[0] & below) + __popcll(be[1] & below) + __popcll(be[2] & below) + __popcll(be[3] & below);
#pragma unroll
                    for (int e = 0; e < 4; ++e) { if (eqf[e]) { tk[e] = er < kk; ++er; } }
                    ebase += __popcll(be[0]) + __popcll(be[1]) + __popcll(be[2]) + __popcll(be[3]);
                }
                unsigned long long bt[4];
#pragma unroll
                for (int e = 0; e < 4; ++e) bt[e] = __ballot(tk[e]);
                int pos = obase + __popcll(bt[0] & below) + __popcll(bt[1] & below) + __popcll(bt[2] & below) + __popcll(bt[3] & below);
#pragma unroll
                for (int e = 0; e < 4; ++e) { if (tk[e]) { if (pos < 256) so[pos] = 256 * it + 4 * lane + e; ++pos; } }
                obase += __popcll(bt[0]) + __popcll(bt[1]) + __popcll(bt[2]) + __popcll(bt[3]);
            }
        }
    }
    __syncthreads();
    if (PROBE_TS >= 20 && F.bid == 0 && F.tid == 0) { unsigned long long* ts = (unsigned long long*)(a.ws + WS_CTL + 32768); const unsigned long long now = __builtin_amdgcn_s_memrealtime(); ts[21] += now - ts[30]; ts[30] = now; }
}
__device__ __forceinline__ void dsa_query(const Frame& F, const Args& a, int row) {
    int lane = F.lane; asm volatile("" : "+v"(lane));
    const int j = lane & 15, kq = lane >> 4;
    const bool samp = row >= MP; const int rs = row - MP;
    const int nsel = samp ? 256 : min(256, 64 * (((row & (SEQ - 1)) >> 6) + 1));
    const bf16_t* KA = samp ? (const bf16_t*)(a.ws + WS_KAS) + (size_t)(rs >> 6) * SKV * 128 : (const bf16_t*)(a.ws + WS_KAP) + (size_t)(row >> 13) * SEQ * 128;
    const bf16_t* VA = samp ? (const bf16_t*)(a.ws + WS_VAS) + (size_t)(rs >> 6) * SKV * 128 : (const bf16_t*)(a.ws + WS_VAP) + (size_t)(row >> 13) * SEQ * 128;
    const int* sel = (const int*)(a.ws + WS_SEL) + (size_t)row * 256;
    const bf16_t* QA = (const bf16_t*)(a.ws + WS_QA) + (size_t)row * 512;
    LAS float* pl = (LAS float*)(F.lds + F.wave * 9216);
    LAS int* sl = (LAS int*)(F.lds + F.wave * 9216 + 8192);
#pragma unroll
    for (int i = 0; i < 4; ++i) sl[lane + 64 * i] = sel[lane + 64 * i];
    bf16x8 bq[4];
#pragma unroll
    for (int ks = 0; ks < 4; ++ks) { bf16x8 z = {}; bq[ks] = (j < 8 && (ks >> 1) == (j >> 2)) ? *(const bf16x8*)(QA + 64 * j + 32 * (ks & 1) + 8 * kq) : z; }
    asm volatile("s_waitcnt lgkmcnt(0)" ::: "memory");
    f32x4 acc[16]; const int nt = nsel >> 4;
#pragma unroll
    for (int hb = 0; hb < 2; ++hb) {
        bf16x8 kfr[8][4];
#pragma unroll
        for (int tt = 0; tt < 8; ++tt) { const int idx = sl[16 * (8 * hb + tt) + j]; const bf16_t* kr = KA + (size_t)idx * 128 + 8 * kq;
#pragma unroll
            for (int ks = 0; ks < 4; ++ks) kfr[tt][ks] = *(const bf16x8*)(kr + 32 * ks); }
#pragma unroll
        for (int tt = 0; tt < 8; ++tt) { f32x4 c2 = {0.f, 0.f, 0.f, 0.f};
#pragma unroll
            for (int ks = 0; ks < 4; ++ks) c2 = __builtin_amdgcn_mfma_f32_16x16x32_bf16(kfr[tt][ks], bq[ks], c2, 0, 0, 0);
            acc[8 * hb + tt] = (8 * hb + tt < nt) ? c2 : (f32x4){-INFINITY, -INFINITY, -INFINITY, -INFINITY}; }
    }
    float mx = -INFINITY;
#pragma unroll
    for (int t = 0; t < 16; ++t) mx = fmaxf(mx, fmaxf(fmaxf(acc[t][0], acc[t][1]), fmaxf(acc[t][2], acc[t][3])));
    mx = fmaxf(mx, __shfl_xor(mx, 16)); mx = fmaxf(mx, __shfl_xor(mx, 32));
    float sum = 0.f;
#pragma unroll
    for (int t = 0; t < 16; ++t)
#pragma unroll
        for (int i = 0; i < 4; ++i) { const float p = __builtin_amdgcn_exp2f(acc[t][i] - mx); acc[t][i] = p; sum += p; }
    sum += __shfl_xor(sum, 16); sum += __shfl_xor(sum, 32);
    const float inv = 1.0f / sum;
    if (j < 8) {
#pragma unroll
        for (int t = 0; t < 16; ++t)
#pragma unroll
            for (int i = 0; i < 4; ++i) pl[(16 * t + 4 * kq + i) * 8 + j] = acc[t][i] * inv;
    }
    asm volatile("s_waitcnt lgkmcnt(0)" ::: "memory");
    const int rg = lane >> 4, ch = lane & 15, g = ch >> 3;
    f32x2 o[4][4];
#pragma unroll
    for (int hh = 0; hh < 4; ++hh)
#pragma unroll
        for (int d = 0; d < 4; ++d) o[hh][d] = (f32x2){0.f, 0.f};
    const char* vbase = (const char*)VA + 16 * ch;
#pragma unroll 32
    for (int i = 0; i < (nsel >> 2); ++i) { const int s = 4 * i + rg; const int idx = sl[s];
        const u32x4 v = *(const u32x4*)(vbase + (size_t)idx * 256); const f32x4 p4 = *(const LAS f32x4*)(pl + s * 8 + 4 * g);
        f32x2 vv[4];
#pragma unroll
        for (int d = 0; d < 4; ++d) vv[d] = (f32x2){__uint_as_float(v[d] << 16), __uint_as_float(v[d] & 0xffff0000u)};
#pragma unroll
        for (int hh = 0; hh < 4; ++hh)
#pragma unroll
            for (int d = 0; d < 4; ++d) o[hh][d] += vv[d] * p4[hh]; }
#pragma unroll
    for (int hh = 0; hh < 4; ++hh)
#pragma unroll
        for (int d = 0; d < 4; ++d) { o[hh][d].x += __shfl_xor(o[hh][d].x, 16); o[hh][d].y += __shfl_xor(o[hh][d].y, 16); o[hh][d].x += __shfl_xor(o[hh][d].x, 32); o[hh][d].y += __shfl_xor(o[hh][d].y, 32); }
    { u32x4 wv; const int hh = rg;
      f32x2 s0 = o[0][0], s1 = o[0][1], s2 = o[0][2], s3 = o[0][3];
      if (hh == 1) { s0 = o[1][0]; s1 = o[1][1]; s2 = o[1][2]; s3 = o[1][3]; } else if (hh == 2) { s0 = o[2][0]; s1 = o[2][1]; s2 = o[2][2]; s3 = o[2][3]; } else if (hh == 3) { s0 = o[3][0]; s1 = o[3][1]; s2 = o[3][2]; s3 = o[3][3]; }
      wv.x = pk2(s0.x, s0.y); wv.y = pk2(s1.x, s1.y); wv.z = pk2(s2.x, s2.y); wv.w = pk2(s3.x, s3.y);
      *(u32x4*)((bf16_t*)(a.ws + WS_YA) + (size_t)row * 512 + 64 * (4 * g + hh) + 8 * (ch & 7)) = wv; }
    asm volatile("s_waitcnt lgkmcnt(0)" ::: "memory");
}
constexpr int VST = 72;
constexpr int FOX_V = 0, FOX_M = 8 * 64 * VST * 2  , FOX_L = FOX_M + 2048, FOX_O = FOX_L + 256, FOX_END = FOX_O + 64 * 65 * 4;
static_assert(FOX_END + 65 * 64 * 4 + 64 * 144 <= 131072, "fox lds");
__device__ __forceinline__ int crow(int r, int hi) { return (r & 3) + 8 * (r >> 2) + 4 * hi; }
__device__ __forceinline__ bf16x8 cvt8(f32x4 a, f32x4 b) { u32x4 w; w.x = pk2(a[0], a[1]); w.y = pk2(a[2], a[3]); w.z = pk2(b[0], b[1]); w.w = pk2(b[2], b[3]); return __builtin_bit_cast(bf16x8, w); }
__device__ __forceinline__ void fox_unit(const Frame& F, const Args& a, int unit) {
    constexpr bool samp = true; int b, h, qi, ntiles, rowq0; const float* Cb;
    if (samp) { b = unit >> 3; h = unit & 7; qi = 64; ntiles = 65; rowq0 = MP + b * DS; Cb = (const float*)(a.ws + WS_CBS) + ((size_t)b * 8 + h) * SKV; }
    else { const int r = unit - 256; qi = 127 - (r >> 4); b = (r >> 3) & 1; h = r & 7; ntiles = qi + 1; rowq0 = b * SEQ + 64 * qi; Cb = (const float*)(a.ws + WS_CBP) + ((size_t)b * 8 + h) * SEQ; }
    int lane = F.lane; asm volatile("" : "+v"(lane)); int tidl = F.tid; asm volatile("" : "+v"(tidl));
    const int q32 = lane & 31, hi = lane >> 5, w = F.wave;
    const bf16_t* Kb = samp ? (const bf16_t*)(a.ws + WS_KBS) + (size_t)(b * DS) * 512 + 64 * h : (const bf16_t*)(a.ws + WS_KBP) + (size_t)(b * SEQ) * 512 + 64 * h;
    const bf16_t* Vb = samp ? (const bf16_t*)(a.ws + WS_VBS) + (size_t)(b * DS) * 512 + 64 * h : (const bf16_t*)(a.ws + WS_VBP) + (size_t)(b * SEQ) * 512 + 64 * h;
    const float* Kc = a.c_bk + ((size_t)b * PAST * 8 + h) * 64; const float* Vc = a.c_bv + ((size_t)b * PAST * 8 + h) * 64;
    LAS bf16_t* vl = (LAS bf16_t*)(F.lds + FOX_V) + w * 64 * VST;
    LAS float* mb = (LAS float*)(F.lds + FOX_M); LAS float* lt = (LAS float*)(F.lds + FOX_L); LAS float* ot = (LAS float*)(F.lds + FOX_O);
    for (int e = tidl; e < 64 * 65 + 64; e += NTHR) lt[e] = 0.f;
    LAS float* cbl = (LAS float*)(F.lds + FOX_END);
    for (int e = tidl; e < ntiles * 16; e += NTHR) *(LAS f32x4*)(cbl + 4 * e) = *(const f32x4*)(Cb + 4 * e);
    __syncthreads();
    LAS unsigned char* ql = F.lds + FOX_END + 65 * 64 * 4;
    { const bf16_t* QB = (const bf16_t*)(a.ws + WS_QB); const int r = tidl >> 3, ch = tidl & 7;
      *(LAS u32x4*)(ql + r * 144 + 16 * ch) = *(const u32x4*)(QB + (size_t)(rowq0 + r) * 512 + 64 * h + 8 * ch); }
    __syncthreads();
    const LAS unsigned char* qlw = ql + q32 * 144 + 16 * hi;
    float mrun[2] = {-INFINITY, -INFINITY}, lrun[2] = {0.f, 0.f};
    f32x16 o[2][2];
#pragma unroll
    for (int qb = 0; qb < 2; ++qb)
#pragma unroll
        for (int db = 0; db < 2; ++db)
#pragma unroll
            for (int r = 0; r < 16; ++r) o[qb][db][r] = 0.f;
    const int gi = lane >> 4, li = lane & 15;
    const unsigned kofb = (unsigned)(q32 * 1024 + 16 * hi);
    const unsigned kofc = (unsigned)(q32 * 2048 + 32 * hi);
    const unsigned cof = (unsigned)(16 * hi);
    const int troff = ((4 * hi + (li >> 2)) * VST + 16 * (gi & 1) + 4 * (li & 3));
    const int nmine = (w < ntiles) ? ((ntiles - 1 - w) >> 3) + 1 : 0;
    for (int ii = nmine - 1; ii >= 0; --ii) {
        const int tile = w + 8 * ii;
        const bool cache = samp && tile < 64, diag = (tile == ntiles - 1);
        const int kv0 = 64 * tile; const int kvl = samp ? (cache ? kv0 : 0) : kv0;
        bf16x8 kf[2][4];
        if (cache) {
            const char* kp = (const char*)Kc + (size_t)kvl * 2048 + kofc;
#pragma unroll
            for (int hf = 0; hf < 2; ++hf) { const char* kph = kp + hf * 65536;
#pragma unroll
                for (int ks = 0; ks < 4; ++ks) kf[hf][ks] = cvt8(*(const f32x4*)(kph + 64 * ks), *(const f32x4*)(kph + 64 * ks + 16)); }
        } else {
            const char* kp = (const char*)Kb + (size_t)kvl * 1024 + kofb;
#pragma unroll
            for (int hf = 0; hf < 2; ++hf) { const char* kph = kp + hf * 32768;
#pragma unroll
                for (int ks = 0; ks < 4; ++ks) kf[hf][ks] = *(const bf16x8*)(kph + 32 * ks); }
        }
        asm volatile("" ::: "memory");
        f32x16 s[2][2]; float mx[2];
#pragma unroll
        for (int qb = 0; qb < 2; ++qb) {
#pragma unroll
            for (int hf = 0; hf < 2; ++hf) {
#pragma unroll
                for (int g4 = 0; g4 < 4; ++g4) { const f32x4 c4 = *(const LAS f32x4*)((const LAS char*)(cbl + kv0) + cof + (128 * hf + 32 * g4));
                    s[qb][hf][4 * g4 + 0] = c4[0]; s[qb][hf][4 * g4 + 1] = c4[1]; s[qb][hf][4 * g4 + 2] = c4[2]; s[qb][hf][4 * g4 + 3] = c4[3]; }
#pragma unroll
                for (int ks = 0; ks < 4; ++ks) s[qb][hf] = __builtin_amdgcn_mfma_f32_32x32x16_bf16(kf[hf][ks], *(const LAS bf16x8*)(qlw + qb * 32 * 144 + 32 * ks), s[qb][hf], 0, 0, 0);
            }
            if (diag) { const int ql = 32 * qb + q32;
#pragma unroll
                for (int hf = 0; hf < 2; ++hf)
#pragma unroll
                    for (int r = 0; r < 16; ++r) if (32 * hf + crow(r, hi) > ql) s[qb][hf][r] = -INFINITY; }
            float m_ = -INFINITY;
#pragma unroll
            for (int r = 0; r < 16; ++r) m_ = fmaxf(m_, fmaxf(s[qb][0][r], s[qb][1][r]));
            mx[qb] = fmaxf(m_, __shfl_xor(m_, 32));
        }
        if (!__all(mx[0] < mrun[0] - 160.0f && mx[1] < mrun[1] - 160.0f)) {
            if (cache) {
                const char* vp = (const char*)Vc + (size_t)kvl * 2048 + (unsigned)(lane * 2048);
#pragma unroll
                for (int c = 0; c < 16; ++c) { const f32x4 v = *(const f32x4*)(vp + 16 * c);
                    u32x2 wv; wv.x = pk2(v[0], v[1]); wv.y = pk2(v[2], v[3]); *(LAS u32x2*)(vl + lane * VST + 4 * c) = wv;
                    if ((c & 7) == 7) asm volatile("" ::: "memory"); }
            } else {
                const char* vp = (const char*)Vb + (size_t)kvl * 1024 + (unsigned)(lane * 1024);
#pragma unroll
                for (int c = 0; c < 8; ++c) *(LAS u32x4*)(vl + lane * VST + 8 * c) = *(const u32x4*)(vp + 16 * c);
                asm volatile("" ::: "memory");
            }
#pragma unroll
            for (int qb = 0; qb < 2; ++qb) {
                const float mn = fmaxf(mrun[qb], mx[qb]); const float al = __builtin_amdgcn_exp2f(mrun[qb] - mn); mrun[qb] = mn;
                float sum = 0.f;
#pragma unroll
                for (int hf = 0; hf < 2; ++hf)
#pragma unroll
                    for (int r = 0; r < 16; ++r) { const float p = __builtin_amdgcn_exp2f(s[qb][hf][r] - mn); s[qb][hf][r] = p; sum += p; }
                lrun[qb] = lrun[qb] * al + sum;
                if (__any(al != 1.0f)) {
#pragma unroll
                    for (int db = 0; db < 2; ++db)
#pragma unroll
                        for (int r = 0; r < 16; ++r) o[qb][db][r] *= al; }
                bf16x8 pk[4];
#pragma unroll
                for (int k4 = 0; k4 < 4; ++k4) { const int hf = k4 >> 1, r0 = 8 * (k4 & 1); u32x4 wv;
                    wv.x = pk2(s[qb][hf][r0 + 0], s[qb][hf][r0 + 1]); wv.y = pk2(s[qb][hf][r0 + 2], s[qb][hf][r0 + 3]); wv.z = pk2(s[qb][hf][r0 + 4], s[qb][hf][r0 + 5]); wv.w = pk2(s[qb][hf][r0 + 6], s[qb][hf][r0 + 7]);
                    pk[k4] = __builtin_bit_cast(bf16x8, wv); }
                asm volatile("s_waitcnt lgkmcnt(0)" ::: "memory");
#pragma unroll
                for (int db = 0; db < 2; ++db)
#pragma unroll
                    for (int k4 = 0; k4 < 4; ++k4) {
                        const LAS bf16_t* p0 = vl + troff + (16 * k4) * VST + 32 * db;
                        const s16x4 lo = __builtin_bit_cast(s16x4, __builtin_amdgcn_ds_read_tr16_b64_v4i16((LAS s16x4*)p0));
                        const s16x4 hh = __builtin_bit_cast(s16x4, __builtin_amdgcn_ds_read_tr16_b64_v4i16((LAS s16x4*)(p0 + 8 * VST)));
                        const bf16x8 vt = (bf16x8){lo[0], lo[1], lo[2], lo[3], hh[0], hh[1], hh[2], hh[3]};
                        o[qb][db] = __builtin_amdgcn_mfma_f32_32x32x16_bf16(vt, pk[k4], o[qb][db], 0, 0, 0);
                    }
            }
            asm volatile("s_waitcnt lgkmcnt(0)" ::: "memory");
        }
    }
#pragma unroll
    for (int qb = 0; qb < 2; ++qb) { lrun[qb] += __shfl_xor(lrun[qb], 32); if (hi == 0) mb[w * 64 + 32 * qb + q32] = mrun[qb]; }
    __syncthreads();
#pragma unroll
    for (int qb = 0; qb < 2; ++qb) {
        const int q = 32 * qb + q32; float mg = -INFINITY;
#pragma unroll
        for (int ww = 0; ww < NWAVES; ++ww) mg = fmaxf(mg, mb[ww * 64 + q]);
        const float sc = __builtin_amdgcn_exp2f(mrun[qb] - mg);
        if (w < ntiles) {
            if (hi == 0) __hip_atomic_fetch_add(lt + q, lrun[qb] * sc, __ATOMIC_RELAXED, __HIP_MEMORY_SCOPE_WORKGROUP);
#pragma unroll
            for (int db = 0; db < 2; ++db)
#pragma unroll
                for (int r = 0; r < 16; ++r) __hip_atomic_fetch_add(ot + q * 65 + 32 * db + crow(r, hi), o[qb][db][r] * sc, __ATOMIC_RELAXED, __HIP_MEMORY_SCOPE_WORKGROUP);
        }
    }
    __syncthreads();
    { const int q = tidl >> 3, d0 = 8 * (tidl & 7); const float il = 1.0f / lt[q]; const LAS float* op = ot + q * 65 + d0;
      u32x4 wv; wv.x = pk2(op[0] * il, op[1] * il); wv.y = pk2(op[2] * il, op[3] * il); wv.z = pk2(op[4] * il, op[5] * il); wv.w = pk2(op[6] * il, op[7] * il);
      *(u32x4*)((bf16_t*)(a.ws + WS_YB) + (size_t)(rowq0 + q) * 512 + 64 * h + d0) = wv; }
    __syncthreads();
}

constexpr int FP_ROWB = 144, FP_V = 64 * FP_ROWB, FP_C = 2 * FP_V, FP_BUF = FP_C + 256;
__device__ __forceinline__ void fox_prompt_unit(const Frame& F, const Args& a, int b, int h, int j) {
    int lane = F.lane; asm volatile("" : "+v"(lane)); int tid = F.tid; asm volatile("" : "+v"(tid));
    const int q32 = lane & 31, hi = lane >> 5, w = F.wave;
    const int NT = 4 * (j + 1), myT = 4 * j + (w >> 1);
    const char* kg = (const char*)((const bf16_t*)(a.ws + WS_KBP) + (size_t)(b * SEQ) * 512 + 64 * h) + (size_t)(tid >> 3) * 1024 + 16 * (tid & 7);
    const char* vg = (const char*)((const bf16_t*)(a.ws + WS_VBP) + (size_t)(b * SEQ) * 512 + 64 * h) + (size_t)(tid >> 3) * 1024 + 16 * (tid & 7);
    const float* cg = (const float*)(a.ws + WS_CBP) + ((size_t)b * 8 + h) * SEQ + 4 * (tid & 15);
    LAS unsigned char* lb = F.lds;
    const int lw = (tid >> 3) * FP_ROWB + 16 * (tid & 7);
    const bf16_t* qp = (const bf16_t*)(a.ws + WS_QB) + (size_t)(b * SEQ + 256 * j + 32 * w + q32) * 512 + 64 * h + 8 * hi;
    bf16x8 qf[4];
#pragma unroll
    for (int ks = 0; ks < 4; ++ks) qf[ks] = *(const bf16x8*)(qp + 16 * ks);
    u32x4 kr[2], vr[2]; f32x4 br[2];
#pragma unroll
    for (int sb = 0; sb < 2; ++sb) { kr[sb] = *(const u32x4*)(kg + (size_t)(NT - 1 - sb) * 65536); vr[sb] = *(const u32x4*)(vg + (size_t)(NT - 1 - sb) * 65536); br[sb] = *(const f32x4*)(cg + 64 * (NT - 1 - sb)); }
#pragma unroll
    for (int sb = 0; sb < 2; ++sb) { *(LAS u32x4*)(lb + sb * FP_BUF + lw) = kr[sb]; *(LAS u32x4*)(lb + sb * FP_BUF + FP_V + lw) = vr[sb]; if (tid < 16) *(LAS f32x4*)(lb + sb * FP_BUF + FP_C + 16 * tid) = br[sb]; }
    __syncthreads();
    float mrun = -INFINITY, lrun = 0.f; f32x16 o[2];
#pragma unroll
    for (int db = 0; db < 2; ++db)
#pragma unroll
        for (int r = 0; r < 16; ++r) o[db][r] = 0.f;
    const int gi = lane >> 4, li = lane & 15;
    const int troff = ((4 * hi + (li >> 2)) * FP_ROWB + 2 * (16 * (gi & 1) + 4 * (li & 3)));
    const int kroff = q32 * FP_ROWB + 16 * hi;
    for (int st = 0; st < NT / 2; ++st) {
        const int t0 = NT - 1 - 2 * st; const int cur = st & 1; const bool more = (t0 >= 3);
        if (more) {
#pragma unroll
            for (int sb = 0; sb < 2; ++sb) { kr[sb] = *(const u32x4*)(kg + (size_t)(t0 - 2 - sb) * 65536); vr[sb] = *(const u32x4*)(vg + (size_t)(t0 - 2 - sb) * 65536); br[sb] = *(const f32x4*)(cg + 64 * (t0 - 2 - sb)); } }
#pragma unroll
        for (int sb = 0; sb < 2; ++sb) {
        const int t = t0 - sb;
        if (t <= myT) {
            const LAS unsigned char* kb_ = lb + (2 * cur + sb) * FP_BUF; const LAS unsigned char* vb_ = kb_ + FP_V; const LAS unsigned char* cb_ = kb_ + FP_C + 16 * hi;
            f32x16 s[2];
#pragma unroll
            for (int hf = 0; hf < 2; ++hf) {
#pragma unroll
                for (int g4 = 0; g4 < 4; ++g4) { const f32x4 c4 = *(const LAS f32x4*)(cb_ + 128 * hf + 32 * g4);
                    s[hf][4 * g4 + 0] = c4[0]; s[hf][4 * g4 + 1] = c4[1]; s[hf][4 * g4 + 2] = c4[2]; s[hf][4 * g4 + 3] = c4[3]; }
#pragma unroll
                for (int ks = 0; ks < 4; ++ks) s[hf] = __builtin_amdgcn_mfma_f32_32x32x16_bf16(*(const LAS bf16x8*)(kb_ + kroff + hf * 32 * FP_ROWB + 32 * ks), qf[ks], s[hf], 0, 0, 0);
            }
            if (t == myT) { const int ql = 32 * (w & 1) + q32;
#pragma unroll
                for (int hf = 0; hf < 2; ++hf)
#pragma unroll
                    for (int r = 0; r < 16; ++r) if (32 * hf + crow(r, hi) > ql) s[hf][r] = -INFINITY; }
            float mx = -INFINITY;
#pragma unroll
            for (int r = 0; r < 16; ++r) mx = fmaxf(mx, fmaxf(s[0][r], s[1][r]));
            mx = fmaxf(mx, __shfl_xor(mx, 32));
            if (!__all(mx < mrun - 160.0f)) {
            const float mn = fmaxf(mrun, mx); const float al = __builtin_amdgcn_exp2f(mrun - mn); mrun = mn;
            float sum = 0.f;
#pragma unroll
            for (int hf = 0; hf < 2; ++hf)
#pragma unroll
                for (int r = 0; r < 16; ++r) { const float p = __builtin_amdgcn_exp2f(s[hf][r] - mn); s[hf][r] = p; sum += p; }
            lrun = lrun * al + sum;
            if (__any(al != 1.0f)) {
#pragma unroll
            for (int db = 0; db < 2; ++db)
#pragma unroll
                for (int r = 0; r < 16; ++r) o[db][r] *= al; }
            bf16x8 pk[4];
#pragma unroll
            for (int k4 = 0; k4 < 4; ++k4) { const int hf = k4 >> 1, r0 = 8 * (k4 & 1); u32x4 wv;
                wv.x = pk2(s[hf][r0 + 0], s[hf][r0 + 1]); wv.y = pk2(s[hf][r0 + 2], s[hf][r0 + 3]); wv.z = pk2(s[hf][r0 + 4], s[hf][r0 + 5]); wv.w = pk2(s[hf][r0 + 6], s[hf][r0 + 7]);
                pk[k4] = __builtin_bit_cast(bf16x8, wv); }
#pragma unroll
            for (int db = 0; db < 2; ++db)
#pragma unroll
                for (int k4 = 0; k4 < 4; ++k4) {
                    const LAS unsigned char* p0 = vb_ + troff + (16 * k4) * FP_ROWB + 64 * db;
                    const s16x4 lo = __builtin_bit_cast(s16x4, __builtin_amdgcn_ds_read_tr16_b64_v4i16((LAS s16x4*)p0));
                    const s16x4 hh = __builtin_bit_cast(s16x4, __builtin_amdgcn_ds_read_tr16_b64_v4i16((LAS s16x4*)(p0 + 8 * FP_ROWB)));
                    const bf16x8 vt = (bf16x8){lo[0], lo[1], lo[2], lo[3], hh[0], hh[1], hh[2], hh[3]};
                    o[db] = __builtin_amdgcn_mfma_f32_32x32x16_bf16(vt, pk[k4], o[db], 0, 0, 0);
                }
            }
        }
        }
        if (more) {
#pragma unroll
            for (int sb = 0; sb < 2; ++sb) { LAS unsigned char* nb = lb + (2 * (cur ^ 1) + sb) * FP_BUF; *(LAS u32x4*)(nb + lw) = kr[sb]; *(LAS u32x4*)(nb + FP_V + lw) = vr[sb]; if (tid < 16) *(LAS f32x4*)(nb + FP_C + 16 * tid) = br[sb]; } }
        __syncthreads();
    }
    lrun += __shfl_xor(lrun, 32);
    const float il = 1.0f / lrun;
    bf16_t* yo = (bf16_t*)(a.ws + WS_YB) + (size_t)(b * SEQ + 256 * j + 32 * w + q32) * 512 + 64 * h + 4 * hi;
#pragma unroll
    for (int db = 0; db < 2; ++db)
#pragma unroll
        for (int g4 = 0; g4 < 4; ++g4) { u32x2 wv; wv.x = pk2(o[db][4 * g4 + 0] * il, o[db][4 * g4 + 1] * il); wv.y = pk2(o[db][4 * g4 + 2] * il, o[db][4 * g4 + 3] * il);
            *(u32x2*)(yo + 32 * db + 8 * g4) = wv; }
}
#define XB_TMO      128
#define XB_XCNT(j)  (256  + 64 * (j))
#define XB_XSUB(j)  (1280 + 64 * (j))
#define XB_XGEN(j)  (2304 + 64 * (j))
#define XB_TOP      3328
#define XB_TOPGEN   3392
#define XCD_BAR_WORDS 3456
#define XB_SPIN_CAP (1u << 18)

__device__ __forceinline__ unsigned xb_ld(unsigned* p)              { return __hip_atomic_load(p, __ATOMIC_RELAXED, __HIP_MEMORY_SCOPE_AGENT); }
__device__ __forceinline__ unsigned xb_add(unsigned* p, unsigned v) { return __hip_atomic_fetch_add(p, v, __ATOMIC_RELAXED, __HIP_MEMORY_SCOPE_AGENT); }
__device__ __forceinline__ unsigned xb_xcc_id() { return (unsigned)__builtin_amdgcn_s_getreg((3 << 11) | 20) & 0xFu; }
#define XB_SPIN(cond, bar) do { unsigned _sp = 0; while (cond) { __builtin_amdgcn_s_sleep(1); \
    if ((++_sp & 255u) == 0u) { if (xb_ld(&(bar)[XB_TMO])) break; if (_sp > XB_SPIN_CAP) { atomicAdd(&(bar)[XB_TMO], 1u); break; } } } } while (0)

struct XcdBarrier {
    unsigned* bar; unsigned x;
    volatile LAS unsigned* st;
};

__device__ __forceinline__ XcdBarrier xcd_barrier_post(unsigned* bar, volatile LAS unsigned* st) {
    XcdBarrier b; b.bar = bar; b.x = xb_xcc_id(); b.st = st;
    if (threadIdx.x == 0) (void)xb_add(&bar[XB_XCNT(b.x)], 1u);
    return b;
}
__device__ __forceinline__ void xcd_barrier_complete(unsigned* bar, unsigned x, unsigned& nloc, unsigned& nx) {
    const unsigned G = gridDim.x * gridDim.y * gridDim.z;
    unsigned sum, cnt, mine, sp = 0u;
    for (;;) {
        sum = 0u; cnt = 0u; mine = 0u;
#pragma unroll
        for (unsigned j = 0; j < 16; ++j) { const unsigned c = xb_ld(&bar[XB_XCNT(j)]); sum += c; cnt += (c > 0u) ? 1u : 0u; mine = (j == x) ? c : mine; }
        if (sum == G) break;
        __builtin_amdgcn_s_sleep(1);
        if ((++sp & 255u) == 0u) { if (xb_ld(&bar[XB_TMO])) break; if (sp > XB_SPIN_CAP) { atomicAdd(&bar[XB_TMO], 1u); break; } }
    }
    nloc = mine > 0u ? mine : 1u; nx = cnt > 0u ? cnt : 1u;
}

__device__ __forceinline__ void xcd_barrier(const XcdBarrier& b) {
    asm volatile("s_waitcnt vmcnt(0)" ::: "memory");
    __syncthreads();
    if (threadIdx.x == 0) {
        unsigned* bar = b.bar;
        __builtin_amdgcn_s_waitcnt(0);
        unsigned nloc = b.st[0], nx = b.st[1];
        if (nloc == 0u) { xcd_barrier_complete(bar, b.x, nloc, nx); b.st[0] = nloc; b.st[1] = nx; }
        const unsigned old = xb_add(&bar[XB_XSUB(b.x)], 1u);
        const unsigned gen = old / nloc;
        if (old + 1u == (gen + 1u) * nloc) {
            __builtin_amdgcn_fence(__ATOMIC_RELEASE, "agent");
            asm volatile("s_waitcnt vmcnt(0)" ::: "memory");
            const unsigned og = xb_add(&bar[XB_TOP], 1u);
            const unsigned tg = og / nx;
            if (og + 1u == (tg + 1u) * nx) xb_add(&bar[XB_TOPGEN], 1u);
            else XB_SPIN(xb_ld(&bar[XB_TOPGEN]) == tg, bar);
            __builtin_amdgcn_fence(__ATOMIC_ACQUIRE, "agent");
            xb_add(&bar[XB_XGEN(b.x)], 1u);
            asm volatile("s_waitcnt vmcnt(0)" ::: "memory");
        } else {
            XB_SPIN(xb_ld(&bar[XB_XGEN(b.x)]) == gen, bar);
            __builtin_amdgcn_fence(__ATOMIC_ACQUIRE, "agent");
            asm volatile("s_waitcnt vmcnt(0)" ::: "memory");
        }
    }
    __syncthreads();
}
constexpr int N_PHASES = 13;
#ifndef MK_PER_PHASE
#define MK_PER_PHASE 0
#endif
template <class Epi> __device__ __forceinline__ void run_gemm(const Frame& F, const bf16_t* A, const bf16_t* Bt, int N, int K, const Epi& E) {
    pg8::Gemm g{A, Bt, MT, N, K}; pg8::StaticOrder S; S.init(MT, N, F.G, F.bid);
    pg8::gemm_phase<Epi, pg8::StaticOrder, true, true>(F.lds, g, S, E);
}
__global__ void __launch_bounds__(NTHR, 2) mega_fwd(Args a) {
    __builtin_assume(__builtin_amdgcn_workitem_id_y() == 0); __builtin_assume(__builtin_amdgcn_workitem_id_z() == 0);
    extern __shared__ __attribute__((aligned(16))) unsigned char lds_raw[];
    cg::grid_group grid = cg::this_grid();
    Frame F; F.lds = (LAS unsigned char*)lds_raw; F.tid = threadIdx.x; F.lane = F.tid & 63; F.wave = __builtin_amdgcn_readfirstlane(F.tid >> 6); F.G = gridDim.x; F.bid = blockIdx.x;
    unsigned char* ws = a.ws;
    LAS int* sh_item = (LAS int*)(F.lds + 131072);
    volatile LAS unsigned* bst = (volatile LAS unsigned*)(F.lds + 131072 + 64);
    if (F.tid < 2) bst[F.tid] = 0u;
    __syncthreads();
    const bool fused = (a.ph_hi - a.ph_lo) > 1;
    XcdBarrier xbar; xbar.bar = (unsigned*)(ws + WS_CTL) + 4096; xbar.x = 0; xbar.st = bst;
    const int lo = a.ph_lo, hi = a.ph_hi;
#define IN(k) (lo <= (k) && (k) < hi)
#ifndef PROBE_TS
#define PROBE_TS -1
#endif
#define STAMP(k) do { if (PROBE_TS >= 0 && F.bid == 0 && F.tid == 0) ((unsigned long long*)(ws + WS_CTL + 32768))[k] = __builtin_amdgcn_s_memrealtime(); } while (0)
#define SEAM(k) do { if (IN(k) && IN((k) + 1)) { if ((k) == 0) grid.sync(); else xcd_barrier(xbar); } STAMP((k) + 1); } while (0)
    STAMP(0);
#ifndef PROBE_DUP
#define PROBE_DUP 0
#endif
#define REP(code) (PROBE_DUP == (code) ? 2 : 1)
    if (IN(0)) { for (int rep = 0; rep < REP(1); ++rep) p0_prologue(F, a); } SEAM(0);
    if (fused) xbar = xcd_barrier_post((unsigned*)(ws + WS_CTL) + 4096, bst);
    if (PROBE_DUP == 8) { for (int i = 0; i < 10; ++i) grid.sync(); }
    if (IN(1)) for (int rep = 0; rep < 1; ++rep) { pg8::EpiSwiGLU E{(bf16_t*)(ws + WS_H)}; run_gemm(F, (const bf16_t*)(ws + WS_XB), (const bf16_t*)(ws + WS_W1U), NUP, DM, E); } SEAM(1);
    if (PROBE_DUP == 9) { pg8::EpiSwiGLU E2{(bf16_t*)(ws + WS_H)}; run_gemm(F, (const bf16_t*)(ws + WS_XB), (const bf16_t*)(ws + WS_W1U), NUP, DM, E2); xcd_barrier(xbar); }
    if (IN(2)) for (int rep = 0; rep < 1; ++rep) { pg8::EpiRes E{a.x_p, a.x_s, (float*)(ws + WS_Z), 0.5f}; run_gemm(F, (const bf16_t*)(ws + WS_H), (const bf16_t*)(ws + WS_W1D), DM, DFF, E); if (PROBE_DUP == 10) run_gemm(F, (const bf16_t*)(ws + WS_H), (const bf16_t*)(ws + WS_W1D), DM, DFF, E); } SEAM(2);
    if (IN(3)) for (int rep = 0; rep < REP(3); ++rep) { ln_pass(F, (const float*)(ws + WS_Z), a.ln1g, a.ln1b, (float*)(ws + WS_HF1), (bf16_t*)(ws + WS_HB)); } SEAM(3);
    if (IN(4)) for (int rep = 0; rep < 1; ++rep) {
        pg8::EpiWin E{a.out, (bf16_t*)(ws + WS_QA), (bf16_t*)(ws + WS_IQ), (bf16_t*)(ws + WS_QB), (bf16_t*)(ws + WS_KAP), (bf16_t*)(ws + WS_VAP), (bf16_t*)(ws + WS_IKP), (bf16_t*)(ws + WS_KBP), (bf16_t*)(ws + WS_VBP),
                      (bf16_t*)(ws + WS_KAS), (bf16_t*)(ws + WS_VAS), (bf16_t*)(ws + WS_IKS), (bf16_t*)(ws + WS_KBS), (bf16_t*)(ws + WS_VBS), (bf16_t*)(ws + WS_G), (float*)(ws + WS_IW), (float*)(ws + WS_LF),
                      (const pg8::f32x2*)(ws + WS_ROPE), a.b_f, a.b_gate};
        run_gemm(F, (const bf16_t*)(ws + WS_HB), (const bf16_t*)(ws + WS_WIN), NINP, DM, E);
        if (PROBE_DUP == 11) run_gemm(F, (const bf16_t*)(ws + WS_HB), (const bf16_t*)(ws + WS_WIN), NINP, DM, E);
    } SEAM(4);
    if (IN(5)) {
        if (F.bid < NB + DB) cumsum_block(F, a, F.bid);
        for (int rep = 0; rep < REP(5); ++rep) { unsigned* ctr = (unsigned*)(ws + WS_CTL) + 128 * rep;
        for (;;) { if (F.tid == 0) *sh_item = (int)atomicAdd(ctr, 1u); __syncthreads(); const int item = *sh_item; __syncthreads(); if (item >= 1152) break; indexer_item(F, a, item); } }
    } SEAM(5);
    if (IN(6)) {
        unsigned* ctr = (unsigned*)(ws + WS_CTL) + 64;
        for (;;) { if (F.tid == 0) *sh_item = (int)atomicAdd(ctr, 1u); __syncthreads(); const int item = *sh_item; __syncthreads();
            if (item >= 512 + MT / 8) break;
            int kind, idx;
            if (item < 512) { kind = item & 1; idx = item >> 1; } else { kind = 2; idx = item - 512; }
            if (PROBE_TS >= 20 && F.bid == 0 && F.tid == 0) ((unsigned long long*)(ws + WS_CTL + 32768))[30] = __builtin_amdgcn_s_memrealtime();
            if (kind == 0) fox_unit(F, a, idx);
            else if (kind == 1) { const int bh = idx >> 4, s = idx & 15; fox_prompt_unit(F, a, bh >> 3, bh & 7, 31 - s); fox_prompt_unit(F, a, bh >> 3, bh & 7, s); }
            else { dsa_query(F, a, idx * 8 + F.wave); }
            if (PROBE_TS >= 20) { __syncthreads(); if (F.bid == 0 && F.tid == 0) { unsigned long long* ts = (unsigned long long*)(ws + WS_CTL + 32768); ts[kind == 0 ? 22 : kind == 1 ? 23 : 24] += __builtin_amdgcn_s_memrealtime() - ts[30]; } } }
        if (PROBE_DUP == 6) { ctr += 64; for (;;) { if (F.tid == 0) *sh_item = (int)atomicAdd(ctr, 1u); __syncthreads(); const int item = *sh_item; __syncthreads(); if (item >= 512) break; if (item < 256) fox_unit(F, a, item); else { const int p = item - 256, bh = p >> 4, s = p & 15; fox_prompt_unit(F, a, bh >> 3, bh & 7, 31 - s); fox_prompt_unit(F, a, bh >> 3, bh & 7, s); } } }
        if (PROBE_DUP == 7) { ctr += 64; for (;;) { if (F.tid == 0) *sh_item = (int)atomicAdd(ctr, 1u); __syncthreads(); const int item = *sh_item; __syncthreads(); if (item >= MT / 64) break;
            const int r0 = item * 64; for (int i = 0; i < 8; ++i) dsa_query(F, a, r0 + 8 * i + F.wave); } }
    } SEAM(6);
    if (IN(7)) for (int rep = 0; rep < 1; ++rep) {
        pg8::EpiProjA EA{(const bf16_t*)(ws + WS_G), (float*)(ws + WS_MM)}; run_gemm(F, (const bf16_t*)(ws + WS_YA), (const bf16_t*)(ws + WS_WPA), DM, 512, EA);
        pg8::EpiProjB EB{(const bf16_t*)(ws + WS_G), (const float*)(ws + WS_MM), (bf16_t*)(ws + WS_MMB)}; run_gemm(F, (const bf16_t*)(ws + WS_YB), (const bf16_t*)(ws + WS_WPB), DM, 512, EB);
    } SEAM(7);
    if (IN(8)) for (int rep = 0; rep < 1; ++rep) { pg8::EpiRes E{(const float*)(ws + WS_HF1), (const float*)(ws + WS_HF1) + (size_t)MP * DM, (float*)(ws + WS_Z), 1.0f}; run_gemm(F, (const bf16_t*)(ws + WS_MMB), (const bf16_t*)(ws + WS_WO), DM, DM, E); if (PROBE_DUP == 12) run_gemm(F, (const bf16_t*)(ws + WS_MMB), (const bf16_t*)(ws + WS_WO), DM, DM, E); } SEAM(8);
    if (IN(9)) for (int rep = 0; rep < REP(3); ++rep) { ln_pass(F, (const float*)(ws + WS_Z), a.ln2g, a.ln2b, (float*)(ws + WS_HF2), (bf16_t*)(ws + WS_HB)); } SEAM(9);
    if (IN(10)) for (int rep = 0; rep < 1; ++rep) { pg8::EpiSwiGLU E{(bf16_t*)(ws + WS_H)}; run_gemm(F, (const bf16_t*)(ws + WS_HB), (const bf16_t*)(ws + WS_W2U), NUP, DM, E); if (PROBE_DUP == 14) run_gemm(F, (const bf16_t*)(ws + WS_HB), (const bf16_t*)(ws + WS_W2U), NUP, DM, E); } SEAM(10);
    if (IN(11)) for (int rep = 0; rep < 1; ++rep) { pg8::EpiRes E{(const float*)(ws + WS_HF2), (const float*)(ws + WS_HF2) + (size_t)MP * DM, (float*)(ws + WS_Z), 0.5f}; run_gemm(F, (const bf16_t*)(ws + WS_H), (const bf16_t*)(ws + WS_W2D), DM, DFF, E); if (PROBE_DUP == 13) run_gemm(F, (const bf16_t*)(ws + WS_H), (const bf16_t*)(ws + WS_W2D), DM, DFF, E); } SEAM(11);
    if (IN(12)) for (int rep = 0; rep < REP(3); ++rep) { ln_pass(F, (const float*)(ws + WS_Z), a.ln3g, a.ln3b, a.out + O_Y, nullptr); }
    if (PROBE_TS >= 0 && F.bid == 0) {
        __syncthreads(); STAMP(13); __threadfence(); __syncthreads();
        const unsigned long long* ts = (const unsigned long long*)(ws + WS_CTL + 32768);
        const unsigned long long t0 = __hip_atomic_load(ts + PROBE_TS, __ATOMIC_RELAXED, __HIP_MEMORY_SCOPE_AGENT), t1 = __hip_atomic_load(ts + PROBE_TS + 1, __ATOMIC_RELAXED, __HIP_MEMORY_SCOPE_AGENT);
        const float us = (PROBE_TS >= 20) ? (float)t0 * 0.01f : (float)(t1 - t0) * 0.01f; const float eps = sqrtf(us * 1e-4f);
        for (int i = F.tid; i < 16384; i += NTHR) a.out[O_SLF + i] *= (1.0f + eps);
    }
#undef IN
#undef SEAM
}

extern "C" void kernel_launch(void* const* d_in, const int* in_sizes, int n_in, void* d_out, int out_size, void* d_ws, size_t ws_size, hipStream_t stream) {
    static int grid = 0;
    if (grid == 0) {
        if (n_in != 24 || ws_size < WS_END) { fprintf(stderr, "kernel_launch: expected 24 inputs and >= %zu bytes of workspace (got %d, %zu)\n", (size_t)WS_END, n_in, ws_size); grid = -1; return; }
        int dev = 0, cus = 0, per_cu = 0;
        hipGetDevice(&dev); hipDeviceGetAttribute(&cus, hipDeviceAttributeMultiprocessorCount, dev);
        if (hipFuncSetAttribute((const void*)mega_fwd, hipFuncAttributeMaxDynamicSharedMemorySize, LDS_BYTES) != hipSuccess) { fprintf(stderr, "kernel_launch: hipFuncSetAttribute failed\n"); grid = -1; return; }
        hipOccupancyMaxActiveBlocksPerMultiprocessor(&per_cu, (const void*)mega_fwd, NTHR, LDS_BYTES);
        (void)hipGetLastError();
        if (per_cu < 1) { fprintf(stderr, "kernel_launch: occupancy query says %d blocks per CU\n", per_cu); per_cu = 1; }
        grid = cus;
    }
    if (grid < 0) return;
    Args a{};
    const float** p = (const float**)&a;
    for (int i = 0; i < 24; ++i) p[i] = (const float*)d_in[i];
    a.out = (float*)d_out; a.ws = (unsigned char*)d_ws;
    for (int j = 0; j < 32; ++j) a.invf[j] = pow(10000.0, -(double)j / 32.0);
#if MK_PER_PHASE
    for (int ph = 0; ph < N_PHASES; ++ph) { a.ph_lo = ph; a.ph_hi = ph + 1; void* args[] = {&a};
        hipError_t e = hipLaunchCooperativeKernel((const void*)mega_fwd, dim3(grid), dim3(NTHR), args, LDS_BYTES, stream);
        if (e != hipSuccess) { fprintf(stderr, "launch of phase %d failed: %s\n", ph, hipGetErrorString(e)); break; } }
#else
    a.ph_lo = 0; a.ph_hi = N_PHASES; void* args[] = {&a};
    hipError_t e = hipLaunchCooperativeKernel((const void*)mega_fwd, dim3(grid), dim3(NTHR), args, LDS_BYTES, stream);
    if (e != hipSuccess) fprintf(stderr, "cooperative launch failed: %s (grid %d)\n", hipGetErrorString(e), grid);
#endif
}
```

```cpp
#include <hip/hip_runtime.h>
#include <hip/hip_cooperative_groups.h>
#include <cstdio>
#include <cstdint>
#include <cmath>
namespace cg = cooperative_groups;

constexpr int DM = 1024, SEQ = 8192, NB = 2, DB = 32, DS = 64, PAST = 4096, SKV = PAST + DS  ;
constexpr int MP = NB * SEQ  , MS = DB * DS  , MT = MP + MS  ;
constexpr int DFF = 2816, NUP = 2 * DFF, NIN = 4944, NINP = 5120;
constexpr float ALPHA = 1.189207115002721f;
constexpr float LN_EPS = 1e-5f;
constexpr float LOG2E = 1.4426950408889634f;
constexpr float QSCALE = 0.125f * LOG2E;
constexpr float IWSCALE = 0.35355339059327373f * 0.125f;
constexpr size_t O_Y = 0, O_PAK = 18874368, O_PAV = 20971520, O_PIK = 23068672, O_PBK = 24117248, O_PBV = 32505856, O_PLF = 40894464,
                 O_SAK = 41025536, O_SAV = 41287680, O_SIK = 41549824, O_SBK = 41680896, O_SBV = 42729472, O_SLF = 43778048;
#define MK_PER_PHASE 0
#define PROBE_DUP 0
#define PROBE_TS -1
namespace pg8 {
#define PG8_LAS __attribute__((address_space(3)))
typedef unsigned short bf16_t;
typedef short bf16x8 __attribute__((ext_vector_type(8)));
typedef float f32x4 __attribute__((ext_vector_type(4)));
typedef unsigned u32x4 __attribute__((ext_vector_type(4)));
constexpr int BM = 256, BK = 64, HALF = 128, HTB = HALF * BK * 2  , STAGE_BYTES = 8 * HTB, NXCD = 8, WGM = 8;

__host__ __device__ __forceinline__ int lds_byte(int r, int c) { const int st = (r >> 4) * 2 + (c >> 5), rr = r & 15, cc = c & 31, ob = rr * 64 + cc * 2; return st * 1024 + (ob ^ (((ob >> 9) & 1) << 5)); }
__host__ __device__ __forceinline__ void stage_rc(int b, int& R, int& C) { const int st = b / 1024, sb = b % 1024, swz = sb ^ (((sb >> 9) & 1) << 5); R = (st >> 1) * 16 + swz / 64; C = (st & 1) * 32 + (swz % 64) / 2; }
__host__ __device__ __forceinline__ int perm32(int rho) { const int n = rho >> 4, i = rho & 15; return 8 * (i >> 2) + 4 * n + (i & 3); }

struct Unit { int pm, pn; };
struct Gemm { const bf16_t* A; const bf16_t* Bt; int M, N, K; };

struct StaticOrder {
    int nM, nN, nwg, G, c;
    __host__ __device__ void init(int M, int N, int G_, int c_) { nM = M / BM; nN = N / BM; nwg = nM * nN; G = G_; c = c_; }
    __host__ __device__ bool next(int i, Unit& u) const {
        const long L = (long)i * G + c; if (L >= nwg) return false;
        int wgid = (int)L; { const int q = nwg / NXCD, r = nwg % NXCD, xcd = wgid % NXCD, off = wgid / NXCD; wgid = (xcd < r ? xcd * (q + 1) : r * (q + 1) + (xcd - r) * q) + off; }
        const int nig = WGM * nN, gid = wgid / nig, fm = gid * WGM, gsz = (nM - fm) < WGM ? (nM - fm) : WGM;
        u.pm = fm + ((wgid % nig) % gsz); u.pn = (wgid % nig) / gsz; return true;
    }
    __device__ __forceinline__ void a_ready(const Unit&) const {}
    __device__ __forceinline__ void done(const Unit&) const {}
};

__device__ __forceinline__ unsigned cvt_pk_bf16(float lo, float hi) { unsigned r; asm volatile("v_cvt_pk_bf16_f32 %0, %1, %2" : "=v"(r) : "v"(lo), "v"(hi)); return r; }
typedef float f32x2 __attribute__((ext_vector_type(2)));
typedef unsigned u32x2 __attribute__((ext_vector_type(2)));
typedef float f32x2 __attribute__((ext_vector_type(2)));
__device__ __forceinline__ float bf2f(unsigned short b) { return __uint_as_float((unsigned)b << 16); }
__device__ __forceinline__ float fsigmoid(float x) { return __builtin_amdgcn_rcpf(1.0f + __builtin_amdgcn_exp2f(-x * LOG2E)); }
__device__ __forceinline__ float flogsig(float x) {
    const float e = __builtin_amdgcn_exp2f(-fabsf(x) * LOG2E);
    const float l1p = (e < 0.03125f) ? e * (1.0f - e * (0.5f - e * (0.33333333f - 0.25f * e))) : __logf(1.0f + e);
    return fminf(x, 0.f) - l1p;
}
__device__ __forceinline__ u32x2 pack4(f32x4 v) { u32x2 w; w.x = cvt_pk_bf16(v[0], v[1]); w.y = cvt_pk_bf16(v[2], v[3]); return w; }

struct EpiSwiGLU {
    static constexpr bool PERM = true, AFTER_DRAIN = false;
    bf16_t* H;
    __device__ __forceinline__ void operator()(const f32x4 (&acc)[2][2][4][2], const Unit& u, int wr, int wc, int fr, int fq) const {
        const int row0 = u.pm * BM + wr * 64 + fr, col0 = u.pn * 128 + wc * 32 + 8 * fq;
#pragma unroll
        for (int ai = 0; ai < 2; ++ai)
#pragma unroll
            for (int m = 0; m < 4; ++m) {
                bf16_t* rowp = H + (size_t)(row0 + ai * HALF + m * 16) * DFF + col0;
                f32x4 h[2];
#pragma unroll
                for (int n = 0; n < 2; ++n) { const f32x4 a = acc[ai][0][m][n], g = acc[ai][1][m][n];
#pragma unroll
                    for (int i = 0; i < 4; ++i) h[n][i] = a[i] * fsigmoid(a[i]) * g[i]; }
                u32x4 w; w.x = cvt_pk_bf16(h[0][0], h[0][1]); w.y = cvt_pk_bf16(h[0][2], h[0][3]); w.z = cvt_pk_bf16(h[1][0], h[1][1]); w.w = cvt_pk_bf16(h[1][2], h[1][3]);
                *(u32x4*)rowp = w;
            }
    }
};
struct EpiRes {
    static constexpr bool PERM = false, AFTER_DRAIN = false;
    const float* resP; const float* resS; float* Z; float s;
    __device__ __forceinline__ void operator()(const f32x4 (&acc)[2][2][4][2], const Unit& u, int wr, int wc, int fr, int fq) const {
        const int row0 = u.pm * BM + wr * 64 + fr, col0 = u.pn * BM + wc * 32 + 4 * fq;
        const float* rb = (u.pm < MP / BM) ? resP : (resS - (size_t)MP * DM);
#pragma unroll
        for (int ai = 0; ai < 2; ++ai) {
            f32x4 r[4][2][2];
#pragma unroll
            for (int m = 0; m < 4; ++m) { const size_t off = (size_t)(row0 + ai * HALF + m * 16) * DM + col0;
#pragma unroll
                for (int bj = 0; bj < 2; ++bj)
#pragma unroll
                    for (int n = 0; n < 2; ++n) r[m][bj][n] = *(const f32x4*)(rb + off + bj * HALF + n * 16); }
#pragma unroll
            for (int m = 0; m < 4; ++m) { const size_t off = (size_t)(row0 + ai * HALF + m * 16) * DM + col0;
#pragma unroll
                for (int bj = 0; bj < 2; ++bj)
#pragma unroll
                    for (int n = 0; n < 2; ++n) *(f32x4*)(Z + off + bj * HALF + n * 16) = r[m][bj][n] * ALPHA + acc[ai][bj][m][n] * s; }
        }
    }
};
struct EpiProjA {
    static constexpr bool PERM = false, AFTER_DRAIN = false;
    const bf16_t* G; float* MM;
    __device__ __forceinline__ void operator()(const f32x4 (&acc)[2][2][4][2], const Unit& u, int wr, int wc, int fr, int fq) const {
        const int row0 = u.pm * BM + wr * 64 + fr, col0 = u.pn * BM + wc * 32 + 4 * fq;
#pragma unroll
        for (int ai = 0; ai < 2; ++ai) {
            u32x2 gq[4][2][2];
#pragma unroll
            for (int m = 0; m < 4; ++m) { const size_t row = (size_t)(row0 + ai * HALF + m * 16);
#pragma unroll
                for (int bj = 0; bj < 2; ++bj)
#pragma unroll
                    for (int n = 0; n < 2; ++n) gq[m][bj][n] = *(const u32x2*)(G + row * 2048 + col0 + bj * HALF + n * 16); }
#pragma unroll
            for (int m = 0; m < 4; ++m) { const size_t row = (size_t)(row0 + ai * HALF + m * 16);
#pragma unroll
                for (int bj = 0; bj < 2; ++bj)
#pragma unroll
                    for (int n = 0; n < 2; ++n) { const int c = col0 + bj * HALF + n * 16; const u32x2 g = gq[m][bj][n];
                        f32x4 gv; gv[0] = __uint_as_float(g.x << 16); gv[1] = __uint_as_float(g.x & 0xffff0000u); gv[2] = __uint_as_float(g.y << 16); gv[3] = __uint_as_float(g.y & 0xffff0000u);
                        *(f32x4*)(MM + row * DM + c) = gv * acc[ai][bj][m][n]; } }
        }
    }
};
struct EpiProjB {
    static constexpr bool PERM = false, AFTER_DRAIN = false;
    const bf16_t* G; const float* MM; bf16_t* MMb;
    __device__ __forceinline__ void operator()(const f32x4 (&acc)[2][2][4][2], const Unit& u, int wr, int wc, int fr, int fq) const {
        const int row0 = u.pm * BM + wr * 64 + fr, col0 = u.pn * BM + wc * 32 + 4 * fq;
#pragma unroll
        for (int ai = 0; ai < 2; ++ai)
#pragma unroll
            for (int m = 0; m < 4; ++m) { const size_t row = (size_t)(row0 + ai * HALF + m * 16);
#pragma unroll
                for (int bj = 0; bj < 2; ++bj)
#pragma unroll
                    for (int n = 0; n < 2; ++n) { const int c = col0 + bj * HALF + n * 16; const u32x2 g = *(const u32x2*)(G + row * 2048 + 1024 + c);
                        f32x4 gv; gv[0] = __uint_as_float(g.x << 16); gv[1] = __uint_as_float(g.x & 0xffff0000u); gv[2] = __uint_as_float(g.y << 16); gv[3] = __uint_as_float(g.y & 0xffff0000u);
                        const f32x4 mm = *(const f32x4*)(MM + row * DM + c);
                        *(u32x2*)(MMb + row * DM + c) = pack4(mm + gv * acc[ai][bj][m][n]); } }
    }
};
struct EpiWin {
    static constexpr bool PERM = false, AFTER_DRAIN = false;
    float* out; bf16_t *QA, *IQ, *QB, *KAp, *VAp, *IKp, *KBp, *VBp, *KAs, *VAs, *IKs, *KBs, *VBs, *G; float *IW, *LF; const f32x2* rope; const float* b_f; const float* b_gate;
    __device__ __forceinline__ void operator()(const f32x4 (&acc)[2][2][4][2], const Unit& u, int wr, int wc, int fr, int fq) const {
        const int T = u.pn; const bool samp = u.pm >= MP / BM;
#pragma unroll
        for (int ai = 0; ai < 2; ++ai)
#pragma unroll
            for (int m = 0; m < 4; ++m) {
                const int row = u.pm * BM + ai * HALF + wr * 64 + m * 16 + fr; const int rs = row - MP;
                const int pos = samp ? PAST + (rs & 63) : (row & (SEQ - 1));
                const size_t srow = samp ? ((size_t)(rs >> 6) * SKV + PAST + (rs & 63)) : (size_t)row;
                if (T == 0 || T == 1 || T == 3 || T == 4) {
                    bf16_t* dst = (T < 2) ? QA + (size_t)row * 512 + 256 * T : IQ + (size_t)row * 512 + 256 * (T - 3);
                    const float sc = (T < 2) ? QSCALE : 1.0f;
#pragma unroll
                    for (int n = 0; n < 2; ++n) { const int j0 = 16 * n + 4 * fq; const f32x4 x1 = acc[ai][0][m][n], x2 = acc[ai][1][m][n]; f32x4 o1, o2;
#pragma unroll
                        for (int i = 0; i < 4; ++i) { const f32x2 cs = rope[pos * 32 + j0 + i]; o1[i] = (x1[i] * cs.x - x2[i] * cs.y) * sc; o2[i] = (x2[i] * cs.x + x1[i] * cs.y) * sc; }
                        *(u32x2*)(dst + 64 * wc + j0) = pack4(o1); *(u32x2*)(dst + 64 * wc + 32 + j0) = pack4(o2); }
                } else if (T == 2) {
                    if (wc < 2) {
                        float* kf = out + (samp ? O_SAK + (size_t)rs * 128 : O_PAK + (size_t)row * 128) + 64 * wc; bf16_t* kb = (samp ? KAs : KAp) + srow * 128 + 64 * wc;
#pragma unroll
                        for (int n = 0; n < 2; ++n) { const int j0 = 16 * n + 4 * fq; const f32x4 x1 = acc[ai][0][m][n], x2 = acc[ai][1][m][n]; f32x4 o1, o2;
#pragma unroll
                            for (int i = 0; i < 4; ++i) { const f32x2 cs = rope[pos * 32 + j0 + i]; o1[i] = x1[i] * cs.x - x2[i] * cs.y; o2[i] = x2[i] * cs.x + x1[i] * cs.y; }
                            *(f32x4*)(kf + j0) = o1; *(f32x4*)(kf + 32 + j0) = o2; *(u32x2*)(kb + j0) = pack4(o1); *(u32x2*)(kb + 32 + j0) = pack4(o2); }
                    } else {
                        float* vf = out + (samp ? O_SAV + (size_t)rs * 128 : O_PAV + (size_t)row * 128); bf16_t* vb = (samp ? VAs : VAp) + srow * 128;
#pragma unroll
                        for (int bj = 0; bj < 2; ++bj)
#pragma unroll
                            for (int n = 0; n < 2; ++n) { const int c = 64 * bj + 32 * (wc - 2) + 16 * n + 4 * fq; *(f32x4*)(vf + c) = acc[ai][bj][m][n]; *(u32x2*)(vb + c) = pack4(acc[ai][bj][m][n]); }
                    }
                } else if (T == 5) {
                    if (wc == 0) {
                        float* kf = out + (samp ? O_SIK + (size_t)rs * 64 : O_PIK + (size_t)row * 64); bf16_t* kb = (samp ? IKs : IKp) + srow * 64;
#pragma unroll
                        for (int n = 0; n < 2; ++n) { const int j0 = 16 * n + 4 * fq; const f32x4 x1 = acc[ai][0][m][n], x2 = acc[ai][1][m][n]; f32x4 o1, o2;
#pragma unroll
                            for (int i = 0; i < 4; ++i) { const f32x2 cs = rope[pos * 32 + j0 + i]; o1[i] = x1[i] * cs.x - x2[i] * cs.y; o2[i] = x2[i] * cs.x + x1[i] * cs.y; }
                            *(f32x4*)(kf + j0) = o1; *(f32x4*)(kf + 32 + j0) = o2; *(u32x2*)(kb + j0) = pack4(o1); *(u32x2*)(kb + 32 + j0) = pack4(o2); }
                    } else if (wc == 1) {
                        const f32x4 v = acc[ai][0][m][0];
                        if (fq < 2) { int fqm = fq; asm volatile("" : "+v"(fqm)); *(f32x4*)(IW + (size_t)row * 8 + 4 * fqm) = v * IWSCALE; }
                        else { int fql = fq; asm volatile("" : "+v"(fql)); const int i0 = 4 * (fql - 2); f32x4 lf; const f32x4 bfv = *(const f32x4*)(b_f + i0);
#pragma unroll
                            for (int i = 0; i < 4; ++i) lf[i] = flogsig(v[i] + bfv[i]);
                            *(f32x4*)(out + (samp ? O_SLF + (size_t)rs * 8 : O_PLF + (size_t)row * 8) + i0) = lf; *(f32x4*)(LF + (size_t)row * 8 + i0) = lf; }
                    }
                } else if (T < 8) {
                    bf16_t* dst = QB + (size_t)row * 512 + 256 * (T - 6) + 32 * wc + 4 * fq;
#pragma unroll
                    for (int bj = 0; bj < 2; ++bj)
#pragma unroll
                        for (int n = 0; n < 2; ++n) *(u32x2*)(dst + 128 * bj + 16 * n) = pack4(acc[ai][bj][m][n] * QSCALE);
                } else if (T < 12) {
                    const bool isv = T >= 10; const int c0 = 256 * ((T - 8) & 1) + 32 * wc + 4 * fq;
                    float* df = out + (isv ? (samp ? O_SBV + (size_t)rs * 512 : O_PBV + (size_t)row * 512) : (samp ? O_SBK + (size_t)rs * 512 : O_PBK + (size_t)row * 512)) + c0;
                    bf16_t* db = (isv ? (samp ? VBs + (size_t)rs * 512 : VBp + (size_t)row * 512) : (samp ? KBs + (size_t)rs * 512 : KBp + (size_t)row * 512)) + c0;
#pragma unroll
                    for (int bj = 0; bj < 2; ++bj)
#pragma unroll
                        for (int n = 0; n < 2; ++n) { *(f32x4*)(df + 128 * bj + 16 * n) = acc[ai][bj][m][n]; *(u32x2*)(db + 128 * bj + 16 * n) = pack4(acc[ai][bj][m][n]); }
                } else {
                    const int c0 = 256 * (T - 12) + 32 * wc + 4 * fq; bf16_t* dst = G + (size_t)row * 2048 + c0;
#pragma unroll
                    for (int bj = 0; bj < 2; ++bj)
#pragma unroll
                        for (int n = 0; n < 2; ++n) { const f32x4 bg = *(const f32x4*)(b_gate + c0 + 128 * bj + 16 * n); f32x4 g;
#pragma unroll
                            for (int i = 0; i < 4; ++i) g[i] = fsigmoid(acc[ai][bj][m][n][i] + bg[i]);
                            *(u32x2*)(dst + 128 * bj + 16 * n) = pack4(g); }
                }
            }
    }
};
template <class Epi, class Sched, bool ALIGN_EPI = false, bool SP2 = false>
__device__ __forceinline__ void gemm_phase(PG8_LAS unsigned char* lds, const Gemm g, const Sched& S, const Epi& E) {
    const int tid = threadIdx.x, wid = __builtin_amdgcn_readfirstlane(tid >> 6), lane = tid & 63, wr = wid >> 2, wc = wid & 3, fr = lane & 15, fq = lane >> 4;
    const int K = g.K, nt = K / BK;
    unsigned voffA[2], voffB[2];
#pragma unroll
    for (int i = 0; i < 2; ++i) { int R, C; stage_rc(tid * 16 + i * 8192, R, C); const int Rb = Epi::PERM ? ((R & ~31) + perm32(R & 31)) : R;
        voffA[i] = (unsigned)(R * K + C) * 2u; voffB[i] = (unsigned)(Rb * K + C) * 2u; }
    const size_t kstep = (size_t)(BK * 2);
    const size_t hstep = (size_t)HALF * K * 2;
    const size_t tstep = 2 * hstep;
    const unsigned ldsw = (unsigned)wid * 1024u;
    const int aoff = lds_byte(wr * 64 + fr, fq * 8), boff = lds_byte(wc * 32 + fr, fq * 8);
#define PG8_SA(b, h) (((b) * 2 + (h)) * HTB)
#define PG8_SB(b, h) ((4 + (b) * 2 + (h)) * HTB)
#define PG8_STAGE(bufoff, gbase, voff) do { _Pragma("unroll") for (int _i = 0; _i < 2; ++_i) \
        __builtin_amdgcn_global_load_lds((const unsigned*)((const char*)(gbase) + (voff)[_i]), (PG8_LAS unsigned*)(lds + (bufoff) + ldsw + _i * 8192), 16, 0, 0); } while (0)
#define PG8_LDA(dst, b, h) do { _Pragma("unroll") for (int m = 0; m < 4; ++m) _Pragma("unroll") for (int k = 0; k < 2; ++k) dst[m][k] = *(const PG8_LAS bf16x8*)(lds + PG8_SA(b, h) + aoff + m * 2048 + k * 1024); } while (0)
#define PG8_LDB(dst, b, h) do { _Pragma("unroll") for (int n = 0; n < 2; ++n) _Pragma("unroll") for (int k = 0; k < 2; ++k) dst[n][k] = *(const PG8_LAS bf16x8*)(lds + PG8_SB(b, h) + boff + n * 2048 + k * 1024); } while (0)
#define PG8_MMA(ai, bj, At, Bt) do { __builtin_amdgcn_s_setprio(1); _Pragma("unroll") for (int m = 0; m < 4; ++m) _Pragma("unroll") for (int n = 0; n < 2; ++n) _Pragma("unroll") for (int k = 0; k < 2; ++k) \
        acc[ai][bj][m][n] = __builtin_amdgcn_mfma_f32_16x16x32_bf16(Bt[n][k], At[m][k], acc[ai][bj][m][n], 0, 0, 0); __builtin_amdgcn_s_setprio(0); } while (0)
#define PG8_WAIT_V(n) asm volatile("s_waitcnt vmcnt(" #n ")" ::: "memory")
#define PG8_WAIT_L(n) asm volatile("s_waitcnt lgkmcnt(" #n ")" ::: "memory")
#define PG8_BAR __builtin_amdgcn_s_barrier()
#define PG8_SCHED __builtin_amdgcn_sched_barrier(0)
    Unit cur, nxt; int ui = 0;
    if (!S.next(0, cur)) return;
    f32x4 acc[2][2][4][2];
#pragma unroll
    for (int a = 0; a < 2; ++a)
#pragma unroll
        for (int b = 0; b < 2; ++b)
#pragma unroll
            for (int m = 0; m < 4; ++m)
#pragma unroll
                for (int n = 0; n < 2; ++n) acc[a][b][m][n] = (f32x4){0.f, 0.f, 0.f, 0.f};
    bf16x8 At[4][2], B0[2][2], B1[2][2];
    const char* cA = (const char*)g.A + (size_t)cur.pm * tstep; const char* cB = (const char*)g.Bt + (size_t)cur.pn * tstep;
    S.a_ready(cur);
    if constexpr (SP2) {
        PG8_STAGE(PG8_SB(0, 0), cB, voffB); PG8_STAGE(PG8_SB(0, 1), cB + hstep, voffB); PG8_STAGE(PG8_SA(0, 0), cA, voffA); PG8_STAGE(PG8_SA(0, 1), cA + hstep, voffA);
        if (wr == 1) PG8_BAR;
        PG8_WAIT_V(2); PG8_BAR;
        PG8_STAGE(PG8_SB(1, 0), cB + kstep, voffB); PG8_STAGE(PG8_SA(1, 0), cA + kstep, voffA); PG8_STAGE(PG8_SB(1, 1), cB + hstep + kstep, voffB);
        PG8_WAIT_V(6); PG8_BAR;
    } else {
        PG8_STAGE(PG8_SB(0, 0), cB, voffB); PG8_STAGE(PG8_SA(0, 0), cA, voffA); PG8_STAGE(PG8_SB(0, 1), cB + hstep, voffB); PG8_STAGE(PG8_SA(0, 1), cA + hstep, voffA);
        if (wr == 1) PG8_BAR;
        PG8_WAIT_V(4); PG8_BAR;
        PG8_STAGE(PG8_SB(1, 0), cB + kstep, voffB); PG8_STAGE(PG8_SA(1, 0), cA + kstep, voffA); PG8_STAGE(PG8_SB(1, 1), cB + hstep + kstep, voffB);
        PG8_WAIT_V(6); PG8_BAR;
    }
    for (;;) {
        const bool has_next = S.next(ui + 1, nxt);
        const char* nA = has_next ? (const char*)g.A + (size_t)nxt.pm * tstep : cA; const char* nB = has_next ? (const char*)g.Bt + (size_t)nxt.pn * tstep : cB;
        for (int t = 0; t < nt; t += 2) {
            const bool last = (t == nt - 2);
            const char* a1 = cA + (size_t)(t + 1) * kstep;
            const char* a2 = last ? nA : cA + (size_t)(t + 2) * kstep; const char* b2 = last ? nB : cB + (size_t)(t + 2) * kstep;
            const char* a3 = a2 + kstep; const char* b3 = b2 + kstep;
            if (last && has_next) S.a_ready(nxt);
            if constexpr (SP2) {
            PG8_LDB(B0, 0, 0); PG8_LDB(B1, 0, 1); PG8_SCHED; PG8_LDA(At, 0, 0); PG8_STAGE(PG8_SA(1, 1), a1 + hstep, voffA);
            PG8_WAIT_V(8); PG8_WAIT_L(0); PG8_BAR; PG8_MMA(0, 0, At, B0); PG8_MMA(0, 1, At, B1); PG8_BAR; PG8_SCHED;
            PG8_LDA(At, 0, 1); PG8_STAGE(PG8_SB(0, 0), b2, voffB); PG8_STAGE(PG8_SB(0, 1), b2 + hstep, voffB); PG8_STAGE(PG8_SA(0, 0), a2, voffA);
            PG8_WAIT_V(8); PG8_WAIT_L(0); PG8_BAR; PG8_MMA(1, 0, At, B0); PG8_MMA(1, 1, At, B1); PG8_BAR; PG8_SCHED;
            PG8_LDB(B0, 1, 0); PG8_LDB(B1, 1, 1); PG8_SCHED; PG8_LDA(At, 1, 0); PG8_STAGE(PG8_SA(0, 1), a2 + hstep, voffA);
            PG8_WAIT_V(8); PG8_WAIT_L(0); PG8_BAR; PG8_MMA(0, 0, At, B0); PG8_MMA(0, 1, At, B1); PG8_BAR; PG8_SCHED;
            PG8_LDA(At, 1, 1); PG8_STAGE(PG8_SB(1, 0), b3, voffB); PG8_STAGE(PG8_SB(1, 1), b3 + hstep, voffB); PG8_STAGE(PG8_SA(1, 0), a3, voffA);
            PG8_WAIT_V(8); PG8_WAIT_L(0); PG8_BAR; PG8_MMA(1, 0, At, B0); PG8_MMA(1, 1, At, B1); PG8_BAR; PG8_SCHED;
            } else {
            PG8_LDB(B0, 0, 0); PG8_SCHED; PG8_LDA(At, 0, 0); PG8_STAGE(PG8_SA(1, 1), a1 + hstep, voffA);
            PG8_WAIT_L(8); PG8_BAR; PG8_WAIT_L(0); PG8_MMA(0, 0, At, B0); PG8_BAR; PG8_SCHED;
            PG8_LDB(B1, 0, 1); PG8_STAGE(PG8_SB(0, 0), b2, voffB);
            PG8_BAR; PG8_WAIT_L(0); PG8_MMA(0, 1, At, B1); PG8_BAR;
            PG8_LDA(At, 0, 1); PG8_STAGE(PG8_SA(0, 0), a2, voffA);
            PG8_BAR; PG8_WAIT_L(0); PG8_MMA(1, 0, At, B0); PG8_BAR; PG8_SCHED;
            PG8_STAGE(PG8_SB(0, 1), b2 + hstep, voffB);
            PG8_WAIT_V(6); PG8_BAR; PG8_MMA(1, 1, At, B1); PG8_BAR;
            PG8_LDB(B0, 1, 0); PG8_SCHED; PG8_LDA(At, 1, 0); PG8_STAGE(PG8_SA(0, 1), a2 + hstep, voffA);
            PG8_WAIT_L(8); PG8_BAR; PG8_WAIT_L(0); PG8_MMA(0, 0, At, B0); PG8_BAR; PG8_SCHED;
            PG8_LDB(B1, 1, 1); PG8_STAGE(PG8_SB(1, 0), b3, voffB);
            PG8_BAR; PG8_WAIT_L(0); PG8_MMA(0, 1, At, B1); PG8_BAR;
            PG8_LDA(At, 1, 1); PG8_STAGE(PG8_SA(1, 0), a3, voffA);
            PG8_BAR; PG8_WAIT_L(0); PG8_MMA(1, 0, At, B0); PG8_BAR; PG8_SCHED;
            PG8_STAGE(PG8_SB(1, 1), b3 + hstep, voffB);
            PG8_WAIT_V(6); PG8_BAR; PG8_MMA(1, 1, At, B1); PG8_BAR;
            }
        }
        if constexpr (ALIGN_EPI) { if (wr == 0) PG8_BAR; }
        if constexpr (!Epi::AFTER_DRAIN) { E(acc, cur, wr, wc, fr, fq); S.done(cur); }
        if (!has_next) break;
#pragma unroll
        for (int a = 0; a < 2; ++a)
#pragma unroll
            for (int b = 0; b < 2; ++b)
#pragma unroll
                for (int m = 0; m < 4; ++m)
#pragma unroll
                    for (int n = 0; n < 2; ++n) acc[a][b][m][n] = (f32x4){0.f, 0.f, 0.f, 0.f};
        cur = nxt; cA = nA; cB = nB; ++ui;
        if constexpr (ALIGN_EPI) { if (wr == 1) PG8_BAR; }
    }
    PG8_WAIT_V(0);
    if constexpr (!ALIGN_EPI) { if (wr == 0) PG8_BAR; }
    PG8_BAR;
    if constexpr (Epi::AFTER_DRAIN) { E.fused(acc, cur, wr, wc, fr, fq, lds, wid, lane); S.done(cur); }
#undef PG8_SA
#undef PG8_SB
#undef PG8_STAGE
#undef PG8_LDA
#undef PG8_LDB
#undef PG8_MMA
#undef PG8_WAIT_V
#undef PG8_WAIT_L
#undef PG8_BAR
#undef PG8_SCHED
}
}
#define LAS __attribute__((address_space(3)))
typedef unsigned short bf16_t;
typedef short bf16x8 __attribute__((ext_vector_type(8)));
typedef short s16x4 __attribute__((ext_vector_type(4)));
typedef float f32x4 __attribute__((ext_vector_type(4)));
typedef float f32x2 __attribute__((ext_vector_type(2)));
typedef float f32x16 __attribute__((ext_vector_type(16)));
typedef unsigned u32x4 __attribute__((ext_vector_type(4)));
typedef unsigned u32x2 __attribute__((ext_vector_type(2)));
using pg8::cvt_pk_bf16; using pg8::bf2f;
constexpr int NWAVES = 8, NTHR = 512, LDS_BYTES = 147456;
constexpr size_t MiB = 1u << 20;
constexpr size_t WS_CTL = 0;
constexpr size_t WS_ROPE = 1 * MiB;
constexpr size_t WS_W1U = 4 * MiB, WS_W1D = 16 * MiB, WS_WIN = 22 * MiB, WS_WPA = 33 * MiB, WS_WPB = 34 * MiB, WS_WO = 35 * MiB, WS_W2U = 37 * MiB, WS_W2D = 49 * MiB;
constexpr size_t WS_XB = 56 * MiB;
constexpr size_t WS_H = 92 * MiB;
constexpr size_t WS_Z = 192 * MiB;
constexpr size_t WS_HF1 = 264 * MiB, WS_HF2 = 336 * MiB;
constexpr size_t WS_HB = 408 * MiB;
constexpr size_t WS_QA = 444 * MiB, WS_IQ = 462 * MiB, WS_QB = 480 * MiB;
constexpr size_t WS_KAP = 498 * MiB, WS_VAP = 502 * MiB, WS_IKP = 506 * MiB;
constexpr size_t WS_KBP = 508 * MiB, WS_VBP = 524 * MiB;
constexpr size_t WS_KAS = 540 * MiB, WS_VAS = 573 * MiB, WS_IKS = 606 * MiB;
constexpr size_t WS_KBS = 623 * MiB, WS_VBS = 625 * MiB;
constexpr size_t WS_IW = 627 * MiB, WS_LF = 628 * MiB;
constexpr size_t WS_CBP = 629 * MiB, WS_CBS = 630 * MiB;
constexpr size_t WS_G = 635 * MiB;
constexpr size_t WS_SEL = 707 * MiB;
constexpr size_t WS_YA = 725 * MiB, WS_YB = 743 * MiB;
constexpr size_t WS_MM = 761 * MiB;
constexpr size_t WS_MMB = 833 * MiB;
constexpr size_t WS_SCR = 869 * MiB;
constexpr size_t WS_END = 997 * MiB;

struct Args {
    const float *x_p, *x_s, *c_ak, *c_av, *c_aik, *c_bk, *c_bv, *c_blf, *w1u, *w1d, *ln1g, *ln1b, *win, *b_f, *b_gate, *wpa, *wpb, *wo, *ln2g, *ln2b, *w2u, *w2d, *ln3g, *ln3b;
    float* out; unsigned char* ws; double invf[32]; int ph_lo, ph_hi;
};
struct Frame { LAS unsigned char* lds; int tid, lane, wave, G, bid; };

__device__ __forceinline__ unsigned f2bf(float f) { unsigned u = __float_as_uint(f); return (u + 0x7fffu + ((u >> 16) & 1u)) >> 16; }
__device__ __forceinline__ unsigned pk2(float lo, float hi) { return cvt_pk_bf16(lo, hi); }
__device__ __forceinline__ float wave_sum(float v) {
#pragma unroll
    for (int o = 1; o < 64; o <<= 1) v += __shfl_xor(v, o);
    return v;
}
__host__ __device__ __forceinline__ int rope_src(int P) { return 64 * ((P & 127) >> 5) + (P & 31) + ((P >> 7) << 5); }
struct SrcId { __device__ __forceinline__ int operator()(int n) const { return n; } };
struct SrcUp { __device__ __forceinline__ int operator()(int n) const { const int t = n >> 8, p = n & 255; return (p < 128) ? 128 * t + p : DFF + 128 * t + (p - 128); } };
struct SrcWin { __device__ __forceinline__ int operator()(int n) const {
    const int T = n >> 8, P = n & 255, bj = P >> 7, q = P & 127;
    if (T < 2) return 256 * T + rope_src(P);
    if (T == 2) return (q < 64) ? 512 + 64 * (q >> 5) + (q & 31) + 32 * bj : 640 + 64 * bj + (q - 64);
    if (T < 5) return 768 + 256 * (T - 3) + rope_src(P);
    if (T == 5) { if (q < 32) return 1280 + q + 32 * bj; if (bj == 0 && q < 40) return 1344 + (q - 32); if (bj == 0 && q < 48) return 2888 + (q - 40); return -1; }
    if (T < 8) return 1352 + 256 * (T - 6) + P;
    if (T < 10) return 1864 + 256 * (T - 8) + P;
    if (T < 12) return 2376 + 256 * (T - 10) + P;
    return 2896 + 256 * (T - 12) + P; } };
template <class F> __device__ __forceinline__ void transpose_item(const float* W, int K, int N, int ND, bf16_t* WT, LAS float* scr, int item, int lane, F srcf) {
    const int nblk = ND / 32, kb = item / nblk, nb = item % nblk, k0 = 64 * kb, n0 = 32 * nb;
    const int sc = srcf(n0 + (lane & 31));
    float wv[32];
#pragma unroll
    for (int i = 0; i < 32; ++i) { const int kk = 2 * i + (lane >> 5); wv[i] = (sc >= 0) ? W[(size_t)(k0 + kk) * N + sc] : 0.f; }
#pragma unroll
    for (int i = 0; i < 32; ++i) { const int kk = 2 * i + (lane >> 5); scr[kk * 33 + (lane & 31)] = wv[i]; }
    asm volatile("s_waitcnt lgkmcnt(0)" ::: "memory");
    const int c = lane & 7;
#pragma unroll
    for (int j = 0; j < 4; ++j) { const int n = (lane >> 3) + 8 * j; const LAS float* s = scr + (8 * c) * 33 + n;
        u32x4 o; o.x = pk2(s[0 * 33], s[1 * 33]); o.y = pk2(s[2 * 33], s[3 * 33]); o.z = pk2(s[4 * 33], s[5 * 33]); o.w = pk2(s[6 * 33], s[7 * 33]);
        *(u32x4*)(WT + (size_t)(n0 + n) * K + k0 + 8 * c) = o; }
    asm volatile("s_waitcnt lgkmcnt(0)" ::: "memory");
}
__device__ __forceinline__ void cvt_rows(const float* src, bf16_t* dst, size_t n4, size_t per_src, size_t per_dst, size_t gt, size_t ngt) {
#pragma unroll 16
    for (size_t e = gt; e < n4; e += ngt) { const size_t b = e / per_src, r = e - b * per_src; const f32x4 v = *(const f32x4*)(src + 4 * e);
        u32x2 w; w.x = pk2(v[0], v[1]); w.y = pk2(v[2], v[3]); *(u32x2*)(dst + 4 * (b * per_dst + r)) = w; }
}
__device__ __forceinline__ void p0_prologue(const Frame& F, const Args& a) {
    unsigned char* ws = a.ws;
    if (F.bid == 0) { unsigned* ctl = (unsigned*)(ws + WS_CTL); if (F.tid < 256) ctl[F.tid] = 0u; for (int i = F.tid; i < 3456; i += NTHR) ctl[4096 + i] = 0u; }
    LAS float* scr = (LAS float*)(F.lds + F.wave * 16384);
    const int gw = F.bid * NWAVES + F.wave, NGW = F.G * NWAVES;
    constexpr int I_UP = 16 * (NUP / 32), I_DN = (DFF / 64) * 32, I_IN = 16 * (NINP / 32), I_P = 8 * 32, I_O = 16 * 32;
    constexpr int NIT = 2 * I_UP + 2 * I_DN + I_IN + 2 * I_P + I_O;
    for (int it = gw; it < NIT; it += NGW) {
        int r = it;
        if (r < I_UP) { transpose_item(a.w1u, DM, NUP, NUP, (bf16_t*)(ws + WS_W1U), scr, r, F.lane, SrcUp()); continue; } r -= I_UP;
        if (r < I_UP) { transpose_item(a.w2u, DM, NUP, NUP, (bf16_t*)(ws + WS_W2U), scr, r, F.lane, SrcUp()); continue; } r -= I_UP;
        if (r < I_DN) { transpose_item(a.w1d, DFF, DM, DM, (bf16_t*)(ws + WS_W1D), scr, r, F.lane, SrcId()); continue; } r -= I_DN;
        if (r < I_DN) { transpose_item(a.w2d, DFF, DM, DM, (bf16_t*)(ws + WS_W2D), scr, r, F.lane, SrcId()); continue; } r -= I_DN;
        if (r < I_IN) { transpose_item(a.win, DM, NIN, NINP, (bf16_t*)(ws + WS_WIN), scr, r, F.lane, SrcWin()); continue; } r -= I_IN;
        if (r < I_P) { transpose_item(a.wpa, 512, DM, DM, (bf16_t*)(ws + WS_WPA), scr, r, F.lane, SrcId()); continue; } r -= I_P;
        if (r < I_P) { transpose_item(a.wpb, 512, DM, DM, (bf16_t*)(ws + WS_WPB), scr, r, F.lane, SrcId()); continue; } r -= I_P;
        transpose_item(a.wo, DM, DM, DM, (bf16_t*)(ws + WS_WO), scr, r, F.lane, SrcId());
    }
    const size_t gt = (size_t)F.bid * NTHR + F.tid, ngt = (size_t)F.G * NTHR;
    cvt_rows(a.x_p, (bf16_t*)(ws + WS_XB), (size_t)MP * DM / 4, (size_t)MP * DM / 4, 0, gt, ngt);
    cvt_rows(a.x_s, (bf16_t*)(ws + WS_XB) + (size_t)MP * DM, (size_t)MS * DM / 4, (size_t)MS * DM / 4, 0, gt, ngt);
    cvt_rows(a.c_ak, (bf16_t*)(ws + WS_KAS), (size_t)DB * PAST * 32, (size_t)PAST * 32, (size_t)SKV * 32, gt, ngt);
    cvt_rows(a.c_av, (bf16_t*)(ws + WS_VAS), (size_t)DB * PAST * 32, (size_t)PAST * 32, (size_t)SKV * 32, gt, ngt);
    cvt_rows(a.c_aik, (bf16_t*)(ws + WS_IKS), (size_t)DB * PAST * 16, (size_t)PAST * 16, (size_t)SKV * 16, gt, ngt);
    f32x2* rope = (f32x2*)(ws + WS_ROPE);
    for (size_t e = gt; e < (size_t)SEQ * 32; e += ngt) {
        const int pos = (int)(e >> 5), j = (int)(e & 31); const double ang = (double)pos * a.invf[j];
        const double kq = __builtin_rint(ang * 0.63661977236758134308); double r = __builtin_fma(-kq, 1.57079632679489655800e+00, ang); r = __builtin_fma(-kq, 6.12323399573676603587e-17, r);
        const double r2 = r * r;
        const double sn = r * (1.0 + r2 * (-1.0 / 6 + r2 * (1.0 / 120 + r2 * (-1.0 / 5040 + r2 * (1.0 / 362880 + r2 * (-1.0 / 39916800 + r2 * (1.0 / 6227020800.0)))))));
        const double cn = 1.0 + r2 * (-0.5 + r2 * (1.0 / 24 + r2 * (-1.0 / 720 + r2 * (1.0 / 40320 + r2 * (-1.0 / 3628800 + r2 * (1.0 / 479001600.0))))));
        const int qd = ((int)(long long)kq) & 3; double s, c;
        if (qd == 0) { s = sn; c = cn; } else if (qd == 1) { s = cn; c = -sn; } else if (qd == 2) { s = -sn; c = -cn; } else { s = -cn; c = sn; }
        rope[e] = (f32x2){(float)c, (float)s};
    }
}
__device__ __forceinline__ void ln_pass(const Frame& F, const float* Z, const float* g, const float* b, float* of, bf16_t* ob) {
    const int gw = F.bid * NWAVES + F.wave, NGW = F.G * NWAVES;
    f32x4 gv[4], bv[4];
#pragma unroll
    for (int j = 0; j < 4; ++j) { gv[j] = *(const f32x4*)(g + 4 * F.lane + 256 * j); bv[j] = *(const f32x4*)(b + 4 * F.lane + 256 * j); }
    for (int rowb = gw; rowb < MT; rowb += 4 * NGW) {
        int rows[4]; bool has[4]; f32x4 v[4][4]; float sm[4], sq[4];
#pragma unroll
        for (int k = 0; k < 4; ++k) { rows[k] = rowb + k * NGW; has[k] = rows[k] < MT; if (!has[k]) rows[k] = rowb; }
#pragma unroll
        for (int k = 0; k < 4; ++k) { const f32x4* zr = (const f32x4*)(Z + (size_t)rows[k] * DM) + F.lane;
#pragma unroll
            for (int j = 0; j < 4; ++j) v[k][j] = zr[64 * j]; }
#pragma unroll
        for (int k = 0; k < 4; ++k) { float s = 0.f;
#pragma unroll
            for (int j = 0; j < 4; ++j) s += (v[k][j][0] + v[k][j][1]) + (v[k][j][2] + v[k][j][3]);
            sm[k] = s; }
#pragma unroll
        for (int o = 1; o < 64; o <<= 1) {
#pragma unroll
            for (int k = 0; k < 4; ++k) sm[k] += __shfl_xor(sm[k], o); }
#pragma unroll
        for (int k = 0; k < 4; ++k) { const float mean = sm[k] * (1.f / DM); float q = 0.f;
#pragma unroll
            for (int j = 0; j < 4; ++j) { v[k][j] = v[k][j] - mean; q += (v[k][j][0] * v[k][j][0] + v[k][j][1] * v[k][j][1]) + (v[k][j][2] * v[k][j][2] + v[k][j][3] * v[k][j][3]); }
            sq[k] = q; }
#pragma unroll
        for (int o = 1; o < 64; o <<= 1) {
#pragma unroll
            for (int k = 0; k < 4; ++k) sq[k] += __shfl_xor(sq[k], o); }
#pragma unroll
        for (int k = 0; k < 4; ++k) {
            if (has[k]) { const float rstd = 1.f / sqrtf(sq[k] * (1.f / DM) + LN_EPS);
#pragma unroll
                for (int j = 0; j < 4; ++j) { const f32x4 y = v[k][j] * rstd * gv[j] + bv[j];
                    *((f32x4*)(of + (size_t)rows[k] * DM) + F.lane + 64 * j) = y;
                    if (ob) { u32x2 w; w.x = pk2(y[0], y[1]); w.y = pk2(y[2], y[3]); *((u32x2*)(ob + (size_t)rows[k] * DM) + F.lane + 64 * j) = w; } } }
        }
    }
}
__device__ __forceinline__ void cumsum_block(const Frame& F, const Args& a, int sb) {
    LAS float* wt = (LAS float*)F.lds;
    const int tid = F.tid, lane = F.lane;
    const bool prm = sb < NB; const int b = prm ? sb : sb - NB;
    const int nrows = prm ? SEQ : SKV; const bool act = 16 * tid < nrows;
    const float* LF = (const float*)(a.ws + WS_LF);
    const float* src = prm ? LF + ((size_t)sb * SEQ + 16 * tid) * 8
                           : (16 * tid < PAST ? a.c_blf + ((size_t)b * PAST + 16 * tid) * 8 : LF + ((size_t)MP + b * DS + (16 * tid - PAST)) * 8);
    f32x4 v[16][2];
#pragma unroll
    for (int r = 0; r < 16; ++r) { v[r][0] = act ? *(const f32x4*)(src + 8 * r) : (f32x4){0.f, 0.f, 0.f, 0.f}; v[r][1] = act ? *(const f32x4*)(src + 8 * r + 4) : (f32x4){0.f, 0.f, 0.f, 0.f}; }
#pragma unroll
    for (int r = 1; r < 16; ++r) { v[r][0] += v[r - 1][0]; v[r][1] += v[r - 1][1]; }
    f32x4 t0 = v[15][0], t1 = v[15][1];
#pragma unroll
    for (int off = 1; off < 64; off <<= 1) {
#pragma unroll
        for (int i = 0; i < 4; ++i) { const float u0 = __shfl_up(t0[i], off), u1 = __shfl_up(t1[i], off); if (lane >= off) { t0[i] += u0; t1[i] += u1; } } }
    if (lane == 63) { *(LAS f32x4*)(wt + F.wave * 8) = t0; *(LAS f32x4*)(wt + F.wave * 8 + 4) = t1; }
    __syncthreads();
    f32x4 e0 = t0 - v[15][0], e1 = t1 - v[15][1];
    for (int ww = 0; ww < F.wave; ++ww) { e0 += *(const LAS f32x4*)(wt + ww * 8); e1 += *(const LAS f32x4*)(wt + ww * 8 + 4); }
    if (act) {
        float* dst = (prm ? (float*)(a.ws + WS_CBP) + (size_t)sb * 8 * SEQ : (float*)(a.ws + WS_CBS) + (size_t)b * 8 * SKV) + 16 * tid;
#pragma unroll
        for (int h = 0; h < 8; ++h) { float* dh = dst + (size_t)h * nrows;
#pragma unroll
            for (int r4 = 0; r4 < 4; ++r4) { f32x4 o;
#pragma unroll
                for (int i = 0; i < 4; ++i) o[i] = -(v[4 * r4 + i][h >> 2][h & 3] + (h < 4 ? e0[h & 3] : e1[h & 3])) * LOG2E;
                *(f32x4*)(dh + 4 * r4) = o; } }
    }
    __syncthreads();
}
__device__ __forceinline__ unsigned f2key(float f) { const unsigned u = __float_as_uint(f); return (u & 0x80000000u) ? ~u : (u | 0x80000000u); }
__device__ __forceinline__ void radix_list(const LAS unsigned* lk, int cnt, int k, LAS unsigned* hist, int lane, unsigned& tau, int& kk_out) {
    unsigned prefix = 0; int kk = k;
#pragma unroll 1
    for (int lev = 0; lev < 4; ++lev) {
        const int shift = 24 - 8 * lev;
        *(LAS u32x4*)(hist + 4 * lane) = (u32x4){0u, 0u, 0u, 0u};
        asm volatile("s_waitcnt lgkmcnt(0)" ::: "memory");
        for (int i = lane; i < cnt; i += 64) { const unsigned key = lk[i];
            if (lev == 0 || (key >> (shift + 8)) == prefix) __hip_atomic_fetch_add(&hist[(key >> shift) & 255u], 1u, __ATOMIC_RELAXED, __HIP_MEMORY_SCOPE_WORKGROUP); }
        asm volatile("s_waitcnt lgkmcnt(0)" ::: "memory");
        const u32x4 hb = *(const LAS u32x4*)(hist + 4 * lane);
        unsigned T = hb[0] + hb[1] + hb[2] + hb[3];
#pragma unroll
        for (int off = 1; off < 64; off <<= 1) { const unsigned v = __shfl_down(T, off); if (lane + off < 64) T += v; }
        const unsigned long long bal = __ballot(T >= (unsigned)kk);
        const int js = __popcll(bal) - 1;
        unsigned run = __shfl(T, (js + 1) & 63); if (js >= 63) run = 0u;
        const u32x4 hj = *(const LAS u32x4*)(hist + 4 * js);
        int digit = 4 * js;
        if (run + hj[3] >= (unsigned)kk) digit += 3;
        else { run += hj[3]; if (run + hj[2] >= (unsigned)kk) digit += 2; else { run += hj[2]; if (run + hj[1] >= (unsigned)kk) digit += 1; else run += hj[1]; } }
        kk -= (int)run; prefix = (prefix << 8) | (unsigned)digit;
        asm volatile("s_waitcnt lgkmcnt(0)" ::: "memory");
    }
    tau = prefix; kk_out = kk;
}
__device__ __forceinline__ void indexer_item(const Frame& F, const Args& a, int item) {
    int b, c, qq; bool samp;
    if (item < 504) { c = 127 - (item >> 3); b = (item >> 2) & 1; qq = item & 3; samp = false; }
    else if (item < 632) { const int s = item - 504; b = s >> 2; qq = s & 3; c = 64; samp = true; }
    else { const int r = item - 632; c = 64 - (r >> 3); b = (r >> 2) & 1; qq = r & 3; samp = false; }
    const int qrow0 = samp ? MP + b * DS + 16 * qq : b * SEQ + 64 * c + 16 * qq;
    const int n = samp ? SKV : 64 * (c + 1);
    const bf16_t* IK = samp ? (const bf16_t*)(a.ws + WS_IKS) + (size_t)b * SKV * 64 : (const bf16_t*)(a.ws + WS_IKP) + (size_t)b * SEQ * 64;
    const bf16_t* IQ = (const bf16_t*)(a.ws + WS_IQ); const float* IW = (const float*)(a.ws + WS_IW);
    int* SEL = (int*)(a.ws + WS_SEL);
    int lane = F.lane; asm volatile("" : "+v"(lane));
    const int l31 = lane & 31, hi = lane >> 5;
    if (n <= 256) {
        for (int e = F.tid; e < 16 * 256; e += NTHR) { const int q = e >> 8, s = e & 255; SEL[(size_t)(qrow0 + q) * 256 + s] = (s < n) ? s : 0; }
        return;
    }
    float* scr = (float*)(a.ws + WS_SCR) + (size_t)F.bid * 16 * 8192;
    if (PROBE_TS >= 20 && F.bid == 0 && F.tid == 0) ((unsigned long long*)(a.ws + WS_CTL + 32768))[30] = __builtin_amdgcn_s_memrealtime();
    {
        bf16x8 afr[4][4]; f32x4 wq[4][2][2];
        const int qa = 2 * ((l31 >> 2) & 1) + (l31 >> 4), ha = 4 * ((l31 >> 3) & 1) + (l31 & 3);
#pragma unroll
        for (int mt = 0; mt < 4; ++mt) {
#pragma unroll
            for (int ks = 0; ks < 4; ++ks) afr[mt][ks] = *(const bf16x8*)(IQ + (size_t)(qrow0 + 4 * mt + qa) * 512 + 64 * ha + 16 * ks + 8 * hi);
#pragma unroll
            for (int aa = 0; aa < 2; ++aa) { const float* wp = IW + (size_t)(qrow0 + 4 * mt + 2 * hi + aa) * 8; wq[mt][aa][0] = *(const f32x4*)wp; wq[mt][aa][1] = *(const f32x4*)(wp + 4); }
        }
        bf16x8 bnx[4];
        { const int kt0 = (F.wave < n / 32) ? F.wave : 0;
#pragma unroll
          for (int ks = 0; ks < 4; ++ks) bnx[ks] = *(const bf16x8*)(IK + (size_t)(32 * kt0 + l31) * 64 + 16 * ks + 8 * hi); }
        for (int kt = F.wave; kt < n / 32; kt += NWAVES) {
            bf16x8 bfr[4];
#pragma unroll
            for (int ks = 0; ks < 4; ++ks) bfr[ks] = bnx[ks];
            { const int ktn = (kt + NWAVES < n / 32) ? kt + NWAVES : kt;
#pragma unroll
              for (int ks = 0; ks < 4; ++ks) bnx[ks] = *(const bf16x8*)(IK + (size_t)(32 * ktn + l31) * 64 + 16 * ks + 8 * hi); }
#pragma unroll
            for (int mt = 0; mt < 4; ++mt) {
                f32x16 acc = {};
#pragma unroll
                for (int ks = 0; ks < 4; ++ks) acc = __builtin_amdgcn_mfma_f32_32x32x16_bf16(afr[mt][ks], bfr[ks], acc, 0, 0, 0);
#pragma unroll
                for (int aa = 0; aa < 2; ++aa) { float s = 0.f;
#pragma unroll
                    for (int h = 0; h < 8; ++h) s += fmaxf(acc[8 * aa + h], 0.f) * wq[mt][aa][h >> 2][h & 3];
                    scr[(size_t)(4 * mt + 2 * hi + aa) * 8192 + 32 * kt + l31] = s; }
            }
        }
    }
    __syncthreads(); __builtin_amdgcn_fence(__ATOMIC_ACQUIRE, "agent");
    if (PROBE_TS >= 20 && F.bid == 0 && F.tid == 0) { unsigned long long* ts = (unsigned long long*)(a.ws + WS_CTL + 32768); const unsigned long long now = __builtin_amdgcn_s_memrealtime(); ts[20] += now - ts[30]; ts[30] = now; }
    LAS unsigned* hist = (LAS unsigned*)(F.lds + F.wave * 14336);
    LAS unsigned* lk = hist + 2048; LAS unsigned short* li = (LAS unsigned short*)(hist + 3072);
    const int n4 = n >> 2;
    for (int q = F.wave; q < 16; q += NWAVES) {
        const float* sp = scr + (size_t)q * 8192;
        u32x4 k[32];
#pragma unroll
        for (int it = 0; it < 32; ++it) {
            const int i4 = 64 * it + lane; const f32x4 v = *(const f32x4*)(sp + 4 * i4); const bool ok = i4 < n4;
            k[it] = (u32x4){ok ? f2key(v[0]) : 0u, ok ? f2key(v[1]) : 0u, ok ? f2key(v[2]) : 0u, ok ? f2key(v[3]) : 0u};
        }
        int* so = SEL + (size_t)(qrow0 + q) * 256;
        unsigned pivot = 0u;
        if (n > 1024) {
#pragma unroll
            for (int j = 0; j < 8; ++j) lk[64 * j + lane] = k[4 * j][0];
            asm volatile("s_waitcnt lgkmcnt(0)" ::: "memory");
            int dummy; radix_list(lk, 512, 30, hist, lane, pivot, dummy);
        }
        int cl = 0;
#pragma unroll
        for (int it = 0; it < 32; ++it)
#pragma unroll
            for (int e = 0; e < 4; ++e) cl += (k[it][e] >= pivot && k[it][e] != 0u) ? 1 : 0;
        int cinc = cl;
#pragma unroll
        for (int off = 1; off < 64; off <<= 1) { const int v = __shfl_up(cinc, off); if (lane >= off) cinc += v; }
        const int c1 = __shfl(cinc, 63);
        if (c1 >= 256 && c1 <= 1024) {
            int p = cinc - cl;
#pragma unroll
            for (int it = 0; it < 32; ++it) {
                if (64 * it < n4) {
#pragma unroll
                    for (int e = 0; e < 4; ++e) { const unsigned key = k[it][e]; if (key >= pivot && key != 0u) { lk[p] = key; li[p] = (unsigned short)(256 * it + 4 * lane + e); ++p; } }
                }
            }
            asm volatile("s_waitcnt lgkmcnt(0)" ::: "memory");
            unsigned tau; int kq; radix_list(lk, c1, 256, hist, lane, tau, kq);
            if (lane < 2) hist[64 + lane] = 0u;
            asm volatile("s_waitcnt lgkmcnt(0)" ::: "memory");
            int ce_l = 0;
            for (int i = lane; i < c1; i += 64) ce_l += (lk[i] == tau) ? 1 : 0;
            int ce = ce_l;
#pragma unroll
            for (int off = 1; off < 64; off <<= 1) ce += __shfl_xor(ce, off);
            if (ce == kq || ce <= 64) {
                if (ce != kq) {
                    for (int i = lane; i < c1; i += 64) if (lk[i] == tau) { const unsigned t = __hip_atomic_fetch_add(&hist[65], 1u, __ATOMIC_RELAXED, __HIP_MEMORY_SCOPE_WORKGROUP); hist[t] = li[i]; }
                    asm volatile("s_waitcnt lgkmcnt(0)" ::: "memory");
                }
                for (int i = lane; i < c1; i += 64) { const unsigned key = lk[i]; const unsigned id = li[i]; bool take = key > tau;
                    if (key == tau) { if (ce == kq) take = true; else { int rk = 0; for (int t = 0; t < ce; ++t) rk += (hist[t] < id) ? 1 : 0; take = rk < kq; } }
                    if (take) { const unsigned pos = __hip_atomic_fetch_add(&hist[64], 1u, __ATOMIC_RELAXED, __HIP_MEMORY_SCOPE_WORKGROUP); if (pos < 256u) so[pos] = (int)id; } }
                asm volatile("s_waitcnt lgkmcnt(0)" ::: "memory");
                continue;
            }
        }
        unsigned prefix = 0; int kk = 256;
#pragma unroll 1
        for (int lev = 0; lev < 3; ++lev) {
            const int shift = (lev == 0) ? 21 : (lev == 1) ? 10 : 0, bits = (lev == 2) ? 10 : 11, nbin = 1 << bits, per = nbin >> 6;
            const unsigned hshift = (unsigned)(shift + bits), bmask = (unsigned)(nbin - 1);
            for (int j = 0; j < per; ++j) hist[lane + 64 * j] = 0u;
            asm volatile("s_waitcnt lgkmcnt(0)" ::: "memory");
#pragma unroll
            for (int it = 0; it < 32; ++it) {
                if (64 * it < n4) {
#pragma unroll
                    for (int e = 0; e < 4; ++e) { const unsigned key = k[it][e];
                        const bool m = (lev == 0) ? (key != 0u) : ((key >> hshift) == prefix && key != 0u);
                        if (m) __hip_atomic_fetch_add(&hist[(key >> shift) & bmask], 1u, __ATOMIC_RELAXED, __HIP_MEMORY_SCOPE_WORKGROUP); }
                }
            }
            asm volatile("s_waitcnt lgkmcnt(0)" ::: "memory");
            unsigned s = 0; for (int j = 0; j < per; ++j) s += hist[lane * per + ((j + lane) & (per - 1))];
            unsigned T = s;
#pragma unroll
            for (int off = 1; off < 64; off <<= 1) { const unsigned v = __shfl_down(T, off); if (lane + off < 64) T += v; }
            const unsigned long long bal = __ballot(T >= (unsigned)kk);
            const int js = __popcll(bal) - 1;
            unsigned run = __shfl(T, (js + 1) & 63); if (js >= 63) run = 0u;
            int digit = js * per;
            for (int bb = per - 1; bb >= 0; --bb) { const unsigned cnt = hist[js * per + bb]; if (run + cnt >= (unsigned)kk) { digit = js * per + bb; break; } run += cnt; }
            kk -= (int)run; prefix = (prefix << bits) | (unsigned)digit;
            asm volatile("s_waitcnt lgkmcnt(0)" ::: "memory");
        }
        int obase = 0, ebase = 0;
        const unsigned long long below = (1ull << lane) - 1ull;
#pragma unroll
        for (int it = 0; it < 32; ++it) {
            if (64 * it < n4) {
                bool tk[4]; unsigned long long be[4]; bool eqf[4]; unsigned long long anyeq = 0ull;
#pragma unroll
                for (int e = 0; e < 4; ++e) { eqf[e] = (k[it][e] == prefix); be[e] = __ballot(eqf[e]); anyeq |= be[e]; tk[e] = k[it][e] > prefix; }
                if (anyeq) {
                    int er = ebase + __popcll(be[0] & below) + __popcll(be[1] & below) + __popcll(be[2] & below) + __popcll(be[3] & below);
#pragma unroll
                    for (int e = 0; e < 4; ++e) { if (eqf[e]) { tk[e] = er < kk; ++er; } }
                    ebase += __popcll(be[0]) + __popcll(be[1]) + __popcll(be[2]) + __popcll(be[3]);
                }
                unsigned long long bt[4];
#pragma unroll
                for (int e = 0; e < 4; ++e) bt[e] = __ballot(tk[e]);
                int pos = obase + __popcll(bt[0] & below) + __popcll(bt[1] & below) + __popcll(bt[2] & below) + __popcll(bt[3] & below);
#pragma unroll
                for (int e = 0; e < 4; ++e) { if (tk[e]) { if (pos < 256) so[pos] = 256 * it + 4 * lane + e; ++pos; } }
                obase += __popcll(bt[0]) + __popcll(bt[1]) + __popcll(bt[2]) + __popcll(bt[3]);
            }
        }
    }
    __syncthreads();
    if (PROBE_TS >= 20 && F.bid == 0 && F.tid == 0) { unsigned long long* ts = (unsigned long long*)(a.ws + WS_CTL + 32768); const unsigned long long now = __builtin_amdgcn_s_memrealtime(); ts[21] += now - ts[30]; ts[30] = now; }
}
__device__ __forceinline__ void dsa_query(const Frame& F, const Args& a, int row) {
    int lane = F.lane; asm volatile("" : "+v"(lane));
    const int j = lane & 15, kq = lane >> 4;
    const bool samp = row >= MP; const int rs = row - MP;
    const int nsel = samp ? 256 : min(256, 64 * (((row & (SEQ - 1)) >> 6) + 1));
    const bf16_t* KA = samp ? (const bf16_t*)(a.ws + WS_KAS) + (size_t)(rs >> 6) * SKV * 128 : (const bf16_t*)(a.ws + WS_KAP) + (size_t)(row >> 13) * SEQ * 128;
    const bf16_t* VA = samp ? (const bf16_t*)(a.ws + WS_VAS) + (size_t)(rs >> 6) * SKV * 128 : (const bf16_t*)(a.ws + WS_VAP) + (size_t)(row >> 13) * SEQ * 128;
    const int* sel = (const int*)(a.ws + WS_SEL) + (size_t)row * 256;
    const bf16_t* QA = (const bf16_t*)(a.ws + WS_QA) + (size_t)row * 512;
    LAS float* pl = (LAS float*)(F.lds + F.wave * 9216);
    LAS int* sl = (LAS int*)(F.lds + F.wave * 9216 + 8192);
#pragma unroll
    for (int i = 0; i < 4; ++i) sl[lane + 64 * i] = sel[lane + 64 * i];
    bf16x8 bq[4];
#pragma unroll
    for (int ks = 0; ks < 4; ++ks) { bf16x8 z = {}; bq[ks] = (j < 8 && (ks >> 1) == (j >> 2)) ? *(const bf16x8*)(QA + 64 * j + 32 * (ks & 1) + 8 * kq) : z; }
    asm volatile("s_waitcnt lgkmcnt(0)" ::: "memory");
    f32x4 acc[16]; const int nt = nsel >> 4;
#pragma unroll
    for (int hb = 0; hb < 2; ++hb) {
        bf16x8 kfr[8][4];
#pragma unroll
        for (int tt = 0; tt < 8; ++tt) { const int idx = sl[16 * (8 * hb + tt) + j]; const bf16_t* kr = KA + (size_t)idx * 128 + 8 * kq;
#pragma unroll
            for (int ks = 0; ks < 4; ++ks) kfr[tt][ks] = *(const bf16x8*)(kr + 32 * ks); }
#pragma unroll
        for (int tt = 0; tt < 8; ++tt) { f32x4 c2 = {0.f, 0.f, 0.f, 0.f};
#pragma unroll
            for (int ks = 0; ks < 4; ++ks) c2 = __builtin_amdgcn_mfma_f32_16x16x32_bf16(kfr[tt][ks], bq[ks], c2, 0, 0, 0);
            acc[8 * hb + tt] = (8 * hb + tt < nt) ? c2 : (f32x4){-INFINITY, -INFINITY, -INFINITY, -INFINITY}; }
    }
    float mx = -INFINITY;
#pragma unroll
    for (int t = 0; t < 16; ++t) mx = fmaxf(mx, fmaxf(fmaxf(acc[t][0], acc[t][1]), fmaxf(acc[t][2], acc[t][3])));
    mx = fmaxf(mx, __shfl_xor(mx, 16)); mx = fmaxf(mx, __shfl_xor(mx, 32));
    float sum = 0.f;
#pragma unroll
    for (int t = 0; t < 16; ++t)
#pragma unroll
        for (int i = 0; i < 4; ++i) { const float p = __builtin_amdgcn_exp2f(acc[t][i] - mx); acc[t][i] = p; sum += p; }
    sum += __shfl_xor(sum, 16); sum += __shfl_xor(sum, 32);
    const float inv = 1.0f / sum;
    if (j < 8) {
#pragma unroll
        for (int t = 0; t < 16; ++t)
#pragma unroll
            for (int i = 0; i < 4; ++i) pl[(16 * t + 4 * kq + i) * 8 + j] = acc[t][i] * inv;
    }
    asm volatile("s_waitcnt lgkmcnt(0)" ::: "memory");
    const int rg = lane >> 4, ch = lane & 15, g = ch >> 3;
    f32x2 o[4][4];
#pragma unroll
    for (int hh = 0; hh < 4; ++hh)
#pragma unroll
        for (int d = 0; d < 4; ++d) o[hh][d] = (f32x2){0.f, 0.f};
    const char* vbase = (const char*)VA + 16 * ch;
#pragma unroll 32
    for (int i = 0; i < (nsel >> 2); ++i) { const int s = 4 * i + rg; const int idx = sl[s];
        const u32x4 v = *(const u32x4*)(vbase + (size_t)idx * 256); const f32x4 p4 = *(const LAS f32x4*)(pl + s * 8 + 4 * g);
        f32x2 vv[4];
#pragma unroll
        for (int d = 0; d < 4; ++d) vv[d] = (f32x2){__uint_as_float(v[d] << 16), __uint_as_float(v[d] & 0xffff0000u)};
#pragma unroll
        for (int hh = 0; hh < 4; ++hh)
#pragma unroll
            for (int d = 0; d < 4; ++d) o[hh][d] += vv[d] * p4[hh]; }
#pragma unroll
    for (int hh = 0; hh < 4; ++hh)
#pragma unroll
        for (int d = 0; d < 4; ++d) { o[hh][d].x += __shfl_xor(o[hh][d].x, 16); o[hh][d].y += __shfl_xor(o[hh][d].y, 16); o[hh][d].x += __shfl_xor(o[hh][d].x, 32); o[hh][d].y += __shfl_xor(o[hh][d].y, 32); }
    { u32x4 wv; const int hh = rg;
      f32x2 s0 = o[0][0], s1 = o[0][1], s2 = o[0][2], s3 = o[0][3];
      if (hh == 1) { s0 = o[1][0]; s1 = o[1][1]; s2 = o[1][2]; s3 = o[1][3]; } else if (hh == 2) { s0 = o[2][0]; s1 = o[2][1]; s2 = o[2][2]; s3 = o[2][3]; } else if (hh == 3) { s0 = o[3][0]; s1 = o[3][1]; s2 = o[3][2]; s3 = o[3][3]; }
      wv.x = pk2(s0.x, s0.y); wv.y = pk2(s1.x, s1.y); wv.z = pk2(s2.x, s2.y); wv.w = pk2(s3.x, s3.y);
      *(u32x4*)((bf16_t*)(a.ws + WS_YA) + (size_t)row * 512 + 64 * (4 * g + hh) + 8 * (ch & 7)) = wv; }
    asm volatile("s_waitcnt lgkmcnt(0)" ::: "memory");
}
constexpr int VST = 72;
constexpr int FOX_V = 0, FOX_M = 8 * 64 * VST * 2  , FOX_L = FOX_M + 2048, FOX_O = FOX_L + 256, FOX_END = FOX_O + 64 * 65 * 4;
static_assert(FOX_END + 65 * 64 * 4 + 64 * 144 <= 131072, "fox lds");
__device__ __forceinline__ int crow(int r, int hi) { return (r & 3) + 8 * (r >> 2) + 4 * hi; }
__device__ __forceinline__ bf16x8 cvt8(f32x4 a, f32x4 b) { u32x4 w; w.x = pk2(a[0], a[1]); w.y = pk2(a[2], a[3]); w.z = pk2(b[0], b[1]); w.w = pk2(b[2], b[3]); return __builtin_bit_cast(bf16x8, w); }
__device__ __forceinline__ void fox_unit(const Frame& F, const Args& a, int unit) {
    constexpr bool samp = true; int b, h, qi, ntiles, rowq0; const float* Cb;
    if (samp) { b = unit >> 3; h = unit & 7; qi = 64; ntiles = 65; rowq0 = MP + b * DS; Cb = (const float*)(a.ws + WS_CBS) + ((size_t)b * 8 + h) * SKV; }
    else { const int r = unit - 256; qi = 127 - (r >> 4); b = (r >> 3) & 1; h = r & 7; ntiles = qi + 1; rowq0 = b * SEQ + 64 * qi; Cb = (const float*)(a.ws + WS_CBP) + ((size_t)b * 8 + h) * SEQ; }
    int lane = F.lane; asm volatile("" : "+v"(lane)); int tidl = F.tid; asm volatile("" : "+v"(tidl));
    const int q32 = lane & 31, hi = lane >> 5, w = F.wave;
    const bf16_t* Kb = samp ? (const bf16_t*)(a.ws + WS_KBS) + (size_t)(b * DS) * 512 + 64 * h : (const bf16_t*)(a.ws + WS_KBP) + (size_t)(b * SEQ) * 512 + 64 * h;
    const bf16_t* Vb = samp ? (const bf16_t*)(a.ws + WS_VBS) + (size_t)(b * DS) * 512 + 64 * h : (const bf16_t*)(a.ws + WS_VBP) + (size_t)(b * SEQ) * 512 + 64 * h;
    const float* Kc = a.c_bk + ((size_t)b * PAST * 8 + h) * 64; const float* Vc = a.c_bv + ((size_t)b * PAST * 8 + h) * 64;
    LAS bf16_t* vl = (LAS bf16_t*)(F.lds + FOX_V) + w * 64 * VST;
    LAS float* mb = (LAS float*)(F.lds + FOX_M); LAS float* lt = (LAS float*)(F.lds + FOX_L); LAS float* ot = (LAS float*)(F.lds + FOX_O);
    for (int e = tidl; e < 64 * 65 + 64; e += NTHR) lt[e] = 0.f;
    LAS float* cbl = (LAS float*)(F.lds + FOX_END);
    for (int e = tidl; e < ntiles * 16; e += NTHR) *(LAS f32x4*)(cbl + 4 * e) = *(const f32x4*)(Cb + 4 * e);
    __syncthreads();
    LAS unsigned char* ql = F.lds + FOX_END + 65 * 64 * 4;
    { const bf16_t* QB = (const bf16_t*)(a.ws + WS_QB); const int r = tidl >> 3, ch = tidl & 7;
      *(LAS u32x4*)(ql + r * 144 + 16 * ch) = *(const u32x4*)(QB + (size_t)(rowq0 + r) * 512 + 64 * h + 8 * ch); }
    __syncthreads();
    const LAS unsigned char* qlw = ql + q32 * 144 + 16 * hi;
    float mrun[2] = {-INFINITY, -INFINITY}, lrun[2] = {0.f, 0.f};
    f32x16 o[2][2];
#pragma unroll
    for (int qb = 0; qb < 2; ++qb)
#pragma unroll
        for (int db = 0; db < 2; ++db)
#pragma unroll
            for (int r = 0; r < 16; ++r) o[qb][db][r] = 0.f;
    const int gi = lane >> 4, li = lane & 15;
    const unsigned kofb = (unsigned)(q32 * 1024 + 16 * hi);
    const unsigned kofc = (unsigned)(q32 * 2048 + 32 * hi);
    const unsigned cof = (unsigned)(16 * hi);
    const int troff = ((4 * hi + (li >> 2)) * VST + 16 * (gi & 1) + 4 * (li & 3));
    const int nmine = (w < ntiles) ? ((ntiles - 1 - w) >> 3) + 1 : 0;
    for (int ii = nmine - 1; ii >= 0; --ii) {
        const int tile = w + 8 * ii;
        const bool cache = samp && tile < 64, diag = (tile == ntiles - 1);
        const int kv0 = 64 * tile; const int kvl = samp ? (cache ? kv0 : 0) : kv0;
        bf16x8 kf[2][4];
        if (cache) {
            const char* kp = (const char*)Kc + (size_t)kvl * 2048 + kofc;
#pragma unroll
            for (int hf = 0; hf < 2; ++hf) { const char* kph = kp + hf * 65536;
#pragma unroll
                for (int ks = 0; ks < 4; ++ks) kf[hf][ks] = cvt8(*(const f32x4*)(kph + 64 * ks), *(const f32x4*)(kph + 64 * ks + 16)); }
        } else {
            const char* kp = (const char*)Kb + (size_t)kvl * 1024 + kofb;
#pragma unroll
            for (int hf = 0; hf < 2; ++hf) { const char* kph = kp + hf * 32768;
#pragma unroll
                for (int ks = 0; ks < 4; ++ks) kf[hf][ks] = *(const bf16x8*)(kph + 32 * ks); }
        }
        asm volatile("" ::: "memory");
        f32x16 s[2][2]; float mx[2];
#pragma unroll
        for (int qb = 0; qb < 2; ++qb) {
#pragma unroll
            for (int hf = 0; hf < 2; ++hf) {
#pragma unroll
                for (int g4 = 0; g4 < 4; ++g4) { const f32x4 c4 = *(const LAS f32x4*)((const LAS char*)(cbl + kv0) + cof + (128 * hf + 32 * g4));
                    s[qb][hf][4 * g4 + 0] = c4[0]; s[qb][hf][4 * g4 + 1] = c4[1]; s[qb][hf][4 * g4 + 2] = c4[2]; s[qb][hf][4 * g4 + 3] = c4[3]; }
#pragma unroll
                for (int ks = 0; ks < 4; ++ks) s[qb][hf] = __builtin_amdgcn_mfma_f32_32x32x16_bf16(kf[hf][ks], *(const LAS bf16x8*)(qlw + qb * 32 * 144 + 32 * ks), s[qb][hf], 0, 0, 0);
            }
            if (diag) { const int ql = 32 * qb + q32;
#pragma unroll
                for (int hf = 0; hf < 2; ++hf)
#pragma unroll
                    for (int r = 0; r < 16; ++r) if (32 * hf + crow(r, hi) > ql) s[qb][hf][r] = -INFINITY; }
            float m_ = -INFINITY;
#pragma unroll
            for (int r = 0; r < 16; ++r) m_ = fmaxf(m_, fmaxf(s[qb][0][r], s[qb][1][r]));
            mx[qb] = fmaxf(m_, __shfl_xor(m_, 32));
        }
        if (!__all(mx[0] < mrun[0] - 160.0f && mx[1] < mrun[1] - 160.0f)) {
            if (cache) {
                const char* vp = (const char*)Vc + (size_t)kvl * 2048 + (unsigned)(lane * 2048);
#pragma unroll
                for (int c = 0; c < 16; ++c) { const f32x4 v = *(const f32x4*)(vp + 16 * c);
                    u32x2 wv; wv.x = pk2(v[0], v[1]); wv.y = pk2(v[2], v[3]); *(LAS u32x2*)(vl + lane * VST + 4 * c) = wv;
                    if ((c & 7) == 7) asm volatile("" ::: "memory"); }
            } else {
                const char* vp = (const char*)Vb + (size_t)kvl * 1024 + (unsigned)(lane * 1024);
#pragma unroll
                for (int c = 0; c < 8; ++c) *(LAS u32x4*)(vl + lane * VST + 8 * c) = *(const u32x4*)(vp + 16 * c);
                asm volatile("" ::: "memory");
            }
#pragma unroll
            for (int qb = 0; qb < 2; ++qb) {
                const float mn = fmaxf(mrun[qb], mx[qb]); const float al = __builtin_amdgcn_exp2f(mrun[qb] - mn); mrun[qb] = mn;
                float sum = 0.f;
#pragma unroll
                for (int hf = 0; hf < 2; ++hf)
#pragma unroll
                    for (int r = 0; r < 16; ++r) { const float p = __builtin_amdgcn_exp2f(s[qb][hf][r] - mn); s[qb][hf][r] = p; sum += p; }
                lrun[qb] = lrun[qb] * al + sum;
                if (__any(al != 1.0f)) {
#pragma unroll
                    for (int db = 0; db < 2; ++db)
#pragma unroll
                        for (int r = 0; r < 16; ++r) o[qb][db][r] *= al; }
                bf16x8 pk[4];
#pragma unroll
                for (int k4 = 0; k4 < 4; ++k4) { const int hf = k4 >> 1, r0 = 8 * (k4 & 1); u32x4 wv;
                    wv.x = pk2(s[qb][hf][r0 + 0], s[qb][hf][r0 + 1]); wv.y = pk2(s[qb][hf][r0 + 2], s[qb][hf][r0 + 3]); wv.z = pk2(s[qb][hf][r0 + 4], s[qb][hf][r0 + 5]); wv.w = pk2(s[qb][hf][r0 + 6], s[qb][hf][r0 + 7]);
                    pk[k4] = __builtin_bit_cast(bf16x8, wv); }
                asm volatile("s_waitcnt lgkmcnt(0)" ::: "memory");
#pragma unroll
                for (int db = 0; db < 2; ++db)
#pragma unroll
                    for (int k4 = 0; k4 < 4; ++k4) {
                        const LAS bf16_t* p0 = vl + troff + (16 * k4) * VST + 32 * db;
                        const s16x4 lo = __builtin_bit_cast(s16x4, __builtin_amdgcn_ds_read_tr16_b64_v4i16((LAS s16x4*)p0));
                        const s16x4 hh = __builtin_bit_cast(s16x4, __builtin_amdgcn_ds_read_tr16_b64_v4i16((LAS s16x4*)(p0 + 8 * VST)));
                        const bf16x8 vt = (bf16x8){lo[0], lo[1], lo[2], lo[3], hh[0], hh[1], hh[2], hh[3]};
                        o[qb][db] = __builtin_amdgcn_mfma_f32_32x32x16_bf16(vt, pk[k4], o[qb][db], 0, 0, 0);
                    }
            }
            asm volatile("s_waitcnt lgkmcnt(0)" ::: "memory");
        }
    }
#pragma unroll
    for (int qb = 0; qb < 2; ++qb) { lrun[qb] += __shfl_xor(lrun[qb], 32); if (hi == 0) mb[w * 64 + 32 * qb + q32] = mrun[qb]; }
    __syncthreads();
#pragma unroll
    for (int qb = 0; qb < 2; ++qb) {
        const int q = 32 * qb + q32; float mg = -INFINITY;
#pragma unroll
        for (int ww = 0; ww < NWAVES; ++ww) mg = fmaxf(mg, mb[ww * 64 + q]);
        const float sc = __builtin_amdgcn_exp2f(mrun[qb] - mg);
        if (w < ntiles) {
            if (hi == 0) __hip_atomic_fetch_add(lt + q, lrun[qb] * sc, __ATOMIC_RELAXED, __HIP_MEMORY_SCOPE_WORKGROUP);
#pragma unroll
            for (int db = 0; db < 2; ++db)
#pragma unroll
                for (int r = 0; r < 16; ++r) __hip_atomic_fetch_add(ot + q * 65 + 32 * db + crow(r, hi), o[qb][db][r] * sc, __ATOMIC_RELAXED, __HIP_MEMORY_SCOPE_WORKGROUP);
        }
    }
    __syncthreads();
    { const int q = tidl >> 3, d0 = 8 * (tidl & 7); const float il = 1.0f / lt[q]; const LAS float* op = ot + q * 65 + d0;
      u32x4 wv; wv.x = pk2(op[0] * il, op[1] * il); wv.y = pk2(op[2] * il, op[3] * il); wv.z = pk2(op[4] * il, op[5] * il); wv.w = pk2(op[6] * il, op[7] * il);
      *(u32x4*)((bf16_t*)(a.ws + WS_YB) + (size_t)(rowq0 + q) * 512 + 64 * h + d0) = wv; }
    __syncthreads();
}

constexpr int FP_ROWB = 144, FP_V = 64 * FP_ROWB, FP_C = 2 * FP_V, FP_BUF = FP_C + 256;
__device__ __forceinline__ void fox_prompt_unit(const Frame& F, const Args& a, int b, int h, int j) {
    int lane = F.lane; asm volatile("" : "+v"(lane)); int tid = F.tid; asm volatile("" : "+v"(tid));
    const int q32 = lane & 31, hi = lane >> 5, w = F.wave;
    const int NT = 4 * (j + 1), myT = 4 * j + (w >> 1);
    const char* kg = (const char*)((const bf16_t*)(a.ws + WS_KBP) + (size_t)(b * SEQ) * 512 + 64 * h) + (size_t)(tid >> 3) * 1024 + 16 * (tid & 7);
    const char* vg = (const char*)((const bf16_t*)(a.ws + WS_VBP) + (size_t)(b * SEQ) * 512 + 64 * h) + (size_t)(tid >> 3) * 1024 + 16 * (tid & 7);
    const float* cg = (const float*)(a.ws + WS_CBP) + ((size_t)b * 8 + h) * SEQ + 4 * (tid & 15);
    LAS unsigned char* lb = F.lds;
    const int lw = (tid >> 3) * FP_ROWB + 16 * (tid & 7);
    const bf16_t* qp = (const bf16_t*)(a.ws + WS_QB) + (size_t)(b * SEQ + 256 * j + 32 * w + q32) * 512 + 64 * h + 8 * hi;
    bf16x8 qf[4];
#pragma unroll
    for (int ks = 0; ks < 4; ++ks) qf[ks] = *(const bf16x8*)(qp + 16 * ks);
    u32x4 kr[2], vr[2]; f32x4 br[2];
#pragma unroll
    for (int sb = 0; sb < 2; ++sb) { kr[sb] = *(const u32x4*)(kg + (size_t)(NT - 1 - sb) * 65536); vr[sb] = *(const u32x4*)(vg + (size_t)(NT - 1 - sb) * 65536); br[sb] = *(const f32x4*)(cg + 64 * (NT - 1 - sb)); }
#pragma unroll
    for (int sb = 0; sb < 2; ++sb) { *(LAS u32x4*)(lb + sb * FP_BUF + lw) = kr[sb]; *(LAS u32x4*)(lb + sb * FP_BUF + FP_V + lw) = vr[sb]; if (tid < 16) *(LAS f32x4*)(lb + sb * FP_BUF + FP_C + 16 * tid) = br[sb]; }
    __syncthreads();
    float mrun = -INFINITY, lrun = 0.f; f32x16 o[2];
#pragma unroll
    for (int db = 0; db < 2; ++db)
#pragma unroll
        for (int r = 0; r < 16; ++r) o[db][r] = 0.f;
    const int gi = lane >> 4, li = lane & 15;
    const int troff = ((4 * hi + (li >> 2)) * FP_ROWB + 2 * (16 * (gi & 1) + 4 * (li & 3)));
    const int kroff = q32 * FP_ROWB + 16 * hi;
    for (int st = 0; st < NT / 2; ++st) {
        const int t0 = NT - 1 - 2 * st; const int cur = st & 1; const bool more = (t0 >= 3);
        if (more) {
#pragma unroll
            for (int sb = 0; sb < 2; ++sb) { kr[sb] = *(const u32x4*)(kg + (size_t)(t0 - 2 - sb) * 65536); vr[sb] = *(const u32x4*)(vg + (size_t)(t0 - 2 - sb) * 65536); br[sb] = *(const f32x4*)(cg + 64 * (t0 - 2 - sb)); } }
#pragma unroll
        for (int sb = 0; sb < 2; ++sb) {
        const int t = t0 - sb;
        if (t <= myT) {
            const LAS unsigned char* kb_ = lb + (2 * cur + sb) * FP_BUF; const LAS unsigned char* vb_ = kb_ + FP_V; const LAS unsigned char* cb_ = kb_ + FP_C + 16 * hi;
            f32x16 s[2];
#pragma unroll
            for (int hf = 0; hf < 2; ++hf) {
#pragma unroll
                for (int g4 = 0; g4 < 4; ++g4) { const f32x4 c4 = *(const LAS f32x4*)(cb_ + 128 * hf + 32 * g4);
                    s[hf][4 * g4 + 0] = c4[0]; s[hf][4 * g4 + 1] = c4[1]; s[hf][4 * g4 + 2] = c4[2]; s[hf][4 * g4 + 3] = c4[3]; }
#pragma unroll
                for (int ks = 0; ks < 4; ++ks) s[hf] = __builtin_amdgcn_mfma_f32_32x32x16_bf16(*(const LAS bf16x8*)(kb_ + kroff + hf * 32 * FP_ROWB + 32 * ks), qf[ks], s[hf], 0, 0, 0);
            }
            if (t == myT) { const int ql = 32 * (w & 1) + q32;
#pragma unroll
                for (int hf = 0; hf < 2; ++hf)
#pragma unroll
                    for (int r = 0; r < 16; ++r) if (32 * hf + crow(r, hi) > ql) s[hf][r] = -INFINITY; }
            float mx = -INFINITY;
#pragma unroll
            for (int r = 0; r < 16; ++r) mx = fmaxf(mx, fmaxf(s[0][r], s[1][r]));
            mx = fmaxf(mx, __shfl_xor(mx, 32));
            if (!__all(mx < mrun - 160.0f)) {
            const float mn = fmaxf(mrun, mx); const float al = __builtin_amdgcn_exp2f(mrun - mn); mrun = mn;
            float sum = 0.f;
#pragma unroll
            for (int hf = 0; hf < 2; ++hf)
#pragma unroll
                for (int r = 0; r < 16; ++r) { const float p = __builtin_amdgcn_exp2f(s[hf][r] - mn); s[hf][r] = p; sum += p; }
            lrun = lrun * al + sum;
            if (__any(al != 1.0f)) {
#pragma unroll
            for (int db = 0; db < 2; ++db)
#pragma unroll
                for (int r = 0; r < 16; ++r) o[db][r] *= al; }
            bf16x8 pk[4];
#pragma unroll
            for (int k4 = 0; k4 < 4; ++k4) { const int hf = k4 >> 1, r0 = 8 * (k4 & 1); u32x4 wv;
                wv.x = pk2(s[hf][r0 + 0], s[hf][r0 + 1]); wv.y = pk2(s[hf][r0 + 2], s[hf][r0 + 3]); wv.z = pk2(s[hf][r0 + 4], s[hf][r0 + 5]); wv.w = pk2(s[hf][r0 + 6], s[hf][r0 + 7]);
                pk[k4] = __builtin_bit_cast(bf16x8, wv); }
#pragma unroll
            for (int db = 0; db < 2; ++db)
#pragma unroll
                for (int k4 = 0; k4 < 4; ++k4) {
                    const LAS unsigned char* p0 = vb_ + troff + (16 * k4) * FP_ROWB + 64 * db;
                    const s16x4 lo = __builtin_bit_cast(s16x4, __builtin_amdgcn_ds_read_tr16_b64_v4i16((LAS s16x4*)p0));
                    const s16x4 hh = __builtin_bit_cast(s16x4, __builtin_amdgcn_ds_read_tr16_b64_v4i16((LAS s16x4*)(p0 + 8 * FP_ROWB)));
                    const bf16x8 vt = (bf16x8){lo[0], lo[1], lo[2], lo[3], hh[0], hh[1], hh[2], hh[3]};
                    o[db] = __builtin_amdgcn_mfma_f32_32x32x16_bf16(vt, pk[k4], o[db], 0, 0, 0);
                }
            }
        }
        }
        if (more) {
#pragma unroll
            for (int sb = 0; sb < 2; ++sb) { LAS unsigned char* nb = lb + (2 * (cur ^ 1) + sb) * FP_BUF; *(LAS u32x4*)(nb + lw) = kr[sb]; *(LAS u32x4*)(nb + FP_V + lw) = vr[sb]; if (tid < 16) *(LAS f32x4*)(nb + FP_C + 16 * tid) = br[sb]; } }
        __syncthreads();
    }
    lrun += __shfl_xor(lrun, 32);
    const float il = 1.0f / lrun;
    bf16_t* yo = (bf16_t*)(a.ws + WS_YB) + (size_t)(b * SEQ + 256 * j + 32 * w + q32) * 512 + 64 * h + 4 * hi;
#pragma unroll
    for (int db = 0; db < 2; ++db)
#pragma unroll
        for (int g4 = 0; g4 < 4; ++g4) { u32x2 wv; wv.x = pk2(o[db][4 * g4 + 0] * il, o[db][4 * g4 + 1] * il); wv.y = pk2(o[db][4 * g4 + 2] * il, o[db][4 * g4 + 3] * il);
            *(u32x2*)(yo + 32 * db + 8 * g4) = wv; }
}
#define XB_TMO      128
#define XB_XCNT(j)  (256  + 64 * (j))
#define XB_XSUB(j)  (1280 + 64 * (j))
#define XB_XGEN(j)  (2304 + 64 * (j))
#define XB_TOP      3328
#define XB_TOPGEN   3392
#define XCD_BAR_WORDS 3456
#define XB_SPIN_CAP (1u << 18)

__device__ __forceinline__ unsigned xb_ld(unsigned* p)              { return __hip_atomic_load(p, __ATOMIC_RELAXED, __HIP_MEMORY_SCOPE_AGENT); }
__device__ __forceinline__ unsigned xb_add(unsigned* p, unsigned v) { return __hip_atomic_fetch_add(p, v, __ATOMIC_RELAXED, __HIP_MEMORY_SCOPE_AGENT); }
__device__ __forceinline__ unsigned xb_xcc_id() { return (unsigned)__builtin_amdgcn_s_getreg((3 << 11) | 20) & 0xFu; }
#define XB_SPIN(cond, bar) do { unsigned _sp = 0; while (cond) { __builtin_amdgcn_s_sleep(1); \
    if ((++_sp & 255u) == 0u) { if (xb_ld(&(bar)[XB_TMO])) break; if (_sp > XB_SPIN_CAP) { atomicAdd(&(bar)[XB_TMO], 1u); break; } } } } while (0)

struct XcdBarrier {
    unsigned* bar; unsigned x;
    volatile LAS unsigned* st;
};

__device__ __forceinline__ XcdBarrier xcd_barrier_post(unsigned* bar, volatile LAS unsigned* st) {
    XcdBarrier b; b.bar = bar; b.x = xb_xcc_id(); b.st = st;
    if (threadIdx.x == 0) (void)xb_add(&bar[XB_XCNT(b.x)], 1u);
    return b;
}
__device__ __forceinline__ void xcd_barrier_complete(unsigned* bar, unsigned x, unsigned& nloc, unsigned& nx) {
    const unsigned G = gridDim.x * gridDim.y * gridDim.z;
    unsigned sum, cnt, mine, sp = 0u;
    for (;;) {
        sum = 0u; cnt = 0u; mine = 0u;
#pragma unroll
        for (unsigned j = 0; j < 16; ++j) { const unsigned c = xb_ld(&bar[XB_XCNT(j)]); sum += c; cnt += (c > 0u) ? 1u : 0u; mine = (j == x) ? c : mine; }
        if (sum == G) break;
        __builtin_amdgcn_s_sleep(1);
        if ((++sp & 255u) == 0u) { if (xb_ld(&bar[XB_TMO])) break; if (sp > XB_SPIN_CAP) { atomicAdd(&bar[XB_TMO], 1u); break; } }
    }
    nloc = mine > 0u ? mine : 1u; nx = cnt > 0u ? cnt : 1u;
}

__device__ __forceinline__ void xcd_barrier(const XcdBarrier& b) {
    asm volatile("s_waitcnt vmcnt(0)" ::: "memory");
    __syncthreads();
    if (threadIdx.x == 0) {
        unsigned* bar = b.bar;
        __builtin_amdgcn_s_waitcnt(0);
        unsigned nloc = b.st[0], nx = b.st[1];
        if (nloc == 0u) { xcd_barrier_complete(bar, b.x, nloc, nx); b.st[0] = nloc; b.st[1] = nx; }
        const unsigned old = xb_add(&bar[XB_XSUB(b.x)], 1u);
        const unsigned gen = old / nloc;
        if (old + 1u == (gen + 1u) * nloc) {
            __builtin_amdgcn_fence(__ATOMIC_RELEASE, "agent");
            asm volatile("s_waitcnt vmcnt(0)" ::: "memory");
            const unsigned og = xb_add(&bar[XB_TOP], 1u);
            const unsigned tg = og / nx;
            if (og + 1u == (tg + 1u) * nx) xb_add(&bar[XB_TOPGEN], 1u);
            else XB_SPIN(xb_ld(&bar[XB_TOPGEN]) == tg, bar);
            __builtin_amdgcn_fence(__ATOMIC_ACQUIRE, "agent");
            xb_add(&bar[XB_XGEN(b.x)], 1u);
            asm volatile("s_waitcnt vmcnt(0)" ::: "memory");
        } else {
            XB_SPIN(xb_ld(&bar[XB_XGEN(b.x)]) == gen, bar);
            __builtin_amdgcn_fence(__ATOMIC_ACQUIRE, "agent");
            asm volatile("s_waitcnt vmcnt(0)" ::: "memory");
        }
    }
    __syncthreads();
}
constexpr int N_PHASES = 13;
#ifndef MK_PER_PHASE
#define MK_PER_PHASE 0
#endif
template <class Epi> __device__ __forceinline__ void run_gemm(const Frame& F, const bf16_t* A, const bf16_t* Bt, int N, int K, const Epi& E) {
    pg8::Gemm g{A, Bt, MT, N, K}; pg8::StaticOrder S; S.init(MT, N, F.G, F.bid);
    pg8::gemm_phase<Epi, pg8::StaticOrder, true, true>(F.lds, g, S, E);
}
__global__ void __launch_bounds__(NTHR, 2) mega_fwd(Args a) {
    __builtin_assume(__builtin_amdgcn_workitem_id_y() == 0); __builtin_assume(__builtin_amdgcn_workitem_id_z() == 0);
    extern __shared__ __attribute__((aligned(16))) unsigned char lds_raw[];
    cg::grid_group grid = cg::this_grid();
    Frame F; F.lds = (LAS unsigned char*)lds_raw; F.tid = threadIdx.x; F.lane = F.tid & 63; F.wave = __builtin_amdgcn_readfirstlane(F.tid >> 6); F.G = gridDim.x; F.bid = blockIdx.x;
    unsigned char* ws = a.ws;
    LAS int* sh_item = (LAS int*)(F.lds + 131072);
    volatile LAS unsigned* bst = (volatile LAS unsigned*)(F.lds + 131072 + 64);
    if (F.tid < 2) bst[F.tid] = 0u;
    __syncthreads();
    const bool fused = (a.ph_hi - a.ph_lo) > 1;
    XcdBarrier xbar; xbar.bar = (unsigned*)(ws + WS_CTL) + 4096; xbar.x = 0; xbar.st = bst;
    const int lo = a.ph_lo, hi = a.ph_hi;
#define IN(k) (lo <= (k) && (k) < hi)
#ifndef PROBE_TS
#define PROBE_TS -1
#endif
#define STAMP(k) do { if (PROBE_TS >= 0 && F.bid == 0 && F.tid == 0) ((unsigned long long*)(ws + WS_CTL + 32768))[k] = __builtin_amdgcn_s_memrealtime(); } while (0)
#define SEAM(k) do { if (IN(k) && IN((k) + 1)) { if ((k) == 0) grid.sync(); else xcd_barrier(xbar); } STAMP((k) + 1); } while (0)
    STAMP(0);
#ifndef PROBE_DUP
#define PROBE_DUP 0
#endif
#define REP(code) (PROBE_DUP == (code) ? 2 : 1)
    if (IN(0)) { for (int rep = 0; rep < REP(1); ++rep) p0_prologue(F, a); } SEAM(0);
    if (fused) xbar = xcd_barrier_post((unsigned*)(ws + WS_CTL) + 4096, bst);
    if (PROBE_DUP == 8) { for (int i = 0; i < 10; ++i) grid.sync(); }
    if (IN(1)) for (int rep = 0; rep < 1; ++rep) { pg8::EpiSwiGLU E{(bf16_t*)(ws + WS_H)}; run_gemm(F, (const bf16_t*)(ws + WS_XB), (const bf16_t*)(ws + WS_W1U), NUP, DM, E); } SEAM(1);
    if (PROBE_DUP == 9) { pg8::EpiSwiGLU E2{(bf16_t*)(ws + WS_H)}; run_gemm(F, (const bf16_t*)(ws + WS_XB), (const bf16_t*)(ws + WS_W1U), NUP, DM, E2); xcd_barrier(xbar); }
    if (IN(2)) for (int rep = 0; rep < 1; ++rep) { pg8::EpiRes E{a.x_p, a.x_s, (float*)(ws + WS_Z), 0.5f}; run_gemm(F, (const bf16_t*)(ws + WS_H), (const bf16_t*)(ws + WS_W1D), DM, DFF, E); if (PROBE_DUP == 10) run_gemm(F, (const bf16_t*)(ws + WS_H), (const bf16_t*)(ws + WS_W1D), DM, DFF, E); } SEAM(2);
    if (IN(3)) for (int rep = 0; rep < REP(3); ++rep) { ln_pass(F, (const float*)(ws + WS_Z), a.ln1g, a.ln1b, (float*)(ws + WS_HF1), (bf16_t*)(ws + WS_HB)); } SEAM(3);
    if (IN(4)) for (int rep = 0; rep < 1; ++rep) {
        pg8::EpiWin E{a.out, (bf16_t*)(ws + WS_QA), (bf16_t*)(ws + WS_IQ), (bf16_t*)(ws + WS_QB), (bf16_t*)(ws + WS_KAP), (bf16_t*)(ws + WS_VAP), (bf16_t*)(ws + WS_IKP), (bf16_t*)(ws + WS_KBP), (bf16_t*)(ws + WS_VBP),
                      (bf16_t*)(ws + WS_KAS), (bf16_t*)(ws + WS_VAS), (bf16_t*)(ws + WS_IKS), (bf16_t*)(ws + WS_KBS), (bf16_t*)(ws + WS_VBS), (bf16_t*)(ws + WS_G), (float*)(ws + WS_IW), (float*)(ws + WS_LF),
                      (const pg8::f32x2*)(ws + WS_ROPE), a.b_f, a.b_gate};
        run_gemm(F, (const bf16_t*)(ws + WS_HB), (const bf16_t*)(ws + WS_WIN), NINP, DM, E);
        if (PROBE_DUP == 11) run_gemm(F, (const bf16_t*)(ws + WS_HB), (const bf16_t*)(ws + WS_WIN), NINP, DM, E);
    } SEAM(4);
    if (IN(5)) {
        if (F.bid < NB + DB) cumsum_block(F, a, F.bid);
        for (int rep = 0; rep < REP(5); ++rep) { unsigned* ctr = (unsigned*)(ws + WS_CTL) + 128 * rep;
        for (;;) { if (F.tid == 0) *sh_item = (int)atomicAdd(ctr, 1u); __syncthreads(); const int item = *sh_item; __syncthreads(); if (item >= 1152) break; indexer_item(F, a, item); } }
    } SEAM(5);
    if (IN(6)) {
        unsigned* ctr = (unsigned*)(ws + WS_CTL) + 64;
        for (;;) { if (F.tid == 0) *sh_item = (int)atomicAdd(ctr, 1u); __syncthreads(); const int item = *sh_item; __syncthreads();
            if (item >= 512 + MT / 8) break;
            int kind, idx;
            if (item < 256) { kind = item & 1; idx = item >> 1; }
            else if (item < 384) { kind = 1; idx = 128 + (item - 256); }
            else if (item < 1024) { const int r = item - 384, g5 = r / 5, k5 = r - 5 * g5; if (k5 == 0) { kind = 0; idx = 128 + g5; } else { kind = 2; idx = 4 * g5 + (k5 - 1); } }
            else { kind = 2; idx = 512 + (item - 1024); }
            if (PROBE_TS >= 20 && F.bid == 0 && F.tid == 0) ((unsigned long long*)(ws + WS_CTL + 32768))[30] = __builtin_amdgcn_s_memrealtime();
            if (kind == 0) fox_unit(F, a, idx);
            else if (kind == 1) { const int bh = idx >> 4, s = idx & 15; fox_prompt_unit(F, a, bh >> 3, bh & 7, 31 - s); fox_prompt_unit(F, a, bh >> 3, bh & 7, s); }
            else { dsa_query(F, a, idx * 8 + F.wave); }
            if (PROBE_TS >= 20) { __syncthreads(); if (F.bid == 0 && F.tid == 0) { unsigned long long* ts = (unsigned long long*)(ws + WS_CTL + 32768); ts[kind == 0 ? 22 : kind == 1 ? 23 : 24] += __builtin_amdgcn_s_memrealtime() - ts[30]; } } }
        if (PROBE_DUP == 6) { ctr += 64; for (;;) { if (F.tid == 0) *sh_item = (int)atomicAdd(ctr, 1u); __syncthreads(); const int item = *sh_item; __syncthreads(); if (item >= 512) break; if (item < 256) fox_unit(F, a, item); else { const int p = item - 256, bh = p >> 4, s = p & 15; fox_prompt_unit(F, a, bh >> 3, bh & 7, 31 - s); fox_prompt_unit(F, a, bh >> 3, bh & 7, s); } } }
        if (PROBE_DUP == 7) { ctr += 64; for (;;) { if (F.tid == 0) *sh_item = (int)atomicAdd(ctr, 1u); __syncthreads(); const int item = *sh_item; __syncthreads(); if (item >= MT / 64) break;
            const int r0 = item * 64; for (int i = 0; i < 8; ++i) dsa_query(F, a, r0 + 8 * i + F.wave); } }
    } SEAM(6);
    if (IN(7)) for (int rep = 0; rep < 1; ++rep) {
        pg8::EpiProjA EA{(const bf16_t*)(ws + WS_G), (float*)(ws + WS_MM)}; run_gemm(F, (const bf16_t*)(ws + WS_YA), (const bf16_t*)(ws + WS_WPA), DM, 512, EA);
        pg8::EpiProjB EB{(const bf16_t*)(ws + WS_G), (const float*)(ws + WS_MM), (bf16_t*)(ws + WS_MMB)}; run_gemm(F, (const bf16_t*)(ws + WS_YB), (const bf16_t*)(ws + WS_WPB), DM, 512, EB);
    } SEAM(7);
    if (IN(8)) for (int rep = 0; rep < 1; ++rep) { pg8::EpiRes E{(const float*)(ws + WS_HF1), (const float*)(ws + WS_HF1) + (size_t)MP * DM, (float*)(ws + WS_Z), 1.0f}; run_gemm(F, (const bf16_t*)(ws + WS_MMB), (const bf16_t*)(ws + WS_WO), DM, DM, E); if (PROBE_DUP == 12) run_gemm(F, (const bf16_t*)(ws + WS_MMB), (const bf16_t*)(ws + WS_WO), DM, DM, E); } SEAM(8);
    if (IN(9)) for (int rep = 0; rep < REP(3); ++rep) { ln_pass(F, (const float*)(ws + WS_Z), a.ln2g, a.ln2b, (float*)(ws + WS_HF2), (bf16_t*)(ws + WS_HB)); } SEAM(9);
    if (IN(10)) for (int rep = 0; rep < 1; ++rep) { pg8::EpiSwiGLU E{(bf16_t*)(ws + WS_H)}; run_gemm(F, (const bf16_t*)(ws + WS_HB), (const bf16_t*)(ws + WS_W2U), NUP, DM, E); if (PROBE_DUP == 14) run_gemm(F, (const bf16_t*)(ws + WS_HB), (const bf16_t*)(ws + WS_W2U), NUP, DM, E); } SEAM(10);
    if (IN(11)) for (int rep = 0; rep < 1; ++rep) { pg8::EpiRes E{(const float*)(ws + WS_HF2), (const float*)(ws + WS_HF2) + (size_t)MP * DM, (float*)(ws + WS_Z), 0.5f}; run_gemm(F, (const bf16_t*)(ws + WS_H), (const bf16_t*)(ws + WS_W2D), DM, DFF, E); if (PROBE_DUP == 13) run_gemm(F, (const bf16_t*)(ws + WS_H), (const bf16_t*)(ws + WS_W2D), DM, DFF, E); } SEAM(11);
    if (IN(12)) for (int rep = 0; rep < REP(3); ++rep) { ln_pass(F, (const float*)(ws + WS_Z), a.ln3g, a.ln3b, a.out + O_Y, nullptr); }
    if (PROBE_TS >= 0 && F.bid == 0) {
        __syncthreads(); STAMP(13); __threadfence(); __syncthreads();
        const unsigned long long* ts = (const unsigned long long*)(ws + WS_CTL + 32768);
        const unsigned long long t0 = __hip_atomic_load(ts + PROBE_TS, __ATOMIC_RELAXED, __HIP_MEMORY_SCOPE_AGENT), t1 = __hip_atomic_load(ts + PROBE_TS + 1, __ATOMIC_RELAXED, __HIP_MEMORY_SCOPE_AGENT);
        const float us = (PROBE_TS >= 20) ? (float)t0 * 0.01f : (float)(t1 - t0) * 0.01f; const float eps = sqrtf(us * 1e-4f);
        for (int i = F.tid; i < 16384; i += NTHR) a.out[O_SLF + i] *= (1.0f + eps);
    }
#undef IN
#undef SEAM
}

extern "C" void kernel_launch(void* const* d_in, const int* in_sizes, int n_in, void* d_out, int out_size, void* d_ws, size_t ws_size, hipStream_t stream) {
    static int grid = 0;
    if (grid == 0) {
        if (n_in != 24 || ws_size < WS_END) { fprintf(stderr, "kernel_launch: expected 24 inputs and >= %zu bytes of workspace (got %d, %zu)\n", (size_t)WS_END, n_in, ws_size); grid = -1; return; }
        int dev = 0, cus = 0, per_cu = 0;
        hipGetDevice(&dev); hipDeviceGetAttribute(&cus, hipDeviceAttributeMultiprocessorCount, dev);
        if (hipFuncSetAttribute((const void*)mega_fwd, hipFuncAttributeMaxDynamicSharedMemorySize, LDS_BYTES) != hipSuccess) { fprintf(stderr, "kernel_launch: hipFuncSetAttribute failed\n"); grid = -1; return; }
        hipOccupancyMaxActiveBlocksPerMultiprocessor(&per_cu, (const void*)mega_fwd, NTHR, LDS_BYTES);
        (void)hipGetLastError();
        if (per_cu < 1) { fprintf(stderr, "kernel_launch: occupancy query says %d blocks per CU\n", per_cu); per_cu = 1; }
        grid = cus;
    }
    if (grid < 0) return;
    Args a{};
    const float** p = (const float**)&a;
    for (int i = 0; i < 24; ++i) p[i] = (const float*)d_in[i];
    a.out = (float*)d_out; a.ws = (unsigned char*)d_ws;
    for (int j = 0; j < 32; ++j) a.invf[j] = pow(10000.0, -(double)j / 32.0);
#if MK_PER_PHASE
    for (int ph = 0; ph < N_PHASES; ++ph) { a.ph_lo = ph; a.ph_hi = ph + 1; void* args[] = {&a};
        hipError_t e = hipLaunchCooperativeKernel((const void*)mega_fwd, dim3(grid), dim3(NTHR), args, LDS_BYTES, stream);
        if (e != hipSuccess) { fprintf(stderr, "launch of phase %d failed: %s\n", ph, hipGetErrorString(e)); break; } }
#else
    a.ph_lo = 0; a.ph_hi = N_PHASES; void* args[] = {&a};
    hipError_t e = hipLaunchCooperativeKernel((const void*)mega_fwd, dim3(grid), dim3(NTHR), args, LDS_BYTES, stream);
    if (e != hipSuccess) fprintf(stderr, "cooperative launch failed: %s (grid %d)\n", hipGetErrorString(e), grid);
#endif
}
```
